# Optimizing an MI355X kernel written in HIP

```python
import math
import jax, jax.numpy as jnp
from jax import lax
import numpy as np

D_MODEL = 2048
BATCH = 16
SEQ = 2048
DEPTH = 1

N_DIFF_HEADS = 8
DIFF_HEAD_DIM = 128
DIFF_QK_HALF = DIFF_HEAD_DIM // 2
N_DSA_HEADS = 8
DSA_HEAD_DIM = 128
N_IDX_HEADS = 16
IDX_HEAD_DIM = 64
DSA_TOPK_MAX = 256
PEER_HEADS = 8
PEER_NKEYS = 128
PEER_N_EXPERTS = PEER_NKEYS * PEER_NKEYS
PEER_QDIM = 256
PEER_HALF = PEER_QDIM // 2
PEER_TOPK = 16
Q_BLOCK = 128
TOKEN_CHUNK = 128
LN_EPS = 1e-5
RMS_EPS = 1e-5
ALPHA = (2 * DEPTH) ** 0.25
BETA = (8 * DEPTH) ** -0.25

DIFF_W = N_DIFF_HEADS * DIFF_HEAD_DIM
DSA_QW = N_DSA_HEADS * DSA_HEAD_DIM
IDX_QW = N_IDX_HEADS * IDX_HEAD_DIM
MIX_W = DIFF_W + DSA_QW
IN_SPLITS = (DIFF_W, DIFF_W, DIFF_W, DSA_QW, DSA_HEAD_DIM, DSA_HEAD_DIM, IDX_QW, IDX_HEAD_DIM, N_IDX_HEADS)
IN_IS_VALUE = (False, False, True, False, False, True, False, False, False)
IN_COLS = sum(IN_SPLITS)

kernel_name = "hymba_diffattn_dsa_peer_deepnorm"


def _alibi_slopes():
    n = N_DIFF_HEADS + N_DSA_HEADS
    s = 2.0 ** (-8.0 * np.arange(1, n + 1) / n)
    return (jnp.asarray(s[0::2], dtype=jnp.float32), jnp.asarray(s[1::2], dtype=jnp.float32))


def _layer_norm(x, g, b):
    xf = x.astype(jnp.float32)
    mu = jnp.mean(xf, axis=-1, keepdims=True)
    var = jnp.mean(jnp.square(xf - mu), axis=-1, keepdims=True)
    return ((xf - mu) * lax.rsqrt(var + LN_EPS) * g.astype(jnp.float32) + b.astype(jnp.float32)).astype(x.dtype)


def _split_columns(proj):
    offsets = [int(o) for o in np.cumsum(IN_SPLITS)[:-1]]
    return jnp.split(proj, offsets, axis=-1)


def _diff_attention(q, k, v, lam, lam_init, subln_g, slopes):
    B, S = q.shape[0], q.shape[1]
    scale = DIFF_QK_HALF ** -0.5
    kpos = jnp.arange(S)

    def block(i):
        qs = lax.dynamic_slice_in_dim(q, i * Q_BLOCK, Q_BLOCK, axis=1)
        qpos = i * Q_BLOCK + jnp.arange(Q_BLOCK)
        logits = jnp.einsum('bqhcd,bshcd->bchqs', qs, k).astype(jnp.float32) * scale
        dist = (qpos[:, None] - kpos[None, :]).astype(jnp.float32)
        logits = jnp.where(dist >= 0, logits - slopes[:, None, None] * dist, -jnp.inf)
        p = jax.nn.softmax(logits, axis=-1)
        w = p[:, 0] - lam * p[:, 1]
        return jnp.einsum('bhqs,bshd->bqhd', w.astype(v.dtype), v)

    out = lax.map(block, jnp.arange(S // Q_BLOCK))
    out = jnp.moveaxis(out, 0, 1).reshape(B, S, N_DIFF_HEADS, DIFF_HEAD_DIM)
    of = out.astype(jnp.float32)
    of = of * lax.rsqrt(jnp.mean(jnp.square(of), axis=-1, keepdims=True) + RMS_EPS)
    of = of * subln_g.astype(jnp.float32) * (1.0 - lam_init)
    return of.astype(v.dtype)


def _dsa_attention(q, k, v, iq, ik, iw, slopes):
    B, S = q.shape[0], q.shape[1]
    topk = min(DSA_TOPK_MAX, S // 4)
    scale = DSA_HEAD_DIM ** -0.5
    idx_scale = (IDX_HEAD_DIM ** -0.5) * (N_IDX_HEADS ** -0.5)
    kpos = jnp.arange(S)
    gather = jax.vmap(lambda t, idx: t[idx])

    def block(i):
        qs = lax.dynamic_slice_in_dim(q, i * Q_BLOCK, Q_BLOCK, axis=1)
        iqs = lax.dynamic_slice_in_dim(iq, i * Q_BLOCK, Q_BLOCK, axis=1)
        iws = lax.dynamic_slice_in_dim(iw, i * Q_BLOCK, Q_BLOCK, axis=1)
        qpos = i * Q_BLOCK + jnp.arange(Q_BLOCK)
        rel = jax.nn.relu(jnp.einsum('bqhd,bsd->bqhs', iqs, ik).astype(jnp.float32))
        iscore = jnp.einsum('bqh,bqhs->bqs', iws.astype(jnp.float32), rel) * idx_scale
        iscore = jnp.where(kpos[None, :] <= qpos[:, None], iscore, -jnp.inf)
        _, sel = lax.top_k(iscore, topk)
        ks = gather(k, sel)
        vs = gather(v, sel)
        logits = jnp.einsum('bqhd,bqkd->bhqk', qs, ks).astype(jnp.float32) * scale
        dist = (qpos[None, :, None] - sel).astype(jnp.float32)
        logits = jnp.where((dist >= 0)[:, None], logits - slopes[None, :, None, None] * dist[:, None], -jnp.inf)
        p = jax.nn.softmax(logits, axis=-1)
        return jnp.einsum('bhqk,bqkd->bqhd', p.astype(vs.dtype), vs)

    out = lax.map(block, jnp.arange(S // Q_BLOCK))
    return jnp.moveaxis(out, 0, 1).reshape(B, S, N_DSA_HEADS, DSA_HEAD_DIM)


def _peer(x, wq, sk1, sk2, u, v):
    B, S, D = x.shape
    xt = x.reshape((B * S) // TOKEN_CHUNK, TOKEN_CHUNK, D)

    def chunk(xc):
        qh = (xc @ wq).reshape(TOKEN_CHUNK, PEER_HEADS, 2, PEER_HALF)
        s1 = jnp.einsum('chd,nd->chn', qh[:, :, 0], sk1).astype(jnp.float32)
        s2 = jnp.einsum('chd,nd->chn', qh[:, :, 1], sk2).astype(jnp.float32)
        v1, i1 = lax.top_k(s1, PEER_TOPK)
        v2, i2 = lax.top_k(s2, PEER_TOPK)
        cand = (v1[..., :, None] + v2[..., None, :]).reshape(TOKEN_CHUNK, PEER_HEADS, PEER_TOPK * PEER_TOPK)
        cidx = (i1[..., :, None] * PEER_NKEYS + i2[..., None, :]).reshape(TOKEN_CHUNK, PEER_HEADS, PEER_TOPK * PEER_TOPK)
        top_s, pos = lax.top_k(cand, PEER_TOPK)
        eidx = jnp.take_along_axis(cidx, pos, axis=-1)
        g = jax.nn.softmax(top_s, axis=-1)
        ue = u[eidx]
        h = jnp.einsum('cd,chkd->chk', xc, ue).astype(jnp.float32)
        a = jax.nn.gelu(h, approximate=False) * g
        ve = v[eidx]
        return jnp.einsum('chk,chkd->cd', a.astype(ve.dtype), ve)

    return lax.map(chunk, xt).reshape(B, S, D)


def setup_inputs(seed: int = 0) -> dict:
    key = jax.random.key(seed)
    ks = jax.random.split(key, 20)
    f32 = jnp.float32
    col_scale = jnp.asarray(np.concatenate([np.full(n, BETA if isv else 1.0) for n, isv in zip(IN_SPLITS, IN_IS_VALUE)]).astype(np.float32))
    x = jax.random.normal(ks[0], (BATCH, SEQ, D_MODEL), f32)
    w_in = jax.random.normal(ks[1], (DEPTH, D_MODEL, IN_COLS), f32) * (D_MODEL ** -0.5) * col_scale
    w_o = jax.random.normal(ks[2], (DEPTH, MIX_W, D_MODEL), f32) * (MIX_W ** -0.5) * BETA
    lambda_q1 = jax.random.normal(ks[3], (DEPTH, DIFF_QK_HALF), f32) * 0.1
    lambda_k1 = jax.random.normal(ks[4], (DEPTH, DIFF_QK_HALF), f32) * 0.1
    lambda_q2 = jax.random.normal(ks[5], (DEPTH, DIFF_QK_HALF), f32) * 0.1
    lambda_k2 = jax.random.normal(ks[6], (DEPTH, DIFF_QK_HALF), f32) * 0.1
    subln_g = 1.0 + 0.02 * jax.random.normal(ks[7], (DEPTH, DIFF_HEAD_DIM), f32)
    ln1_g = 1.0 + 0.02 * jax.random.normal(ks[8], (DEPTH, D_MODEL), f32)
    ln1_b = 0.02 * jax.random.normal(ks[9], (DEPTH, D_MODEL), f32)
    peer_wq = jax.random.normal(ks[10], (DEPTH, D_MODEL, PEER_HEADS * PEER_QDIM), f32) * (D_MODEL ** -0.5)
    peer_k1 = jax.random.normal(ks[11], (DEPTH, PEER_NKEYS, PEER_HALF), f32) * (PEER_HALF ** -0.5)
    peer_k2 = jax.random.normal(ks[12], (DEPTH, PEER_NKEYS, PEER_HALF), f32) * (PEER_HALF ** -0.5)
    peer_u = jax.random.normal(ks[13], (DEPTH, PEER_N_EXPERTS, D_MODEL), f32) * (D_MODEL ** -0.5) * BETA
    peer_v = jax.random.normal(ks[14], (DEPTH, PEER_N_EXPERTS, D_MODEL), f32) * BETA
    ln2_g = 1.0 + 0.02 * jax.random.normal(ks[15], (DEPTH, D_MODEL), f32)
    ln2_b = 0.02 * jax.random.normal(ks[16], (DEPTH, D_MODEL), f32)
    return {"x": x, "w_in": w_in, "w_o": w_o, "lambda_q1": lambda_q1, "lambda_k1": lambda_k1,
            "lambda_q2": lambda_q2, "lambda_k2": lambda_k2, "subln_g": subln_g, "ln1_g": ln1_g,
            "ln1_b": ln1_b, "peer_wq": peer_wq, "peer_k1": peer_k1, "peer_k2": peer_k2,
            "peer_u": peer_u, "peer_v": peer_v, "ln2_g": ln2_g, "ln2_b": ln2_b}


def reference(x, w_in, w_o, lambda_q1, lambda_k1, lambda_q2, lambda_k2, subln_g, ln1_g, ln1_b,
              peer_wq, peer_k1, peer_k2, peer_u, peer_v, ln2_g, ln2_b):
    B, S, _ = x.shape
    slopes_diff, slopes_dsa = _alibi_slopes()
    for l in range(DEPTH):
        proj = x @ w_in[l]
        dq, dk, dv, sq, sk, sv, iq, ik, iw = _split_columns(proj)
        lam_init = 0.8 - 0.6 * math.exp(-0.3 * l)
        lam = (jnp.exp(jnp.sum(lambda_q1[l].astype(jnp.float32) * lambda_k1[l].astype(jnp.float32)))
               - jnp.exp(jnp.sum(lambda_q2[l].astype(jnp.float32) * lambda_k2[l].astype(jnp.float32)))
               + lam_init)
        diff_out = _diff_attention(
            dq.reshape(B, S, N_DIFF_HEADS, 2, DIFF_QK_HALF),
            dk.reshape(B, S, N_DIFF_HEADS, 2, DIFF_QK_HALF),
            dv.reshape(B, S, N_DIFF_HEADS, DIFF_HEAD_DIM),
            lam, lam_init, subln_g[l], slopes_diff)
        dsa_out = _dsa_attention(
            sq.reshape(B, S, N_DSA_HEADS, DSA_HEAD_DIM), sk, sv,
            iq.reshape(B, S, N_IDX_HEADS, IDX_HEAD_DIM), ik, iw, slopes_dsa)
        mixed = jnp.concatenate([diff_out.reshape(B, S, DIFF_W), dsa_out.reshape(B, S, DSA_QW)], axis=-1) @ w_o[l]
        x = _layer_norm(ALPHA * x + mixed, ln1_g[l], ln1_b[l])
        y = _peer(x, peer_wq[l], peer_k1[l], peer_k2[l], peer_u[l], peer_v[l])
        x = _layer_norm(ALPHA * x + y, ln2_g[l], ln2_b[l])
    return x
```

```cpp
#include <hip/hip_runtime.h>
#include <hip/hip_cooperative_groups.h>
#include <cstdio>
#include <cstdint>
namespace cg = cooperative_groups;

#ifndef MK_ONE_LAUNCH
#define MK_ONE_LAUNCH 0
#endif

constexpr int NB = 16, SEQ = 2048, DM = 2048, NTOK = NB * SEQ;
constexpr int NPROJ = 5456, LDP = 5632;
constexpr int C_DQ = 0, C_DK = 1024, C_DV = 2048, C_SQ = 3072, C_SK = 4096, C_SV = 4224, C_IQ = 4352, C_IK = 5376, C_IW = 5440;
constexpr int NEXP = 16384;
constexpr float LN_EPS = 1e-5f, RMS_EPS = 1e-5f;
constexpr float ALPHA = 1.189207115002721f;
constexpr float LAM_INIT = 0.2f;
constexpr float LOG2E = 1.4426950408889634f;

constexpr size_t MiB = (size_t)1 << 20;
constexpr size_t WS_XB = 0;
constexpr size_t WS_PROJ = 128 * MiB;
constexpr size_t WS_EIDX = 384 * MiB;
constexpr size_t WS_EG = 400 * MiB;
constexpr size_t WS_X1B = 480 * MiB;
constexpr size_t WS_UB = 608 * MiB;
constexpr size_t WS_VB = 672 * MiB;
constexpr size_t WS_WIN = 736 * MiB;
constexpr size_t WS_WO = 758 * MiB;
constexpr size_t WS_WQ = 766 * MiB;
constexpr size_t WS_END = 774 * MiB;

constexpr int LDS_BYTES = 147456;

typedef unsigned short bf16;
#define LAS __attribute__((address_space(3)))

namespace pg8 {
#define PG8_LAS __attribute__((address_space(3)))
typedef unsigned short bf16_t;
typedef short bf16x8 __attribute__((ext_vector_type(8)));
typedef float f32x4 __attribute__((ext_vector_type(4)));
typedef unsigned u32x4 __attribute__((ext_vector_type(4)));
constexpr int BM = 256, BK = 64, HALF = 128, HTB = HALF * BK * 2  , STAGE_BYTES = 8 * HTB, NXCD = 8, WGM = 8;

__host__ __device__ __forceinline__ int lds_byte(int r, int c) { const int st = (r >> 4) * 2 + (c >> 5), rr = r & 15, cc = c & 31, ob = rr * 64 + cc * 2; return st * 1024 + (ob ^ (((ob >> 9) & 1) << 5)); }
__host__ __device__ __forceinline__ void stage_rc(int b, int& R, int& C) { const int st = b / 1024, sb = b % 1024, swz = sb ^ (((sb >> 9) & 1) << 5); R = (st >> 1) * 16 + swz / 64; C = (st & 1) * 32 + (swz % 64) / 2; }
__host__ __device__ __forceinline__ int perm32(int rho) { const int n = rho >> 4, i = rho & 15; return 8 * (i >> 2) + 4 * n + (i & 3); }

struct Unit { int pm, pn; };
struct Gemm { const bf16_t* A; const bf16_t* Bt; int M, N, K; };

struct StaticOrder {
    int nM, nN, nwg, G, c;
    __host__ __device__ void init(int M, int N, int G_, int c_) { nM = M / BM; nN = N / BM; nwg = nM * nN; G = G_; c = c_; }
    __host__ __device__ bool next(int i, Unit& u) const {
        const long L = (long)i * G + c; if (L >= nwg) return false;
        int wgid = (int)L; { const int q = nwg / NXCD, r = nwg % NXCD, xcd = wgid % NXCD, off = wgid / NXCD; wgid = (xcd < r ? xcd * (q + 1) : r * (q + 1) + (xcd - r) * q) + off; }
        const int nig = WGM * nN, gid = wgid / nig, fm = gid * WGM, gsz = (nM - fm) < WGM ? (nM - fm) : WGM;
        u.pm = fm + ((wgid % nig) % gsz); u.pn = (wgid % nig) / gsz; return true;
    }
    __device__ __forceinline__ void a_ready(const Unit&) const {}
    __device__ __forceinline__ void done(const Unit&) const {}
};
__device__ __forceinline__ unsigned cvt_pk_bf16(float lo, float hi) { unsigned r; asm volatile("v_cvt_pk_bf16_f32 %0, %1, %2" : "=v"(r) : "v"(lo), "v"(hi)); return r; }
typedef float f32x2 __attribute__((ext_vector_type(2)));
__device__ __forceinline__ f32x2 gelu_pk(f32x2 v) {
    const f32x2 av = __builtin_elementwise_abs(v), d = av * 0.2316418882f + 1.0f;
    f32x2 t; t.x = __builtin_amdgcn_rcpf(d.x); t.y = __builtin_amdgcn_rcpf(d.y);
    f32x2 q = t * 0.5307027145f + (-0.7265760135f); q = q * t + 0.7107068705f; q = q * t + (-0.142248368f); q = q * t + 0.127414796f; q = q * t;
    const f32x2 s = (v * v) * (-0.72134752044f);
    f32x2 e; e.x = __builtin_amdgcn_exp2f(s.x); e.y = __builtin_amdgcn_exp2f(s.y);
    const f32x2 m = v * (q * e), r = v - m;
    f32x2 o; o.x = v.x < 0.f ? m.x : r.x; o.y = v.y < 0.f ? m.y : r.y; return o;
}

template <int ACT  > struct EpiBf16 {
    static constexpr bool PERM = true, AFTER_DRAIN = false; static_assert(ACT == 0 || ACT == 1, "EpiBf16: ACT is 0 (none) or 1 (gelu_pk)");
    bf16_t* O; int ldc; const float* bias; int split_cols; size_t split_stride; float scale0;
    __device__ __forceinline__ void operator()(const f32x4 (&acc)[2][2][4][2], const Unit& u, int wr, int wc, int fr, int fq) const {
        const int row0 = u.pm * BM + wr * 64 + fr; int colt = u.pn * BM; bf16_t* base = O;
        float sc = 1.f; if (split_cols) { const int t = colt / split_cols; base += (size_t)t * split_stride; colt -= t * split_cols; if (t == 0) sc = scale0; }
        const int col0 = colt + wc * 32 + 8 * fq, bcol0 = u.pn * BM + wc * 32 + 8 * fq;
        f32x4 bv[2][2];
#pragma unroll
        for (int bj = 0; bj < 2; ++bj)
#pragma unroll
            for (int n = 0; n < 2; ++n) bv[bj][n] = bias ? *(const f32x4*)(bias + bcol0 + bj * HALF + 4 * n) : (f32x4){0.f, 0.f, 0.f, 0.f};
#pragma unroll
        for (int ai = 0; ai < 2; ++ai)
#pragma unroll
            for (int m = 0; m < 4; ++m) { bf16_t* rowp = base + (size_t)(row0 + ai * HALF + m * 16) * ldc + col0;
#pragma unroll
                for (int bj = 0; bj < 2; ++bj) { f32x4 v0 = acc[ai][bj][m][0] + bv[bj][0], v1 = acc[ai][bj][m][1] + bv[bj][1];
                    if (ACT == 1) { f32x2 a = gelu_pk((f32x2){v0[0], v0[1]}), b = gelu_pk((f32x2){v0[2], v0[3]}), c = gelu_pk((f32x2){v1[0], v1[1]}), d = gelu_pk((f32x2){v1[2], v1[3]});
                        v0 = (f32x4){a.x, a.y, b.x, b.y}; v1 = (f32x4){c.x, c.y, d.x, d.y}; }
                    v0 = v0 * sc; v1 = v1 * sc; u32x4 w; w.x = cvt_pk_bf16(v0[0], v0[1]); w.y = cvt_pk_bf16(v0[2], v0[3]); w.z = cvt_pk_bf16(v1[0], v1[1]); w.w = cvt_pk_bf16(v1[2], v1[3]);
                    *(u32x4*)(rowp + bj * HALF) = w; } }
    }
};
struct EpiResid {
    static constexpr bool PERM = false, AFTER_DRAIN = false;
    const float* X; float* Z; int ldc; float alpha;
    __device__ __forceinline__ void operator()(const f32x4 (&acc)[2][2][4][2], const Unit& u, int wr, int wc, int fr, int fq) const {
        const int row0 = u.pm * BM + wr * 64 + fr, col0 = u.pn * BM + wc * 32 + 4 * fq;
#pragma unroll
        for (int ai = 0; ai < 2; ++ai)
#pragma unroll
            for (int m = 0; m < 4; ++m) { const size_t off = (size_t)(row0 + ai * HALF + m * 16) * ldc + col0;
#pragma unroll
                for (int bj = 0; bj < 2; ++bj)
#pragma unroll
                    for (int n = 0; n < 2; ++n) { const f32x4 xv = *(const f32x4*)(X + off + bj * HALF + n * 16);
                        *(f32x4*)(Z + off + bj * HALF + n * 16) = xv * alpha + acc[ai][bj][m][n]; }
                asm volatile("" ::: "memory"); }
    }
};

template <class Epi, class Sched, bool ALIGN_EPI = false, bool SP2 = false>
__device__ __forceinline__ void gemm_phase(PG8_LAS unsigned char* lds, const Gemm g, const Sched& S, const Epi& E) {
    const int tid = threadIdx.x, wid = __builtin_amdgcn_readfirstlane(tid >> 6), lane = tid & 63, wr = wid >> 2, wc = wid & 3, fr = lane & 15, fq = lane >> 4;
    const int K = g.K, nt = K / BK;
    unsigned voffA[2], voffB[2];
#pragma unroll
    for (int i = 0; i < 2; ++i) { int R, C; stage_rc(tid * 16 + i * 8192, R, C); const int Rb = Epi::PERM ? ((R & ~31) + perm32(R & 31)) : R;
        voffA[i] = (unsigned)(R * K + C) * 2u; voffB[i] = (unsigned)(Rb * K + C) * 2u; }
    const size_t kstep = (size_t)(BK * 2);
    const size_t hstep = (size_t)HALF * K * 2;
    const size_t tstep = 2 * hstep;
    const unsigned ldsw = (unsigned)wid * 1024u;
    const int aoff = lds_byte(wr * 64 + fr, fq * 8), boff = lds_byte(wc * 32 + fr, fq * 8);
#define PG8_SA(b, h) (((b) * 2 + (h)) * HTB)
#define PG8_SB(b, h) ((4 + (b) * 2 + (h)) * HTB)
#define PG8_STAGE(bufoff, gbase, voff) do { _Pragma("unroll") for (int _i = 0; _i < 2; ++_i) \
        __builtin_amdgcn_global_load_lds((const unsigned*)((const char*)(gbase) + (voff)[_i]), (PG8_LAS unsigned*)(lds + (bufoff) + ldsw + _i * 8192), 16, 0, 0); } while (0)
#define PG8_LDA(dst, b, h) do { _Pragma("unroll") for (int m = 0; m < 4; ++m) _Pragma("unroll") for (int k = 0; k < 2; ++k) dst[m][k] = *(const PG8_LAS bf16x8*)(lds + PG8_SA(b, h) + aoff + m * 2048 + k * 1024); } while (0)
#define PG8_LDB(dst, b, h) do { _Pragma("unroll") for (int n = 0; n < 2; ++n) _Pragma("unroll") for (int k = 0; k < 2; ++k) dst[n][k] = *(const PG8_LAS bf16x8*)(lds + PG8_SB(b, h) + boff + n * 2048 + k * 1024); } while (0)
#define PG8_MMA(ai, bj, At, Bt) do { __builtin_amdgcn_s_setprio(1); _Pragma("unroll") for (int m = 0; m < 4; ++m) _Pragma("unroll") for (int n = 0; n < 2; ++n) _Pragma("unroll") for (int k = 0; k < 2; ++k) \
        acc[ai][bj][m][n] = __builtin_amdgcn_mfma_f32_16x16x32_bf16(Bt[n][k], At[m][k], acc[ai][bj][m][n], 0, 0, 0); __builtin_amdgcn_s_setprio(0); } while (0)
#define PG8_WAIT_V(n) asm volatile("s_waitcnt vmcnt(" #n ")" ::: "memory")
#define PG8_WAIT_L(n) asm volatile("s_waitcnt lgkmcnt(" #n ")" ::: "memory")
#define PG8_BAR __builtin_amdgcn_s_barrier()
#define PG8_SCHED __builtin_amdgcn_sched_barrier(0)
    Unit cur, nxt; int ui = 0;
    if (!S.next(0, cur)) return;
    f32x4 acc[2][2][4][2];
#pragma unroll
    for (int a = 0; a < 2; ++a)
#pragma unroll
        for (int b = 0; b < 2; ++b)
#pragma unroll
            for (int m = 0; m < 4; ++m)
#pragma unroll
                for (int n = 0; n < 2; ++n) acc[a][b][m][n] = (f32x4){0.f, 0.f, 0.f, 0.f};
    bf16x8 At[4][2], B0[2][2], B1[2][2];
    const char* cA = (const char*)g.A + (size_t)cur.pm * tstep; const char* cB = (const char*)g.Bt + (size_t)cur.pn * tstep;
    S.a_ready(cur);
    if constexpr (SP2) {
        PG8_STAGE(PG8_SB(0, 0), cB, voffB); PG8_STAGE(PG8_SB(0, 1), cB + hstep, voffB); PG8_STAGE(PG8_SA(0, 0), cA, voffA); PG8_STAGE(PG8_SA(0, 1), cA + hstep, voffA);
        if (wr == 1) PG8_BAR;
        PG8_WAIT_V(2); PG8_BAR;
        PG8_STAGE(PG8_SB(1, 0), cB + kstep, voffB); PG8_STAGE(PG8_SA(1, 0), cA + kstep, voffA); PG8_STAGE(PG8_SB(1, 1), cB + hstep + kstep, voffB);
        PG8_WAIT_V(6); PG8_BAR;
    } else {
        PG8_STAGE(PG8_SB(0, 0), cB, voffB); PG8_STAGE(PG8_SA(0, 0), cA, voffA); PG8_STAGE(PG8_SB(0, 1), cB + hstep, voffB); PG8_STAGE(PG8_SA(0, 1), cA + hstep, voffA);
        if (wr == 1) PG8_BAR;
        PG8_WAIT_V(4); PG8_BAR;
        PG8_STAGE(PG8_SB(1, 0), cB + kstep, voffB); PG8_STAGE(PG8_SA(1, 0), cA + kstep, voffA); PG8_STAGE(PG8_SB(1, 1), cB + hstep + kstep, voffB);
        PG8_WAIT_V(6); PG8_BAR;
    }
    for (;;) {
        const bool has_next = S.next(ui + 1, nxt);
        const char* nA = has_next ? (const char*)g.A + (size_t)nxt.pm * tstep : cA; const char* nB = has_next ? (const char*)g.Bt + (size_t)nxt.pn * tstep : cB;
        for (int t = 0; t < nt; t += 2) {
            const bool last = (t == nt - 2);
            const char* a1 = cA + (size_t)(t + 1) * kstep;
            const char* a2 = last ? nA : cA + (size_t)(t + 2) * kstep; const char* b2 = last ? nB : cB + (size_t)(t + 2) * kstep;
            const char* a3 = a2 + kstep; const char* b3 = b2 + kstep;
            if (last && has_next) S.a_ready(nxt);
            if constexpr (SP2) {
            PG8_LDB(B0, 0, 0); PG8_LDB(B1, 0, 1); PG8_SCHED; PG8_LDA(At, 0, 0); PG8_STAGE(PG8_SA(1, 1), a1 + hstep, voffA);
            PG8_WAIT_V(8); PG8_WAIT_L(0); PG8_BAR; PG8_MMA(0, 0, At, B0); PG8_MMA(0, 1, At, B1); PG8_BAR; PG8_SCHED;
            PG8_LDA(At, 0, 1); PG8_STAGE(PG8_SB(0, 0), b2, voffB); PG8_STAGE(PG8_SB(0, 1), b2 + hstep, voffB); PG8_STAGE(PG8_SA(0, 0), a2, voffA);
            PG8_WAIT_V(8); PG8_WAIT_L(0); PG8_BAR; PG8_MMA(1, 0, At, B0); PG8_MMA(1, 1, At, B1); PG8_BAR; PG8_SCHED;
            PG8_LDB(B0, 1, 0); PG8_LDB(B1, 1, 1); PG8_SCHED; PG8_LDA(At, 1, 0); PG8_STAGE(PG8_SA(0, 1), a2 + hstep, voffA);
            PG8_WAIT_V(8); PG8_WAIT_L(0); PG8_BAR; PG8_MMA(0, 0, At, B0); PG8_MMA(0, 1, At, B1); PG8_BAR; PG8_SCHED;
            PG8_LDA(At, 1, 1); PG8_STAGE(PG8_SB(1, 0), b3, voffB); PG8_STAGE(PG8_SB(1, 1), b3 + hstep, voffB); PG8_STAGE(PG8_SA(1, 0), a3, voffA);
            PG8_WAIT_V(8); PG8_WAIT_L(0); PG8_BAR; PG8_MMA(1, 0, At, B0); PG8_MMA(1, 1, At, B1); PG8_BAR; PG8_SCHED;
            } else {
            PG8_LDB(B0, 0, 0); PG8_SCHED; PG8_LDA(At, 0, 0); PG8_STAGE(PG8_SA(1, 1), a1 + hstep, voffA);
            PG8_WAIT_L(8); PG8_BAR; PG8_WAIT_L(0); PG8_MMA(0, 0, At, B0); PG8_BAR; PG8_SCHED;
            PG8_LDB(B1, 0, 1); PG8_STAGE(PG8_SB(0, 0), b2, voffB);
            PG8_BAR; PG8_WAIT_L(0); PG8_MMA(0, 1, At, B1); PG8_BAR;
            PG8_LDA(At, 0, 1); PG8_STAGE(PG8_SA(0, 0), a2, voffA);
            PG8_BAR; PG8_WAIT_L(0); PG8_MMA(1, 0, At, B0); PG8_BAR; PG8_SCHED;
            PG8_STAGE(PG8_SB(0, 1), b2 + hstep, voffB);
            PG8_WAIT_V(6); PG8_BAR; PG8_MMA(1, 1, At, B1); PG8_BAR;
            PG8_LDB(B0, 1, 0); PG8_SCHED; PG8_LDA(At, 1, 0); PG8_STAGE(PG8_SA(0, 1), a2 + hstep, voffA);
            PG8_WAIT_L(8); PG8_BAR; PG8_WAIT_L(0); PG8_MMA(0, 0, At, B0); PG8_BAR; PG8_SCHED;
            PG8_LDB(B1, 1, 1); PG8_STAGE(PG8_SB(1, 0), b3, voffB);
            PG8_BAR; PG8_WAIT_L(0); PG8_MMA(0, 1, At, B1); PG8_BAR;
            PG8_LDA(At, 1, 1); PG8_STAGE(PG8_SA(1, 0), a3, voffA);
            PG8_BAR; PG8_WAIT_L(0); PG8_MMA(1, 0, At, B0); PG8_BAR; PG8_SCHED;
            PG8_STAGE(PG8_SB(1, 1), b3 + hstep, voffB);
            PG8_WAIT_V(6); PG8_BAR; PG8_MMA(1, 1, At, B1); PG8_BAR;
            }
        }
        if constexpr (ALIGN_EPI) { if (wr == 0) PG8_BAR; }
        if constexpr (!Epi::AFTER_DRAIN) { E(acc, cur, wr, wc, fr, fq); S.done(cur); }
        if (!has_next) break;
#pragma unroll
        for (int a = 0; a < 2; ++a)
#pragma unroll
            for (int b = 0; b < 2; ++b)
#pragma unroll
                for (int m = 0; m < 4; ++m)
#pragma unroll
                    for (int n = 0; n < 2; ++n) acc[a][b][m][n] = (f32x4){0.f, 0.f, 0.f, 0.f};
        cur = nxt; cA = nA; cB = nB; ++ui;
        if constexpr (ALIGN_EPI) { if (wr == 1) PG8_BAR; }
    }
    PG8_WAIT_V(0);
    if constexpr (!ALIGN_EPI) { if (wr == 0) PG8_BAR; }
    PG8_BAR;
    if constexpr (Epi::AFTER_DRAIN) { E.fused(acc, cur, wr, wc, fr, fq, lds, wid, lane); S.done(cur); }
#undef PG8_SA
#undef PG8_SB
#undef PG8_STAGE
#undef PG8_LDA
#undef PG8_LDB
#undef PG8_MMA
#undef PG8_WAIT_V
#undef PG8_WAIT_L
#undef PG8_BAR
#undef PG8_SCHED
}
}


namespace att {
using bf16x8 = __attribute__((ext_vector_type(8))) short;
using s16x4  = __attribute__((ext_vector_type(4))) short;
using f32x16 = __attribute__((ext_vector_type(16))) float;
using u32x4  = __attribute__((ext_vector_type(4))) unsigned;
using u32x2  = __attribute__((ext_vector_type(2))) unsigned;
constexpr int SHM_V = 16384, SHM_K = 16384;
constexpr int L_V = 0, L_K = 32768, L_WS = 69632, L_SEL = 131072, L_END = 139264;
#ifndef ATT_SDEPTH
#define ATT_SDEPTH 1
#endif
constexpr int SDEPTH = ATT_SDEPTH;
constexpr float THR2 = 11.0f;
#define KSWZ(row, colB) ((row) * 256 + ((colB) ^ (((row) & 7) << 4)))
#define SBAR() __builtin_amdgcn_sched_barrier(0)
__device__ __forceinline__ int crow(int r, int hi) { return (r & 3) + 8 * (r >> 2) + 4 * hi; }
__device__ __forceinline__ unsigned cvtpk(float lo, float hi) { unsigned r; asm volatile("v_cvt_pk_bf16_f32 %0, %1, %2" : "=v"(r) : "v"(lo), "v"(hi)); return r; }
__device__ __forceinline__ bf16x8 ld8(const bf16* p) { return *reinterpret_cast<const bf16x8*>(p); }
__device__ __forceinline__ float bf2f(bf16 v) { return __uint_as_float((unsigned)v << 16); }
__device__ __forceinline__ float ninf() { return __uint_as_float(0xff800000u); }

template <int ND0> __device__ __forceinline__ void qkt(f32x16& p0, f32x16& p1, const char* Ks, const bf16x8* qr, int r32, int hi, int d0base) {
  p0 = f32x16{}; p1 = f32x16{};
#pragma unroll
  for (int d0 = 0; d0 < ND0; ++d0) { const int cb = ((d0base + d0) * 16 + hi * 8) * 2;
    bf16x8 b0 = *reinterpret_cast<const bf16x8*>(Ks + KSWZ(r32, cb));
    bf16x8 b1 = *reinterpret_cast<const bf16x8*>(Ks + KSWZ(32 + r32, cb));
    p0 = __builtin_amdgcn_mfma_f32_32x32x16_bf16(b0, qr[d0], p0, 0, 0, 0);
    p1 = __builtin_amdgcn_mfma_f32_32x32x16_bf16(b1, qr[d0], p1, 0, 0, 0); }
}
__device__ __forceinline__ int v_st(int k, int c) { const int kk = (k & ~0xC) | ((k & 4) << 1) | ((k & 8) >> 1); return ((kk >> 3) * 4 + (c >> 5)) * 512 + ((kk & 7) * 32 + (c & 31)) * 2; }
__device__ __forceinline__ int v_rd_base(int lane) { return ((lane & 3) << 3) | (((lane >> 2) & 3) << 6) | (((lane >> 4) & 1) << 5) | (((lane >> 5) & 1) << 8); }
constexpr int v_rd_off(int d0, int ks, int half) { return d0 * 512 + ks * 4096 + half * 2048; }
template <int OFF> __device__ __forceinline__ s16x4 tr_read(int vb) {
  s16x4 r; asm volatile("ds_read_b64_tr_b16 %0, %1 offset:%2" : "=&v"(r) : "v"(vb), "i"(OFF) : "memory"); return r;
}
template <int D0> __device__ __forceinline__ void pv_one(f32x16& od, int vb, bf16x8 pa0, bf16x8 pa1, bf16x8 pa2, bf16x8 pa3) {
#define PK(L, H) (bf16x8){L[0], L[1], L[2], L[3], H[0], H[1], H[2], H[3]}
  { const s16x4 l0 = tr_read<v_rd_off(D0, 0, 0)>(vb), h0 = tr_read<v_rd_off(D0, 0, 1)>(vb), l1 = tr_read<v_rd_off(D0, 1, 0)>(vb), h1 = tr_read<v_rd_off(D0, 1, 1)>(vb);
    asm volatile("s_waitcnt lgkmcnt(0)" ::: "memory"); SBAR();
    od = __builtin_amdgcn_mfma_f32_32x32x16_bf16(pa0, PK(l0, h0), od, 0, 0, 0);
    od = __builtin_amdgcn_mfma_f32_32x32x16_bf16(pa1, PK(l1, h1), od, 0, 0, 0); }
  { const s16x4 l2 = tr_read<v_rd_off(D0, 2, 0)>(vb), h2 = tr_read<v_rd_off(D0, 2, 1)>(vb), l3 = tr_read<v_rd_off(D0, 3, 0)>(vb), h3 = tr_read<v_rd_off(D0, 3, 1)>(vb);
    asm volatile("s_waitcnt lgkmcnt(0)" ::: "memory"); SBAR();
    od = __builtin_amdgcn_mfma_f32_32x32x16_bf16(pa2, PK(l2, h2), od, 0, 0, 0);
    od = __builtin_amdgcn_mfma_f32_32x32x16_bf16(pa3, PK(l3, h3), od, 0, 0, 0); }
#undef PK
}
__device__ __forceinline__ void pv_d0(f32x16* o, int vb, bf16x8 pa0, bf16x8 pa1, bf16x8 pa2, bf16x8 pa3) {
  pv_one<0>(o[0], vb, pa0, pa1, pa2, pa3); pv_one<1>(o[1], vb, pa0, pa1, pa2, pa3); pv_one<2>(o[2], vb, pa0, pa1, pa2, pa3); pv_one<3>(o[3], vb, pa0, pa1, pa2, pa3);
}

template <int MODE> __device__ __forceinline__ void partialSM(f32x16& p0, f32x16& p1, float Cs, float slope2, float thr, int k0, int qpos, int hi,
                                                              const char* selrow, bool diag, float& m_reg, float& off, float& alpha) {
#pragma unroll
  for (int r = 0; r < 16; ++r) { const float cr = (float)((r & 3) + 8 * (r >> 2)); p0[r] = fmaf(p0[r], Cs, cr); p1[r] = fmaf(p1[r], Cs, cr); }
  if (MODE == 0) {
    if (diag) { const int dqh = qpos - k0 - 4 * hi;
#pragma unroll
      for (int r = 0; r < 16; ++r) { const int cr = (r & 3) + 8 * (r >> 2); if (cr > dqh) p0[r] = ninf(); if (cr + 32 > dqh) p1[r] = ninf(); } }
  } else {
    const u32x2 w = *reinterpret_cast<const u32x2*>(selrow + (k0 >> 5) * 4);
    const unsigned w0 = w.x >> (4 * hi), w1 = w.y >> (4 * hi);
#pragma unroll
    for (int r = 0; r < 16; ++r) { const int cr = (r & 3) + 8 * (r >> 2); if ((w0 >> cr) & 1u) p0[r] = ninf(); if ((w1 >> cr) & 1u) p1[r] = ninf(); }
  }
  float pm0 = p0[0], pm1 = p1[0];
#pragma unroll
  for (int r = 1; r < 16; ++r) { pm0 = fmaxf(pm0, p0[r]); pm1 = fmaxf(pm1, p1[r]); }
  const float tb = (float)(k0 + 4 * hi - qpos);
  float tmax = fmaxf(pm0, pm1 + 32.f) + tb;
  { auto rr = __builtin_amdgcn_permlane32_swap(__float_as_uint(tmax), __float_as_uint(tmax), false, false);
    tmax = fmaxf(__uint_as_float(rr[0]), __uint_as_float(rr[1])); }
  if (__builtin_expect(__all(tmax - m_reg <= thr), 1)) { alpha = 1.f; }
  else { const float mn = fmaxf(m_reg, tmax); alpha = __builtin_amdgcn_exp2f((m_reg - mn) * slope2); m_reg = mn; }
  off = (tb - m_reg) * slope2;
#pragma unroll
  for (int r = 0; r < 16; ++r) p0[r] = __builtin_amdgcn_exp2f(fmaf(p0[r], slope2, off));
}
__device__ __forceinline__ void finishSM(f32x16& p0, f32x16& p1, float slope2, float off1, float alpha, float& l_reg, bf16x8& pa0, bf16x8& pa1, bf16x8& pa2, bf16x8& pa3) {
#pragma unroll
  for (int r = 0; r < 16; ++r) p1[r] = __builtin_amdgcn_exp2f(fmaf(p1[r], slope2, off1));
  float ps = 0;
#pragma unroll
  for (int r = 0; r < 16; ++r) ps += p0[r];
#pragma unroll
  for (int r = 0; r < 16; ++r) ps += p1[r];
  { auto rr = __builtin_amdgcn_permlane32_swap(__float_as_uint(ps), __float_as_uint(ps), false, false);
    ps = __uint_as_float(rr[0]) + __uint_as_float(rr[1]); }
  l_reg = l_reg * alpha + ps;
#define PK4(P, BASE, OUT) do { unsigned a0 = cvtpk(P[BASE + 0], P[BASE + 1]), a1 = cvtpk(P[BASE + 2], P[BASE + 3]);   \
    unsigned b0 = cvtpk(P[BASE + 4], P[BASE + 5]), b1 = cvtpk(P[BASE + 6], P[BASE + 7]);                              \
    auto r0 = __builtin_amdgcn_permlane32_swap(a0, b0, false, false); auto r1 = __builtin_amdgcn_permlane32_swap(a1, b1, false, false); \
    u32x4 w = {r0[0], r1[0], r0[1], r1[1]}; OUT = *reinterpret_cast<bf16x8*>(&w); } while (0)
  PK4(p0, 0, pa0); PK4(p0, 8, pa1); PK4(p1, 0, pa2); PK4(p1, 8, pa3);
#undef PK4
}

__device__ __forceinline__ void cnt_ge(int& cnt, unsigned a, unsigned b) { asm volatile("v_cmp_ge_u32_e32 vcc, %1, %2\n\tv_addc_co_u32_e32 %0, vcc, 0, %0, vcc" : "+v"(cnt) : "v"(a), "v"(b) : "vcc"); }
__device__ __forceinline__ void cnt_gt(int& cnt, unsigned a, unsigned b) { asm volatile("v_cmp_gt_u32_e32 vcc, %1, %2\n\tv_addc_co_u32_e32 %0, vcc, 0, %0, vcc" : "+v"(cnt) : "v"(a), "v"(b) : "vcc"); }
__device__ __forceinline__ unsigned wlane(unsigned val, int ln, unsigned old) { asm volatile("v_writelane_b32 %0, %1, %2" : "+v"(old) : "s"(val), "s"(ln)); return old; }
__device__ __forceinline__ int half_sum(int x, int hi) {
  x += __builtin_amdgcn_update_dpp(0, x, 0x111, 0xf, 0xf, true);
  x += __builtin_amdgcn_update_dpp(0, x, 0x112, 0xf, 0xf, true);
  x += __builtin_amdgcn_update_dpp(0, x, 0x114, 0xf, 0xf, true);
  x += __builtin_amdgcn_update_dpp(0, x, 0x118, 0xf, 0xf, true);
  const int a = __builtin_amdgcn_readlane(x, 15) + __builtin_amdgcn_readlane(x, 31);
  const int b = __builtin_amdgcn_readlane(x, 47) + __builtin_amdgcn_readlane(x, 63);
  return hi ? b : a;
}
__device__ __forceinline__ unsigned take_low(unsigned m, int k) {
  while (__builtin_popcount(m) > k) m &= ~(0x80000000u >> __builtin_clz(m));
  return m;
}

__device__ __forceinline__ void dsa_select(const bf16* __restrict__ PROJ, int b, int q0, unsigned* SEL, char* lds) {
  int tid = threadIdx.x; asm volatile("" : "+v"(tid));
  const int wid = __builtin_amdgcn_readfirstlane(tid >> 6), lane = tid & 63, r32 = lane & 31, hi = lane >> 5;
  const size_t tokb = (size_t)b * SEQ;
  const int nt32 = (q0 >> 5) + 1;
  for (int rd = 0; rd < 2; ++rd) {
    const int tl = rd * 16 + wid * 2, tA = q0 + tl;
    const bf16* ap = PROJ + (tokb + tA + (r32 >> 4)) * LDP + C_IQ + (r32 & 15) * 64 + hi * 8;
    bf16x8 af[4];
#pragma unroll
    for (int ks = 0; ks < 4; ++ks) af[ks] = ld8(ap + ks * 16);
    float w[16];
#pragma unroll
    for (int r = 0; r < 16; ++r) { const int head = (r & 3) + 8 * ((r >> 2) & 1) + 4 * hi; w[r] = bf2f(PROJ[(tokb + tA + (r >> 3)) * LDP + C_IW + head]); }
    unsigned* kst = (unsigned*)(lds + wid * 16384);
    const bf16* bp = PROJ + (tokb + r32) * LDP + C_IK + hi * 8;
    bf16x8 nx[4];
#pragma unroll
    for (int ks = 0; ks < 4; ++ks) nx[ks] = ld8(bp + ks * 16);
    const int myq = tA + hi;
    for (int j = 0; j < nt32; ++j) {
      bf16x8 cu[4];
#pragma unroll
      for (int ks = 0; ks < 4; ++ks) cu[ks] = nx[ks];
      if (j + 1 < nt32) { bp += (size_t)32 * LDP;
#pragma unroll
        for (int ks = 0; ks < 4; ++ks) nx[ks] = ld8(bp + ks * 16); }
      f32x16 c = f32x16{};
#pragma unroll
      for (int ks = 0; ks < 4; ++ks) c = __builtin_amdgcn_mfma_f32_32x32x16_bf16(af[ks], cu[ks], c, 0, 0, 0);
      float s0 = 0.f, s1 = 0.f;
#pragma unroll
      for (int r = 0; r < 8; ++r) { s0 = fmaf(w[r], fmaxf(c[r], 0.f), s0); s1 = fmaf(w[8 + r], fmaxf(c[8 + r], 0.f), s1); }
      auto rr = __builtin_amdgcn_permlane32_swap(__float_as_uint(s0), __float_as_uint(s1), false, false);
      const float tot = __uint_as_float(rr[0]) + __uint_as_float(rr[1]);
      const unsigned bits = __float_as_uint(tot);
      const unsigned srt = bits ^ ((unsigned)((int)bits >> 31) | 0x80000000u);
      kst[j * 64 + lane] = (j * 32 + r32 <= myq) ? srt : 0u;
    }
    for (int j = nt32; j < 64; ++j) kst[j * 64 + lane] = 0u;
    unsigned key[64];
#pragma unroll
    for (int j = 0; j < 64; ++j) key[j] = kst[j * 64 + lane];
    unsigned T = 0u;
    if (tA + 2 > 256) {
      for (int bit = 31; bit >= 0; --bit) {
        const unsigned cand = T | (1u << bit);
        int cnt = 0;
#pragma unroll
        for (int cc = 0; cc < 8; ++cc) { if (cc * 8 < nt32) {
#pragma unroll
          for (int e = 0; e < 8; ++e) cnt_ge(cnt, key[cc * 8 + e], cand); } }
        const int tot = half_sum(cnt, hi);
        if (tot >= 256) T = cand;
      }
    }
    const unsigned Tm = T > 1u ? T : 1u;
    int cge = 0;
#pragma unroll
    for (int cc = 0; cc < 8; ++cc) { if (cc * 8 < nt32) {
#pragma unroll
      for (int e = 0; e < 8; ++e) cnt_ge(cge, key[cc * 8 + e], Tm); } }
    cge = half_sum(cge, hi);
    int ln = lane; asm volatile("" : "+v"(ln));
    unsigned m0 = 0xffffffffu, m1 = 0xffffffffu;
    if (__all(cge <= 256)) {
#pragma unroll
      for (int j = 0; j < 64; ++j) {
        const unsigned long long bal = __ballot(!(key[j] >= Tm));
        m0 = (ln == j) ? (unsigned)bal : m0; m1 = (ln == j) ? (unsigned)(bal >> 32) : m1; }
    } else {
      int cgt = 0;
#pragma unroll
      for (int cc = 0; cc < 8; ++cc) { if (cc * 8 < nt32) {
#pragma unroll
        for (int e = 0; e < 8; ++e) cnt_gt(cgt, key[cc * 8 + e], Tm); } }
      cgt = half_sum(cgt, hi);
      int need_lo = 256 - __builtin_amdgcn_readlane(cgt, 0), need_hi = 256 - __builtin_amdgcn_readlane(cgt, 32);
#pragma unroll 1
      for (int j = 0; j < 64; ++j) {
        const unsigned kj = kst[j * 64 + lane];
        const unsigned long long eqm = __ballot(kj == Tm), gtm = __ballot(kj > Tm);
        const unsigned tl_ = take_low((unsigned)eqm, need_lo > 0 ? need_lo : 0), th_ = take_low((unsigned)(eqm >> 32), need_hi > 0 ? need_hi : 0);
        need_lo -= __builtin_popcount(tl_); need_hi -= __builtin_popcount(th_);
        const unsigned sl = (unsigned)gtm | tl_, sh = (unsigned)(gtm >> 32) | th_;
        m0 = (ln == j) ? ~sl : m0; m1 = (ln == j) ? ~sh : m1; }
    }
    SEL[tl * 64 + lane] = m0; SEL[(tl + 1) * 64 + lane] = m1;
  }
}

template <int MODE>
__device__ __forceinline__ void attn_unit(const bf16* __restrict__ PROJ, bf16* __restrict__ ATT, int b, int h, int qb, char* lds, float lam, const float* __restrict__ subln_g) {
  int tid = threadIdx.x; asm volatile("" : "+v"(tid));
  const int wid = __builtin_amdgcn_readfirstlane(tid >> 6), lane = tid & 63, r32 = lane & 31, hi = lane >> 5;
  constexpr int ND0 = MODE == 0 ? 4 : 8;
  const int q0 = MODE == 0 ? qb * 128 : qb * 32;
  const int wq = MODE == 0 ? (wid & 3) * 32 : 0;
  const int c = MODE == 0 ? (wid >> 2) : 0;
  const int qpos = q0 + wq + r32;
  const size_t tokb = (size_t)b * SEQ;
  const bf16* Qw = PROJ + (tokb + qpos) * LDP + (MODE == 0 ? C_DQ + h * 128 + c * 64 : C_SQ + wid * 128) + hi * 8;
  const bf16* Kh = PROJ + tokb * LDP + (MODE == 0 ? C_DK + h * 128 : C_SK);
  const bf16* Vh = PROJ + tokb * LDP + (MODE == 0 ? C_DV + h * 128 : C_SV);
  const int NT = MODE == 0 ? 2 * (qb + 1) : 2 * ((q0 + 32 + 127) >> 7);
  const float slope2 = (MODE == 0 ? exp2f(-0.5f * (float)(2 * h + 1)) : exp2f(-(float)(wid + 1))) * LOG2E;
  const float Cs = (MODE == 0 ? 0.125f : 0.08838834764831845f) * LOG2E / slope2;
  const float thr = THR2 / slope2, c32 = 32.f * slope2;
  char* V_lds = lds + L_V; char* K_lds = lds + L_K;
  float* ws = (float*)(lds + L_WS) + wid * 64; float* li_l = ws; float* al_l = ws + 32;
  unsigned* SEL = (unsigned*)(lds + L_SEL);
  const char* selrow = (const char*)(SEL + r32 * 64);
  if (MODE == 1) { dsa_select(PROJ, b, q0, SEL, lds); __syncthreads(); }

  float m_reg = -1e30f, l_reg = 0; f32x16 o[4] = {}; bf16x8 qr[ND0];
#pragma unroll
  for (int d0 = 0; d0 < ND0; ++d0) qr[d0] = ld8(Qw + d0 * 16);
  const int sr = tid >> 4, sc = (tid & 15) * 8, vst0 = v_st(sr, sc), vst1 = v_st(32 + sr, sc);
  const int vb0 = (int)(uintptr_t)V_lds + v_rd_base(lane);
  struct { bf16x8 vs0, vs1, ks0, ks1; } sr_[SDEPTH];
#define SLOAD(i, k0) do { sr_[i].vs0 = ld8(&Vh[(size_t)((k0) + sr) * LDP + sc]); sr_[i].vs1 = ld8(&Vh[(size_t)((k0) + 32 + sr) * LDP + sc]); \
    sr_[i].ks0 = ld8(&Kh[(size_t)((k0) + sr) * LDP + sc]); sr_[i].ks1 = ld8(&Kh[(size_t)((k0) + 32 + sr) * LDP + sc]); } while (0)
#define SWRITE(bb, i) do { *(bf16x8*)(V_lds + (bb) * SHM_V + vst0) = sr_[i].vs0;          \
    *(bf16x8*)(V_lds + (bb) * SHM_V + vst1) = sr_[i].vs1; const int kc = sc * 2;               \
    *(bf16x8*)(K_lds + (bb) * SHM_K + KSWZ(sr, kc)) = sr_[i].ks0;                       \
    *(bf16x8*)(K_lds + (bb) * SHM_K + KSWZ(32 + sr, kc)) = sr_[i].ks1; } while (0)
#define SWAIT() do { if constexpr (SDEPTH == 2) asm volatile("s_waitcnt vmcnt(4)" ::: "memory"); else asm volatile("s_waitcnt vmcnt(0)" ::: "memory"); } while (0)
#define RESC(a) do { if (__any((a) < 1.f)) { if (hi == 0) al_l[r32] = (a); asm volatile("s_waitcnt lgkmcnt(0)" ::: "memory"); \
    _Pragma("unroll") for (int d = 0; d < 4; ++d) _Pragma("unroll") for (int r = 0; r < 16; ++r) o[d][r] *= al_l[crow(r, hi)]; } } while (0)
#define DIAG(k0) ((k0) + 63 > q0 + wq)
  f32x16 pA0, pA1, pB0, pB1; float ofA, ofB, alA, alB; bf16x8 pa0, pa1, pa2, pa3;
  constexpr int SE = 0, SO = SDEPTH - 1;
  SLOAD(SE, 0); asm volatile("s_waitcnt vmcnt(0)" ::: "memory"); SWRITE(0, SE); __syncthreads();
  qkt<ND0>(pA0, pA1, K_lds, qr, r32, hi, c * 4); partialSM<MODE>(pA0, pA1, Cs, slope2, thr, 0, qpos, hi, selrow, DIAG(0), m_reg, ofA, alA);
  SLOAD(SO, 64); if constexpr (SDEPTH == 2) { if (2 < NT) SLOAD(SE, 128); }
  SWAIT(); SWRITE(1, SO); __syncthreads();
  for (int j = 1; j + 1 < NT; j += 2) {
    SBAR(); qkt<ND0>(pB0, pB1, K_lds + SHM_K, qr, r32, hi, c * 4);
    finishSM(pA0, pA1, slope2, ofA + c32, alA, l_reg, pa0, pa1, pa2, pa3); SBAR();
    SLOAD(SO, (j + SDEPTH) * 64); SBAR();
    pv_d0(o, vb0, pa0, pa1, pa2, pa3); partialSM<MODE>(pB0, pB1, Cs, slope2, thr, j * 64, qpos, hi, selrow, DIAG(j * 64), m_reg, ofB, alB);
    __syncthreads(); SWAIT(); SWRITE(0, SE);
    RESC(alB); __syncthreads();
    SBAR(); qkt<ND0>(pA0, pA1, K_lds, qr, r32, hi, c * 4);
    finishSM(pB0, pB1, slope2, ofB + c32, alB, l_reg, pa0, pa1, pa2, pa3); SBAR();
    if (SDEPTH == 1 || j + 3 < NT) SLOAD(SE, (j + 1 + SDEPTH) * 64); SBAR();
    pv_d0(o, vb0 + SHM_V, pa0, pa1, pa2, pa3); partialSM<MODE>(pA0, pA1, Cs, slope2, thr, (j + 1) * 64, qpos, hi, selrow, DIAG((j + 1) * 64), m_reg, ofA, alA);
    __syncthreads(); SWAIT(); SWRITE(1, SO);
    RESC(alA); __syncthreads();
  }
  SBAR(); qkt<ND0>(pB0, pB1, K_lds + SHM_K, qr, r32, hi, c * 4);
  finishSM(pA0, pA1, slope2, ofA + c32, alA, l_reg, pa0, pa1, pa2, pa3); SBAR();
  pv_d0(o, vb0, pa0, pa1, pa2, pa3); partialSM<MODE>(pB0, pB1, Cs, slope2, thr, (NT - 1) * 64, qpos, hi, selrow, DIAG((NT - 1) * 64), m_reg, ofB, alB);
  __syncthreads(); RESC(alB);
  finishSM(pB0, pB1, slope2, ofB + c32, alB, l_reg, pa0, pa1, pa2, pa3); SBAR();
  pv_d0(o, vb0 + SHM_V, pa0, pa1, pa2, pa3);
#undef SLOAD
#undef SWRITE
#undef SWAIT
#undef RESC
#undef DIAG
  if (hi == 0) li_l[r32] = l_reg; asm volatile("s_waitcnt lgkmcnt(0)" ::: "memory");
  {
    float rli[16];
#pragma unroll
    for (int r = 0; r < 16; ++r) rli[r] = __builtin_amdgcn_rcpf(li_l[crow(r, hi)]);
#pragma unroll
    for (int d0 = 0; d0 < 4; ++d0)
#pragma unroll
      for (int r = 0; r < 16; ++r) o[d0][r] *= rli[r];
  }
  __syncthreads();
  if (MODE == 0) {
    float* X = (float*)lds;
    if (wid >= 4) {
#pragma unroll
      for (int d0 = 0; d0 < 4; ++d0)
#pragma unroll
        for (int r = 0; r < 16; ++r) X[(wid - 4) * 4096 + crow(r, hi) * 128 + d0 * 32 + r32] = o[d0][r];
    }
    __syncthreads();
    if (wid < 4) {
#pragma unroll
      for (int d0 = 0; d0 < 4; ++d0)
#pragma unroll
        for (int r = 0; r < 16; ++r) o[d0][r] -= lam * X[wid * 4096 + crow(r, hi) * 128 + d0 * 32 + r32];
    }
    __syncthreads();
  }
  if (MODE == 1 || wid < 4) {
    bf16* stg = (bf16*)(lds + wid * 8704);
#pragma unroll
    for (int d0 = 0; d0 < 4; ++d0)
#pragma unroll
      for (int r = 0; r < 16; r += 2) {
        const unsigned pk = cvtpk(o[d0][r], o[d0][r + 1]);
        stg[crow(r, hi) * 136 + d0 * 32 + r32] = (bf16)(pk & 0xffffu);
        stg[crow(r + 1, hi) * 136 + d0 * 32 + r32] = (bf16)(pk >> 16);
      }
    asm volatile("s_waitcnt lgkmcnt(0)" ::: "memory");
    bf16x8 v[8];
#pragma unroll
    for (int j = 0; j < 8; ++j) v[j] = *reinterpret_cast<const bf16x8*>(stg + r32 * 136 + hi * 64 + j * 8);
    bf16* orow = ATT + (tokb + q0 + wq + r32) * DM + (MODE == 0 ? h * 128 : 1024 + wid * 128) + hi * 64;
    if (MODE == 0) {
      float ss = 0.f;
#pragma unroll
      for (int j = 0; j < 8; ++j)
#pragma unroll
        for (int e = 0; e < 8; ++e) { const float x = bf2f((bf16)v[j][e]); ss = fmaf(x, x, ss); }
      { auto rr = __builtin_amdgcn_permlane32_swap(__float_as_uint(ss), __float_as_uint(ss), false, false);
        ss = __uint_as_float(rr[0]) + __uint_as_float(rr[1]); }
      const float rs = __builtin_amdgcn_rsqf(ss * (1.0f / 128.0f) + RMS_EPS) * (1.0f - LAM_INIT);
#pragma unroll
      for (int j = 0; j < 8; ++j) { float y[8];
#pragma unroll
        for (int e = 0; e < 8; ++e) y[e] = bf2f((bf16)v[j][e]) * rs * subln_g[hi * 64 + j * 8 + e];
        u32x4 w = {cvtpk(y[0], y[1]), cvtpk(y[2], y[3]), cvtpk(y[4], y[5]), cvtpk(y[6], y[7])};
        *reinterpret_cast<u32x4*>(orow + j * 8) = w; }
    } else {
#pragma unroll
      for (int j = 0; j < 8; ++j) *reinterpret_cast<bf16x8*>(orow + j * 8) = v[j];
    }
  }
  __syncthreads();
}
}

typedef float f32x4 __attribute__((ext_vector_type(4)));
typedef unsigned u32x4 __attribute__((ext_vector_type(4)));
typedef unsigned u32x2 __attribute__((ext_vector_type(2)));
__device__ __forceinline__ unsigned cvt_pk(float lo, float hi) { unsigned r; asm volatile("v_cvt_pk_bf16_f32 %0, %1, %2" : "=v"(r) : "v"(lo), "v"(hi)); return r; }
__device__ __forceinline__ float bf_lo(unsigned w) { return __uint_as_float(w << 16); }
__device__ __forceinline__ float bf_hi(unsigned w) { return __uint_as_float(w & 0xffff0000u); }
__device__ __forceinline__ float wave_sum(float v) {
#pragma unroll
  for (int o = 1; o < 64; o <<= 1) v += __shfl_xor(v, o);
  return v;
}

__device__ __forceinline__ void cvt_stream(const float* __restrict__ src, bf16* __restrict__ dst, size_t n8, size_t gtid, size_t gsz) {
  for (size_t i = gtid; i < n8; i += gsz) {
    const f32x4 a = *reinterpret_cast<const f32x4*>(src + i * 8), b = *reinterpret_cast<const f32x4*>(src + i * 8 + 4);
    u32x4 w = {cvt_pk(a[0], a[1]), cvt_pk(a[2], a[3]), cvt_pk(b[0], b[1]), cvt_pk(b[2], b[3])};
    *reinterpret_cast<u32x4*>(dst + i * 8) = w;
  }
}
__device__ __forceinline__ void transpose_item(const float* __restrict__ W, int K, int N, bf16* __restrict__ WT, LAS float* scr, int kb, int nb, int lane) {
  const int k0 = 64 * kb, n0 = 32 * nb; const int nn = n0 + (lane & 31); const bool ok = nn < N;
#pragma unroll 8
  for (int i = 0; i < 32; ++i) { const int kk = 2 * i + (lane >> 5); scr[kk * 33 + (lane & 31)] = ok ? W[(size_t)(k0 + kk) * N + nn] : 0.f; }
  asm volatile("s_waitcnt lgkmcnt(0)" ::: "memory");
  const int c = lane & 7;
#pragma unroll
  for (int j = 0; j < 4; ++j) { const int n = (lane >> 3) + 8 * j; const LAS float* s = scr + (8 * c) * 33 + n;
    u32x4 o; o.x = cvt_pk(s[0 * 33], s[1 * 33]); o.y = cvt_pk(s[2 * 33], s[3 * 33]); o.z = cvt_pk(s[4 * 33], s[5 * 33]); o.w = cvt_pk(s[6 * 33], s[7 * 33]);
    *reinterpret_cast<u32x4*>(WT + (size_t)(n0 + n) * K + k0 + 8 * c) = o; }
  asm volatile("s_waitcnt lgkmcnt(0)" ::: "memory");
}

__device__ __forceinline__ void ln_row(const float* __restrict__ zrow, const float* __restrict__ g, const float* __restrict__ bta, float* __restrict__ orow, bf16* __restrict__ obrow, int lane) {
  f32x4 v[8]; float s = 0.f;
#pragma unroll
  for (int j = 0; j < 4; ++j) { v[2 * j] = *reinterpret_cast<const f32x4*>(zrow + 512 * j + 8 * lane); v[2 * j + 1] = *reinterpret_cast<const f32x4*>(zrow + 512 * j + 8 * lane + 4); }
#pragma unroll
  for (int j = 0; j < 8; ++j) s += (v[j][0] + v[j][1]) + (v[j][2] + v[j][3]);
  const float mean = wave_sum(s) * (1.f / DM); float s2 = 0.f;
#pragma unroll
  for (int j = 0; j < 8; ++j) { v[j] = v[j] - mean; s2 += (v[j][0] * v[j][0] + v[j][1] * v[j][1]) + (v[j][2] * v[j][2] + v[j][3] * v[j][3]); }
  const float rstd = 1.0f / sqrtf(wave_sum(s2) * (1.f / DM) + LN_EPS);
#pragma unroll
  for (int j = 0; j < 4; ++j) {
    const int e0 = 512 * j + 8 * lane;
    const f32x4 g0 = *reinterpret_cast<const f32x4*>(g + e0), g1 = *reinterpret_cast<const f32x4*>(g + e0 + 4);
    const f32x4 b0 = *reinterpret_cast<const f32x4*>(bta + e0), b1 = *reinterpret_cast<const f32x4*>(bta + e0 + 4);
    const f32x4 y0 = v[2 * j] * rstd * g0 + b0, y1 = v[2 * j + 1] * rstd * g1 + b1;
    *reinterpret_cast<f32x4*>(orow + e0) = y0; *reinterpret_cast<f32x4*>(orow + e0 + 4) = y1;
    if (obrow) { u32x4 w = {cvt_pk(y0[0], y0[1]), cvt_pk(y0[2], y0[3]), cvt_pk(y1[0], y1[1]), cvt_pk(y1[2], y1[3])}; *reinterpret_cast<u32x4*>(obrow + e0) = w; }
  }
}

namespace peer {
using bf16x8 = att::bf16x8; using f32x16 = att::f32x16;
constexpr int L_K1 = 0, L_K2 = 32768, L_SCR = 65536;
__device__ __forceinline__ unsigned srt(float x) { const unsigned b = __float_as_uint(x); return b ^ ((unsigned)((int)b >> 31) | 0x80000000u); }
__device__ __forceinline__ float unsrt(unsigned u) { const unsigned b = (u & 0x80000000u) ? (u ^ 0x80000000u) : ~u; return __uint_as_float(b); }
__device__ __forceinline__ unsigned umax(unsigned a, unsigned b) { return a > b ? a : b; }
__device__ __forceinline__ unsigned pair_max(unsigned m) {
  auto rr = __builtin_amdgcn_permlane32_swap(m, m, false, false); return umax(rr[0], rr[1]);
}
__device__ __forceinline__ void load_keys(const float* __restrict__ k1, const float* __restrict__ k2, char* lds) {
  for (int i = threadIdx.x; i < 2 * 128 * 16; i += 512) {
    const int t = i >> 11, row = (i >> 4) & 127, ch = i & 15; const float* src = (t ? k2 : k1) + row * 128 + ch * 8;
    const f32x4 a = *reinterpret_cast<const f32x4*>(src), b = *reinterpret_cast<const f32x4*>(src + 4);
    u32x4 w = {cvt_pk(a[0], a[1]), cvt_pk(a[2], a[3]), cvt_pk(b[0], b[1]), cvt_pk(b[2], b[3])};
    *reinterpret_cast<u32x4*>(lds + (t ? L_K2 : L_K1) + KSWZ(row, ch * 16)) = w;
  }
}
__device__ __forceinline__ void top16_of_128(const bf16x8* qf, const char* Kt, int r32, int hi, unsigned (&win)[16]) {
  unsigned pk[64];
#pragma unroll
  for (int t = 0; t < 4; ++t) {
    f32x16 c = f32x16{};
#pragma unroll
    for (int ks = 0; ks < 8; ++ks) { const bf16x8 a = *reinterpret_cast<const bf16x8*>(Kt + KSWZ(32 * t + r32, (ks * 16 + hi * 8) * 2));
      c = __builtin_amdgcn_mfma_f32_32x32x16_bf16(a, qf[ks], c, 0, 0, 0); }
#pragma unroll
    for (int r = 0; r < 16; ++r) { const int n = 32 * t + att::crow(r, hi); pk[t * 16 + r] = (srt(c[r]) & 0xffffff80u) | (unsigned)(127 - n); }
  }
#pragma unroll
  for (int k = 0; k < 16; ++k) {
    unsigned m = pk[0];
#pragma unroll
    for (int i = 1; i < 64; ++i) m = umax(m, pk[i]);
    m = pair_max(m); win[k] = m;
#pragma unroll
    for (int i = 0; i < 64; ++i) pk[i] = (pk[i] == m) ? 0u : pk[i];
  }
}
__device__ __forceinline__ void score_unit(const bf16* __restrict__ PQ, int* __restrict__ EIDX, float* __restrict__ EG, int t0, char* lds) {
  const int tid = threadIdx.x, wid = tid >> 6, lane = tid & 63, r32 = lane & 31, hi = lane >> 5;
  const bf16* qp = PQ + (size_t)(t0 + r32) * DM + wid * 256 + hi * 8;
  unsigned w1[16], w2[16];
  { bf16x8 qf[8];
#pragma unroll
    for (int ks = 0; ks < 8; ++ks) qf[ks] = att::ld8(qp + ks * 16);
    top16_of_128(qf, lds + L_K1, r32, hi, w1); }
  { bf16x8 qf[8];
#pragma unroll
    for (int ks = 0; ks < 8; ++ks) qf[ks] = att::ld8(qp + 128 + ks * 16);
    top16_of_128(qf, lds + L_K2, r32, hi, w2); }
  unsigned char* scr = (unsigned char*)(lds + L_SCR + wid * 1024) + r32 * 32;
  if (hi == 0) {
#pragma unroll
    for (int k = 0; k < 16; ++k) { scr[k] = (unsigned char)(127u - (w1[k] & 127u)); scr[16 + k] = (unsigned char)(127u - (w2[k] & 127u)); }
  }
  float v1[16], v2[16];
#pragma unroll
  for (int k = 0; k < 16; ++k) { v1[k] = unsrt(w1[k] & 0xffffff80u); v2[k] = unsrt(w2[k] & 0xffffff80u); }
  unsigned cd[25]; const unsigned hm0 = 0u - (unsigned)hi;
  { const unsigned e_ = (srt(v1[0] + v2[0]) & 0xffffff00u) | 255u, o_ = (srt(v1[0] + v2[1]) & 0xffffff00u) | 254u; cd[0] = (e_ & ~hm0) | (o_ & hm0); }
  { const unsigned e_ = (srt(v1[0] + v2[2]) & 0xffffff00u) | 253u, o_ = (srt(v1[0] + v2[3]) & 0xffffff00u) | 252u; cd[1] = (e_ & ~hm0) | (o_ & hm0); }
  { const unsigned e_ = (srt(v1[0] + v2[4]) & 0xffffff00u) | 251u, o_ = (srt(v1[0] + v2[5]) & 0xffffff00u) | 250u; cd[2] = (e_ & ~hm0) | (o_ & hm0); }
  { const unsigned e_ = (srt(v1[0] + v2[6]) & 0xffffff00u) | 249u, o_ = (srt(v1[0] + v2[7]) & 0xffffff00u) | 248u; cd[3] = (e_ & ~hm0) | (o_ & hm0); }
  { const unsigned e_ = (srt(v1[0] + v2[8]) & 0xffffff00u) | 247u, o_ = (srt(v1[0] + v2[9]) & 0xffffff00u) | 246u; cd[4] = (e_ & ~hm0) | (o_ & hm0); }
  { const unsigned e_ = (srt(v1[0] + v2[10]) & 0xffffff00u) | 245u, o_ = (srt(v1[0] + v2[11]) & 0xffffff00u) | 244u; cd[5] = (e_ & ~hm0) | (o_ & hm0); }
  { const unsigned e_ = (srt(v1[0] + v2[12]) & 0xffffff00u) | 243u, o_ = (srt(v1[0] + v2[13]) & 0xffffff00u) | 242u; cd[6] = (e_ & ~hm0) | (o_ & hm0); }
  { const unsigned e_ = (srt(v1[0] + v2[14]) & 0xffffff00u) | 241u, o_ = (srt(v1[0] + v2[15]) & 0xffffff00u) | 240u; cd[7] = (e_ & ~hm0) | (o_ & hm0); }
  { const unsigned e_ = (srt(v1[1] + v2[0]) & 0xffffff00u) | 239u, o_ = (srt(v1[1] + v2[1]) & 0xffffff00u) | 238u; cd[8] = (e_ & ~hm0) | (o_ & hm0); }
  { const unsigned e_ = (srt(v1[1] + v2[2]) & 0xffffff00u) | 237u, o_ = (srt(v1[1] + v2[3]) & 0xffffff00u) | 236u; cd[9] = (e_ & ~hm0) | (o_ & hm0); }
  { const unsigned e_ = (srt(v1[1] + v2[4]) & 0xffffff00u) | 235u, o_ = (srt(v1[1] + v2[5]) & 0xffffff00u) | 234u; cd[10] = (e_ & ~hm0) | (o_ & hm0); }
  { const unsigned e_ = (srt(v1[1] + v2[6]) & 0xffffff00u) | 233u, o_ = (srt(v1[1] + v2[7]) & 0xffffff00u) | 232u; cd[11] = (e_ & ~hm0) | (o_ & hm0); }
  { const unsigned e_ = (srt(v1[2] + v2[0]) & 0xffffff00u) | 223u, o_ = (srt(v1[2] + v2[1]) & 0xffffff00u) | 222u; cd[12] = (e_ & ~hm0) | (o_ & hm0); }
  { const unsigned e_ = (srt(v1[2] + v2[2]) & 0xffffff00u) | 221u, o_ = (srt(v1[2] + v2[3]) & 0xffffff00u) | 220u; cd[13] = (e_ & ~hm0) | (o_ & hm0); }
  { const unsigned e_ = (srt(v1[2] + v2[4]) & 0xffffff00u) | 219u, o_ = (srt(v1[3] + v2[0]) & 0xffffff00u) | 207u; cd[14] = (e_ & ~hm0) | (o_ & hm0); }
  { const unsigned e_ = (srt(v1[3] + v2[1]) & 0xffffff00u) | 206u, o_ = (srt(v1[3] + v2[2]) & 0xffffff00u) | 205u; cd[15] = (e_ & ~hm0) | (o_ & hm0); }
  { const unsigned e_ = (srt(v1[3] + v2[3]) & 0xffffff00u) | 204u, o_ = (srt(v1[4] + v2[0]) & 0xffffff00u) | 191u; cd[16] = (e_ & ~hm0) | (o_ & hm0); }
  { const unsigned e_ = (srt(v1[4] + v2[1]) & 0xffffff00u) | 190u, o_ = (srt(v1[4] + v2[2]) & 0xffffff00u) | 189u; cd[17] = (e_ & ~hm0) | (o_ & hm0); }
  { const unsigned e_ = (srt(v1[5] + v2[0]) & 0xffffff00u) | 175u, o_ = (srt(v1[5] + v2[1]) & 0xffffff00u) | 174u; cd[18] = (e_ & ~hm0) | (o_ & hm0); }
  { const unsigned e_ = (srt(v1[6] + v2[0]) & 0xffffff00u) | 159u, o_ = (srt(v1[6] + v2[1]) & 0xffffff00u) | 158u; cd[19] = (e_ & ~hm0) | (o_ & hm0); }
  { const unsigned e_ = (srt(v1[7] + v2[0]) & 0xffffff00u) | 143u, o_ = (srt(v1[7] + v2[1]) & 0xffffff00u) | 142u; cd[20] = (e_ & ~hm0) | (o_ & hm0); }
  { const unsigned e_ = (srt(v1[8] + v2[0]) & 0xffffff00u) | 127u, o_ = (srt(v1[9] + v2[0]) & 0xffffff00u) | 111u; cd[21] = (e_ & ~hm0) | (o_ & hm0); }
  { const unsigned e_ = (srt(v1[10] + v2[0]) & 0xffffff00u) | 95u, o_ = (srt(v1[11] + v2[0]) & 0xffffff00u) | 79u; cd[22] = (e_ & ~hm0) | (o_ & hm0); }
  { const unsigned e_ = (srt(v1[12] + v2[0]) & 0xffffff00u) | 63u, o_ = (srt(v1[13] + v2[0]) & 0xffffff00u) | 47u; cd[23] = (e_ & ~hm0) | (o_ & hm0); }
  { const unsigned e_ = (srt(v1[14] + v2[0]) & 0xffffff00u) | 31u, o_ = (srt(v1[15] + v2[0]) & 0xffffff00u) | 15u; cd[24] = (e_ & ~hm0) | (o_ & hm0); }
  unsigned win[16];
#pragma unroll
  for (int k = 0; k < 16; ++k) {
    unsigned m = cd[0];
#pragma unroll
    for (int i = 1; i < 25; ++i) m = umax(m, cd[i]);
    m = pair_max(m); win[k] = m;
#pragma unroll
    for (int i = 0; i < 25; ++i) cd[i] = (cd[i] == m) ? 0u : cd[i];
  }
  asm volatile("s_waitcnt lgkmcnt(0)" ::: "memory");
  const float smax = unsrt(win[0] & 0xffffff00u);
  float ex[16], den = 0.f;
#pragma unroll
  for (int k = 0; k < 16; ++k) { ex[k] = __builtin_amdgcn_exp2f((unsrt(win[k] & 0xffffff00u) - smax) * LOG2E); den += ex[k]; }
  const float rden = 1.0f / den; const unsigned hm = 0u - (unsigned)hi;
  int* eo = EIDX + (size_t)(t0 + r32) * 128 + wid * 16 + hi * 8; float* go = EG + (size_t)(t0 + r32) * 128 + wid * 16 + hi * 8;
#pragma unroll
  for (int kk = 0; kk < 8; ++kk) {
    const unsigned wv = (win[kk] & ~hm) | (win[8 + kk] & hm); const float gv = __uint_as_float((__float_as_uint(ex[kk]) & ~hm) | (__float_as_uint(ex[8 + kk]) & hm)) * rden;
    const int flat = 255 - (int)(wv & 255u), a = flat >> 4, bq = flat & 15;
    eo[kk] = (int)scr[a] * 128 + (int)scr[16 + bq]; go[kk] = gv;
  }
  asm volatile("s_waitcnt lgkmcnt(0)" ::: "memory");
}
}

__device__ __forceinline__ void peer_token(const float* __restrict__ X1, const bf16* __restrict__ UB, const bf16* __restrict__ VB, const int* __restrict__ EIDX, const float* __restrict__ EG,
                                           const float* __restrict__ g2, const float* __restrict__ b2, float* __restrict__ out, int tok, int lane) {
  const float* xr = X1 + (size_t)tok * DM;
  float x[32], y[32];
#pragma unroll
  for (int j = 0; j < 4; ++j) { const f32x4 a = *reinterpret_cast<const f32x4*>(xr + 512 * j + 8 * lane), b = *reinterpret_cast<const f32x4*>(xr + 512 * j + 8 * lane + 4);
#pragma unroll
    for (int e = 0; e < 4; ++e) { x[8 * j + e] = a[e]; x[8 * j + 4 + e] = b[e]; } }
#pragma unroll
  for (int i = 0; i < 32; ++i) y[i] = 0.f;
  const int id_a = EIDX[(size_t)tok * 128 + lane], id_b = EIDX[(size_t)tok * 128 + 64 + lane];
  const float g_a = EG[(size_t)tok * 128 + lane], g_b = EG[(size_t)tok * 128 + 64 + lane];
  const int hi = lane >> 5, b4 = (lane >> 4) & 1;
  float pr_h2 = 0.f, pr_g = 0.f;
  for (int bt = 0; bt < 32; ++bt) {
    const int idv = bt < 16 ? id_a : id_b; const float gvv = bt < 16 ? g_a : g_b; const int kb = (bt & 15) * 4;
    int eid[4];
#pragma unroll
    for (int e = 0; e < 4; ++e) eid[e] = __builtin_amdgcn_readlane(idv, kb + e);
    u32x4 uw[4][4];
#pragma unroll
    for (int e = 0; e < 4; ++e) { const bf16* ur = UB + (size_t)eid[e] * DM + 8 * lane;
#pragma unroll
      for (int j = 0; j < 4; ++j) uw[e][j] = *reinterpret_cast<const u32x4*>(ur + 512 * j); }
    float d[4];
#pragma unroll
    for (int e = 0; e < 4; ++e) { float s = 0.f;
#pragma unroll
      for (int j = 0; j < 4; ++j)
#pragma unroll
        for (int q = 0; q < 4; ++q) { const unsigned wv = uw[e][j][q]; s = fmaf(bf_lo(wv), x[8 * j + 2 * q], s); s = fmaf(bf_hi(wv), x[8 * j + 2 * q + 1], s); }
      d[e] = s; }
    float v0, v1;
    { const float s0 = hi ? d[0] : d[2], s1 = hi ? d[1] : d[3]; const float k0 = hi ? d[2] : d[0], k1 = hi ? d[3] : d[1];
      v0 = k0 + __shfl_xor(s0, 32); v1 = k1 + __shfl_xor(s1, 32); }
    float hsum;
    { const float s = b4 ? v0 : v1, k = b4 ? v1 : v0; hsum = k + __shfl_xor(s, 16); }
    hsum += __shfl_xor(hsum, 8); hsum += __shfl_xor(hsum, 4); hsum += __shfl_xor(hsum, 2); hsum += __shfl_xor(hsum, 1);
    const int el = 2 * hi + b4;
    const float gk = __shfl(gvv, kb + el);
    pr_h2 += hsum * hsum; pr_g += gk;
    const float av = 0.5f * hsum * (1.0f + erff(hsum * 0.70710678118654752f)) * gk;
    float a[4];
#pragma unroll
    for (int e = 0; e < 4; ++e) a[e] = __uint_as_float((unsigned)__builtin_amdgcn_readlane((int)__float_as_uint(av), 32 * (e >> 1) + 16 * (e & 1)));
#pragma unroll
    for (int e = 0; e < 4; ++e) { const bf16* vr = VB + (size_t)eid[e] * DM + 8 * lane;
#pragma unroll
      for (int j = 0; j < 4; ++j) uw[e][j] = *reinterpret_cast<const u32x4*>(vr + 512 * j); }
#pragma unroll
    for (int e = 0; e < 4; ++e)
#pragma unroll
      for (int j = 0; j < 4; ++j)
#pragma unroll
        for (int q = 0; q < 4; ++q) { const unsigned wv = uw[e][j][q]; y[8 * j + 2 * q] = fmaf(a[e], bf_lo(wv), y[8 * j + 2 * q]); y[8 * j + 2 * q + 1] = fmaf(a[e], bf_hi(wv), y[8 * j + 2 * q + 1]); }
  }
#if defined(PROBE)
  { float K = 0.f;
    if (PROBE == 1) K = 100.f * sqrtf(wave_sum(pr_h2) * (1.f / 16.f / 128.f));
    if (PROBE == 2) K = 100.f * wave_sum(pr_g) * (1.f / 16.f);
    if (PROBE == 3) { float q = 0.f; for (int i = 0; i < 32; ++i) q += y[i] * y[i]; K = 100.f * sqrtf(wave_sum(q) * (1.f / 2048.f)); }
    float* orow = out + (size_t)tok * DM;
    for (int j = 0; j < 4; ++j) { const int e0 = 512 * j + 8 * lane; for (int e = 0; e < 8; ++e) orow[e0 + e] = K; }
    return; }
#endif
  float s = 0.f;
#pragma unroll
  for (int i = 0; i < 32; ++i) { y[i] = fmaf(ALPHA, x[i], y[i]); s += y[i]; }
  const float mean = wave_sum(s) * (1.f / DM); float s2 = 0.f;
#pragma unroll
  for (int i = 0; i < 32; ++i) { y[i] -= mean; s2 = fmaf(y[i], y[i], s2); }
  const float rstd = 1.0f / sqrtf(wave_sum(s2) * (1.f / DM) + LN_EPS);
  float* orow = out + (size_t)tok * DM;
#pragma unroll
  for (int j = 0; j < 4; ++j) {
    const int e0 = 512 * j + 8 * lane;
    const f32x4 ga = *reinterpret_cast<const f32x4*>(g2 + e0), gb = *reinterpret_cast<const f32x4*>(g2 + e0 + 4);
    const f32x4 ba = *reinterpret_cast<const f32x4*>(b2 + e0), bb = *reinterpret_cast<const f32x4*>(b2 + e0 + 4);
    f32x4 o0, o1;
#pragma unroll
    for (int e = 0; e < 4; ++e) { o0[e] = y[8 * j + e] * rstd * ga[e] + ba[e]; o1[e] = y[8 * j + 4 + e] * rstd * gb[e] + bb[e]; }
    *reinterpret_cast<f32x4*>(orow + e0) = o0; *reinterpret_cast<f32x4*>(orow + e0 + 4) = o1;
  }
}

struct Args {
  const float* in[17];
  float* out; unsigned char* ws; int ph_lo, ph_hi;
};
constexpr int N_PHASES = 8;

__global__ void __launch_bounds__(512, 2) mega_fwd(Args args) {
  extern __shared__ __attribute__((aligned(16))) unsigned char lds_raw[];
  LAS unsigned char* ldsl = (LAS unsigned char*)lds_raw;
  char* lds = (char*)lds_raw;
  const int tid = threadIdx.x, lane = tid & 63, wave = __builtin_amdgcn_readfirstlane(tid >> 6);
  const int G = gridDim.x, bx = blockIdx.x;
  unsigned char* ws = args.ws;
  const float* x = args.in[0];
  bf16* XB = (bf16*)(ws + WS_XB); bf16* ATT = XB; bf16* PQ = XB;
  bf16* PROJ = (bf16*)(ws + WS_PROJ); float* X1 = (float*)(ws + WS_PROJ);
  int* EIDX = (int*)(ws + WS_EIDX); float* EG = (float*)(ws + WS_EG);
  bf16* X1B = (bf16*)(ws + WS_X1B); bf16* UB = (bf16*)(ws + WS_UB); bf16* VB = (bf16*)(ws + WS_VB);
  bf16* WIN = (bf16*)(ws + WS_WIN); bf16* WO = (bf16*)(ws + WS_WO); bf16* WQ = (bf16*)(ws + WS_WQ);
  float* Z = args.out;
  const int lo = args.ph_lo, hi_ph = args.ph_hi;
#if MK_ONE_LAUNCH
  cg::grid_group grid = cg::this_grid();
#define GRID_SYNC() grid.sync()
#else
#define GRID_SYNC() do {} while (0)
#endif
#ifndef PH_MASK
#define PH_MASK 0xff
#endif
#define IN(k) (((PH_MASK >> (k)) & 1) && lo <= (k) && (k) < hi_ph)
#define SEAM(k) do { if (IN(k) && IN((k) + 1)) GRID_SYNC(); } while (0)

  if (IN(0)) {
    const size_t gtid = (size_t)bx * 512 + tid, gsz = (size_t)G * 512;
    cvt_stream(x, XB, (size_t)NTOK * DM / 8, gtid, gsz);
    cvt_stream(args.in[13], UB, (size_t)NEXP * DM / 8, gtid, gsz);
    cvt_stream(args.in[14], VB, (size_t)NEXP * DM / 8, gtid, gsz);
    LAS float* scr = (LAS float*)(ldsl + wave * 8704);
    const int gw = bx * 8 + wave, NGW = G * 8;
    constexpr int I_IN = (DM / 64) * (LDP / 32), I_SQ = (DM / 64) * (DM / 32);
    for (int it = gw; it < I_IN + 2 * I_SQ; it += NGW) {
      if (it < I_IN) transpose_item(args.in[1], DM, NPROJ, WIN, scr, it / (LDP / 32), it % (LDP / 32), lane);
      else if (it < I_IN + I_SQ) { const int r = it - I_IN; transpose_item(args.in[2], DM, DM, WO, scr, r / (DM / 32), r % (DM / 32), lane); }
      else { const int r = it - I_IN - I_SQ; transpose_item(args.in[10], DM, DM, WQ, scr, r / (DM / 32), r % (DM / 32), lane); }
    }
    __syncthreads();
  }
  SEAM(0);
  if (IN(1)) {
    pg8::Gemm g{XB, WIN, NTOK, LDP, DM}; pg8::StaticOrder S; S.init(NTOK, LDP, G, bx);
    pg8::EpiBf16<0> E{PROJ, LDP, nullptr, 0, 0, 1.f};
    pg8::gemm_phase<pg8::EpiBf16<0>, pg8::StaticOrder, true, true>(ldsl, g, S, E);
    __syncthreads();
  }
  SEAM(1);
  if (IN(2)) {
    float lam;
    { const float a = args.in[3][lane] * args.in[4][lane], b = args.in[5][lane] * args.in[6][lane];
      lam = __expf(wave_sum(a)) - __expf(wave_sum(b)) + LAM_INIT; }
    for (int rnd = 0; rnd * G < 1024; ++rnd) {
      const int i = rnd * G + ((rnd & 1) ? (G - 1 - bx) : bx);
      if (i < 1024) { const int qb = 63 - (i >> 4), b = i & 15; att::attn_unit<1>(PROJ, ATT, b, 0, qb, lds, lam, args.in[7]); }
    }
    for (int rnd = 0; rnd * G < 2048; ++rnd) {
      const int j = rnd * G + ((rnd & 1) ? (G - 1 - bx) : bx);
      if (j < 2048) { const int qb = 15 - (j >> 7), bh = j & 127; att::attn_unit<0>(PROJ, ATT, bh >> 3, bh & 7, qb, lds, lam, args.in[7]); }
    }
  }
  SEAM(2);
  if (IN(3)) {
    pg8::Gemm g{ATT, WO, NTOK, DM, DM}; pg8::StaticOrder S; S.init(NTOK, DM, G, bx);
    pg8::EpiResid E{x, Z, DM, ALPHA};
    pg8::gemm_phase<pg8::EpiResid, pg8::StaticOrder, true, true>(ldsl, g, S, E);
    __syncthreads();
  }
  SEAM(3);
  if (IN(4)) {
    const int gw = bx * 8 + wave, NGW = G * 8;
    for (int m = gw; m < NTOK; m += NGW) ln_row(Z + (size_t)m * DM, args.in[8], args.in[9], X1 + (size_t)m * DM, X1B + (size_t)m * DM, lane);
  }
  SEAM(4);
  if (IN(5)) {
    pg8::Gemm g{X1B, WQ, NTOK, DM, DM}; pg8::StaticOrder S; S.init(NTOK, DM, G, bx);
    pg8::EpiBf16<0> E{PQ, DM, nullptr, 0, 0, 1.f};
    pg8::gemm_phase<pg8::EpiBf16<0>, pg8::StaticOrder, true, true>(ldsl, g, S, E);
    __syncthreads();
  }
  SEAM(5);
  if (IN(6)) {
    peer::load_keys(args.in[11], args.in[12], lds);
    __syncthreads();
    for (int u = bx; u < NTOK / 32; u += G) peer::score_unit(PQ, EIDX, EG, u * 32, lds);
    __syncthreads();
  }
  SEAM(6);
  if (IN(7)) {
    const int gw = bx * 8 + wave, NGW = G * 8;
    for (int m = gw; m < NTOK; m += NGW) peer_token(X1, UB, VB, EIDX, EG, args.in[15], args.in[16], args.out, m, lane);
  }
#undef IN
#undef SEAM
}

extern "C" void kernel_launch(void* const* d_in, const int* in_sizes, int n_in, void* d_out, int out_size, void* d_ws, size_t ws_size, hipStream_t stream) {
  static int grid = 0;
  if (grid == 0) {
    if (n_in != 17 || in_sizes[0] != NTOK * DM || out_size != NTOK * DM || ws_size < WS_END) {
      fprintf(stderr, "kernel_launch: unexpected shapes: n_in %d in0 %d out %d ws %zu (need >= %zu)\n", n_in, n_in > 0 ? in_sizes[0] : -1, out_size, ws_size, (size_t)WS_END); grid = -1; return; }
    int dev = 0, cus = 0, per_cu = 0;
    if (hipGetDevice(&dev) != hipSuccess || hipDeviceGetAttribute(&cus, hipDeviceAttributeMultiprocessorCount, dev) != hipSuccess) { grid = -1; return; }
    if (hipFuncSetAttribute((const void*)mega_fwd, hipFuncAttributeMaxDynamicSharedMemorySize, LDS_BYTES) != hipSuccess) { fprintf(stderr, "kernel_launch: hipFuncSetAttribute failed\n"); grid = -1; return; }
    if (hipOccupancyMaxActiveBlocksPerMultiprocessor(&per_cu, (const void*)mega_fwd, 512, LDS_BYTES) != hipSuccess || per_cu < 1) { fprintf(stderr, "kernel_launch: occupancy query says %d\n", per_cu); per_cu = 1; }
    (void)hipGetLastError();
    grid = cus * (per_cu > 1 ? 1 : per_cu);
  }
  if (grid < 0) return;
  Args a{};
  for (int i = 0; i < 17; ++i) a.in[i] = (const float*)d_in[i];
  a.out = (float*)d_out; a.ws = (unsigned char*)d_ws;
#if MK_ONE_LAUNCH
  a.ph_lo = 0; a.ph_hi = N_PHASES;
  void* kargs[] = {&a};
  hipError_t e = hipLaunchCooperativeKernel((const void*)mega_fwd, dim3(grid), dim3(512), kargs, LDS_BYTES, stream);
  if (e != hipSuccess) fprintf(stderr, "kernel_launch: cooperative launch failed: %s (grid %d)\n", hipGetErrorString(e), grid);
#else
  for (int p = 0; p < N_PHASES; ++p) {
    a.ph_lo = p; a.ph_hi = p + 1;
    hipLaunchKernelGGL(mega_fwd, dim3(grid), dim3(512), LDS_BYTES, stream, a);
  }
  const hipError_t le = hipPeekAtLastError();
  if (le != hipSuccess) fprintf(stderr, "kernel_launch: launch failed: %s\n", hipGetErrorName(le));
#endif
}
```

```cpp
#include <hip/hip_runtime.h>
#include <hip/hip_cooperative_groups.h>
#include <cstdio>
#include <cstdint>
namespace cg = cooperative_groups;

#ifndef MK_ONE_LAUNCH
#define MK_ONE_LAUNCH 1
#endif

constexpr int NB = 16, SEQ = 2048, DM = 2048, NTOK = NB * SEQ;
constexpr int NPROJ = 5456, LDP = 5632;
constexpr int C_DQ = 0, C_DK = 1024, C_DV = 2048, C_SQ = 3072, C_SK = 4096, C_SV = 4224, C_IQ = 4352, C_IK = 5376, C_IW = 5440;
constexpr int NEXP = 16384;
constexpr float LN_EPS = 1e-5f, RMS_EPS = 1e-5f;
constexpr float ALPHA = 1.189207115002721f;
constexpr float LAM_INIT = 0.2f;
constexpr float LOG2E = 1.4426950408889634f;

constexpr size_t MiB = (size_t)1 << 20;
constexpr size_t WS_XB = 0;
constexpr size_t WS_PROJ = 128 * MiB;
constexpr size_t WS_EIDX = 384 * MiB;
constexpr size_t WS_EG = 400 * MiB;
constexpr size_t WS_X1B = 480 * MiB;
constexpr size_t WS_V4C = 416 * MiB;
constexpr size_t WS_EIDP = 432 * MiB;
constexpr size_t WS_CTL = 774 * MiB;
constexpr size_t WS_U8 = 608 * MiB;
constexpr size_t WS_V8 = 640 * MiB;
constexpr size_t WS_HPA = 0;
constexpr size_t WS_X1F8 = 672 * MiB;
constexpr size_t WS_WIN = 736 * MiB;
constexpr size_t WS_WO = 758 * MiB;
constexpr size_t WS_WQ = 766 * MiB;
constexpr size_t WS_A8 = 775 * MiB;
constexpr size_t WS_END = 779 * MiB;

constexpr int LDS_BYTES = 147456;

typedef unsigned short bf16;
#define LAS __attribute__((address_space(3)))


constexpr int HWTAB_OFF = LDS_BYTES - 128;
__device__ __forceinline__ int hw_slot() { return (int)(__builtin_amdgcn_s_getreg((6 << 11) | 4  ) & 63u); }
__device__ __forceinline__ int my_lane() { int r; asm volatile("v_mbcnt_lo_u32_b32 %0, -1, 0\n\tv_mbcnt_hi_u32_b32 %0, -1, %0" : "=v"(r)); return r; }
__device__ __forceinline__ int my_wave() { extern __shared__ __attribute__((aligned(16))) unsigned char lds_raw[]; return __builtin_amdgcn_readfirstlane((int)((volatile unsigned char*)lds_raw)[HWTAB_OFF + hw_slot()]); }
__device__ __forceinline__ int my_tid() { return my_wave() * 64 + my_lane(); }
namespace pg8 {
#define PG8_LAS __attribute__((address_space(3)))
typedef unsigned short bf16_t;
typedef short bf16x8 __attribute__((ext_vector_type(8)));
typedef float f32x4 __attribute__((ext_vector_type(4)));
typedef unsigned u32x4 __attribute__((ext_vector_type(4)));
typedef int v8i_t __attribute__((ext_vector_type(8)));
typedef int i32x4_t __attribute__((ext_vector_type(4)));
__device__ __forceinline__ v8i_t cat8(bf16x8 lo, bf16x8 hi) { return __builtin_shufflevector(__builtin_bit_cast(i32x4_t, lo), __builtin_bit_cast(i32x4_t, hi), 0, 1, 2, 3, 4, 5, 6, 7); }
constexpr int BM = 256, BK = 64, HALF = 128, HTB = HALF * BK * 2  , STAGE_BYTES = 8 * HTB, NXCD = 8, WGM = 8;

__host__ __device__ __forceinline__ int lds_byte(int r, int c) { const int st = (r >> 4) * 2 + (c >> 5), rr = r & 15, cc = c & 31, ob = rr * 64 + cc * 2; return st * 1024 + (ob ^ (((ob >> 9) & 1) << 5)); }
__host__ __device__ __forceinline__ void stage_rc(int b, int& R, int& C) { const int st = b / 1024, sb = b % 1024, swz = sb ^ (((sb >> 9) & 1) << 5); R = (st >> 1) * 16 + swz / 64; C = (st & 1) * 32 + (swz % 64) / 2; }
__host__ __device__ __forceinline__ int perm32(int rho) { const int n = rho >> 4, i = rho & 15; return 8 * (i >> 2) + 4 * n + (i & 3); }

struct Unit { int pm, pn; };
struct Gemm { const bf16_t* A; const bf16_t* Bt; int M, N, K; };

struct StaticOrder {
    int nM, nN, nwg, G, c;
    __host__ __device__ void init(int M, int N, int G_, int c_) { nM = M / BM; nN = N / BM; nwg = nM * nN; G = G_; c = c_; }
    __host__ __device__ bool next(int i, Unit& u) const {
        const long L = (long)i * G + c; if (L >= nwg) return false;
        int wgid = (int)L; { const int q = nwg / NXCD, r = nwg % NXCD, xcd = wgid % NXCD, off = wgid / NXCD; wgid = (xcd < r ? xcd * (q + 1) : r * (q + 1) + (xcd - r) * q) + off; }
        const int nig = WGM * nN, gid = wgid / nig, fm = gid * WGM, gsz = (nM - fm) < WGM ? (nM - fm) : WGM;
        u.pm = fm + ((wgid % nig) % gsz); u.pn = (wgid % nig) / gsz; return true;
    }
    __device__ __forceinline__ void a_ready(const Unit&) const {}
    __device__ __forceinline__ void done(const Unit&) const {}
};
__device__ __forceinline__ unsigned cvt_pk_bf16(float lo, float hi) { unsigned r; asm volatile("v_cvt_pk_bf16_f32 %0, %1, %2" : "=v"(r) : "v"(lo), "v"(hi)); return r; }
typedef float f32x2 __attribute__((ext_vector_type(2)));
__device__ __forceinline__ f32x2 gelu_pk(f32x2 v) {
    const f32x2 av = __builtin_elementwise_abs(v), d = av * 0.2316418882f + 1.0f;
    f32x2 t; t.x = __builtin_amdgcn_rcpf(d.x); t.y = __builtin_amdgcn_rcpf(d.y);
    f32x2 q = t * 0.5307027145f + (-0.7265760135f); q = q * t + 0.7107068705f; q = q * t + (-0.142248368f); q = q * t + 0.127414796f; q = q * t;
    const f32x2 s = (v * v) * (-0.72134752044f);
    f32x2 e; e.x = __builtin_amdgcn_exp2f(s.x); e.y = __builtin_amdgcn_exp2f(s.y);
    const f32x2 m = v * (q * e), r = v - m;
    f32x2 o; o.x = v.x < 0.f ? m.x : r.x; o.y = v.y < 0.f ? m.y : r.y; return o;
}

template <int ACT  > struct EpiBf16 {
    static constexpr bool PERM = true, AFTER_DRAIN = false; static_assert(ACT == 0 || ACT == 1, "EpiBf16: ACT is 0 (none) or 1 (gelu_pk)");
    bf16_t* O; int ldc; const float* bias; int split_cols; size_t split_stride; float scale0;
    __device__ __forceinline__ void operator()(const f32x4 (&acc)[2][2][4][2], const Unit& u, int wr, int wc, int fr, int fq) const {
        const int row0 = u.pm * BM + wr * 64 + fr; int colt = u.pn * BM; bf16_t* base = O;
        float sc = 1.f; if (split_cols) { const int t = colt / split_cols; base += (size_t)t * split_stride; colt -= t * split_cols; if (t == 0) sc = scale0; }
        const int col0 = colt + wc * 32 + 8 * fq, bcol0 = u.pn * BM + wc * 32 + 8 * fq;
        f32x4 bv[2][2];
#pragma unroll
        for (int bj = 0; bj < 2; ++bj)
#pragma unroll
            for (int n = 0; n < 2; ++n) bv[bj][n] = bias ? *(const f32x4*)(bias + bcol0 + bj * HALF + 4 * n) : (f32x4){0.f, 0.f, 0.f, 0.f};
#pragma unroll
        for (int ai = 0; ai < 2; ++ai)
#pragma unroll
            for (int m = 0; m < 4; ++m) { bf16_t* rowp = base + (size_t)(row0 + ai * HALF + m * 16) * ldc + col0;
#pragma unroll
                for (int bj = 0; bj < 2; ++bj) { f32x4 v0 = acc[ai][bj][m][0] + bv[bj][0], v1 = acc[ai][bj][m][1] + bv[bj][1];
                    if (ACT == 1) { f32x2 a = gelu_pk((f32x2){v0[0], v0[1]}), b = gelu_pk((f32x2){v0[2], v0[3]}), c = gelu_pk((f32x2){v1[0], v1[1]}), d = gelu_pk((f32x2){v1[2], v1[3]});
                        v0 = (f32x4){a.x, a.y, b.x, b.y}; v1 = (f32x4){c.x, c.y, d.x, d.y}; }
                    v0 = v0 * sc; v1 = v1 * sc; u32x4 w; w.x = cvt_pk_bf16(v0[0], v0[1]); w.y = cvt_pk_bf16(v0[2], v0[3]); w.z = cvt_pk_bf16(v1[0], v1[1]); w.w = cvt_pk_bf16(v1[2], v1[3]);
                    *(u32x4*)(rowp + bj * HALF) = w; } }
    }
};
struct EpiResid {
    static constexpr bool PERM = true, AFTER_DRAIN = false;
    const bf16_t* X; bf16_t* Z; int ldc; float alpha; float accscale;
    __device__ __forceinline__ void operator()(const f32x4 (&acc)[2][2][4][2], const Unit& u, int wr_, int wc_, int fr_, int fq_) const {
        int t = my_lane(); asm volatile("" : "+v"(t));
        const int wv = my_wave(), wr = wv >> 2, wc = wv & 3, fr = t & 15, fq = t >> 4; (void)wr_; (void)wc_; (void)fr_; (void)fq_;
        const int row0 = u.pm * BM + wr * 64 + fr, col0 = u.pn * BM + wc * 32 + 8 * fq;
#pragma unroll
        for (int ai = 0; ai < 2; ++ai)
#pragma unroll
            for (int m = 0; m < 4; ++m) { const unsigned off = (unsigned)(row0 + ai * HALF + m * 16) * (unsigned)ldc + (unsigned)col0;
#pragma unroll
                for (int bj = 0; bj < 2; ++bj) { const u32x4 xw = *(const u32x4*)(X + off + bj * HALF);
                    const f32x4 x0 = {__uint_as_float(xw.x << 16), __uint_as_float(xw.x & 0xffff0000u), __uint_as_float(xw.y << 16), __uint_as_float(xw.y & 0xffff0000u)};
                    const f32x4 x1 = {__uint_as_float(xw.z << 16), __uint_as_float(xw.z & 0xffff0000u), __uint_as_float(xw.w << 16), __uint_as_float(xw.w & 0xffff0000u)};
                    const f32x4 v0 = x0 * alpha + acc[ai][bj][m][0] * accscale, v1 = x1 * alpha + acc[ai][bj][m][1] * accscale;
                    u32x4 w; w.x = cvt_pk_bf16(v0[0], v0[1]); w.y = cvt_pk_bf16(v0[2], v0[3]); w.z = cvt_pk_bf16(v1[0], v1[1]); w.w = cvt_pk_bf16(v1[2], v1[3]);
                    *(u32x4*)(Z + off + bj * HALF) = w; }
                asm volatile("" ::: "memory"); }
    }
};

template <class Epi, class Sched, bool ALIGN_EPI = false, bool SP2 = false, bool FP8 = false, int SCALE_B = 0x7F7F7F7F>
__device__ __forceinline__ void gemm_phase(PG8_LAS unsigned char* lds, const Gemm g, const Sched& S, const Epi& E) {
    const int tid = my_tid(), wid = __builtin_amdgcn_readfirstlane(tid >> 6), lane = tid & 63, wr = wid >> 2, wc = wid & 3, fr = lane & 15, fq = lane >> 4;
    const int K = g.K, nt = FP8 ? K / 128 : K / BK;
    unsigned voffA[2], voffB[2];
#pragma unroll
    for (int i = 0; i < 2; ++i) { int R, C; stage_rc(tid * 16 + i * 8192, R, C); const int Rb = Epi::PERM ? ((R & ~31) + perm32(R & 31)) : R;
        voffA[i] = FP8 ? (unsigned)(R * K + C * 2) : (unsigned)(R * K + C) * 2u; voffB[i] = FP8 ? (unsigned)(Rb * K + C * 2) : (unsigned)(Rb * K + C) * 2u; }
    const unsigned kstep = (unsigned)(BK * 2);
    const unsigned hstep = (unsigned)HALF * (unsigned)K * (FP8 ? 1u : 2u);
    const unsigned tstep = 2u * hstep;
    const unsigned ldsw = (unsigned)wid * 1024u;
    const int aoff = lds_byte(wr * 64 + fr, fq * 8), boff = lds_byte(wc * 32 + fr, fq * 8);
#define PG8_SA(b, h) (((b) * 2 + (h)) * HTB)
#define PG8_SB(b, h) ((4 + (b) * 2 + (h)) * HTB)
    const __amdgpu_buffer_rsrc_t rsrc_voffA = __builtin_amdgcn_make_buffer_rsrc((void*)g.A, (short)0, -1, 0x00020000), rsrc_voffB = __builtin_amdgcn_make_buffer_rsrc((void*)g.Bt, (short)0, -1, 0x00020000);
    const char* const base_voffA = (const char*)g.A; const char* const base_voffB = (const char*)g.Bt;
#define PG8_STAGE(bufoff, goff, voff) do { _Pragma("unroll") for (int _i = 0; _i < 2; ++_i) { \
        if constexpr (FP8) __builtin_amdgcn_raw_ptr_buffer_load_lds(rsrc_##voff, (PG8_LAS void*)(lds + (bufoff) + ldsw + _i * 8192), 16, (int)(voff)[_i], (int)(goff), 0, 0); \
        else __builtin_amdgcn_global_load_lds((const unsigned*)(base_##voff + (size_t)(goff) + (voff)[_i]), (PG8_LAS unsigned*)(lds + (bufoff) + ldsw + _i * 8192), 16, 0, 0); } } while (0)
#define PG8_LDA(dst, b, h) do { _Pragma("unroll") for (int m = 0; m < 4; ++m) _Pragma("unroll") for (int k = 0; k < 2; ++k) dst[m][k] = *(const PG8_LAS bf16x8*)(lds + PG8_SA(b, h) + aoff + m * 2048 + k * 1024); } while (0)
#define PG8_LDB(dst, b, h) do { _Pragma("unroll") for (int n = 0; n < 2; ++n) _Pragma("unroll") for (int k = 0; k < 2; ++k) dst[n][k] = *(const PG8_LAS bf16x8*)(lds + PG8_SB(b, h) + boff + n * 2048 + k * 1024); } while (0)
#define PG8_MMA(ai, bj, At, Bt) do { __builtin_amdgcn_s_setprio(1); _Pragma("unroll") for (int m = 0; m < 4; ++m) _Pragma("unroll") for (int n = 0; n < 2; ++n) { \
        if constexpr (FP8) acc[ai][bj][m][n] = __builtin_amdgcn_mfma_scale_f32_16x16x128_f8f6f4(cat8(Bt[n][0], Bt[n][1]), cat8(At[m][0], At[m][1]), acc[ai][bj][m][n], 0, 0, 0, SCALE_B, 0, 0x7F7F7F7F); \
        else { _Pragma("unroll") for (int k = 0; k < 2; ++k) acc[ai][bj][m][n] = __builtin_amdgcn_mfma_f32_16x16x32_bf16(Bt[n][k], At[m][k], acc[ai][bj][m][n], 0, 0, 0); } } \
        __builtin_amdgcn_s_setprio(0); } while (0)
#define PG8_WAIT_V(n) asm volatile("s_waitcnt vmcnt(" #n ")" ::: "memory")
#define PG8_WAIT_L(n) asm volatile("s_waitcnt lgkmcnt(" #n ")" ::: "memory")
#define PG8_BAR __builtin_amdgcn_s_barrier()
#define PG8_SCHED __builtin_amdgcn_sched_barrier(0)
    Unit cur, nxt; int ui = 0;
    if (!S.next(0, cur)) return;
    f32x4 acc[2][2][4][2];
#pragma unroll
    for (int a = 0; a < 2; ++a)
#pragma unroll
        for (int b = 0; b < 2; ++b)
#pragma unroll
            for (int m = 0; m < 4; ++m)
#pragma unroll
                for (int n = 0; n < 2; ++n) acc[a][b][m][n] = (f32x4){0.f, 0.f, 0.f, 0.f};
    bf16x8 At[4][2], B0[2][2], B1[2][2];
    unsigned cA = (unsigned)cur.pm * tstep, cB = (unsigned)cur.pn * tstep;
    S.a_ready(cur);
    if constexpr (SP2) {
        PG8_STAGE(PG8_SB(0, 0), cB, voffB); PG8_STAGE(PG8_SB(0, 1), cB + hstep, voffB); PG8_STAGE(PG8_SA(0, 0), cA, voffA); PG8_STAGE(PG8_SA(0, 1), cA + hstep, voffA);
        if (wr == 1) PG8_BAR;
        PG8_WAIT_V(2); PG8_BAR;
        PG8_STAGE(PG8_SB(1, 0), cB + kstep, voffB); PG8_STAGE(PG8_SA(1, 0), cA + kstep, voffA); PG8_STAGE(PG8_SB(1, 1), cB + hstep + kstep, voffB);
        PG8_WAIT_V(6); PG8_BAR;
    } else {
        PG8_STAGE(PG8_SB(0, 0), cB, voffB); PG8_STAGE(PG8_SA(0, 0), cA, voffA); PG8_STAGE(PG8_SB(0, 1), cB + hstep, voffB); PG8_STAGE(PG8_SA(0, 1), cA + hstep, voffA);
        if (wr == 1) PG8_BAR;
        PG8_WAIT_V(4); PG8_BAR;
        PG8_STAGE(PG8_SB(1, 0), cB + kstep, voffB); PG8_STAGE(PG8_SA(1, 0), cA + kstep, voffA); PG8_STAGE(PG8_SB(1, 1), cB + hstep + kstep, voffB);
        PG8_WAIT_V(6); PG8_BAR;
    }
    for (;;) {
        const bool has_next = S.next(ui + 1, nxt);
        const unsigned nA = has_next ? (unsigned)nxt.pm * tstep : cA, nB = has_next ? (unsigned)nxt.pn * tstep : cB;
        for (int t = 0; t < nt; t += 2) {
            const bool last = (t == nt - 2);
            const unsigned a1 = cA + (unsigned)(t + 1) * kstep;
            const unsigned a2 = last ? nA : cA + (unsigned)(t + 2) * kstep, b2 = last ? nB : cB + (unsigned)(t + 2) * kstep;
            const unsigned a3 = a2 + kstep, b3 = b2 + kstep;
            if (last && has_next) S.a_ready(nxt);
            if constexpr (SP2) {
            PG8_LDB(B0, 0, 0); PG8_LDB(B1, 0, 1); PG8_SCHED; PG8_LDA(At, 0, 0); PG8_STAGE(PG8_SA(1, 1), a1 + hstep, voffA);
            PG8_WAIT_V(8); PG8_WAIT_L(0); PG8_BAR; PG8_MMA(0, 0, At, B0); PG8_MMA(0, 1, At, B1); PG8_BAR; PG8_SCHED;
            PG8_LDA(At, 0, 1); PG8_STAGE(PG8_SB(0, 0), b2, voffB); PG8_STAGE(PG8_SB(0, 1), b2 + hstep, voffB); PG8_STAGE(PG8_SA(0, 0), a2, voffA);
            PG8_WAIT_V(8); PG8_WAIT_L(0); PG8_BAR; PG8_MMA(1, 0, At, B0); PG8_MMA(1, 1, At, B1); PG8_BAR; PG8_SCHED;
            PG8_LDB(B0, 1, 0); PG8_LDB(B1, 1, 1); PG8_SCHED; PG8_LDA(At, 1, 0); PG8_STAGE(PG8_SA(0, 1), a2 + hstep, voffA);
            PG8_WAIT_V(8); PG8_WAIT_L(0); PG8_BAR; PG8_MMA(0, 0, At, B0); PG8_MMA(0, 1, At, B1); PG8_BAR; PG8_SCHED;
            PG8_LDA(At, 1, 1); PG8_STAGE(PG8_SB(1, 0), b3, voffB); PG8_STAGE(PG8_SB(1, 1), b3 + hstep, voffB); PG8_STAGE(PG8_SA(1, 0), a3, voffA);
            PG8_WAIT_V(8); PG8_WAIT_L(0); PG8_BAR; PG8_MMA(1, 0, At, B0); PG8_MMA(1, 1, At, B1); PG8_BAR; PG8_SCHED;
            } else {
            PG8_LDB(B0, 0, 0); PG8_SCHED; PG8_LDA(At, 0, 0); PG8_STAGE(PG8_SA(1, 1), a1 + hstep, voffA);
            PG8_WAIT_L(8); PG8_BAR; PG8_WAIT_L(0); PG8_MMA(0, 0, At, B0); PG8_BAR; PG8_SCHED;
            PG8_LDB(B1, 0, 1); PG8_STAGE(PG8_SB(0, 0), b2, voffB);
            PG8_BAR; PG8_WAIT_L(0); PG8_MMA(0, 1, At, B1); PG8_BAR;
            PG8_LDA(At, 0, 1); PG8_STAGE(PG8_SA(0, 0), a2, voffA);
            PG8_BAR; PG8_WAIT_L(0); PG8_MMA(1, 0, At, B0); PG8_BAR; PG8_SCHED;
            PG8_STAGE(PG8_SB(0, 1), b2 + hstep, voffB);
            PG8_WAIT_V(6); PG8_BAR; PG8_MMA(1, 1, At, B1); PG8_BAR;
            PG8_LDB(B0, 1, 0); PG8_SCHED; PG8_LDA(At, 1, 0); PG8_STAGE(PG8_SA(0, 1), a2 + hstep, voffA);
            PG8_WAIT_L(8); PG8_BAR; PG8_WAIT_L(0); PG8_MMA(0, 0, At, B0); PG8_BAR; PG8_SCHED;
            PG8_LDB(B1, 1, 1); PG8_STAGE(PG8_SB(1, 0), b3, voffB);
            PG8_BAR; PG8_WAIT_L(0); PG8_MMA(0, 1, At, B1); PG8_BAR;
            PG8_LDA(At, 1, 1); PG8_STAGE(PG8_SA(1, 0), a3, voffA);
            PG8_BAR; PG8_WAIT_L(0); PG8_MMA(1, 0, At, B0); PG8_BAR; PG8_SCHED;
            PG8_STAGE(PG8_SB(1, 1), b3 + hstep, voffB);
            PG8_WAIT_V(6); PG8_BAR; PG8_MMA(1, 1, At, B1); PG8_BAR;
            }
        }
        if constexpr (ALIGN_EPI) { if (wr == 0) PG8_BAR; }
        if constexpr (!Epi::AFTER_DRAIN) { E(acc, cur, wr, wc, fr, fq); S.done(cur); }
        if (!has_next) break;
#pragma unroll
        for (int a = 0; a < 2; ++a)
#pragma unroll
            for (int b = 0; b < 2; ++b)
#pragma unroll
                for (int m = 0; m < 4; ++m)
#pragma unroll
                    for (int n = 0; n < 2; ++n) acc[a][b][m][n] = (f32x4){0.f, 0.f, 0.f, 0.f};
        cur = nxt; cA = nA; cB = nB; ++ui;
        if constexpr (ALIGN_EPI) { if (wr == 1) PG8_BAR; }
    }
    PG8_WAIT_V(0);
    if constexpr (!ALIGN_EPI) { if (wr == 0) PG8_BAR; }
    PG8_BAR;
    if constexpr (Epi::AFTER_DRAIN) { E.fused(acc, cur, wr, wc, fr, fq, lds, wid, lane); S.done(cur); }
#undef PG8_SA
#undef PG8_SB
#undef PG8_STAGE
#undef PG8_LDA
#undef PG8_LDB
#undef PG8_MMA
#undef PG8_WAIT_V
#undef PG8_WAIT_L
#undef PG8_BAR
#undef PG8_SCHED
}
}


namespace att {
using bf16x8 = __attribute__((ext_vector_type(8))) short;
using s16x4  = __attribute__((ext_vector_type(4))) short;
using f32x16 = __attribute__((ext_vector_type(16))) float;
using u32x4  = __attribute__((ext_vector_type(4))) unsigned;
using u32x2  = __attribute__((ext_vector_type(2))) unsigned;
constexpr int SHM_V = 16384, SHM_K = 16384;
constexpr int L_V = 0, L_K = 32768, L_WS = 69632, L_SEL = 131072, L_END = 139264;
#ifndef ATT_SDEPTH
#define ATT_SDEPTH 1
#endif
constexpr int SDEPTH = ATT_SDEPTH;
constexpr float THR2 = 11.0f;
#define KSWZ(row, colB) ((row) * 256 + ((colB) ^ (((row) & 7) << 4)))
#define SBAR() __builtin_amdgcn_sched_barrier(0)
__device__ __forceinline__ int crow(int r, int hi) { return (r & 3) + 8 * (r >> 2) + 4 * hi; }
__device__ __forceinline__ unsigned cvtpk(float lo, float hi) { unsigned r; asm volatile("v_cvt_pk_bf16_f32 %0, %1, %2" : "=v"(r) : "v"(lo), "v"(hi)); return r; }
__device__ __forceinline__ bf16x8 ld8(const bf16* p) { return *reinterpret_cast<const bf16x8*>(p); }
__device__ __forceinline__ float bf2f(bf16 v) { return __uint_as_float((unsigned)v << 16); }
__device__ __forceinline__ float ninf() { return __uint_as_float(0xff800000u); }

template <int ND0> __device__ __forceinline__ void qkt(f32x16& p0, f32x16& p1, const char* Ks, const bf16x8* qr, int r32, int hi, int d0base) {
  p0 = f32x16{}; p1 = f32x16{};
#pragma unroll
  for (int d0 = 0; d0 < ND0; ++d0) { const int cb = ((d0base + d0) * 16 + hi * 8) * 2;
    bf16x8 b0 = *reinterpret_cast<const bf16x8*>(Ks + KSWZ(r32, cb));
    bf16x8 b1 = *reinterpret_cast<const bf16x8*>(Ks + KSWZ(32 + r32, cb));
    p0 = __builtin_amdgcn_mfma_f32_32x32x16_bf16(b0, qr[d0], p0, 0, 0, 0);
    p1 = __builtin_amdgcn_mfma_f32_32x32x16_bf16(b1, qr[d0], p1, 0, 0, 0); }
}
__device__ __forceinline__ int v_st(int k, int c) { const int kk = (k & ~0xC) | ((k & 4) << 1) | ((k & 8) >> 1); return ((kk >> 3) * 4 + (c >> 5)) * 512 + ((kk & 7) * 32 + (c & 31)) * 2; }
__device__ __forceinline__ int v_rd_base(int lane) { return ((lane & 3) << 3) | (((lane >> 2) & 3) << 6) | (((lane >> 4) & 1) << 5) | (((lane >> 5) & 1) << 8); }
constexpr int v_rd_off(int d0, int ks, int half) { return d0 * 512 + ks * 4096 + half * 2048; }
template <int OFF> __device__ __forceinline__ s16x4 tr_read(int vb) {
  s16x4 r; asm volatile("ds_read_b64_tr_b16 %0, %1 offset:%2" : "=&v"(r) : "v"(vb), "i"(OFF) : "memory"); return r;
}
template <int D0> __device__ __forceinline__ void pv_one(f32x16& od, int vb, bf16x8 pa0, bf16x8 pa1, bf16x8 pa2, bf16x8 pa3) {
#define PK(L, H) (bf16x8){L[0], L[1], L[2], L[3], H[0], H[1], H[2], H[3]}
  { const s16x4 l0 = tr_read<v_rd_off(D0, 0, 0)>(vb), h0 = tr_read<v_rd_off(D0, 0, 1)>(vb), l1 = tr_read<v_rd_off(D0, 1, 0)>(vb), h1 = tr_read<v_rd_off(D0, 1, 1)>(vb);
    asm volatile("s_waitcnt lgkmcnt(0)" ::: "memory"); SBAR();
    od = __builtin_amdgcn_mfma_f32_32x32x16_bf16(pa0, PK(l0, h0), od, 0, 0, 0);
    od = __builtin_amdgcn_mfma_f32_32x32x16_bf16(pa1, PK(l1, h1), od, 0, 0, 0); }
  { const s16x4 l2 = tr_read<v_rd_off(D0, 2, 0)>(vb), h2 = tr_read<v_rd_off(D0, 2, 1)>(vb), l3 = tr_read<v_rd_off(D0, 3, 0)>(vb), h3 = tr_read<v_rd_off(D0, 3, 1)>(vb);
    asm volatile("s_waitcnt lgkmcnt(0)" ::: "memory"); SBAR();
    od = __builtin_amdgcn_mfma_f32_32x32x16_bf16(pa2, PK(l2, h2), od, 0, 0, 0);
    od = __builtin_amdgcn_mfma_f32_32x32x16_bf16(pa3, PK(l3, h3), od, 0, 0, 0); }
#undef PK
}
__device__ __forceinline__ void pv_d0(f32x16* o, int vb, bf16x8 pa0, bf16x8 pa1, bf16x8 pa2, bf16x8 pa3) {
  pv_one<0>(o[0], vb, pa0, pa1, pa2, pa3); pv_one<1>(o[1], vb, pa0, pa1, pa2, pa3); pv_one<2>(o[2], vb, pa0, pa1, pa2, pa3); pv_one<3>(o[3], vb, pa0, pa1, pa2, pa3);
}

template <int MODE> __device__ __forceinline__ void partialSM(f32x16& p0, f32x16& p1, float Cs, float slope2, float thr, int k0, int qpos, int hi,
                                                              const char* selrow, bool diag, float& m_reg, float& off, float& alpha, bool& dead) {
#pragma unroll
  for (int r = 0; r < 16; ++r) { const float cr = (float)((r & 3) + 8 * (r >> 2)); p0[r] = fmaf(p0[r], Cs, cr); p1[r] = fmaf(p1[r], Cs, cr); }
  if (MODE == 0) {
    if (diag) { const int dqh = qpos - k0 - 4 * hi;
#pragma unroll
      for (int r = 0; r < 16; ++r) { const int cr = (r & 3) + 8 * (r >> 2); if (cr > dqh) p0[r] = ninf(); if (cr + 32 > dqh) p1[r] = ninf(); } }
  } else {
    const u32x2 w = *reinterpret_cast<const u32x2*>(selrow + (k0 >> 5) * 4);
    const unsigned w0 = w.x >> (4 * hi), w1 = w.y >> (4 * hi);
#pragma unroll
    for (int r = 0; r < 16; ++r) { const int cr = (r & 3) + 8 * (r >> 2); if ((w0 >> cr) & 1u) p0[r] = ninf(); if ((w1 >> cr) & 1u) p1[r] = ninf(); }
  }
  float pm0 = p0[0], pm1 = p1[0];
#pragma unroll
  for (int r = 1; r < 16; ++r) { pm0 = fmaxf(pm0, p0[r]); pm1 = fmaxf(pm1, p1[r]); }
  const float tb = (float)(k0 + 4 * hi - qpos);
  float tmax = fmaxf(pm0, pm1 + 32.f) + tb;
  { auto rr = __builtin_amdgcn_permlane32_swap(__float_as_uint(tmax), __float_as_uint(tmax), false, false);
    tmax = fmaxf(__uint_as_float(rr[0]), __uint_as_float(rr[1])); }
  dead = (MODE == 0) && __all((tmax - m_reg) * slope2 < -150.f);
  if (dead) { alpha = 1.f; off = 0.f; return; }
  if (__builtin_expect(__all(tmax - m_reg <= thr), 1)) { alpha = 1.f; }
  else { const float mn = fmaxf(m_reg, tmax); alpha = __builtin_amdgcn_exp2f((m_reg - mn) * slope2); m_reg = mn; }
  off = (tb - m_reg) * slope2;
#pragma unroll
  for (int r = 0; r < 16; ++r) p0[r] = __builtin_amdgcn_exp2f(fmaf(p0[r], slope2, off));
}
__device__ __forceinline__ void finishSM(f32x16& p0, f32x16& p1, float slope2, float off1, float alpha, float& l_reg, bf16x8& pa0, bf16x8& pa1, bf16x8& pa2, bf16x8& pa3) {
#pragma unroll
  for (int r = 0; r < 16; ++r) p1[r] = __builtin_amdgcn_exp2f(fmaf(p1[r], slope2, off1));
  float ps = 0;
#pragma unroll
  for (int r = 0; r < 16; ++r) ps += p0[r];
#pragma unroll
  for (int r = 0; r < 16; ++r) ps += p1[r];
  { auto rr = __builtin_amdgcn_permlane32_swap(__float_as_uint(ps), __float_as_uint(ps), false, false);
    ps = __uint_as_float(rr[0]) + __uint_as_float(rr[1]); }
  l_reg = l_reg * alpha + ps;
#define PK4(P, BASE, OUT) do { unsigned a0 = cvtpk(P[BASE + 0], P[BASE + 1]), a1 = cvtpk(P[BASE + 2], P[BASE + 3]);   \
    unsigned b0 = cvtpk(P[BASE + 4], P[BASE + 5]), b1 = cvtpk(P[BASE + 6], P[BASE + 7]);                              \
    auto r0 = __builtin_amdgcn_permlane32_swap(a0, b0, false, false); auto r1 = __builtin_amdgcn_permlane32_swap(a1, b1, false, false); \
    u32x4 w = {r0[0], r1[0], r0[1], r1[1]}; OUT = *reinterpret_cast<bf16x8*>(&w); } while (0)
  PK4(p0, 0, pa0); PK4(p0, 8, pa1); PK4(p1, 0, pa2); PK4(p1, 8, pa3);
#undef PK4
}

typedef float f32x2v __attribute__((ext_vector_type(2)));
__device__ __forceinline__ void cnt_ge(int& cnt, unsigned a, unsigned b) { asm volatile("v_cmp_ge_u32_e32 vcc, %1, %2\n\tv_addc_co_u32_e32 %0, vcc, 0, %0, vcc" : "+v"(cnt) : "v"(a), "v"(b) : "vcc"); }
__device__ __forceinline__ void cnt_gt(int& cnt, unsigned a, unsigned b) { asm volatile("v_cmp_gt_u32_e32 vcc, %1, %2\n\tv_addc_co_u32_e32 %0, vcc, 0, %0, vcc" : "+v"(cnt) : "v"(a), "v"(b) : "vcc"); }
__device__ __forceinline__ void cnt_ge4(int& c0, int& c1, int& c2, int& c3, unsigned k0, unsigned k1, unsigned k2, unsigned k3, unsigned b) {
  unsigned long long m0, m1, m2, m3;
  asm volatile("v_cmp_ge_u32_e64 %4, %8, %12\n\tv_cmp_ge_u32_e64 %5, %9, %12\n\tv_cmp_ge_u32_e64 %6, %10, %12\n\tv_cmp_ge_u32_e64 %7, %11, %12\n\t"
               "v_addc_co_u32_e64 %0, %4, 0, %0, %4\n\tv_addc_co_u32_e64 %1, %5, 0, %1, %5\n\tv_addc_co_u32_e64 %2, %6, 0, %2, %6\n\tv_addc_co_u32_e64 %3, %7, 0, %3, %7"
               : "+v"(c0), "+v"(c1), "+v"(c2), "+v"(c3), "=&s"(m0), "=&s"(m1), "=&s"(m2), "=&s"(m3) : "v"(k0), "v"(k1), "v"(k2), "v"(k3), "v"(b));
}
__device__ __forceinline__ unsigned wlane(unsigned val, int ln, unsigned old) { asm volatile("v_writelane_b32 %0, %1, %2" : "+v"(old) : "s"(val), "s"(ln)); return old; }
__device__ __forceinline__ int half_sum(int x, int hi) {
  x += __builtin_amdgcn_update_dpp(0, x, 0x111, 0xf, 0xf, true);
  x += __builtin_amdgcn_update_dpp(0, x, 0x112, 0xf, 0xf, true);
  x += __builtin_amdgcn_update_dpp(0, x, 0x114, 0xf, 0xf, true);
  x += __builtin_amdgcn_update_dpp(0, x, 0x118, 0xf, 0xf, true);
  const int a = __builtin_amdgcn_readlane(x, 15) + __builtin_amdgcn_readlane(x, 31);
  const int b = __builtin_amdgcn_readlane(x, 47) + __builtin_amdgcn_readlane(x, 63);
  return hi ? b : a;
}
__device__ __forceinline__ unsigned take_low(unsigned m, int k) {
  while (__builtin_popcount(m) > k) m &= ~(0x80000000u >> __builtin_clz(m));
  return m;
}

__device__ __forceinline__ void dsa_select(const bf16* __restrict__ PROJ, int b, int q0, unsigned* SEL, char* lds) {
  int tid = my_tid(); asm volatile("" : "+v"(tid));
  const int wid = __builtin_amdgcn_readfirstlane(tid >> 6), lane = tid & 63, r32 = lane & 31, hi = lane >> 5;
  const size_t tokb = (size_t)b * SEQ;
  const int nt32 = (q0 >> 5) + 1, nch = (nt32 + 15) >> 4;
  const int srow = wid * 64 + (lane >> 3), spc = lane & 7;
  const unsigned sloff = (unsigned)((srow * LDP + 8 * spc) * 2);
  const __amdgpu_buffer_rsrc_t srd = __builtin_amdgcn_make_buffer_rsrc((void*)(PROJ + tokb * LDP + C_IK), (short)0, (int)(SEQ * LDP * 2), 0x00020000);
  bf16x8 af[4]; float w[16]; bf16x8 st[8];
#define DSA_LOADS(RD) do { const int tA_ = q0 + (RD) * 16 + wid * 2; \
    const bf16* ap_ = PROJ + (tokb + tA_ + (r32 >> 4)) * LDP + C_IQ + (r32 & 15) * 64 + hi * 8; \
    _Pragma("unroll") for (int ks = 0; ks < 4; ++ks) af[ks] = ld8(ap_ + ks * 16); \
    _Pragma("unroll") for (int r = 0; r < 16; ++r) { const int head = (r & 3) + 8 * ((r >> 2) & 1) + 4 * hi; w[r] = bf2f(PROJ[(tokb + tA_ + (r >> 3)) * LDP + C_IW + head]); } \
    _Pragma("unroll") for (int i = 0; i < 8; ++i) st[i] = __builtin_bit_cast(bf16x8, __builtin_amdgcn_raw_buffer_load_b128(srd, (int)(sloff + (unsigned)(8 * i * LDP * 2)), 0, 0)); } while (0)
  DSA_LOADS(0);
  for (int rd = 0; rd < 2; ++rd) {
    const int tl = rd * 16 + wid * 2, tA = q0 + tl;
#pragma unroll
    for (int r = 0; r < 16; ++r) w[r] *= 0.5f;
    const int myq = tA + hi;
    unsigned key[64];
#pragma unroll
    for (int c = 0; c < 4; ++c) {
      if (c < nch) {
        char* buf = lds + (c & 1) * 65536;
#pragma unroll
        for (int i = 0; i < 8; ++i) { const int row = srow + 8 * i; *reinterpret_cast<bf16x8*>(buf + row * 128 + ((spc ^ ((row >> 1) & 7)) << 4)) = st[i]; }
        if (c + 1 < nch) {
#pragma unroll
          for (int i = 0; i < 8; ++i) st[i] = __builtin_bit_cast(bf16x8, __builtin_amdgcn_raw_buffer_load_b128(srd, (int)(sloff + (unsigned)(8 * i * LDP * 2)), 512 * (c + 1) * LDP * 2, 0));
        }
        __syncthreads();
#define IDX_MMA(CC, U) do { const int row_ = 32 * (U) + r32; CC = f32x16{}; _Pragma("unroll") for (int ks = 0; ks < 4; ++ks) { \
            const bf16x8 bfr = *reinterpret_cast<const bf16x8*>(buf + row_ * 128 + (((2 * ks + hi) ^ ((row_ >> 1) & 7)) << 4)); CC = __builtin_amdgcn_mfma_f32_32x32x16_bf16(af[ks], bfr, CC, 0, 0, 0); } } while (0)
#define IDX_RED(CC, U) do { const int j_ = 16 * c + (U); f32x2v l0 = {0.f, 0.f}, l1 = {0.f, 0.f}; \
          _Pragma("unroll") for (int i = 0; i < 4; ++i) { l0 = __builtin_elementwise_fma((f32x2v){w[2 * i], w[2 * i + 1]}, (f32x2v){CC[2 * i], CC[2 * i + 1]}, l0); \
                                                          l1 = __builtin_elementwise_fma((f32x2v){w[8 + 2 * i], w[9 + 2 * i]}, (f32x2v){CC[8 + 2 * i], CC[9 + 2 * i]}, l1); } \
          float s0 = l0[0] + l0[1], s1 = l1[0] + l1[1]; \
          _Pragma("unroll") for (int r = 0; r < 8; ++r) { asm("v_fma_f32 %0, %1, |%2|, %0" : "+v"(s0) : "v"(w[r]), "v"(CC[r])); asm("v_fma_f32 %0, %1, |%2|, %0" : "+v"(s1) : "v"(w[8 + r]), "v"(CC[8 + r])); } \
          auto rr = __builtin_amdgcn_permlane32_swap(__float_as_uint(s0), __float_as_uint(s1), false, false); \
          const float tot = __uint_as_float(rr[0]) + __uint_as_float(rr[1]); \
          const unsigned bits = __float_as_uint(tot); \
          const unsigned srt = bits ^ ((unsigned)((int)bits >> 31) | 0x80000000u); \
          key[j_] = (j_ * 32 + r32 <= myq) ? srt : 0u; } while (0)
#if defined(DSK) && DSK == 3
        { f32x16 ccA, ccB; IDX_MMA(ccA, 0);
#pragma unroll
          for (int u = 0; u < 16; u += 2) { IDX_MMA(ccB, u + 1); IDX_RED(ccA, u); __builtin_amdgcn_sched_barrier(0); if (u + 2 < 16) IDX_MMA(ccA, u + 2); IDX_RED(ccB, u + 1); __builtin_amdgcn_sched_barrier(0); } }
        _Pragma("unroll") for (int u = 0; u < 16; ++u) asm volatile("" :: "v"(key[16 * c + u]));
#endif
        { f32x16 ccA, ccB; IDX_MMA(ccA, 0);
#pragma unroll
          for (int u = 0; u < 16; u += 2) { IDX_MMA(ccB, u + 1); IDX_RED(ccA, u); __builtin_amdgcn_sched_barrier(0); if (u + 2 < 16) IDX_MMA(ccA, u + 2); IDX_RED(ccB, u + 1); __builtin_amdgcn_sched_barrier(0); } }
#undef IDX_MMA
#undef IDX_RED
      } else {
#pragma unroll
        for (int u = 0; u < 16; ++u) key[16 * c + u] = 0u;
      }
    }
    __syncthreads();
    if (rd == 0) DSA_LOADS(1);
    unsigned T = 0u;
    if (tA + 2 > 256) {
      for (int bit = 31; bit >= 0; --bit) {
        const unsigned cand = T | (1u << bit);
        int cnt = 0;
#pragma unroll
        for (int cc = 0; cc < 8; ++cc) { if (cc * 8 < nt32) {
#pragma unroll
          for (int e = 0; e < 8; ++e) cnt_ge(cnt, key[cc * 8 + e], cand); } }
        const int tot = half_sum(cnt, hi);
        if (tot >= 256) T = cand;
        if (__all(tot == 256)) break;
      }
    }
    const unsigned Tm = T > 1u ? T : 1u;
    int cge = 0;
#pragma unroll
    for (int cc = 0; cc < 8; ++cc) { if (cc * 8 < nt32) {
#pragma unroll
      for (int e = 0; e < 8; ++e) cnt_ge(cge, key[cc * 8 + e], Tm); } }
    cge = half_sum(cge, hi);
    int ln = lane; asm volatile("" : "+v"(ln));
    unsigned m0 = 0xffffffffu, m1 = 0xffffffffu;
    if (__all(cge <= 256)) {
#pragma unroll
      for (int j = 0; j < 64; ++j) {
        const unsigned long long bal = __ballot(!(key[j] >= Tm));
        m0 = (ln == j) ? (unsigned)bal : m0; m1 = (ln == j) ? (unsigned)(bal >> 32) : m1; }
    } else {
      unsigned* kst = (unsigned*)(lds + wid * 16384);
#pragma unroll
      for (int j = 0; j < 64; ++j) kst[j * 64 + lane] = key[j];
      int cgt = 0;
#pragma unroll
      for (int cc = 0; cc < 8; ++cc) { if (cc * 8 < nt32) {
#pragma unroll
        for (int e = 0; e < 8; ++e) cnt_gt(cgt, key[cc * 8 + e], Tm); } }
      cgt = half_sum(cgt, hi);
      int need_lo = 256 - __builtin_amdgcn_readlane(cgt, 0), need_hi = 256 - __builtin_amdgcn_readlane(cgt, 32);
#pragma unroll 1
      for (int j = 0; j < 64; ++j) {
        const unsigned kj = kst[j * 64 + lane];
        const unsigned long long eqm = __ballot(kj == Tm), gtm = __ballot(kj > Tm);
        const unsigned tl_ = take_low((unsigned)eqm, need_lo > 0 ? need_lo : 0), th_ = take_low((unsigned)(eqm >> 32), need_hi > 0 ? need_hi : 0);
        need_lo -= __builtin_popcount(tl_); need_hi -= __builtin_popcount(th_);
        const unsigned sl = (unsigned)gtm | tl_, sh = (unsigned)(gtm >> 32) | th_;
        m0 = (ln == j) ? ~sl : m0; m1 = (ln == j) ? ~sh : m1; }
    }
    SEL[tl * 64 + lane] = m0; SEL[(tl + 1) * 64 + lane] = m1;
    __syncthreads();
  }
#undef DSA_LOADS
}

template <int MODE>
__device__ __forceinline__ void attn_unit(const bf16* __restrict__ PROJ, unsigned char* __restrict__ ATT, int b, int h, int qb, char* lds, float lam, const float* __restrict__ subln_g) {
  if (MODE == 1) { dsa_select(PROJ, b, qb * 32, (unsigned*)(lds + L_SEL), lds); __syncthreads(); }
  int tid = my_tid(); asm volatile("" : "+v"(tid));
  const int wid = __builtin_amdgcn_readfirstlane(tid >> 6), lane = tid & 63, r32 = lane & 31, hi = lane >> 5;
  constexpr int ND0 = MODE == 0 ? 4 : 8;
  const int q0 = MODE == 0 ? qb * 128 : qb * 32;
  const int wq = MODE == 0 ? (wid & 3) * 32 : 0;
  const int c = MODE == 0 ? (wid >> 2) : 0;
  const int qpos = q0 + wq + r32;
  const size_t tokb = (size_t)b * SEQ;
  const bf16* Qw = PROJ + (tokb + qpos) * LDP + (MODE == 0 ? C_DQ + h * 128 + c * 64 : C_SQ + wid * 128) + hi * 8;
  const bf16* Kh = PROJ + tokb * LDP + (MODE == 0 ? C_DK + h * 128 : C_SK);
  const bf16* Vh = PROJ + tokb * LDP + (MODE == 0 ? C_DV + h * 128 : C_SV);
  const int NT = MODE == 0 ? 2 * (qb + 1) : 2 * ((q0 + 32 + 127) >> 7);
  const float slope2 = (MODE == 0 ? exp2f(-0.5f * (float)(2 * h + 1)) : exp2f(-(float)(wid + 1))) * LOG2E;
  const float Cs = (MODE == 0 ? 0.125f : 0.08838834764831845f) * LOG2E / slope2;
  const float thr = THR2 / slope2, c32 = 32.f * slope2;
  char* V_lds = lds + L_V; char* K_lds = lds + L_K;
  float* ws = (float*)(lds + L_WS) + wid * 64; float* li_l = ws; float* al_l = ws + 32;
  unsigned* SEL = (unsigned*)(lds + L_SEL);
  const char* selrow = (const char*)(SEL + r32 * 64);

  float m_reg = -1e30f, l_reg = 0; f32x16 o[4] = {}; bf16x8 qr[ND0];
#pragma unroll
  for (int d0 = 0; d0 < ND0; ++d0) qr[d0] = ld8(Qw + d0 * 16);
  const int sr = tid >> 4, sc = (tid & 15) * 8, vst0 = v_st(sr, sc), vst1 = v_st(32 + sr, sc);
  const int vb0 = (int)(uintptr_t)V_lds + v_rd_base(lane);
  struct { bf16x8 vs0, vs1, ks0, ks1; } sr_[SDEPTH];
#define SLOAD(i, k0) do { sr_[i].vs0 = ld8(&Vh[(size_t)((k0) + sr) * LDP + sc]); sr_[i].vs1 = ld8(&Vh[(size_t)((k0) + 32 + sr) * LDP + sc]); \
    sr_[i].ks0 = ld8(&Kh[(size_t)((k0) + sr) * LDP + sc]); sr_[i].ks1 = ld8(&Kh[(size_t)((k0) + 32 + sr) * LDP + sc]); } while (0)
#define SWRITE(bb, i) do { *(bf16x8*)(V_lds + (bb) * SHM_V + vst0) = sr_[i].vs0;          \
    *(bf16x8*)(V_lds + (bb) * SHM_V + vst1) = sr_[i].vs1; const int kc = sc * 2;               \
    *(bf16x8*)(K_lds + (bb) * SHM_K + KSWZ(sr, kc)) = sr_[i].ks0;                       \
    *(bf16x8*)(K_lds + (bb) * SHM_K + KSWZ(32 + sr, kc)) = sr_[i].ks1; } while (0)
#define SWAIT() do { if constexpr (SDEPTH == 2) asm volatile("s_waitcnt vmcnt(4)" ::: "memory"); else asm volatile("s_waitcnt vmcnt(0)" ::: "memory"); } while (0)
#define RESC(a) do { if (__any((a) < 1.f)) { if (hi == 0) al_l[r32] = (a); asm volatile("s_waitcnt lgkmcnt(0)" ::: "memory"); \
    _Pragma("unroll") for (int d = 0; d < 4; ++d) _Pragma("unroll") for (int r = 0; r < 16; ++r) o[d][r] *= al_l[crow(r, hi)]; } } while (0)
#define DIAG(k0) ((k0) + 63 > q0 + wq)
  f32x16 pA0, pA1, pB0, pB1; float ofA, ofB, alA, alB; bool deadA = false, deadB = false; bf16x8 pa0, pa1, pa2, pa3;
  constexpr int SE = 0, SO = SDEPTH - 1;
  static_assert(SDEPTH == 1, "the tile loop below is written for one staging register set");
#define KT(i) ((MODE == 0 ? (NT - 1 - (i)) : (i)) * 64)
  SLOAD(SE, KT(0)); asm volatile("s_waitcnt vmcnt(0)" ::: "memory"); SWRITE(0, SE); SLOAD(SE, KT(1)); __syncthreads();
  qkt<ND0>(pA0, pA1, K_lds, qr, r32, hi, c * 4); partialSM<MODE>(pA0, pA1, Cs, slope2, thr, KT(0), qpos, hi, selrow, DIAG(KT(0)), m_reg, ofA, alA, deadA);
  SWAIT(); SWRITE(1, SO); if (2 < NT) SLOAD(SE, KT(2)); __syncthreads();
  for (int j = 1; j + 1 < NT; j += 2) {
    SBAR(); qkt<ND0>(pB0, pB1, K_lds + SHM_K, qr, r32, hi, c * 4);
    if (!deadA) { finishSM(pA0, pA1, slope2, ofA + c32, alA, l_reg, pa0, pa1, pa2, pa3); } SBAR();
    if (!deadA) { pv_d0(o, vb0, pa0, pa1, pa2, pa3); } partialSM<MODE>(pB0, pB1, Cs, slope2, thr, KT(j), qpos, hi, selrow, DIAG(KT(j)), m_reg, ofB, alB, deadB);
    __syncthreads(); SWAIT(); SWRITE(0, SE); SLOAD(SE, KT(j + 2));
    RESC(alB); __syncthreads();
    SBAR(); qkt<ND0>(pA0, pA1, K_lds, qr, r32, hi, c * 4);
    if (!deadB) { finishSM(pB0, pB1, slope2, ofB + c32, alB, l_reg, pa0, pa1, pa2, pa3); } SBAR();
    if (!deadB) { pv_d0(o, vb0 + SHM_V, pa0, pa1, pa2, pa3); } partialSM<MODE>(pA0, pA1, Cs, slope2, thr, KT(j + 1), qpos, hi, selrow, DIAG(KT(j + 1)), m_reg, ofA, alA, deadA);
    __syncthreads(); SWAIT(); SWRITE(1, SO); if (j + 3 < NT) SLOAD(SO, KT(j + 3));
    RESC(alA); __syncthreads();
  }
  SBAR(); qkt<ND0>(pB0, pB1, K_lds + SHM_K, qr, r32, hi, c * 4);
  if (!deadA) { finishSM(pA0, pA1, slope2, ofA + c32, alA, l_reg, pa0, pa1, pa2, pa3); } SBAR();
  if (!deadA) { pv_d0(o, vb0, pa0, pa1, pa2, pa3); } partialSM<MODE>(pB0, pB1, Cs, slope2, thr, KT(NT - 1), qpos, hi, selrow, DIAG(KT(NT - 1)), m_reg, ofB, alB, deadB);
  __syncthreads(); RESC(alB);
  if (!deadB) { finishSM(pB0, pB1, slope2, ofB + c32, alB, l_reg, pa0, pa1, pa2, pa3); } SBAR();
  if (!deadB) { pv_d0(o, vb0 + SHM_V, pa0, pa1, pa2, pa3); }
#undef KT
#undef SLOAD
#undef SWRITE
#undef SWAIT
#undef RESC
#undef DIAG
  if (hi == 0) li_l[r32] = l_reg; asm volatile("s_waitcnt lgkmcnt(0)" ::: "memory");
  {
    float rli[16];
#pragma unroll
    for (int r = 0; r < 16; ++r) rli[r] = __builtin_amdgcn_rcpf(li_l[crow(r, hi)]);
#pragma unroll
    for (int d0 = 0; d0 < 4; ++d0)
#pragma unroll
      for (int r = 0; r < 16; ++r) o[d0][r] *= rli[r];
  }
  __syncthreads();
  if (MODE == 0) {
    float* X = (float*)lds;
    if (wid >= 4) {
#pragma unroll
      for (int d0 = 0; d0 < 4; ++d0)
#pragma unroll
        for (int r = 0; r < 16; ++r) X[(wid - 4) * 4096 + crow(r, hi) * 128 + d0 * 32 + r32] = o[d0][r];
    }
    __syncthreads();
    if (wid < 4) {
#pragma unroll
      for (int d0 = 0; d0 < 4; ++d0)
#pragma unroll
        for (int r = 0; r < 16; ++r) o[d0][r] -= lam * X[wid * 4096 + crow(r, hi) * 128 + d0 * 32 + r32];
    }
    __syncthreads();
  }
  if (MODE == 1 || wid < 4) {
    bf16* stg = (bf16*)(lds + wid * 8704);
#pragma unroll
    for (int d0 = 0; d0 < 4; ++d0)
#pragma unroll
      for (int r = 0; r < 16; r += 2) {
        const unsigned pk = cvtpk(o[d0][r], o[d0][r + 1]);
        stg[crow(r, hi) * 136 + d0 * 32 + r32] = (bf16)(pk & 0xffffu);
        stg[crow(r + 1, hi) * 136 + d0 * 32 + r32] = (bf16)(pk >> 16);
      }
    asm volatile("s_waitcnt lgkmcnt(0)" ::: "memory");
    bf16x8 v[8];
#pragma unroll
    for (int j = 0; j < 8; ++j) v[j] = *reinterpret_cast<const bf16x8*>(stg + r32 * 136 + hi * 64 + j * 8);
    unsigned char* orow = ATT + (tokb + q0 + wq + r32) * DM + (MODE == 0 ? h * 128 : 1024 + wid * 128) + hi * 64;
    float rs = 1.0f;
    if (MODE == 0) {
      float ss = 0.f;
#pragma unroll
      for (int j = 0; j < 8; ++j)
#pragma unroll
        for (int e = 0; e < 8; ++e) { const float x = bf2f((bf16)v[j][e]); ss = fmaf(x, x, ss); }
      { auto rr = __builtin_amdgcn_permlane32_swap(__float_as_uint(ss), __float_as_uint(ss), false, false);
        ss = __uint_as_float(rr[0]) + __uint_as_float(rr[1]); }
      rs = __builtin_amdgcn_rsqf(ss * (1.0f / 128.0f) + RMS_EPS) * (1.0f - LAM_INIT);
    }
#pragma unroll
    for (int jj = 0; jj < 4; ++jj) { u32x4 w;
#pragma unroll
      for (int q = 0; q < 4; ++q) { float y[4];
#pragma unroll
        for (int e = 0; e < 4; ++e) { const int idx = 16 * jj + 4 * q + e; float x = bf2f((bf16)v[idx >> 3][idx & 7]); if (MODE == 0) x = x * rs * subln_g[hi * 64 + idx]; y[e] = x; }
        int p = __builtin_amdgcn_cvt_pk_fp8_f32(y[0], y[1], 0, false); p = __builtin_amdgcn_cvt_pk_fp8_f32(y[2], y[3], p, true); w[q] = (unsigned)p; }
      *reinterpret_cast<u32x4*>(orow + jj * 16) = w; }
  }
  __syncthreads();
}
}

typedef float f32x4 __attribute__((ext_vector_type(4)));
typedef unsigned u32x4 __attribute__((ext_vector_type(4)));
typedef unsigned u32x2 __attribute__((ext_vector_type(2)));
__device__ __forceinline__ unsigned cvt_pk(float lo, float hi) { unsigned r; asm volatile("v_cvt_pk_bf16_f32 %0, %1, %2" : "=v"(r) : "v"(lo), "v"(hi)); return r; }
__device__ __forceinline__ float bf_lo(unsigned w) { return __uint_as_float(w << 16); }
__device__ __forceinline__ float bf_hi(unsigned w) { return __uint_as_float(w & 0xffff0000u); }
__device__ __forceinline__ float wave_sum(float v) {
#pragma unroll
  for (int o = 1; o < 64; o <<= 1) v += __shfl_xor(v, o);
  return v;
}

__device__ __forceinline__ void cvt_stream(const float* __restrict__ src, bf16* __restrict__ dst, size_t n8, size_t gtid, size_t gsz) {
  for (size_t i = gtid; i < n8; i += gsz) {
    const f32x4 a = *reinterpret_cast<const f32x4*>(src + i * 8), b = *reinterpret_cast<const f32x4*>(src + i * 8 + 4);
    u32x4 w = {cvt_pk(a[0], a[1]), cvt_pk(a[2], a[3]), cvt_pk(b[0], b[1]), cvt_pk(b[2], b[3])};
    *reinterpret_cast<u32x4*>(dst + i * 8) = w;
  }
}
__device__ __forceinline__ void cvt_stream2(const float* __restrict__ src, bf16* __restrict__ dst, unsigned char* __restrict__ dst8, size_t n8, size_t gtid, size_t gsz) {
  for (size_t i0 = gtid; i0 < n8; i0 += 4 * gsz) {
    f32x4 a[4], b[4];
#pragma unroll
    for (int q = 0; q < 4; ++q) { const size_t i = i0 + q * gsz; if (i < n8) { a[q] = *reinterpret_cast<const f32x4*>(src + i * 8); b[q] = *reinterpret_cast<const f32x4*>(src + i * 8 + 4); } }
#pragma unroll
    for (int q = 0; q < 4; ++q) { const size_t i = i0 + q * gsz; if (i < n8) {
      u32x4 w = {cvt_pk(a[q][0], a[q][1]), cvt_pk(a[q][2], a[q][3]), cvt_pk(b[q][0], b[q][1]), cvt_pk(b[q][2], b[q][3])};
      *reinterpret_cast<u32x4*>(dst + i * 8) = w;
      int p0 = __builtin_amdgcn_cvt_pk_fp8_f32(a[q][0], a[q][1], 0, false); p0 = __builtin_amdgcn_cvt_pk_fp8_f32(a[q][2], a[q][3], p0, true);
      int p1 = __builtin_amdgcn_cvt_pk_fp8_f32(b[q][0], b[q][1], 0, false); p1 = __builtin_amdgcn_cvt_pk_fp8_f32(b[q][2], b[q][3], p1, true);
      *reinterpret_cast<u32x2*>(dst8 + i * 8) = (u32x2){(unsigned)p0, (unsigned)p1}; } }
  }
}
__device__ __forceinline__ void transpose_item(const float* __restrict__ W, int K, int N, bf16* __restrict__ WT, LAS float* scr, int kb, int nb, int lane) {
  const int k0 = 64 * kb, n0 = 32 * nb; const int nn = n0 + (lane & 31); const bool ok = nn < N;
  float tv[32];
#pragma unroll
  for (int i = 0; i < 32; ++i) { const int kk = 2 * i + (lane >> 5); tv[i] = ok ? W[(size_t)(k0 + kk) * N + nn] : 0.f; }
#pragma unroll
  for (int i = 0; i < 32; ++i) { const int kk = 2 * i + (lane >> 5); scr[kk * 33 + (lane & 31)] = tv[i]; }
  asm volatile("s_waitcnt lgkmcnt(0)" ::: "memory");
  const int c = lane & 7;
#pragma unroll
  for (int j = 0; j < 4; ++j) { const int n = (lane >> 3) + 8 * j; const LAS float* s = scr + (8 * c) * 33 + n;
    u32x4 o; o.x = cvt_pk(s[0 * 33], s[1 * 33]); o.y = cvt_pk(s[2 * 33], s[3 * 33]); o.z = cvt_pk(s[4 * 33], s[5 * 33]); o.w = cvt_pk(s[6 * 33], s[7 * 33]);
    *reinterpret_cast<u32x4*>(WT + (size_t)(n0 + n) * K + k0 + 8 * c) = o; }
  asm volatile("s_waitcnt lgkmcnt(0)" ::: "memory");
}

__device__ __forceinline__ void transpose_item_fp8(const float* __restrict__ W, int K, int N, unsigned char* __restrict__ WT, LAS float* scr, int kb, int nb, int lane, float scale) {
  const int k0 = 64 * kb, n0 = 32 * nb; const int nn = n0 + (lane & 31); const bool ok = nn < N;
  float tv[32];
#pragma unroll
  for (int i = 0; i < 32; ++i) { const int kk = 2 * i + (lane >> 5); tv[i] = ok ? W[(size_t)(k0 + kk) * N + nn] * scale : 0.f; }
#pragma unroll
  for (int i = 0; i < 32; ++i) { const int kk = 2 * i + (lane >> 5); scr[kk * 33 + (lane & 31)] = tv[i]; }
  asm volatile("s_waitcnt lgkmcnt(0)" ::: "memory");
  const int c = lane & 7;
#pragma unroll
  for (int j = 0; j < 4; ++j) { const int n = (lane >> 3) + 8 * j; const LAS float* s = scr + (8 * c) * 33 + n;
    int p0 = __builtin_amdgcn_cvt_pk_fp8_f32(s[0 * 33], s[1 * 33], 0, false); p0 = __builtin_amdgcn_cvt_pk_fp8_f32(s[2 * 33], s[3 * 33], p0, true);
    int p1 = __builtin_amdgcn_cvt_pk_fp8_f32(s[4 * 33], s[5 * 33], 0, false); p1 = __builtin_amdgcn_cvt_pk_fp8_f32(s[6 * 33], s[7 * 33], p1, true);
    *reinterpret_cast<u32x2*>(WT + (size_t)(n0 + n) * K + k0 + 8 * c) = (u32x2){(unsigned)p0, (unsigned)p1}; }
  asm volatile("s_waitcnt lgkmcnt(0)" ::: "memory");
}

__device__ __forceinline__ void ln1_phase(const bf16* __restrict__ Z, const float* __restrict__ g, const float* __restrict__ bta, bf16* __restrict__ OB, unsigned char* __restrict__ O8, int gw, int ngw, int lane) {
  f32x4 gv[8], bv[8];
#pragma unroll
  for (int j = 0; j < 4; ++j) { const int e0 = 512 * j + 8 * lane;
    gv[2 * j] = *reinterpret_cast<const f32x4*>(g + e0); gv[2 * j + 1] = *reinterpret_cast<const f32x4*>(g + e0 + 4);
    bv[2 * j] = *reinterpret_cast<const f32x4*>(bta + e0); bv[2 * j + 1] = *reinterpret_cast<const f32x4*>(bta + e0 + 4); }
  u32x4 nx[4];
  if (gw < NTOK) {
#pragma unroll
    for (int j = 0; j < 4; ++j) nx[j] = *reinterpret_cast<const u32x4*>(Z + (size_t)gw * DM + 512 * j + 8 * lane); }
  for (int m = gw; m < NTOK; m += ngw) {
    float v[32]; float s = 0.f;
#pragma unroll
    for (int j = 0; j < 4; ++j) {
#pragma unroll
      for (int q = 0; q < 4; ++q) { v[8 * j + 2 * q] = bf_lo(nx[j][q]); v[8 * j + 2 * q + 1] = bf_hi(nx[j][q]); } }
    if (m + ngw < NTOK) {
#pragma unroll
      for (int j = 0; j < 4; ++j) nx[j] = *reinterpret_cast<const u32x4*>(Z + (size_t)(m + ngw) * DM + 512 * j + 8 * lane); }
#pragma unroll
    for (int i = 0; i < 32; ++i) s += v[i];
    const float mean = wave_sum(s) * (1.f / DM); float s2 = 0.f;
#pragma unroll
    for (int i = 0; i < 32; ++i) { v[i] -= mean; s2 = fmaf(v[i], v[i], s2); }
    const float rstd = 1.0f / sqrtf(wave_sum(s2) * (1.f / DM) + LN_EPS);
    bf16* obrow = OB + (size_t)m * DM; unsigned char* o8row = O8 + (size_t)m * DM;
#pragma unroll
    for (int j = 0; j < 4; ++j) {
      const int e0 = 512 * j + 8 * lane;
      float y[8];
#pragma unroll
      for (int e = 0; e < 4; ++e) { y[e] = v[8 * j + e] * rstd * gv[2 * j][e] + bv[2 * j][e]; y[4 + e] = v[8 * j + 4 + e] * rstd * gv[2 * j + 1][e] + bv[2 * j + 1][e]; }
      u32x4 w = {cvt_pk(y[0], y[1]), cvt_pk(y[2], y[3]), cvt_pk(y[4], y[5]), cvt_pk(y[6], y[7])}; *reinterpret_cast<u32x4*>(obrow + e0) = w;
      int p0 = __builtin_amdgcn_cvt_pk_fp8_f32(y[0], y[1], 0, false); p0 = __builtin_amdgcn_cvt_pk_fp8_f32(y[2], y[3], p0, true);
      int p1 = __builtin_amdgcn_cvt_pk_fp8_f32(y[4], y[5], 0, false); p1 = __builtin_amdgcn_cvt_pk_fp8_f32(y[6], y[7], p1, true);
      *reinterpret_cast<u32x2*>(o8row + e0) = (u32x2){(unsigned)p0, (unsigned)p1};
    }
  }
}

namespace peer {
using bf16x8 = att::bf16x8; using f32x16 = att::f32x16;
constexpr int L_K1 = 0, L_K2 = 32768, L_SCR = 65536;
__device__ __forceinline__ unsigned srt(float x) { const unsigned b = __float_as_uint(x); return b ^ ((unsigned)((int)b >> 31) | 0x80000000u); }
__device__ __forceinline__ float unsrt(unsigned u) { const unsigned b = (u & 0x80000000u) ? (u ^ 0x80000000u) : ~u; return __uint_as_float(b); }
__device__ __forceinline__ unsigned umax(unsigned a, unsigned b) { return a > b ? a : b; }
__device__ __forceinline__ unsigned pair_max(unsigned m) {
  auto rr = __builtin_amdgcn_permlane32_swap(m, m, false, false); return umax(rr[0], rr[1]);
}
__device__ __forceinline__ void load_keys(const float* __restrict__ k1, const float* __restrict__ k2, char* lds) {
  for (int i = my_tid(); i < 2 * 128 * 16; i += 512) {
    const int t = i >> 11, row = (i >> 4) & 127, ch = i & 15; const float* src = (t ? k2 : k1) + row * 128 + ch * 8;
    const f32x4 a = *reinterpret_cast<const f32x4*>(src), b = *reinterpret_cast<const f32x4*>(src + 4);
    u32x4 w = {cvt_pk(a[0], a[1]), cvt_pk(a[2], a[3]), cvt_pk(b[0], b[1]), cvt_pk(b[2], b[3])};
    *reinterpret_cast<u32x4*>(lds + (t ? L_K2 : L_K1) + KSWZ(row, ch * 16)) = w;
  }
}
#define PK_CE(a, b) do { const unsigned hi_ = (a) > (b) ? (a) : (b), lo_ = (a) > (b) ? (b) : (a); (a) = hi_; (b) = lo_; } while (0)
__device__ __forceinline__ void sort16_desc(unsigned (&v)[64], const int base) {
  PK_CE(v[base + 0], v[base + 1]);
  PK_CE(v[base + 2], v[base + 3]);
  PK_CE(v[base + 0], v[base + 2]);
  PK_CE(v[base + 1], v[base + 3]);
  PK_CE(v[base + 1], v[base + 2]);
  PK_CE(v[base + 4], v[base + 5]);
  PK_CE(v[base + 6], v[base + 7]);
  PK_CE(v[base + 4], v[base + 6]);
  PK_CE(v[base + 5], v[base + 7]);
  PK_CE(v[base + 5], v[base + 6]);
  PK_CE(v[base + 0], v[base + 4]);
  PK_CE(v[base + 2], v[base + 6]);
  PK_CE(v[base + 2], v[base + 4]);
  PK_CE(v[base + 1], v[base + 5]);
  PK_CE(v[base + 3], v[base + 7]);
  PK_CE(v[base + 3], v[base + 5]);
  PK_CE(v[base + 1], v[base + 2]);
  PK_CE(v[base + 3], v[base + 4]);
  PK_CE(v[base + 5], v[base + 6]);
  PK_CE(v[base + 8], v[base + 9]);
  PK_CE(v[base + 10], v[base + 11]);
  PK_CE(v[base + 8], v[base + 10]);
  PK_CE(v[base + 9], v[base + 11]);
  PK_CE(v[base + 9], v[base + 10]);
  PK_CE(v[base + 12], v[base + 13]);
  PK_CE(v[base + 14], v[base + 15]);
  PK_CE(v[base + 12], v[base + 14]);
  PK_CE(v[base + 13], v[base + 15]);
  PK_CE(v[base + 13], v[base + 14]);
  PK_CE(v[base + 8], v[base + 12]);
  PK_CE(v[base + 10], v[base + 14]);
  PK_CE(v[base + 10], v[base + 12]);
  PK_CE(v[base + 9], v[base + 13]);
  PK_CE(v[base + 11], v[base + 15]);
  PK_CE(v[base + 11], v[base + 13]);
  PK_CE(v[base + 9], v[base + 10]);
  PK_CE(v[base + 11], v[base + 12]);
  PK_CE(v[base + 13], v[base + 14]);
  PK_CE(v[base + 0], v[base + 8]);
  PK_CE(v[base + 4], v[base + 12]);
  PK_CE(v[base + 4], v[base + 8]);
  PK_CE(v[base + 2], v[base + 10]);
  PK_CE(v[base + 6], v[base + 14]);
  PK_CE(v[base + 6], v[base + 10]);
  PK_CE(v[base + 2], v[base + 4]);
  PK_CE(v[base + 6], v[base + 8]);
  PK_CE(v[base + 10], v[base + 12]);
  PK_CE(v[base + 1], v[base + 9]);
  PK_CE(v[base + 5], v[base + 13]);
  PK_CE(v[base + 5], v[base + 9]);
  PK_CE(v[base + 3], v[base + 11]);
  PK_CE(v[base + 7], v[base + 15]);
  PK_CE(v[base + 7], v[base + 11]);
  PK_CE(v[base + 3], v[base + 5]);
  PK_CE(v[base + 7], v[base + 9]);
  PK_CE(v[base + 11], v[base + 13]);
  PK_CE(v[base + 1], v[base + 2]);
  PK_CE(v[base + 3], v[base + 4]);
  PK_CE(v[base + 5], v[base + 6]);
  PK_CE(v[base + 7], v[base + 8]);
  PK_CE(v[base + 9], v[base + 10]);
  PK_CE(v[base + 11], v[base + 12]);
  PK_CE(v[base + 13], v[base + 14]);
}
__device__ __forceinline__ void merge_top16(unsigned (&a)[16], const unsigned (&b)[16]) {
#pragma unroll
  for (int i = 0; i < 16; ++i) a[i] = a[i] > b[15 - i] ? a[i] : b[15 - i];
  PK_CE(a[0], a[8]);
  PK_CE(a[1], a[9]);
  PK_CE(a[2], a[10]);
  PK_CE(a[3], a[11]);
  PK_CE(a[4], a[12]);
  PK_CE(a[5], a[13]);
  PK_CE(a[6], a[14]);
  PK_CE(a[7], a[15]);
  PK_CE(a[0], a[4]);
  PK_CE(a[1], a[5]);
  PK_CE(a[2], a[6]);
  PK_CE(a[3], a[7]);
  PK_CE(a[8], a[12]);
  PK_CE(a[9], a[13]);
  PK_CE(a[10], a[14]);
  PK_CE(a[11], a[15]);
  PK_CE(a[0], a[2]);
  PK_CE(a[1], a[3]);
  PK_CE(a[4], a[6]);
  PK_CE(a[5], a[7]);
  PK_CE(a[8], a[10]);
  PK_CE(a[9], a[11]);
  PK_CE(a[12], a[14]);
  PK_CE(a[13], a[15]);
  PK_CE(a[0], a[1]);
  PK_CE(a[2], a[3]);
  PK_CE(a[4], a[5]);
  PK_CE(a[6], a[7]);
  PK_CE(a[8], a[9]);
  PK_CE(a[10], a[11]);
  PK_CE(a[12], a[13]);
  PK_CE(a[14], a[15]);
}
__device__ __forceinline__ void top16_of_128(const bf16x8* qf, const char* Kt, int r32, int hi, unsigned (&win)[16]) {
  unsigned pk[64];
#pragma unroll
  for (int t = 0; t < 4; ++t) {
    f32x16 c = f32x16{};
#pragma unroll
    for (int ks = 0; ks < 8; ++ks) { const bf16x8 a = *reinterpret_cast<const bf16x8*>(Kt + KSWZ(32 * t + r32, (ks * 16 + hi * 8) * 2));
      c = __builtin_amdgcn_mfma_f32_32x32x16_bf16(a, qf[ks], c, 0, 0, 0); }
#pragma unroll
    for (int r = 0; r < 16; ++r) { const int n = 32 * t + att::crow(r, hi); pk[t * 16 + r] = (srt(c[r]) & 0xffffff80u) | (unsigned)(127 - n); }
  }
  sort16_desc(pk, 0); sort16_desc(pk, 16); sort16_desc(pk, 32); sort16_desc(pk, 48);
  unsigned a[16], b[16];
#pragma unroll
  for (int i = 0; i < 16; ++i) { a[i] = pk[i]; b[i] = pk[16 + i]; }
  merge_top16(a, b);
  unsigned c[16];
#pragma unroll
  for (int i = 0; i < 16; ++i) { c[i] = pk[32 + i]; b[i] = pk[48 + i]; }
  merge_top16(c, b);
  merge_top16(a, c);
#pragma unroll
  for (int i = 0; i < 16; ++i) { auto rr = __builtin_amdgcn_permlane32_swap(a[i], a[i], false, false); b[i] = hi ? rr[0] : rr[1]; }
  merge_top16(a, b);
#pragma unroll
  for (int i = 0; i < 16; ++i) win[i] = a[i];
}
__device__ __forceinline__ void score_unit(const bf16* __restrict__ PQ, int* __restrict__ EIDX, float* __restrict__ EG, int t0, char* lds) {
  const int wid = my_wave(), lane = my_lane(), r32 = lane & 31, hi = lane >> 5;
  const bf16* qp = PQ + (size_t)(t0 + r32) * DM + wid * 256 + hi * 8;
  unsigned w1[16], w2[16];
  { bf16x8 qf[8];
#pragma unroll
    for (int ks = 0; ks < 8; ++ks) qf[ks] = att::ld8(qp + ks * 16);
    top16_of_128(qf, lds + L_K1, r32, hi, w1); }
  { bf16x8 qf[8];
#pragma unroll
    for (int ks = 0; ks < 8; ++ks) qf[ks] = att::ld8(qp + 128 + ks * 16);
    top16_of_128(qf, lds + L_K2, r32, hi, w2); }
  unsigned char* scr = (unsigned char*)(lds + L_SCR + wid * 1024) + r32 * 32;
  if (hi == 0) {
#pragma unroll
    for (int k = 0; k < 16; ++k) { scr[k] = (unsigned char)(127u - (w1[k] & 127u)); scr[16 + k] = (unsigned char)(127u - (w2[k] & 127u)); }
  }
  float v1[16], v2[16];
#pragma unroll
  for (int k = 0; k < 16; ++k) { v1[k] = unsrt(w1[k] & 0xffffff80u); v2[k] = unsrt(w2[k] & 0xffffff80u); }
  unsigned cd[25]; const unsigned hm0 = 0u - (unsigned)hi;
  { const unsigned e_ = (srt(v1[0] + v2[0]) & 0xffffff00u) | 255u, o_ = (srt(v1[0] + v2[1]) & 0xffffff00u) | 254u; cd[0] = (e_ & ~hm0) | (o_ & hm0); }
  { const unsigned e_ = (srt(v1[0] + v2[2]) & 0xffffff00u) | 253u, o_ = (srt(v1[0] + v2[3]) & 0xffffff00u) | 252u; cd[1] = (e_ & ~hm0) | (o_ & hm0); }
  { const unsigned e_ = (srt(v1[0] + v2[4]) & 0xffffff00u) | 251u, o_ = (srt(v1[0] + v2[5]) & 0xffffff00u) | 250u; cd[2] = (e_ & ~hm0) | (o_ & hm0); }
  { const unsigned e_ = (srt(v1[0] + v2[6]) & 0xffffff00u) | 249u, o_ = (srt(v1[0] + v2[7]) & 0xffffff00u) | 248u; cd[3] = (e_ & ~hm0) | (o_ & hm0); }
  { const unsigned e_ = (srt(v1[0] + v2[8]) & 0xffffff00u) | 247u, o_ = (srt(v1[0] + v2[9]) & 0xffffff00u) | 246u; cd[4] = (e_ & ~hm0) | (o_ & hm0); }
  { const unsigned e_ = (srt(v1[0] + v2[10]) & 0xffffff00u) | 245u, o_ = (srt(v1[0] + v2[11]) & 0xffffff00u) | 244u; cd[5] = (e_ & ~hm0) | (o_ & hm0); }
  { const unsigned e_ = (srt(v1[0] + v2[12]) & 0xffffff00u) | 243u, o_ = (srt(v1[0] + v2[13]) & 0xffffff00u) | 242u; cd[6] = (e_ & ~hm0) | (o_ & hm0); }
  { const unsigned e_ = (srt(v1[0] + v2[14]) & 0xffffff00u) | 241u, o_ = (srt(v1[0] + v2[15]) & 0xffffff00u) | 240u; cd[7] = (e_ & ~hm0) | (o_ & hm0); }
  { const unsigned e_ = (srt(v1[1] + v2[0]) & 0xffffff00u) | 239u, o_ = (srt(v1[1] + v2[1]) & 0xffffff00u) | 238u; cd[8] = (e_ & ~hm0) | (o_ & hm0); }
  { const unsigned e_ = (srt(v1[1] + v2[2]) & 0xffffff00u) | 237u, o_ = (srt(v1[1] + v2[3]) & 0xffffff00u) | 236u; cd[9] = (e_ & ~hm0) | (o_ & hm0); }
  { const unsigned e_ = (srt(v1[1] + v2[4]) & 0xffffff00u) | 235u, o_ = (srt(v1[1] + v2[5]) & 0xffffff00u) | 234u; cd[10] = (e_ & ~hm0) | (o_ & hm0); }
  { const unsigned e_ = (srt(v1[1] + v2[6]) & 0xffffff00u) | 233u, o_ = (srt(v1[1] + v2[7]) & 0xffffff00u) | 232u; cd[11] = (e_ & ~hm0) | (o_ & hm0); }
  { const unsigned e_ = (srt(v1[2] + v2[0]) & 0xffffff00u) | 223u, o_ = (srt(v1[2] + v2[1]) & 0xffffff00u) | 222u; cd[12] = (e_ & ~hm0) | (o_ & hm0); }
  { const unsigned e_ = (srt(v1[2] + v2[2]) & 0xffffff00u) | 221u, o_ = (srt(v1[2] + v2[3]) & 0xffffff00u) | 220u; cd[13] = (e_ & ~hm0) | (o_ & hm0); }
  { const unsigned e_ = (srt(v1[2] + v2[4]) & 0xffffff00u) | 219u, o_ = (srt(v1[3] + v2[0]) & 0xffffff00u) | 207u; cd[14] = (e_ & ~hm0) | (o_ & hm0); }
  { const unsigned e_ = (srt(v1[3] + v2[1]) & 0xffffff00u) | 206u, o_ = (srt(v1[3] + v2[2]) & 0xffffff00u) | 205u; cd[15] = (e_ & ~hm0) | (o_ & hm0); }
  { const unsigned e_ = (srt(v1[3] + v2[3]) & 0xffffff00u) | 204u, o_ = (srt(v1[4] + v2[0]) & 0xffffff00u) | 191u; cd[16] = (e_ & ~hm0) | (o_ & hm0); }
  { const unsigned e_ = (srt(v1[4] + v2[1]) & 0xffffff00u) | 190u, o_ = (srt(v1[4] + v2[2]) & 0xffffff00u) | 189u; cd[17] = (e_ & ~hm0) | (o_ & hm0); }
  { const unsigned e_ = (srt(v1[5] + v2[0]) & 0xffffff00u) | 175u, o_ = (srt(v1[5] + v2[1]) & 0xffffff00u) | 174u; cd[18] = (e_ & ~hm0) | (o_ & hm0); }
  { const unsigned e_ = (srt(v1[6] + v2[0]) & 0xffffff00u) | 159u, o_ = (srt(v1[6] + v2[1]) & 0xffffff00u) | 158u; cd[19] = (e_ & ~hm0) | (o_ & hm0); }
  { const unsigned e_ = (srt(v1[7] + v2[0]) & 0xffffff00u) | 143u, o_ = (srt(v1[7] + v2[1]) & 0xffffff00u) | 142u; cd[20] = (e_ & ~hm0) | (o_ & hm0); }
  { const unsigned e_ = (srt(v1[8] + v2[0]) & 0xffffff00u) | 127u, o_ = (srt(v1[9] + v2[0]) & 0xffffff00u) | 111u; cd[21] = (e_ & ~hm0) | (o_ & hm0); }
  { const unsigned e_ = (srt(v1[10] + v2[0]) & 0xffffff00u) | 95u, o_ = (srt(v1[11] + v2[0]) & 0xffffff00u) | 79u; cd[22] = (e_ & ~hm0) | (o_ & hm0); }
  { const unsigned e_ = (srt(v1[12] + v2[0]) & 0xffffff00u) | 63u, o_ = (srt(v1[13] + v2[0]) & 0xffffff00u) | 47u; cd[23] = (e_ & ~hm0) | (o_ & hm0); }
  { const unsigned e_ = (srt(v1[14] + v2[0]) & 0xffffff00u) | 31u, o_ = (srt(v1[15] + v2[0]) & 0xffffff00u) | 15u; cd[24] = (e_ & ~hm0) | (o_ & hm0); }
  unsigned win[16];
#pragma unroll
  for (int k = 0; k < 16; ++k) {
    unsigned m = cd[0];
#pragma unroll
    for (int i = 1; i < 25; ++i) m = umax(m, cd[i]);
    m = pair_max(m); win[k] = m;
#pragma unroll
    for (int i = 0; i < 25; ++i) cd[i] = (cd[i] == m) ? 0u : cd[i];
  }
  asm volatile("s_waitcnt lgkmcnt(0)" ::: "memory");
  const float smax = unsrt(win[0] & 0xffffff00u);
  float ex[16], den = 0.f;
#pragma unroll
  for (int k = 0; k < 16; ++k) { ex[k] = __builtin_amdgcn_exp2f((unsrt(win[k] & 0xffffff00u) - smax) * LOG2E); den += ex[k]; }
  const float rden = 1.0f / den; const unsigned hm = 0u - (unsigned)hi;
  int* eo = EIDX + (size_t)(t0 + r32) * 128 + wid * 2 + hi; float* go = EG + (size_t)(t0 + r32) * 128 + wid * 2 + hi;
#pragma unroll
  for (int kk = 0; kk < 8; ++kk) {
    const unsigned wv = (win[kk] & ~hm) | (win[8 + kk] & hm); const float gv = __uint_as_float((__float_as_uint(ex[kk]) & ~hm) | (__float_as_uint(ex[8 + kk]) & hm)) * rden;
    const int flat = 255 - (int)(wv & 255u), a = flat >> 4, bq = flat & 15;
    eo[kk * 16] = (int)scr[a] * 128 + (int)scr[16 + bq]; go[kk * 16] = gv;
  }
  asm volatile("s_waitcnt lgkmcnt(0)" ::: "memory");
}
}

typedef float f32x2 __attribute__((ext_vector_type(2)));
typedef int i32x4 __attribute__((ext_vector_type(4)));
constexpr float U_SCALE = 128.f, V_SCALE = 4.f;
constexpr int NSLICE = 8, SLICE_COLS = 256;
template <int CTRL> __device__ __forceinline__ float dpp_mov(float v) { return __int_as_float(__builtin_amdgcn_update_dpp(0, __float_as_int(v), CTRL, 0xf, 0xf, false)); }
__device__ __forceinline__ void pe_load_ids(const int* __restrict__ EIDX, int t, int g, int (&id)[16]) {
#pragma unroll
  for (int q = 0; q < 4; ++q) { const i32x4 v = *reinterpret_cast<const i32x4*>(EIDX + (size_t)t * 128 + g * 16 + 4 * q); id[4 * q] = v[0]; id[4 * q + 1] = v[1]; id[4 * q + 2] = v[2]; id[4 * q + 3] = v[3]; }
}
__device__ __forceinline__ void pe_issue_segs(const unsigned char* __restrict__ TB, const int (&id)[16], int coff, u32x4 (&seg)[16]) {
#pragma unroll
  for (int i = 0; i < 16; ++i) { const unsigned off = (unsigned)id[i] * 128u + (unsigned)coff; seg[i] = *reinterpret_cast<const u32x4*>(TB + off); }
}
typedef int v8i __attribute__((ext_vector_type(8)));
__device__ __forceinline__ void pe_x8_load(const unsigned char* __restrict__ X8, int t, unsigned xoff, u32x4 (&xw)[4]) {
  const unsigned char* xp = X8 + (size_t)t * DM + xoff;
  xw[0] = *reinterpret_cast<const u32x4*>(xp); xw[1] = *reinterpret_cast<const u32x4*>(xp + 64); xw[2] = *reinterpret_cast<const u32x4*>(xp + 128); xw[3] = *reinterpret_cast<const u32x4*>(xp + 192);
}
__device__ __forceinline__ void peer_u_pass(const unsigned char* __restrict__ X8, const unsigned char* __restrict__ U4, const int* __restrict__ EIDX, bf16* __restrict__ HPs, char* wlds, int t0, int dt, int n, int s, int lane) {
  const int g = lane >> 3, j = lane & 7, e16 = lane & 15, g4 = lane >> 4, c = lane & 15;
  const int coff = s * (NEXP * 128) + 16 * j; const unsigned xoff = (unsigned)(s * SLICE_COLS + 16 * g4);
  int idn[16]; u32x4 seg[16]; u32x4 xC[4], xN[4];
  pe_load_ids(EIDX, t0, g, idn); pe_issue_segs(U4, idn, coff, seg); pe_x8_load(X8, t0, xoff, xN);
  pe_load_ids(EIDX, t0 + (n > 1 ? dt : 0), g, idn);
#pragma unroll 1
  for (int it = 0; it < n; ++it) {
    const int t = t0 + it * dt, tn = t0 + (it + 1 < n ? it + 1 : n - 1) * dt, tnn = t0 + (it + 2 < n ? it + 2 : n - 1) * dt;
#pragma unroll
    for (int i = 0; i < 16; ++i) { const int row = 16 * g + i; *reinterpret_cast<u32x4*>(wlds + row * 128 + ((j ^ (row & 7)) << 4)) = seg[i]; }
#pragma unroll
    for (int p = 0; p < 4; ++p) xC[p] = xN[p];
    pe_issue_segs(U4, idn, coff, seg); pe_x8_load(X8, tn, xoff, xN);
    pe_load_ids(EIDX, tnn, g, idn);
    asm volatile("s_waitcnt lgkmcnt(0)" ::: "memory");
    f32x4 acc[8];
#pragma unroll
    for (int G = 0; G < 8; ++G) acc[G] = (f32x4){0.f, 0.f, 0.f, 0.f};
#pragma unroll
    for (int kh = 0; kh < 2; ++kh) {
      const v8i b = {(int)xC[2 * kh][0], (int)xC[2 * kh][1], (int)xC[2 * kh][2], (int)xC[2 * kh][3], (int)xC[2 * kh + 1][0], (int)xC[2 * kh + 1][1], (int)xC[2 * kh + 1][2], (int)xC[2 * kh + 1][3]};
#pragma unroll
      for (int G = 0; G < 8; ++G) { const int row = 16 * G + e16; const u32x4 sw = *reinterpret_cast<const u32x4*>(wlds + row * 128 + (((4 * kh + g4) ^ (row & 7)) << 4));
        const v8i a = {(int)sw[0], (int)sw[1], (int)sw[2], (int)sw[3], 0, 0, 0, 0};
        acc[G] = __builtin_amdgcn_mfma_scale_f32_16x16x128_f8f6f4(a, b, acc[G], 4  , 0  , 0, 0x7F7F7F7F  , 0, 0x7F7F7F7F); }
    }
    float s0[8], s1[8];
#pragma unroll
    for (int G = 0; G < 8; ++G) { s0[G] = (c & 1) ? acc[G][2] : acc[G][0]; s1[G] = (c & 1) ? acc[G][3] : acc[G][1]; }
    const int Gs = c >> 1;
    const float a0 = (Gs & 4) ? ((Gs & 2) ? ((Gs & 1) ? s0[7] : s0[6]) : ((Gs & 1) ? s0[5] : s0[4])) : ((Gs & 2) ? ((Gs & 1) ? s0[3] : s0[2]) : ((Gs & 1) ? s0[1] : s0[0]));
    const float a1 = (Gs & 4) ? ((Gs & 2) ? ((Gs & 1) ? s1[7] : s1[6]) : ((Gs & 1) ? s1[5] : s1[4])) : ((Gs & 2) ? ((Gs & 1) ? s1[3] : s1[2]) : ((Gs & 1) ? s1[1] : s1[0]));
    *reinterpret_cast<unsigned*>(HPs + (size_t)t * 128 + 16 * Gs + 4 * g4 + 2 * (c & 1)) = cvt_pk(a0, a1);
  }
}
typedef int v2i __attribute__((ext_vector_type(2)));
__device__ __forceinline__ void peer_v_pass(const unsigned char* __restrict__ A8, const unsigned char* __restrict__ V4, const int* __restrict__ EIDX, bf16* __restrict__ Y, char* wlds, int t0, int dt, int n, int s, int lane) {
  const int g = lane >> 3, j = lane & 7, e16 = lane & 15, g4 = lane >> 4;
  const int coff = s * (NEXP * 128) + 16 * j;
  int idn[16]; u32x4 seg[16]; u32x4 aC[2], aN[2];
#define PE_ALOAD(t, aw) do { const unsigned char* ap_ = A8 + (size_t)(t) * 128 + 16 * g4; aw[0] = *reinterpret_cast<const u32x4*>(ap_); aw[1] = *reinterpret_cast<const u32x4*>(ap_ + 64); } while (0)
  pe_load_ids(EIDX, t0, g, idn); pe_issue_segs(V4, idn, coff, seg); PE_ALOAD(t0, aN);
  pe_load_ids(EIDX, t0 + (n > 1 ? dt : 0), g, idn);
#pragma unroll 1
  for (int it = 0; it < n; ++it) {
    const int t = t0 + it * dt, tn = t0 + (it + 1 < n ? it + 1 : n - 1) * dt, tnn = t0 + (it + 2 < n ? it + 2 : n - 1) * dt;
#pragma unroll
    for (int i = 0; i < 16; ++i) { const int row = 16 * g + i; *reinterpret_cast<u32x4*>(wlds + row * 128 + ((j ^ (row & 7)) << 4)) = seg[i]; }
    aC[0] = aN[0]; aC[1] = aN[1];
    pe_issue_segs(V4, idn, coff, seg); PE_ALOAD(tn, aN);
    pe_load_ids(EIDX, tnn, g, idn);
    asm volatile("s_waitcnt lgkmcnt(0)" ::: "memory");
    const v8i a = {(int)aC[0][0], (int)aC[0][1], (int)aC[0][2], (int)aC[0][3], (int)aC[1][0], (int)aC[1][1], (int)aC[1][2], (int)aC[1][3]};
    const int r0 = 32 * g4 + e16, r1 = r0 + 16;
    float yv[4];
#pragma unroll
    for (int q = 0; q < 4; ++q) yv[q] = 0.f;
#pragma unroll
    for (int cb = 0; cb < 16; ++cb) {
      const v2i b0 = __builtin_amdgcn_ds_read_tr4_b64_v2i32((LAS v2i*)(wlds + r0 * 128 + ((((cb >> 1) ^ (r0 & 7)) << 4) | ((cb & 1) << 3))));
      const v2i b1 = __builtin_amdgcn_ds_read_tr4_b64_v2i32((LAS v2i*)(wlds + r1 * 128 + ((((cb >> 1) ^ (r1 & 7)) << 4) | ((cb & 1) << 3))));
      const v8i b = {b0[0], b0[1], b1[0], b1[1], 0, 0, 0, 0};
      const f32x4 d = __builtin_amdgcn_mfma_scale_f32_16x16x128_f8f6f4(a, b, (f32x4){0.f, 0.f, 0.f, 0.f}, 0  , 4  , 0, 0x79797979  , 0, 0x7D7D7D7D  );
      if ((cb & 3) == 0) yv[cb >> 2] = d[0];
      else yv[cb >> 2] = ((cb & 3) == g4) ? d[0] : yv[cb >> 2];
    }
#pragma unroll
    for (int q = 0; q < 4; ++q) Y[(size_t)t * DM + s * SLICE_COLS + 16 * (4 * q + g4) + e16] = (bf16)(cvt_pk(yv[q], 0.f) & 0xffffu);
  }
#undef PE_ALOAD
}
__device__ __forceinline__ void v4c_relayout_item(const unsigned char* __restrict__ V4, unsigned char* __restrict__ V4C, int s, int eb, int lane) {
  const int e = 64 * eb + lane; const unsigned char* src = V4 + (size_t)s * (NEXP * 128) + (size_t)e * 128;
  u32x4 w[8];
#pragma unroll
  for (int q = 0; q < 8; ++q) w[q] = *reinterpret_cast<const u32x4*>(src + 16 * q);
#pragma unroll
  for (int q = 0; q < 8; ++q) {
    *reinterpret_cast<u32x2*>(V4C + (size_t)(16 * s + 2 * q) * (NEXP * 8) + (size_t)e * 8) = (u32x2){w[q][0], w[q][1]};
    *reinterpret_cast<u32x2*>(V4C + (size_t)(16 * s + 2 * q + 1) * (NEXP * 8) + (size_t)e * 8) = (u32x2){w[q][2], w[q][3]}; }
}
__device__ __forceinline__ void eidp_item(const int* __restrict__ EIDX, unsigned* __restrict__ EIDP, int t4, int lane) {
  const int i16 = lane & 15, g4 = lane >> 4; u32x4 w;
#pragma unroll
  for (int e = 0; e < 4; ++e) { const int* r = EIDX + (size_t)(4 * t4 + e) * 128 + 32 * g4 + i16; const unsigned ia = (unsigned)r[0], ib = (unsigned)r[16]; w[e] = (ia ^ ((ia >> 7) & 31u)) | ((ib ^ ((ib >> 7) & 31u)) << 16); }
  *reinterpret_cast<u32x4*>(EIDP + ((size_t)t4 * 64 + lane) * 4) = w;
}
__device__ __forceinline__ void peer_v_pass2(const unsigned char* __restrict__ A8, const unsigned char* __restrict__ V4C, const unsigned* __restrict__ EIDP, bf16* __restrict__ Y, char* lds, int c, int tbeg, int ntok, int wave, int lane) {
  { const int tid = wave * 64 + lane; const unsigned char* tb = V4C + (size_t)c * (NEXP * 8);
#pragma unroll
    for (int i = 0; i < 16; ++i) { const int r2 = i * 512 + tid; const u32x4 w = *reinterpret_cast<const u32x4*>(tb + r2 * 16); const int m = (r2 >> 6) & 31;
      *reinterpret_cast<u32x2*>(lds + ((2 * r2) ^ m) * 8) = (u32x2){w[0], w[1]}; *reinterpret_cast<u32x2*>(lds + ((2 * r2 + 1) ^ m) * 8) = (u32x2){w[2], w[3]}; } }
  __syncthreads();
  const int i16 = lane & 15, g4 = lane >> 4;
  const int nstep = ntok / (16 * 8);
  const unsigned char* abase = A8 + (size_t)i16 * 128 + 16 * g4;
  const unsigned* ibase = EIDP + (size_t)lane * 4;
  bf16* ybase = Y + (size_t)(4 * g4) * DM + 16 * c + i16;
#define PV_LOAD(AW, ID, step) do { const int t0_ = tbeg + 16 * (wave + 8 * ((step) < nstep ? (step) : nstep - 1)); \
    AW[0] = *reinterpret_cast<const u32x4*>(abase + (size_t)t0_ * 128); AW[1] = *reinterpret_cast<const u32x4*>(abase + (size_t)t0_ * 128 + 64); \
    _Pragma("unroll") for (int j = 0; j < 4; ++j) ID[j] = *reinterpret_cast<const u32x4*>(ibase + ((size_t)(t0_ >> 2) + j) * 256); } while (0)
#define PV_READ(ID, j) do { _Pragma("unroll") for (int e = 0; e < 4; ++e) { const unsigned pk = ID[j][e]; \
      b0[j][e] = __builtin_amdgcn_ds_read_tr4_b64_v2i32((LAS v2i*)(lds + ((pk & 0xffffu) << 3))); \
      b1[j][e] = __builtin_amdgcn_ds_read_tr4_b64_v2i32((LAS v2i*)(lds + ((pk >> 16) << 3))); } __builtin_amdgcn_sched_barrier(0); } while (0)
#define PV_MMA(j) do { f32x4 d[4]; _Pragma("unroll") for (int e = 0; e < 4; ++e) { const v8i b = {b0[j][e][0], b0[j][e][1], b1[j][e][0], b1[j][e][1], 0, 0, 0, 0}; \
      d[e] = __builtin_amdgcn_mfma_scale_f32_16x16x128_f8f6f4(a, b, (f32x4){0.f, 0.f, 0.f, 0.f}, 0  , 4  , 0, 0x79797979  , 0, 0x7D7D7D7D  ); } \
    _Pragma("unroll") for (int e = 0; e < 4; ++e) y[e] = (g4 == j) ? d[e][e] : y[e]; __builtin_amdgcn_sched_barrier(0); } while (0)
#define PV_COMPUTE(AW, ID, step) do { const int t0_ = tbeg + 16 * (wave + 8 * (step)); \
    const v8i a = {(int)AW[0][0], (int)AW[0][1], (int)AW[0][2], (int)AW[0][3], (int)AW[1][0], (int)AW[1][1], (int)AW[1][2], (int)AW[1][3]}; \
    float y[4] = {0.f, 0.f, 0.f, 0.f}; v2i b0[4][4], b1[4][4]; \
    PV_READ(ID, 0); PV_READ(ID, 1); PV_MMA(0); PV_READ(ID, 2); PV_MMA(1); PV_READ(ID, 3); PV_MMA(2); PV_MMA(3); \
    _Pragma("unroll") for (int e = 0; e < 4; ++e) { const __bf16 yh = (__bf16)y[e]; ybase[(size_t)(t0_ + e) * DM] = __builtin_bit_cast(unsigned short, yh); } } while (0)
  u32x4 A0[2], A1[2], A2[2], A3[2], I0[4], I1[4], I2[4], I3[4];
  PV_LOAD(A0, I0, 0); PV_LOAD(A1, I1, 1); PV_LOAD(A2, I2, 2);
#pragma unroll 1
  for (int k = 0; k < nstep; k += 4) {
    PV_LOAD(A3, I3, k + 3); PV_COMPUTE(A0, I0, k);
    PV_LOAD(A0, I0, k + 4); PV_COMPUTE(A1, I1, k + 1);
    PV_LOAD(A1, I1, k + 5); PV_COMPUTE(A2, I2, k + 2);
    PV_LOAD(A2, I2, k + 6); PV_COMPUTE(A3, I3, k + 3);
  }
#undef PV_LOAD
#undef PV_COMPUTE
#undef PV_READ
#undef PV_MMA
  __syncthreads();
}
__device__ __forceinline__ void ln2_phase(const bf16* __restrict__ X1, const bf16* __restrict__ Y, const float* __restrict__ g, const float* __restrict__ bta, float* __restrict__ O, int gw, int ngw, int lane) {
  f32x4 gv[8], bv[8];
#pragma unroll
  for (int j = 0; j < 4; ++j) { const int e0 = 512 * j + 8 * lane;
    gv[2 * j] = *reinterpret_cast<const f32x4*>(g + e0); gv[2 * j + 1] = *reinterpret_cast<const f32x4*>(g + e0 + 4);
    bv[2 * j] = *reinterpret_cast<const f32x4*>(bta + e0); bv[2 * j + 1] = *reinterpret_cast<const f32x4*>(bta + e0 + 4); }
  u32x4 na[4], nb[4];
  if (gw < NTOK) {
#pragma unroll
    for (int j = 0; j < 4; ++j) { na[j] = *reinterpret_cast<const u32x4*>(X1 + (size_t)gw * DM + 512 * j + 8 * lane); nb[j] = *reinterpret_cast<const u32x4*>(Y + (size_t)gw * DM + 512 * j + 8 * lane); } }
  for (int m = gw; m < NTOK; m += ngw) {
    float v[32]; float s = 0.f;
#pragma unroll
    for (int j = 0; j < 4; ++j) {
#pragma unroll
      for (int q = 0; q < 4; ++q) { v[8 * j + 2 * q] = fmaf(ALPHA, bf_lo(na[j][q]), bf_lo(nb[j][q])); v[8 * j + 2 * q + 1] = fmaf(ALPHA, bf_hi(na[j][q]), bf_hi(nb[j][q])); } }
    if (m + ngw < NTOK) {
#pragma unroll
      for (int j = 0; j < 4; ++j) { na[j] = *reinterpret_cast<const u32x4*>(X1 + (size_t)(m + ngw) * DM + 512 * j + 8 * lane); nb[j] = *reinterpret_cast<const u32x4*>(Y + (size_t)(m + ngw) * DM + 512 * j + 8 * lane); } }
#pragma unroll
    for (int i = 0; i < 32; ++i) s += v[i];
    const float mean = wave_sum(s) * (1.f / DM); float s2 = 0.f;
#pragma unroll
    for (int i = 0; i < 32; ++i) { v[i] -= mean; s2 = fmaf(v[i], v[i], s2); }
    const float rstd = 1.0f / sqrtf(wave_sum(s2) * (1.f / DM) + LN_EPS);
    float* orow = O + (size_t)m * DM;
#pragma unroll
    for (int j = 0; j < 4; ++j) { const int e0 = 512 * j + 8 * lane;
      f32x4 o0, o1;
#pragma unroll
      for (int e = 0; e < 4; ++e) { o0[e] = v[8 * j + e] * rstd * gv[2 * j][e] + bv[2 * j][e]; o1[e] = v[8 * j + 4 + e] * rstd * gv[2 * j + 1][e] + bv[2 * j + 1][e]; }
      *reinterpret_cast<f32x4*>(orow + e0) = o0; *reinterpret_cast<f32x4*>(orow + e0 + 4) = o1; }
  }
}
__device__ __forceinline__ void cvt_stream_fp4(const float* __restrict__ src, unsigned char* __restrict__ dst, size_t n32, float scale, size_t gtid, size_t gsz) {
  for (size_t i0 = gtid; i0 < n32; i0 += 2 * gsz) {
    f32x4 a[2][8];
#pragma unroll
    for (int h = 0; h < 2; ++h) { const size_t i = i0 + h * gsz; if (i < n32) {
#pragma unroll
      for (int q = 0; q < 8; ++q) a[h][q] = *reinterpret_cast<const f32x4*>(src + i * 32 + 4 * q); } }
#pragma unroll
    for (int h = 0; h < 2; ++h) { const size_t i = i0 + h * gsz; if (i < n32) {
      u32x4 w;
#pragma unroll
      for (int q = 0; q < 4; ++q) { const f32x4 x = a[h][2 * q] * scale, y = a[h][2 * q + 1] * scale;
        unsigned p = __builtin_amdgcn_cvt_scalef32_pk_fp4_f32(0u, x[0], x[1], 1.0f, 0); p = __builtin_amdgcn_cvt_scalef32_pk_fp4_f32(p, x[2], x[3], 1.0f, 1);
        p = __builtin_amdgcn_cvt_scalef32_pk_fp4_f32(p, y[0], y[1], 1.0f, 2); p = __builtin_amdgcn_cvt_scalef32_pk_fp4_f32(p, y[2], y[3], 1.0f, 3); w[q] = p; }
      const size_t e = i >> 6, c16 = i & 63;
      *reinterpret_cast<u32x4*>(dst + (c16 >> 3) * ((size_t)NEXP * 128) + e * 128 + (c16 & 7) * 16) = w; } }
  }
}
__device__ __forceinline__ void peer_tables_share(const float* __restrict__ u, const float* __restrict__ v, unsigned char* __restrict__ U4, unsigned char* __restrict__ V4, int bx, int G) {
  int t = my_tid(); asm volatile("" : "+v"(t));
  const size_t gtid = (size_t)bx * 512 + t, gsz = (size_t)G * 512;
  cvt_stream_fp4(u, U4, (size_t)NEXP * DM / 32, U_SCALE, gtid, gsz);
  cvt_stream_fp4(v, V4, (size_t)NEXP * DM / 32, V_SCALE, gtid, gsz);
}

#define XB_TMO      128
#define XB_XCNT(j)  (256  + 64 * (j))
#define XB_XSUB(j)  (1280 + 64 * (j))
#define XB_XGEN(j)  (2304 + 64 * (j))
#define XB_TOP      3328
#define XB_TOPGEN   3392
#define XCD_BAR_WORDS 3456
#define XB_SPIN_CAP (1u << 18)

__device__ __forceinline__ unsigned xb_ld(unsigned* p)              { return __hip_atomic_load(p, __ATOMIC_RELAXED, __HIP_MEMORY_SCOPE_AGENT); }
__device__ __forceinline__ unsigned xb_add(unsigned* p, unsigned v) { return __hip_atomic_fetch_add(p, v, __ATOMIC_RELAXED, __HIP_MEMORY_SCOPE_AGENT); }
__device__ __forceinline__ unsigned xb_xcc_id() { return (unsigned)__builtin_amdgcn_s_getreg((3 << 11) | 20) & 0xFu; }
#define XB_SPIN(cond, bar) do { unsigned _sp = 0; while (cond) { __builtin_amdgcn_s_sleep(1); \
    if ((++_sp & 255u) == 0u) { if (xb_ld(&(bar)[XB_TMO])) break; if (_sp > XB_SPIN_CAP) { atomicAdd(&(bar)[XB_TMO], 1u); break; } } } } while (0)

struct XcdBarrier {
    unsigned* bar; unsigned x;
    volatile LAS unsigned* st;
};

__device__ __forceinline__ XcdBarrier xcd_barrier_post(unsigned* bar, volatile LAS unsigned* st) {
    XcdBarrier b; b.bar = bar; b.x = xb_xcc_id(); b.st = st;
    if (threadIdx.x == 0) (void)xb_add(&bar[XB_XCNT(b.x)], 1u);
    return b;
}
__device__ __forceinline__ void xcd_barrier_complete(unsigned* bar, unsigned x, unsigned& nloc, unsigned& nx) {
    const unsigned G = gridDim.x * gridDim.y * gridDim.z;
    unsigned sum, cnt, mine, sp = 0u;
    for (;;) {
        sum = 0u; cnt = 0u; mine = 0u;
#pragma unroll
        for (unsigned j = 0; j < 16; ++j) { const unsigned c = xb_ld(&bar[XB_XCNT(j)]); sum += c; cnt += (c > 0u) ? 1u : 0u; mine = (j == x) ? c : mine; }
        if (sum == G) break;
        __builtin_amdgcn_s_sleep(1);
        if ((++sp & 255u) == 0u) { if (xb_ld(&bar[XB_TMO])) break; if (sp > XB_SPIN_CAP) { atomicAdd(&bar[XB_TMO], 1u); break; } }
    }
    nloc = mine > 0u ? mine : 1u; nx = cnt > 0u ? cnt : 1u;
}

__device__ __forceinline__ void xcd_barrier(const XcdBarrier& b) {
    asm volatile("s_waitcnt vmcnt(0)" ::: "memory");
    __syncthreads();
    if (my_tid() == 0) {
        unsigned* bar = b.bar;
        __builtin_amdgcn_s_waitcnt(0);
        unsigned nloc = b.st[0], nx = b.st[1];
        if (nloc == 0u) { xcd_barrier_complete(bar, b.x, nloc, nx); b.st[0] = nloc; b.st[1] = nx; }
        const unsigned old = xb_add(&bar[XB_XSUB(b.x)], 1u);
        const unsigned gen = old / nloc;
        if (old + 1u == (gen + 1u) * nloc) {
            __builtin_amdgcn_fence(__ATOMIC_RELEASE, "agent");
            asm volatile("s_waitcnt vmcnt(0)" ::: "memory");
            const unsigned og = xb_add(&bar[XB_TOP], 1u);
            const unsigned tg = og / nx;
            if (og + 1u == (tg + 1u) * nx) xb_add(&bar[XB_TOPGEN], 1u);
            else XB_SPIN(xb_ld(&bar[XB_TOPGEN]) == tg, bar);
            __builtin_amdgcn_fence(__ATOMIC_ACQUIRE, "agent");
            xb_add(&bar[XB_XGEN(b.x)], 1u);
            asm volatile("s_waitcnt vmcnt(0)" ::: "memory");
        } else {
            XB_SPIN(xb_ld(&bar[XB_XGEN(b.x)]) == gen, bar);
            __builtin_amdgcn_fence(__ATOMIC_ACQUIRE, "agent");
            asm volatile("s_waitcnt vmcnt(0)" ::: "memory");
        }
    }
    __syncthreads();
}


__device__ __forceinline__ void flat_barrier(unsigned* bar) {
    asm volatile("s_waitcnt vmcnt(0)" ::: "memory");
    __syncthreads();
    if (threadIdx.x == 0) {
        const unsigned G = gridDim.x;
        __builtin_amdgcn_fence(__ATOMIC_RELEASE, "agent");
        asm volatile("s_waitcnt vmcnt(0)" ::: "memory");
        const unsigned old = xb_add(&bar[XB_TOP], 1u);
        const unsigned target = (old / G + 1u) * G;
        XB_SPIN(xb_ld(&bar[XB_TOP]) < target, bar);
        __builtin_amdgcn_fence(__ATOMIC_ACQUIRE, "agent");
        asm volatile("s_waitcnt vmcnt(0)" ::: "memory");
    }
    __syncthreads();
}
struct Args {
  const float* in[17];
  float* out; unsigned char* ws; int ph_lo, ph_hi;
};
constexpr int N_PHASES = 12;

__global__ void __launch_bounds__(512, 2) mega_fwd(Args args) {
  extern __shared__ __attribute__((aligned(16))) unsigned char lds_raw[];
  LAS unsigned char* ldsl = (LAS unsigned char*)lds_raw;
  char* lds = (char*)lds_raw;
  { const int t0_ = threadIdx.x; if ((t0_ & 63) == 0) ((volatile unsigned char*)lds_raw)[HWTAB_OFF + hw_slot()] = (unsigned char)(t0_ >> 6); }
  __syncthreads();
  const int wave = my_wave();
#define lane (my_lane())
#define tid (wave * 64 + my_lane())
  const int G = gridDim.x, bx = blockIdx.x;
  unsigned char* ws = args.ws;
  const float* x = args.in[0];
  bf16* XB = (bf16*)(ws + WS_XB); unsigned char* ATT = ws + WS_X1F8; bf16* PQ = XB;
  bf16* PROJ = (bf16*)(ws + WS_PROJ); bf16* ZB = (bf16*)(ws + WS_PROJ); bf16* YB = (bf16*)(ws + WS_PROJ + 128 * MiB);
  int* EIDX = (int*)(ws + WS_EIDX); float* EG = (float*)(ws + WS_EG);
  bf16* X1B = (bf16*)(ws + WS_X1B); unsigned char* U8 = ws + WS_U8; unsigned char* V8 = ws + WS_V8; unsigned char* V4C = ws + WS_V4C; unsigned char* XB8 = ws + WS_X1F8; unsigned char* WIN8 = ws + WS_WIN; constexpr int N_F8 = C_SK;     unsigned* EIDP = (unsigned*)(ws + WS_EIDP);
  unsigned char* A8 = ws + WS_A8; unsigned* ctl = (unsigned*)(ws + WS_CTL); unsigned char* X1F8 = ws + WS_X1F8;
  bf16* WIN = (bf16*)(ws + WS_WIN); unsigned char* WO = ws + WS_WO; bf16* WQ = (bf16*)(ws + WS_WQ);
  const int lo = args.ph_lo, hi_ph = args.ph_hi;
#if MK_ONE_LAUNCH
  volatile LAS unsigned* misc = (volatile LAS unsigned*)(ldsl + LDS_BYTES - 64);
  XcdBarrier xbar; xbar.bar = ctl; xbar.x = xb_xcc_id(); xbar.st = misc + 2;
  if (tid == 0) { misc[2] = 0u; misc[3] = 0u; misc[0] = xb_add(&ctl[XB_XCNT(xbar.x)], 1u); }
  __syncthreads();
  const int my_xcc = (int)xbar.x, my_rank = __builtin_amdgcn_readfirstlane((int)misc[0]);
#endif
#if MK_ONE_LAUNCH
  cg::grid_group grid = cg::this_grid();
#define GRID_SYNC() xcd_barrier(xbar)
#else
#define GRID_SYNC() do {} while (0)
#endif
#ifndef PH_MASK
#define PH_MASK 0xfff
#endif
#ifndef REP_MASK
#define REP_MASK 0
#endif
#define IN(k) (((PH_MASK >> (k)) & 1) && lo <= (k) && (k) < hi_ph)
#define REP(k)
#define SEAM(k) do { if (IN(k) && IN((k) + 1)) GRID_SYNC(); } while (0)

  REP(0) if (IN(0)) {
    const size_t gtid = (size_t)bx * 512 + tid, gsz = (size_t)G * 512;
    cvt_stream2(x, XB, XB8, (size_t)NTOK * DM / 8, gtid, gsz);
    LAS float* scr = (LAS float*)(ldsl + wave * 8704);
    const int gw = bx * 8 + wave, NGW = G * 8;
    constexpr int I_IN = (DM / 64) * (LDP / 32), I_SQ = (DM / 64) * (DM / 32);
    for (int it = gw; it < I_IN + 2 * I_SQ; it += NGW) {
      if (it < I_IN) { const int kb = it / (LDP / 32), nb = it % (LDP / 32);
        if (nb < N_F8 / 32) transpose_item_fp8(args.in[1], DM, NPROJ, WIN8, scr, kb, nb, lane, 64.f);
        else transpose_item(args.in[1], DM, NPROJ, WIN, scr, kb, nb, lane); }
      else if (it < I_IN + I_SQ) { const int r = it - I_IN; transpose_item_fp8(args.in[2], DM, DM, WO, scr, r / (DM / 32), r % (DM / 32), lane, 64.f); }
      else { const int r = it - I_IN - I_SQ; transpose_item(args.in[10], DM, DM, WQ, scr, r / (DM / 32), r % (DM / 32), lane); }
    }
    __syncthreads();
  }
#if MK_ONE_LAUNCH
  if (IN(0) && IN(1)) grid.sync();
#endif
  int vx = bx & 7, vrank = bx >> 3; const int nloc = G >> 3;
#if MK_ONE_LAUNCH
  {
    int npop = 0, before = 0; bool regular = true;
#pragma unroll
    for (int q = 0; q < 16; ++q) { const int cq = (int)__hip_atomic_load(ctl + XB_XCNT(q), __ATOMIC_RELAXED, __HIP_MEMORY_SCOPE_AGENT); if (cq > 0) { ++npop; if (q < my_xcc) ++before; if (cq != nloc) regular = false; } }
    if (regular && npop == 8 && (G & 7) == 0) { vx = before; vrank = my_rank; }
  }
#endif
  const int vcu = vrank * 8 + vx;
  REP(1) if (IN(1)) {
    { pg8::Gemm g{(const pg8::bf16_t*)XB8, (const pg8::bf16_t*)WIN8, NTOK, N_F8, DM}; pg8::StaticOrder S; S.init(NTOK, N_F8, G, vcu);
      pg8::EpiBf16<0> E{PROJ, LDP, nullptr, N_F8, 0, 1.0f / 64.0f};
      pg8::gemm_phase<pg8::EpiBf16<0>, pg8::StaticOrder, true, true, true, 0x7F7F7F7F>(ldsl, g, S, E); }
    __syncthreads();
    { pg8::Gemm g{XB, WIN + (size_t)N_F8 * DM, NTOK, LDP - N_F8, DM}; pg8::StaticOrder S; S.init(NTOK, LDP - N_F8, G, vcu);
      pg8::EpiBf16<0> E{PROJ + N_F8, LDP, nullptr, 0, 0, 1.f};
      pg8::gemm_phase<pg8::EpiBf16<0>, pg8::StaticOrder, true, true>(ldsl, g, S, E); }
    __syncthreads();
  }
  SEAM(1);
  const int cslot = (G * 8 >= 2048) ? (bx & 7) : 0;
  REP(2) if (IN(2)) {
    float lam;
    { const float a = args.in[3][lane] * args.in[4][lane], b = args.in[5][lane] * args.in[6][lane];
      lam = __expf(wave_sum(a)) - __expf(wave_sum(b)) + LAM_INIT; }
    for (int rnd = 0; rnd * G < 1024; ++rnd) {
      const int i = rnd * G + ((rnd & 1) ? (G - 1 - bx) : bx);
      if (i < 1024) { const int qb = 63 - (i >> 4), b = i & 15; att::attn_unit<1>(PROJ, ATT, b, 0, qb, lds, lam, args.in[7]); }
    }
  }
  REP(3) if (IN(3)) {
    float lam;
    { const float a = args.in[3][lane] * args.in[4][lane], b = args.in[5][lane] * args.in[6][lane];
      lam = __expf(wave_sum(a)) - __expf(wave_sum(b)) + LAM_INIT; }
    for (int rnd = 0; rnd * G < 2048; ++rnd) {
      if (rnd == cslot) peer_tables_share(args.in[13], args.in[14], U8, V8, bx, G);
      const int j = rnd * G + ((rnd & 1) ? (G - 1 - bx) : bx);
      if (j < 2048) { const int qb = 15 - (j >> 7), bh = j & 127; att::attn_unit<0>(PROJ, ATT, bh >> 3, (bh + rnd) & 7, qb, lds, lam, args.in[7]); }
    }
  }
  SEAM(3);
  REP(4) if (IN(4)) {
    pg8::Gemm g{(const pg8::bf16_t*)ATT, (const pg8::bf16_t*)WO, NTOK, DM, DM}; pg8::StaticOrder S; S.init(NTOK, DM, G, vcu);
    pg8::EpiResid E{(const pg8::bf16_t*)XB, ZB, DM, ALPHA, 1.0f / 64.0f};
    pg8::gemm_phase<pg8::EpiResid, pg8::StaticOrder, true, true, true, 0x7F7F7F7F>(ldsl, g, S, E);
    __syncthreads();
  }
  SEAM(4);
  REP(5) if (IN(5)) {
    const int gw = bx * 8 + wave, NGW = G * 8;
    ln1_phase(ZB, args.in[8], args.in[9], X1B, X1F8, gw, NGW, lane);
  }
  SEAM(5);
  REP(6) if (IN(6)) {
    pg8::Gemm g{X1B, WQ, NTOK, DM, DM}; pg8::StaticOrder S; S.init(NTOK, DM, G, vcu);
    pg8::EpiBf16<0> E{PQ, DM, nullptr, 0, 0, 1.f};
    pg8::gemm_phase<pg8::EpiBf16<0>, pg8::StaticOrder, true, true>(ldsl, g, S, E);
    __syncthreads();
  }
  SEAM(6);
  REP(7) if (IN(7)) {
    peer::load_keys(args.in[11], args.in[12], lds);
    __syncthreads();
    for (int u = bx; u < NTOK / 32; u += G) peer::score_unit(PQ, EIDX, EG, u * 32, lds);
    __syncthreads();
  }
  SEAM(7);
  bf16* HPA = (bf16*)(ws + WS_HPA);
  REP(8) if (IN(8)) {
    const int wv = vrank * 8 + wave, nwv = nloc * 8;
    peer_u_pass(X1F8, U8, EIDX, HPA + (size_t)vx * NTOK * 128, lds + wave * 16384, wv, nwv, NTOK / nwv, vx, lane);
  }
  SEAM(8);
  REP(9) if (IN(9)) {
    const size_t gtid = (size_t)bx * 512 + tid, gsz = (size_t)G * 512;
    for (size_t i = gtid; i < (size_t)NTOK * 32; i += gsz) {
      f32x4 h = {0.f, 0.f, 0.f, 0.f};
#pragma unroll
      for (int sl = 0; sl < NSLICE; ++sl) { const u32x2 w = *reinterpret_cast<const u32x2*>(HPA + (size_t)sl * NTOK * 128 + i * 4); h += (f32x4){bf_lo(w[0]), bf_hi(w[0]), bf_lo(w[1]), bf_hi(w[1])}; }
      const f32x4 gg = *reinterpret_cast<const f32x4*>(EG + i * 4); float a[4];
#pragma unroll
      for (int e = 0; e < 4; ++e) { const float hv = h[e] * (1.0f / U_SCALE); a[e] = 0.5f * hv * (1.0f + erff(hv * 0.70710678118654752f)) * gg[e] * 64.0f; }
      int p = __builtin_amdgcn_cvt_pk_fp8_f32(a[0], a[1], 0, false); p = __builtin_amdgcn_cvt_pk_fp8_f32(a[2], a[3], p, true);
      *reinterpret_cast<int*>(A8 + i * 4) = p;
    }
    for (int it = bx * 8 + wave; it < NTOK / 4; it += G * 8) eidp_item(EIDX, EIDP, it, lane);
    for (int it = bx * 8 + wave; it < 8 * (NEXP / 64); it += G * 8) v4c_relayout_item(V8, V4C, it / (NEXP / 64), it % (NEXP / 64), lane);
  }
  SEAM(9);
  REP(10) if (IN(10)) {
    for (int u = ((G & 7) == 0) ? vx * nloc + vrank : bx; u < 256; u += G) peer_v_pass2(A8, V4C, EIDP, YB, lds, u >> 1, (u & 1) * (NTOK / 2), NTOK / 2, wave, lane);
  }
  SEAM(10);
  REP(11) if (IN(11)) {
    const int gw = bx * 8 + wave, NGW = G * 8;
    ln2_phase(X1B, YB, args.in[15], args.in[16], args.out, gw, NGW, lane);
  }
#undef IN
#undef SEAM
#undef lane
#undef tid
}

#ifndef REP_MASK
#define REP_MASK 0
#endif
extern "C" void kernel_launch(void* const* d_in, const int* in_sizes, int n_in, void* d_out, int out_size, void* d_ws, size_t ws_size, hipStream_t stream) {
  static int grid = 0;
  if (grid == 0) {
    if (n_in != 17 || in_sizes[0] != NTOK * DM || out_size != NTOK * DM || ws_size < WS_END) {
      fprintf(stderr, "kernel_launch: unexpected shapes: n_in %d in0 %d out %d ws %zu (need >= %zu)\n", n_in, n_in > 0 ? in_sizes[0] : -1, out_size, ws_size, (size_t)WS_END); grid = -1; return; }
    int dev = 0, cus = 0, per_cu = 0;
    if (hipGetDevice(&dev) != hipSuccess || hipDeviceGetAttribute(&cus, hipDeviceAttributeMultiprocessorCount, dev) != hipSuccess) { grid = -1; return; }
    if (hipFuncSetAttribute((const void*)mega_fwd, hipFuncAttributeMaxDynamicSharedMemorySize, LDS_BYTES) != hipSuccess) { fprintf(stderr, "kernel_launch: hipFuncSetAttribute failed\n"); grid = -1; return; }
    if (hipOccupancyMaxActiveBlocksPerMultiprocessor(&per_cu, (const void*)mega_fwd, 512, LDS_BYTES) != hipSuccess || per_cu < 1) { fprintf(stderr, "kernel_launch: occupancy query says %d\n", per_cu); per_cu = 1; }
    (void)hipGetLastError();
    grid = cus * (per_cu > 1 ? 1 : per_cu);
  }
  if (grid < 0) return;
  Args a{};
  for (int i = 0; i < 17; ++i) a.in[i] = (const float*)d_in[i];
  a.out = (float*)d_out; a.ws = (unsigned char*)d_ws;
  if (hipMemsetAsync((char*)d_ws + WS_CTL, 0, 16384, stream) != hipSuccess) { fprintf(stderr, "kernel_launch: memset failed\n"); return; }
#if MK_ONE_LAUNCH
  a.ph_lo = 0; a.ph_hi = N_PHASES;
  void* kargs[] = {&a};
  hipError_t e = hipLaunchCooperativeKernel((const void*)mega_fwd, dim3(grid), dim3(512), kargs, LDS_BYTES, stream);
  if (e != hipSuccess) fprintf(stderr, "kernel_launch: cooperative launch failed: %s (grid %d)\n", hipGetErrorString(e), grid);
#else
  for (int p = 0; p < N_PHASES; ++p) {
    a.ph_lo = p; a.ph_hi = p + 1;
    for (int rep = 0; rep < (((REP_MASK >> p) & 1) ? 2 : 1); ++rep)
      hipLaunchKernelGGL(mega_fwd, dim3(grid), dim3(512), LDS_BYTES, stream, a);
  }
  const hipError_t le = hipPeekAtLastError();
  if (le != hipSuccess) fprintf(stderr, "kernel_launch: launch failed: %s\n", hipGetErrorName(le));
#endif
}
```

```cpp
#include <hip/hip_runtime.h>
#include <hip/hip_cooperative_groups.h>
#include <cstdio>
#include <cstdint>
namespace cg = cooperative_groups;

#ifndef MK_ONE_LAUNCH
#define MK_ONE_LAUNCH 1
#endif

constexpr int NB = 16, SEQ = 2048, DM = 2048, NTOK = NB * SEQ;
constexpr int NPROJ = 5456, LDP = 5632;
constexpr int C_DQ = 0, C_DK = 1024, C_DV = 2048, C_SQ = 3072, C_SK = 4096, C_SV = 4224, C_IQ = 4352, C_IK = 5376, C_IW = 5440;
constexpr int NEXP = 16384;
constexpr float LN_EPS = 1e-5f, RMS_EPS = 1e-5f;
constexpr float ALPHA = 1.189207115002721f;
constexpr float LAM_INIT = 0.2f;
constexpr float LOG2E = 1.4426950408889634f;

constexpr size_t MiB = (size_t)1 << 20;
constexpr size_t WS_XB = 0;
constexpr size_t WS_PROJ = 128 * MiB;
constexpr size_t WS_EIDX = 384 * MiB;
constexpr size_t WS_EG = 400 * MiB;
constexpr size_t WS_X1B = 480 * MiB;
constexpr size_t WS_V4C = 416 * MiB;
constexpr size_t WS_EIDP = 432 * MiB;
constexpr size_t WS_CTL = 774 * MiB;
constexpr size_t WS_U8 = 608 * MiB;
constexpr size_t WS_V8 = 640 * MiB;
constexpr size_t WS_HPA = 0;
constexpr size_t WS_X1F8 = 672 * MiB;
constexpr size_t WS_WIN = 736 * MiB;
constexpr size_t WS_WO = 758 * MiB;
constexpr size_t WS_WQ = 766 * MiB;
constexpr size_t WS_A8 = 775 * MiB;
constexpr size_t WS_END = 779 * MiB;

constexpr int LDS_BYTES = 147456;

typedef unsigned short bf16;
#define LAS __attribute__((address_space(3)))


constexpr int HWTAB_OFF = LDS_BYTES - 128;
__device__ __forceinline__ int hw_slot() { return (int)(__builtin_amdgcn_s_getreg((6 << 11) | 4  ) & 63u); }
__device__ __forceinline__ int my_lane() { int r; asm volatile("v_mbcnt_lo_u32_b32 %0, -1, 0\n\tv_mbcnt_hi_u32_b32 %0, -1, %0" : "=v"(r)); return r; }
__device__ __forceinline__ int my_wave() { extern __shared__ __attribute__((aligned(16))) unsigned char lds_raw[]; return __builtin_amdgcn_readfirstlane((int)((volatile unsigned char*)lds_raw)[HWTAB_OFF + hw_slot()]); }
__device__ __forceinline__ int my_tid() { return my_wave() * 64 + my_lane(); }
namespace pg8 {
#define PG8_LAS __attribute__((address_space(3)))
typedef unsigned short bf16_t;
typedef short bf16x8 __attribute__((ext_vector_type(8)));
typedef float f32x4 __attribute__((ext_vector_type(4)));
typedef unsigned u32x4 __attribute__((ext_vector_type(4)));
typedef int v8i_t __attribute__((ext_vector_type(8)));
typedef int i32x4_t __attribute__((ext_vector_type(4)));
__device__ __forceinline__ v8i_t cat8(bf16x8 lo, bf16x8 hi) { return __builtin_shufflevector(__builtin_bit_cast(i32x4_t, lo), __builtin_bit_cast(i32x4_t, hi), 0, 1, 2, 3, 4, 5, 6, 7); }
constexpr int BM = 256, BK = 64, HALF = 128, HTB = HALF * BK * 2  , STAGE_BYTES = 8 * HTB, NXCD = 8, WGM = 8;

__host__ __device__ __forceinline__ int lds_byte(int r, int c) { const int st = (r >> 4) * 2 + (c >> 5), rr = r & 15, cc = c & 31, ob = rr * 64 + cc * 2; return st * 1024 + (ob ^ (((ob >> 9) & 1) << 5)); }
__host__ __device__ __forceinline__ void stage_rc(int b, int& R, int& C) { const int st = b / 1024, sb = b % 1024, swz = sb ^ (((sb >> 9) & 1) << 5); R = (st >> 1) * 16 + swz / 64; C = (st & 1) * 32 + (swz % 64) / 2; }
__host__ __device__ __forceinline__ int perm32(int rho) { const int n = rho >> 4, i = rho & 15; return 8 * (i >> 2) + 4 * n + (i & 3); }

struct Unit { int pm, pn; };
struct Gemm { const bf16_t* A; const bf16_t* Bt; int M, N, K; };

struct StaticOrder {
    int nM, nN, nwg, G, c;
    __host__ __device__ void init(int M, int N, int G_, int c_) { nM = M / BM; nN = N / BM; nwg = nM * nN; G = G_; c = c_; }
    __host__ __device__ bool next(int i, Unit& u) const {
        const long L = (long)i * G + c; if (L >= nwg) return false;
        int wgid = (int)L; { const int q = nwg / NXCD, r = nwg % NXCD, xcd = wgid % NXCD, off = wgid / NXCD; wgid = (xcd < r ? xcd * (q + 1) : r * (q + 1) + (xcd - r) * q) + off; }
        const int nig = WGM * nN, gid = wgid / nig, fm = gid * WGM, gsz = (nM - fm) < WGM ? (nM - fm) : WGM;
        u.pm = fm + ((wgid % nig) % gsz); u.pn = (wgid % nig) / gsz; return true;
    }
    __device__ __forceinline__ void a_ready(const Unit&) const {}
    __device__ __forceinline__ void done(const Unit&) const {}
};
__device__ __forceinline__ unsigned cvt_pk_bf16(float lo, float hi) { unsigned r; asm volatile("v_cvt_pk_bf16_f32 %0, %1, %2" : "=v"(r) : "v"(lo), "v"(hi)); return r; }
typedef float f32x2 __attribute__((ext_vector_type(2)));
__device__ __forceinline__ f32x2 gelu_pk(f32x2 v) {
    const f32x2 av = __builtin_elementwise_abs(v), d = av * 0.2316418882f + 1.0f;
    f32x2 t; t.x = __builtin_amdgcn_rcpf(d.x); t.y = __builtin_amdgcn_rcpf(d.y);
    f32x2 q = t * 0.5307027145f + (-0.7265760135f); q = q * t + 0.7107068705f; q = q * t + (-0.142248368f); q = q * t + 0.127414796f; q = q * t;
    const f32x2 s = (v * v) * (-0.72134752044f);
    f32x2 e; e.x = __builtin_amdgcn_exp2f(s.x); e.y = __builtin_amdgcn_exp2f(s.y);
    const f32x2 m = v * (q * e), r = v - m;
    f32x2 o; o.x = v.x < 0.f ? m.x : r.x; o.y = v.y < 0.f ? m.y : r.y; return o;
}

template <int ACT  > struct EpiBf16 {
    static constexpr bool PERM = true, AFTER_DRAIN = false; static_assert(ACT == 0 || ACT == 1, "EpiBf16: ACT is 0 (none) or 1 (gelu_pk)");
    bf16_t* O; int ldc; const float* bias; int split_cols; size_t split_stride; float scale0;
    __device__ __forceinline__ void operator()(const f32x4 (&acc)[2][2][4][2], const Unit& u, int wr, int wc, int fr, int fq) const {
        const int row0 = u.pm * BM + wr * 64 + fr; int colt = u.pn * BM; bf16_t* base = O;
        float sc = 1.f; if (split_cols) { const int t = colt / split_cols; base += (size_t)t * split_stride; colt -= t * split_cols; if (t == 0) sc = scale0; }
        const int col0 = colt + wc * 32 + 8 * fq, bcol0 = u.pn * BM + wc * 32 + 8 * fq;
        f32x4 bv[2][2];
#pragma unroll
        for (int bj = 0; bj < 2; ++bj)
#pragma unroll
            for (int n = 0; n < 2; ++n) bv[bj][n] = bias ? *(const f32x4*)(bias + bcol0 + bj * HALF + 4 * n) : (f32x4){0.f, 0.f, 0.f, 0.f};
#pragma unroll
        for (int ai = 0; ai < 2; ++ai)
#pragma unroll
            for (int m = 0; m < 4; ++m) { bf16_t* rowp = base + (size_t)(row0 + ai * HALF + m * 16) * ldc + col0;
#pragma unroll
                for (int bj = 0; bj < 2; ++bj) { f32x4 v0 = acc[ai][bj][m][0] + bv[bj][0], v1 = acc[ai][bj][m][1] + bv[bj][1];
                    if (ACT == 1) { f32x2 a = gelu_pk((f32x2){v0[0], v0[1]}), b = gelu_pk((f32x2){v0[2], v0[3]}), c = gelu_pk((f32x2){v1[0], v1[1]}), d = gelu_pk((f32x2){v1[2], v1[3]});
                        v0 = (f32x4){a.x, a.y, b.x, b.y}; v1 = (f32x4){c.x, c.y, d.x, d.y}; }
                    v0 = v0 * sc; v1 = v1 * sc; u32x4 w; w.x = cvt_pk_bf16(v0[0], v0[1]); w.y = cvt_pk_bf16(v0[2], v0[3]); w.z = cvt_pk_bf16(v1[0], v1[1]); w.w = cvt_pk_bf16(v1[2], v1[3]);
                    *(u32x4*)(rowp + bj * HALF) = w; } }
    }
};
struct EpiResid {
    static constexpr bool PERM = true, AFTER_DRAIN = false;
    const bf16_t* X; bf16_t* Z; int ldc; float alpha; float accscale;
    __device__ __forceinline__ void operator()(const f32x4 (&acc)[2][2][4][2], const Unit& u, int wr_, int wc_, int fr_, int fq_) const {
        int t = my_lane(); asm volatile("" : "+v"(t));
        const int wv = my_wave(), wr = wv >> 2, wc = wv & 3, fr = t & 15, fq = t >> 4; (void)wr_; (void)wc_; (void)fr_; (void)fq_;
        const int row0 = u.pm * BM + wr * 64 + fr, col0 = u.pn * BM + wc * 32 + 8 * fq;
#pragma unroll
        for (int ai = 0; ai < 2; ++ai)
#pragma unroll
            for (int m = 0; m < 4; ++m) { const unsigned off = (unsigned)(row0 + ai * HALF + m * 16) * (unsigned)ldc + (unsigned)col0;
#pragma unroll
                for (int bj = 0; bj < 2; ++bj) { const u32x4 xw = *(const u32x4*)(X + off + bj * HALF);
                    const f32x4 x0 = {__uint_as_float(xw.x << 16), __uint_as_float(xw.x & 0xffff0000u), __uint_as_float(xw.y << 16), __uint_as_float(xw.y & 0xffff0000u)};
                    const f32x4 x1 = {__uint_as_float(xw.z << 16), __uint_as_float(xw.z & 0xffff0000u), __uint_as_float(xw.w << 16), __uint_as_float(xw.w & 0xffff0000u)};
                    const f32x4 v0 = x0 * alpha + acc[ai][bj][m][0] * accscale, v1 = x1 * alpha + acc[ai][bj][m][1] * accscale;
                    u32x4 w; w.x = cvt_pk_bf16(v0[0], v0[1]); w.y = cvt_pk_bf16(v0[2], v0[3]); w.z = cvt_pk_bf16(v1[0], v1[1]); w.w = cvt_pk_bf16(v1[2], v1[3]);
                    *(u32x4*)(Z + off + bj * HALF) = w; }
                asm volatile("" ::: "memory"); }
    }
};

template <class Epi, class Sched, bool ALIGN_EPI = false, bool SP2 = false, bool FP8 = false, int SCALE_B = 0x7F7F7F7F>
__device__ __forceinline__ void gemm_phase(PG8_LAS unsigned char* lds, const Gemm g, const Sched& S, const Epi& E) {
    const int tid = my_tid(), wid = __builtin_amdgcn_readfirstlane(tid >> 6), lane = tid & 63, wr = wid >> 2, wc = wid & 3, fr = lane & 15, fq = lane >> 4;
    const int K = g.K, nt = FP8 ? K / 128 : K / BK;
    unsigned voffA[2], voffB[2];
#pragma unroll
    for (int i = 0; i < 2; ++i) { int R, C; stage_rc(tid * 16 + i * 8192, R, C); const int Rb = Epi::PERM ? ((R & ~31) + perm32(R & 31)) : R;
        voffA[i] = FP8 ? (unsigned)(R * K + C * 2) : (unsigned)(R * K + C) * 2u; voffB[i] = FP8 ? (unsigned)(Rb * K + C * 2) : (unsigned)(Rb * K + C) * 2u; }
    const unsigned kstep = (unsigned)(BK * 2);
    const unsigned hstep = (unsigned)HALF * (unsigned)K * (FP8 ? 1u : 2u);
    const unsigned tstep = 2u * hstep;
    const unsigned ldsw = (unsigned)wid * 1024u;
    const int aoff = lds_byte(wr * 64 + fr, fq * 8), boff = lds_byte(wc * 32 + fr, fq * 8);
#define PG8_SA(b, h) (((b) * 2 + (h)) * HTB)
#define PG8_SB(b, h) ((4 + (b) * 2 + (h)) * HTB)
    const __amdgpu_buffer_rsrc_t rsrc_voffA = __builtin_amdgcn_make_buffer_rsrc((void*)g.A, (short)0, -1, 0x00020000), rsrc_voffB = __builtin_amdgcn_make_buffer_rsrc((void*)g.Bt, (short)0, -1, 0x00020000);
    const char* const base_voffA = (const char*)g.A; const char* const base_voffB = (const char*)g.Bt;
#define PG8_STAGE(bufoff, goff, voff) do { _Pragma("unroll") for (int _i = 0; _i < 2; ++_i) { \
        if constexpr (FP8) __builtin_amdgcn_raw_ptr_buffer_load_lds(rsrc_##voff, (PG8_LAS void*)(lds + (bufoff) + ldsw + _i * 8192), 16, (int)(voff)[_i], (int)(goff), 0, 0); \
        else __builtin_amdgcn_global_load_lds((const unsigned*)(base_##voff + (size_t)(goff) + (voff)[_i]), (PG8_LAS unsigned*)(lds + (bufoff) + ldsw + _i * 8192), 16, 0, 0); } } while (0)
#define PG8_LDA(dst, b, h) do { _Pragma("unroll") for (int m = 0; m < 4; ++m) _Pragma("unroll") for (int k = 0; k < 2; ++k) dst[m][k] = *(const PG8_LAS bf16x8*)(lds + PG8_SA(b, h) + aoff + m * 2048 + k * 1024); } while (0)
#define PG8_LDB(dst, b, h) do { _Pragma("unroll") for (int n = 0; n < 2; ++n) _Pragma("unroll") for (int k = 0; k < 2; ++k) dst[n][k] = *(const PG8_LAS bf16x8*)(lds + PG8_SB(b, h) + boff + n * 2048 + k * 1024); } while (0)
#define PG8_MMA(ai, bj, At, Bt) do { __builtin_amdgcn_s_setprio(1); _Pragma("unroll") for (int m = 0; m < 4; ++m) _Pragma("unroll") for (int n = 0; n < 2; ++n) { \
        if constexpr (FP8) acc[ai][bj][m][n] = __builtin_amdgcn_mfma_scale_f32_16x16x128_f8f6f4(cat8(Bt[n][0], Bt[n][1]), cat8(At[m][0], At[m][1]), acc[ai][bj][m][n], 0, 0, 0, SCALE_B, 0, 0x7F7F7F7F); \
        else { _Pragma("unroll") for (int k = 0; k < 2; ++k) acc[ai][bj][m][n] = __builtin_amdgcn_mfma_f32_16x16x32_bf16(Bt[n][k], At[m][k], acc[ai][bj][m][n], 0, 0, 0); } } \
        __builtin_amdgcn_s_setprio(0); } while (0)
#define PG8_WAIT_V(n) asm volatile("s_waitcnt vmcnt(" #n ")" ::: "memory")
#define PG8_WAIT_L(n) asm volatile("s_waitcnt lgkmcnt(" #n ")" ::: "memory")
#define PG8_BAR __builtin_amdgcn_s_barrier()
#define PG8_SCHED __builtin_amdgcn_sched_barrier(0)
    Unit cur, nxt; int ui = 0;
    if (!S.next(0, cur)) return;
    f32x4 acc[2][2][4][2];
#pragma unroll
    for (int a = 0; a < 2; ++a)
#pragma unroll
        for (int b = 0; b < 2; ++b)
#pragma unroll
            for (int m = 0; m < 4; ++m)
#pragma unroll
                for (int n = 0; n < 2; ++n) acc[a][b][m][n] = (f32x4){0.f, 0.f, 0.f, 0.f};
    bf16x8 At[4][2], B0[2][2], B1[2][2];
    unsigned cA = (unsigned)cur.pm * tstep, cB = (unsigned)cur.pn * tstep;
    S.a_ready(cur);
    if constexpr (SP2) {
        PG8_STAGE(PG8_SB(0, 0), cB, voffB); PG8_STAGE(PG8_SB(0, 1), cB + hstep, voffB); PG8_STAGE(PG8_SA(0, 0), cA, voffA); PG8_STAGE(PG8_SA(0, 1), cA + hstep, voffA);
        if (wr == 1) PG8_BAR;
        PG8_WAIT_V(2); PG8_BAR;
        PG8_STAGE(PG8_SB(1, 0), cB + kstep, voffB); PG8_STAGE(PG8_SA(1, 0), cA + kstep, voffA); PG8_STAGE(PG8_SB(1, 1), cB + hstep + kstep, voffB);
        PG8_WAIT_V(6); PG8_BAR;
    } else {
        PG8_STAGE(PG8_SB(0, 0), cB, voffB); PG8_STAGE(PG8_SA(0, 0), cA, voffA); PG8_STAGE(PG8_SB(0, 1), cB + hstep, voffB); PG8_STAGE(PG8_SA(0, 1), cA + hstep, voffA);
        if (wr == 1) PG8_BAR;
        PG8_WAIT_V(4); PG8_BAR;
        PG8_STAGE(PG8_SB(1, 0), cB + kstep, voffB); PG8_STAGE(PG8_SA(1, 0), cA + kstep, voffA); PG8_STAGE(PG8_SB(1, 1), cB + hstep + kstep, voffB);
        PG8_WAIT_V(6); PG8_BAR;
    }
    for (;;) {
        const bool has_next = S.next(ui + 1, nxt);
        const unsigned nA = has_next ? (unsigned)nxt.pm * tstep : cA, nB = has_next ? (unsigned)nxt.pn * tstep : cB;
        for (int t = 0; t < nt; t += 2) {
            const bool last = (t == nt - 2);
            const unsigned a1 = cA + (unsigned)(t + 1) * kstep;
            const unsigned a2 = last ? nA : cA + (unsigned)(t + 2) * kstep, b2 = last ? nB : cB + (unsigned)(t + 2) * kstep;
            const unsigned a3 = a2 + kstep, b3 = b2 + kstep;
            if (last && has_next) S.a_ready(nxt);
            if constexpr (SP2) {
            PG8_LDB(B0, 0, 0); PG8_LDB(B1, 0, 1); PG8_SCHED; PG8_LDA(At, 0, 0); PG8_STAGE(PG8_SA(1, 1), a1 + hstep, voffA);
            PG8_WAIT_V(8); PG8_WAIT_L(0); PG8_BAR; PG8_MMA(0, 0, At, B0); PG8_MMA(0, 1, At, B1); PG8_BAR; PG8_SCHED;
            PG8_LDA(At, 0, 1); PG8_STAGE(PG8_SB(0, 0), b2, voffB); PG8_STAGE(PG8_SB(0, 1), b2 + hstep, voffB); PG8_STAGE(PG8_SA(0, 0), a2, voffA);
            PG8_WAIT_V(8); PG8_WAIT_L(0); PG8_BAR; PG8_MMA(1, 0, At, B0); PG8_MMA(1, 1, At, B1); PG8_BAR; PG8_SCHED;
            PG8_LDB(B0, 1, 0); PG8_LDB(B1, 1, 1); PG8_SCHED; PG8_LDA(At, 1, 0); PG8_STAGE(PG8_SA(0, 1), a2 + hstep, voffA);
            PG8_WAIT_V(8); PG8_WAIT_L(0); PG8_BAR; PG8_MMA(0, 0, At, B0); PG8_MMA(0, 1, At, B1); PG8_BAR; PG8_SCHED;
            PG8_LDA(At, 1, 1); PG8_STAGE(PG8_SB(1, 0), b3, voffB); PG8_STAGE(PG8_SB(1, 1), b3 + hstep, voffB); PG8_STAGE(PG8_SA(1, 0), a3, voffA);
            PG8_WAIT_V(8); PG8_WAIT_L(0); PG8_BAR; PG8_MMA(1, 0, At, B0); PG8_MMA(1, 1, At, B1); PG8_BAR; PG8_SCHED;
            } else {
            PG8_LDB(B0, 0, 0); PG8_SCHED; PG8_LDA(At, 0, 0); PG8_STAGE(PG8_SA(1, 1), a1 + hstep, voffA);
            PG8_WAIT_L(8); PG8_BAR; PG8_WAIT_L(0); PG8_MMA(0, 0, At, B0); PG8_BAR; PG8_SCHED;
            PG8_LDB(B1, 0, 1); PG8_STAGE(PG8_SB(0, 0), b2, voffB);
            PG8_BAR; PG8_WAIT_L(0); PG8_MMA(0, 1, At, B1); PG8_BAR;
            PG8_LDA(At, 0, 1); PG8_STAGE(PG8_SA(0, 0), a2, voffA);
            PG8_BAR; PG8_WAIT_L(0); PG8_MMA(1, 0, At, B0); PG8_BAR; PG8_SCHED;
            PG8_STAGE(PG8_SB(0, 1), b2 + hstep, voffB);
            PG8_WAIT_V(6); PG8_BAR; PG8_MMA(1, 1, At, B1); PG8_BAR;
            PG8_LDB(B0, 1, 0); PG8_SCHED; PG8_LDA(At, 1, 0); PG8_STAGE(PG8_SA(0, 1), a2 + hstep, voffA);
            PG8_WAIT_L(8); PG8_BAR; PG8_WAIT_L(0); PG8_MMA(0, 0, At, B0); PG8_BAR; PG8_SCHED;
            PG8_LDB(B1, 1, 1); PG8_STAGE(PG8_SB(1, 0), b3, voffB);
            PG8_BAR; PG8_WAIT_L(0); PG8_MMA(0, 1, At, B1); PG8_BAR;
            PG8_LDA(At, 1, 1); PG8_STAGE(PG8_SA(1, 0), a3, voffA);
            PG8_BAR; PG8_WAIT_L(0); PG8_MMA(1, 0, At, B0); PG8_BAR; PG8_SCHED;
            PG8_STAGE(PG8_SB(1, 1), b3 + hstep, voffB);
            PG8_WAIT_V(6); PG8_BAR; PG8_MMA(1, 1, At, B1); PG8_BAR;
            }
        }
        if constexpr (ALIGN_EPI) { if (wr == 0) PG8_BAR; }
        if constexpr (!Epi::AFTER_DRAIN) { E(acc, cur, wr, wc, fr, fq); S.done(cur); }
        if (!has_next) break;
#pragma unroll
        for (int a = 0; a < 2; ++a)
#pragma unroll
            for (int b = 0; b < 2; ++b)
#pragma unroll
                for (int m = 0; m < 4; ++m)
#pragma unroll
                    for (int n = 0; n < 2; ++n) acc[a][b][m][n] = (f32x4){0.f, 0.f, 0.f, 0.f};
        cur = nxt; cA = nA; cB = nB; ++ui;
        if constexpr (ALIGN_EPI) { if (wr == 1) PG8_BAR; }
    }
    PG8_WAIT_V(0);
    if constexpr (!ALIGN_EPI) { if (wr == 0) PG8_BAR; }
    PG8_BAR;
    if constexpr (Epi::AFTER_DRAIN) { E.fused(acc, cur, wr, wc, fr, fq, lds, wid, lane); S.done(cur); }
#undef PG8_SA
#undef PG8_SB
#undef PG8_STAGE
#undef PG8_LDA
#undef PG8_LDB
#undef PG8_MMA
#undef PG8_WAIT_V
#undef PG8_WAIT_L
#undef PG8_BAR
#undef PG8_SCHED
}
}


namespace att {
using bf16x8 = __attribute__((ext_vector_type(8))) short;
using s16x4  = __attribute__((ext_vector_type(4))) short;
using f32x16 = __attribute__((ext_vector_type(16))) float;
using u32x4  = __attribute__((ext_vector_type(4))) unsigned;
using u32x2  = __attribute__((ext_vector_type(2))) unsigned;
constexpr int SHM_V = 16384, SHM_K = 16384;
constexpr int L_V = 0, L_K = 32768, L_WS = 69632, L_SEL = 131072, L_END = 139264;
#ifndef ATT_SDEPTH
#define ATT_SDEPTH 1
#endif
constexpr int SDEPTH = ATT_SDEPTH;
constexpr float THR2 = 11.0f;
#define KSWZ(row, colB) ((row) * 256 + ((colB) ^ (((row) & 7) << 4)))
#define SBAR() __builtin_amdgcn_sched_barrier(0)
__device__ __forceinline__ int crow(int r, int hi) { return (r & 3) + 8 * (r >> 2) + 4 * hi; }
__device__ __forceinline__ unsigned cvtpk(float lo, float hi) { unsigned r; asm volatile("v_cvt_pk_bf16_f32 %0, %1, %2" : "=v"(r) : "v"(lo), "v"(hi)); return r; }
__device__ __forceinline__ bf16x8 ld8(const bf16* p) { return *reinterpret_cast<const bf16x8*>(p); }
__device__ __forceinline__ float bf2f(bf16 v) { return __uint_as_float((unsigned)v << 16); }
__device__ __forceinline__ float ninf() { return __uint_as_float(0xff800000u); }

template <int ND0> __device__ __forceinline__ void qkt(f32x16& p0, f32x16& p1, const char* Ks, const bf16x8* qr, int r32, int hi, int d0base) {
  p0 = f32x16{}; p1 = f32x16{};
#pragma unroll
  for (int d0 = 0; d0 < ND0; ++d0) { const int cb = ((d0base + d0) * 16 + hi * 8) * 2;
    bf16x8 b0 = *reinterpret_cast<const bf16x8*>(Ks + KSWZ(r32, cb));
    bf16x8 b1 = *reinterpret_cast<const bf16x8*>(Ks + KSWZ(32 + r32, cb));
    p0 = __builtin_amdgcn_mfma_f32_32x32x16_bf16(b0, qr[d0], p0, 0, 0, 0);
    p1 = __builtin_amdgcn_mfma_f32_32x32x16_bf16(b1, qr[d0], p1, 0, 0, 0); }
}
__device__ __forceinline__ int v_st(int k, int c) { const int kk = (k & ~0xC) | ((k & 4) << 1) | ((k & 8) >> 1); return ((kk >> 3) * 4 + (c >> 5)) * 512 + ((kk & 7) * 32 + (c & 31)) * 2; }
__device__ __forceinline__ int v_rd_base(int lane) { return ((lane & 3) << 3) | (((lane >> 2) & 3) << 6) | (((lane >> 4) & 1) << 5) | (((lane >> 5) & 1) << 8); }
constexpr int v_rd_off(int d0, int ks, int half) { return d0 * 512 + ks * 4096 + half * 2048; }
template <int OFF> __device__ __forceinline__ s16x4 tr_read(int vb) {
  s16x4 r; asm volatile("ds_read_b64_tr_b16 %0, %1 offset:%2" : "=&v"(r) : "v"(vb), "i"(OFF) : "memory"); return r;
}
template <int D0> __device__ __forceinline__ void pv_one(f32x16& od, int vb, bf16x8 pa0, bf16x8 pa1, bf16x8 pa2, bf16x8 pa3) {
#define PK(L, H) (bf16x8){L[0], L[1], L[2], L[3], H[0], H[1], H[2], H[3]}
  { const s16x4 l0 = tr_read<v_rd_off(D0, 0, 0)>(vb), h0 = tr_read<v_rd_off(D0, 0, 1)>(vb), l1 = tr_read<v_rd_off(D0, 1, 0)>(vb), h1 = tr_read<v_rd_off(D0, 1, 1)>(vb);
    asm volatile("s_waitcnt lgkmcnt(0)" ::: "memory"); SBAR();
    od = __builtin_amdgcn_mfma_f32_32x32x16_bf16(pa0, PK(l0, h0), od, 0, 0, 0);
    od = __builtin_amdgcn_mfma_f32_32x32x16_bf16(pa1, PK(l1, h1), od, 0, 0, 0); }
  { const s16x4 l2 = tr_read<v_rd_off(D0, 2, 0)>(vb), h2 = tr_read<v_rd_off(D0, 2, 1)>(vb), l3 = tr_read<v_rd_off(D0, 3, 0)>(vb), h3 = tr_read<v_rd_off(D0, 3, 1)>(vb);
    asm volatile("s_waitcnt lgkmcnt(0)" ::: "memory"); SBAR();
    od = __builtin_amdgcn_mfma_f32_32x32x16_bf16(pa2, PK(l2, h2), od, 0, 0, 0);
    od = __builtin_amdgcn_mfma_f32_32x32x16_bf16(pa3, PK(l3, h3), od, 0, 0, 0); }
#undef PK
}
__device__ __forceinline__ void pv_d0(f32x16* o, int vb, bf16x8 pa0, bf16x8 pa1, bf16x8 pa2, bf16x8 pa3) {
  pv_one<0>(o[0], vb, pa0, pa1, pa2, pa3); pv_one<1>(o[1], vb, pa0, pa1, pa2, pa3); pv_one<2>(o[2], vb, pa0, pa1, pa2, pa3); pv_one<3>(o[3], vb, pa0, pa1, pa2, pa3);
}

template <int MODE> __device__ __forceinline__ void partialSM(f32x16& p0, f32x16& p1, float Cs, float slope2, float thr, int k0, int qpos, int hi,
                                                              const char* selrow, bool diag, float& m_reg, float& off, float& alpha, bool& dead) {
#pragma unroll
  for (int r = 0; r < 16; ++r) { const float cr = (float)((r & 3) + 8 * (r >> 2)); p0[r] = fmaf(p0[r], Cs, cr); p1[r] = fmaf(p1[r], Cs, cr); }
  if (MODE == 0) {
    if (diag) { const int dqh = qpos - k0 - 4 * hi;
#pragma unroll
      for (int r = 0; r < 16; ++r) { const int cr = (r & 3) + 8 * (r >> 2); if (cr > dqh) p0[r] = ninf(); if (cr + 32 > dqh) p1[r] = ninf(); } }
  } else {
    const u32x2 w = *reinterpret_cast<const u32x2*>(selrow + (k0 >> 5) * 4);
    const unsigned w0 = w.x >> (4 * hi), w1 = w.y >> (4 * hi);
    const float ninf_ = ninf();
#pragma unroll
    for (int r = 0; r < 16; ++r) { const int cr = (r & 3) + 8 * (r >> 2); unsigned t0, t1;
      asm("v_bfe_i32 %0, %1, %2, 1" : "=v"(t0) : "v"(w0), "n"(cr)); asm("v_bfi_b32 %0, %1, %2, %0" : "+v"(p0[r]) : "v"(t0), "s"(ninf_));
      asm("v_bfe_i32 %0, %1, %2, 1" : "=v"(t1) : "v"(w1), "n"(cr)); asm("v_bfi_b32 %0, %1, %2, %0" : "+v"(p1[r]) : "v"(t1), "s"(ninf_)); }
  }
  float pm0 = p0[0], pm1 = p1[0];
#pragma unroll
  for (int r = 1; r < 16; ++r) { pm0 = fmaxf(pm0, p0[r]); pm1 = fmaxf(pm1, p1[r]); }
  const float tb = (float)(k0 + 4 * hi - qpos);
  float tmax = fmaxf(pm0, pm1 + 32.f) + tb;
  { auto rr = __builtin_amdgcn_permlane32_swap(__float_as_uint(tmax), __float_as_uint(tmax), false, false);
    tmax = fmaxf(__uint_as_float(rr[0]), __uint_as_float(rr[1])); }
  dead = (MODE == 0) && __all((tmax - m_reg) * slope2 < -150.f);
  if (dead) { alpha = 1.f; off = 0.f; return; }
  if (__builtin_expect(__all(tmax - m_reg <= thr), 1)) { alpha = 1.f; }
  else { const float mn = fmaxf(m_reg, tmax); alpha = __builtin_amdgcn_exp2f((m_reg - mn) * slope2); m_reg = mn; }
  off = (tb - m_reg) * slope2;
#pragma unroll
  for (int r = 0; r < 16; ++r) p0[r] = __builtin_amdgcn_exp2f(fmaf(p0[r], slope2, off));
}
__device__ __forceinline__ void finishSM(f32x16& p0, f32x16& p1, float slope2, float off1, float alpha, float& l_reg, bf16x8& pa0, bf16x8& pa1, bf16x8& pa2, bf16x8& pa3) {
#pragma unroll
  for (int r = 0; r < 16; ++r) p1[r] = __builtin_amdgcn_exp2f(fmaf(p1[r], slope2, off1));
  float ps = 0;
#pragma unroll
  for (int r = 0; r < 16; ++r) ps += p0[r];
#pragma unroll
  for (int r = 0; r < 16; ++r) ps += p1[r];
  { auto rr = __builtin_amdgcn_permlane32_swap(__float_as_uint(ps), __float_as_uint(ps), false, false);
    ps = __uint_as_float(rr[0]) + __uint_as_float(rr[1]); }
  l_reg = l_reg * alpha + ps;
#define PK4(P, BASE, OUT) do { unsigned a0 = cvtpk(P[BASE + 0], P[BASE + 1]), a1 = cvtpk(P[BASE + 2], P[BASE + 3]);   \
    unsigned b0 = cvtpk(P[BASE + 4], P[BASE + 5]), b1 = cvtpk(P[BASE + 6], P[BASE + 7]);                              \
    auto r0 = __builtin_amdgcn_permlane32_swap(a0, b0, false, false); auto r1 = __builtin_amdgcn_permlane32_swap(a1, b1, false, false); \
    u32x4 w = {r0[0], r1[0], r0[1], r1[1]}; OUT = *reinterpret_cast<bf16x8*>(&w); } while (0)
  PK4(p0, 0, pa0); PK4(p0, 8, pa1); PK4(p1, 0, pa2); PK4(p1, 8, pa3);
#undef PK4
}

typedef float f32x2v __attribute__((ext_vector_type(2)));
__device__ __forceinline__ void cnt_ge(int& cnt, unsigned a, unsigned b) { asm volatile("v_cmp_ge_u32_e32 vcc, %1, %2\n\tv_addc_co_u32_e32 %0, vcc, 0, %0, vcc" : "+v"(cnt) : "v"(a), "v"(b) : "vcc"); }
__device__ __forceinline__ void cnt_gt(int& cnt, unsigned a, unsigned b) { asm volatile("v_cmp_gt_u32_e32 vcc, %1, %2\n\tv_addc_co_u32_e32 %0, vcc, 0, %0, vcc" : "+v"(cnt) : "v"(a), "v"(b) : "vcc"); }
__device__ __forceinline__ void cnt_ge4(int& c0, int& c1, int& c2, int& c3, unsigned k0, unsigned k1, unsigned k2, unsigned k3, unsigned b) {
  unsigned long long m0, m1, m2, m3;
  asm volatile("v_cmp_ge_u32_e64 %4, %8, %12\n\tv_cmp_ge_u32_e64 %5, %9, %12\n\tv_cmp_ge_u32_e64 %6, %10, %12\n\tv_cmp_ge_u32_e64 %7, %11, %12\n\t"
               "v_addc_co_u32_e64 %0, %4, 0, %0, %4\n\tv_addc_co_u32_e64 %1, %5, 0, %1, %5\n\tv_addc_co_u32_e64 %2, %6, 0, %2, %6\n\tv_addc_co_u32_e64 %3, %7, 0, %3, %7"
               : "+v"(c0), "+v"(c1), "+v"(c2), "+v"(c3), "=&s"(m0), "=&s"(m1), "=&s"(m2), "=&s"(m3) : "v"(k0), "v"(k1), "v"(k2), "v"(k3), "v"(b));
}
__device__ __forceinline__ unsigned wlane(unsigned val, int ln, unsigned old) { asm volatile("v_writelane_b32 %0, %1, %2" : "+v"(old) : "s"(val), "s"(ln)); return old; }
__device__ __forceinline__ int half_sum(int x, int hi) {
  x += __builtin_amdgcn_update_dpp(0, x, 0x111, 0xf, 0xf, true);
  x += __builtin_amdgcn_update_dpp(0, x, 0x112, 0xf, 0xf, true);
  x += __builtin_amdgcn_update_dpp(0, x, 0x114, 0xf, 0xf, true);
  x += __builtin_amdgcn_update_dpp(0, x, 0x118, 0xf, 0xf, true);
  const int a = __builtin_amdgcn_readlane(x, 15) + __builtin_amdgcn_readlane(x, 31);
  const int b = __builtin_amdgcn_readlane(x, 47) + __builtin_amdgcn_readlane(x, 63);
  return hi ? b : a;
}
__device__ __forceinline__ unsigned take_low(unsigned m, int k) {
  while (__builtin_popcount(m) > k) m &= ~(0x80000000u >> __builtin_clz(m));
  return m;
}

__device__ __forceinline__ void dsa_select(const bf16* __restrict__ PROJ, int b, int q0, unsigned* SEL, char* lds) {
  int tid = my_tid(); asm volatile("" : "+v"(tid));
  const int wid = __builtin_amdgcn_readfirstlane(tid >> 6), lane = tid & 63, r32 = lane & 31, hi = lane >> 5;
  const size_t tokb = (size_t)b * SEQ;
  const int nt32 = (q0 >> 5) + 1, nch = (nt32 + 15) >> 4;
  const int srow = wid * 64 + (lane >> 3), spc = lane & 7;
  const unsigned sloff = (unsigned)((srow * LDP + 8 * spc) * 2);
  const __amdgpu_buffer_rsrc_t srd = __builtin_amdgcn_make_buffer_rsrc((void*)(PROJ + tokb * LDP + C_IK), (short)0, (int)(SEQ * LDP * 2), 0x00020000);
  bf16x8 af[4]; float w[16]; bf16x8 st[8];
#define DSA_LOADS(RD) do { const int tA_ = q0 + (RD) * 16 + wid * 2; \
    const bf16* ap_ = PROJ + (tokb + tA_ + (r32 >> 4)) * LDP + C_IQ + (r32 & 15) * 64 + hi * 8; \
    _Pragma("unroll") for (int ks = 0; ks < 4; ++ks) af[ks] = ld8(ap_ + ks * 16); \
    _Pragma("unroll") for (int r = 0; r < 16; ++r) { const int head = (r & 3) + 8 * ((r >> 2) & 1) + 4 * hi; w[r] = bf2f(PROJ[(tokb + tA_ + (r >> 3)) * LDP + C_IW + head]); } \
    _Pragma("unroll") for (int i = 0; i < 8; ++i) st[i] = __builtin_bit_cast(bf16x8, __builtin_amdgcn_raw_buffer_load_b128(srd, (int)(sloff + (unsigned)(8 * i * LDP * 2)), 0, 0)); } while (0)
  DSA_LOADS(0);
  for (int rd = 0; rd < 2; ++rd) {
    const int tl = rd * 16 + wid * 2, tA = q0 + tl;
#pragma unroll
    for (int r = 0; r < 16; ++r) w[r] *= 0.5f;
    const int myq = tA + hi;
    unsigned key[64];
#pragma unroll
    for (int c = 0; c < 4; ++c) {
      if (c < nch) {
        char* buf = lds + (c & 1) * 65536;
#pragma unroll
        for (int i = 0; i < 8; ++i) { const int row = srow + 8 * i; *reinterpret_cast<bf16x8*>(buf + row * 128 + ((spc ^ ((row >> 1) & 7)) << 4)) = st[i]; }
        if (c + 1 < nch) {
#pragma unroll
          for (int i = 0; i < 8; ++i) st[i] = __builtin_bit_cast(bf16x8, __builtin_amdgcn_raw_buffer_load_b128(srd, (int)(sloff + (unsigned)(8 * i * LDP * 2)), 512 * (c + 1) * LDP * 2, 0));
        }
        __syncthreads();
#define IDX_MMA(CC, U) do { const int row_ = 32 * (U) + r32; CC = f32x16{}; _Pragma("unroll") for (int ks = 0; ks < 4; ++ks) { \
            const bf16x8 bfr = *reinterpret_cast<const bf16x8*>(buf + row_ * 128 + (((2 * ks + hi) ^ ((row_ >> 1) & 7)) << 4)); CC = __builtin_amdgcn_mfma_f32_32x32x16_bf16(af[ks], bfr, CC, 0, 0, 0); } } while (0)
#define IDX_RED(CC, U) do { const int j_ = 16 * c + (U); f32x2v l0 = {0.f, 0.f}, l1 = {0.f, 0.f}; \
          _Pragma("unroll") for (int i = 0; i < 4; ++i) { l0 = __builtin_elementwise_fma((f32x2v){w[2 * i], w[2 * i + 1]}, (f32x2v){CC[2 * i], CC[2 * i + 1]}, l0); \
                                                          l1 = __builtin_elementwise_fma((f32x2v){w[8 + 2 * i], w[9 + 2 * i]}, (f32x2v){CC[8 + 2 * i], CC[9 + 2 * i]}, l1); } \
          float s0 = l0[0] + l0[1], s1 = l1[0] + l1[1]; \
          _Pragma("unroll") for (int r = 0; r < 8; ++r) { asm("v_fma_f32 %0, %1, |%2|, %0" : "+v"(s0) : "v"(w[r]), "v"(CC[r])); asm("v_fma_f32 %0, %1, |%2|, %0" : "+v"(s1) : "v"(w[8 + r]), "v"(CC[8 + r])); } \
          auto rr = __builtin_amdgcn_permlane32_swap(__float_as_uint(s0), __float_as_uint(s1), false, false); \
          const float tot = __uint_as_float(rr[0]) + __uint_as_float(rr[1]); \
          const unsigned bits = __float_as_uint(tot); \
          const unsigned srt = bits ^ ((unsigned)((int)bits >> 31) | 0x80000000u); \
          key[j_] = (j_ * 32 + r32 <= myq) ? srt : 0u; } while (0)
#if defined(DSK) && DSK == 3
        { f32x16 ccA, ccB; IDX_MMA(ccA, 0);
#pragma unroll
          for (int u = 0; u < 16; u += 2) { IDX_MMA(ccB, u + 1); IDX_RED(ccA, u); __builtin_amdgcn_sched_barrier(0); if (u + 2 < 16) IDX_MMA(ccA, u + 2); IDX_RED(ccB, u + 1); __builtin_amdgcn_sched_barrier(0); } }
        _Pragma("unroll") for (int u = 0; u < 16; ++u) asm volatile("" :: "v"(key[16 * c + u]));
#endif
        { f32x16 ccA, ccB; IDX_MMA(ccA, 0);
#pragma unroll
          for (int u = 0; u < 16; u += 2) { IDX_MMA(ccB, u + 1); IDX_RED(ccA, u); __builtin_amdgcn_sched_barrier(0); if (u + 2 < 16) IDX_MMA(ccA, u + 2); IDX_RED(ccB, u + 1); __builtin_amdgcn_sched_barrier(0); } }
#undef IDX_MMA
#undef IDX_RED
      } else {
#pragma unroll
        for (int u = 0; u < 16; ++u) key[16 * c + u] = 0u;
      }
    }
    __syncthreads();
    if (rd == 0) DSA_LOADS(1);
    unsigned T = 0u;
    if (tA + 2 > 256) {
      for (int bit = 31; bit >= 0; --bit) {
        const unsigned cand = T | (1u << bit);
        int cnt = 0;
#pragma unroll
        for (int cc = 0; cc < 8; ++cc) { if (cc * 8 < nt32) {
#pragma unroll
          for (int e = 0; e < 8; ++e) cnt_ge(cnt, key[cc * 8 + e], cand); } }
        const int tot = half_sum(cnt, hi);
        if (tot >= 256) T = cand;
        if (__all(tot == 256)) break;
      }
    }
    const unsigned Tm = T > 1u ? T : 1u;
    int cge = 0;
#pragma unroll
    for (int cc = 0; cc < 8; ++cc) { if (cc * 8 < nt32) {
#pragma unroll
      for (int e = 0; e < 8; ++e) cnt_ge(cge, key[cc * 8 + e], Tm); } }
    cge = half_sum(cge, hi);
    int ln = lane; asm volatile("" : "+v"(ln));
    unsigned m0 = 0xffffffffu, m1 = 0xffffffffu;
    if (__all(cge <= 256)) {
#pragma unroll
      for (int j = 0; j < 64; ++j) {
        const unsigned long long bal = __ballot(!(key[j] >= Tm));
        m0 = (ln == j) ? (unsigned)bal : m0; m1 = (ln == j) ? (unsigned)(bal >> 32) : m1; }
    } else {
      unsigned* kst = (unsigned*)(lds + wid * 16384);
#pragma unroll
      for (int j = 0; j < 64; ++j) kst[j * 64 + lane] = key[j];
      int cgt = 0;
#pragma unroll
      for (int cc = 0; cc < 8; ++cc) { if (cc * 8 < nt32) {
#pragma unroll
        for (int e = 0; e < 8; ++e) cnt_gt(cgt, key[cc * 8 + e], Tm); } }
      cgt = half_sum(cgt, hi);
      int need_lo = 256 - __builtin_amdgcn_readlane(cgt, 0), need_hi = 256 - __builtin_amdgcn_readlane(cgt, 32);
#pragma unroll 1
      for (int j = 0; j < 64; ++j) {
        const unsigned kj = kst[j * 64 + lane];
        const unsigned long long eqm = __ballot(kj == Tm), gtm = __ballot(kj > Tm);
        const unsigned tl_ = take_low((unsigned)eqm, need_lo > 0 ? need_lo : 0), th_ = take_low((unsigned)(eqm >> 32), need_hi > 0 ? need_hi : 0);
        need_lo -= __builtin_popcount(tl_); need_hi -= __builtin_popcount(th_);
        const unsigned sl = (unsigned)gtm | tl_, sh = (unsigned)(gtm >> 32) | th_;
        m0 = (ln == j) ? ~sl : m0; m1 = (ln == j) ? ~sh : m1; }
    }
    SEL[tl * 64 + lane] = m0; SEL[(tl + 1) * 64 + lane] = m1;
    __syncthreads();
  }
#undef DSA_LOADS
}

template <int MODE>
__device__ __forceinline__ void attn_unit(const bf16* __restrict__ PROJ, unsigned char* __restrict__ ATT, int b, int h, int qb, char* lds, float lam, const float* __restrict__ subln_g) {
  if (MODE == 1) { dsa_select(PROJ, b, qb * 32, (unsigned*)(lds + L_SEL), lds); __syncthreads(); }
  int tid = my_tid(); asm volatile("" : "+v"(tid));
  const int wid = __builtin_amdgcn_readfirstlane(tid >> 6), lane = tid & 63, r32 = lane & 31, hi = lane >> 5;
  constexpr int ND0 = MODE == 0 ? 4 : 8;
  const int q0 = MODE == 0 ? qb * 128 : qb * 32;
  const int wq = MODE == 0 ? (wid & 3) * 32 : 0;
  const int c = MODE == 0 ? (wid >> 2) : 0;
  const int qpos = q0 + wq + r32;
  const size_t tokb = (size_t)b * SEQ;
  const bf16* Qw = PROJ + (tokb + qpos) * LDP + (MODE == 0 ? C_DQ + h * 128 + c * 64 : C_SQ + wid * 128) + hi * 8;
  const bf16* Kh = PROJ + tokb * LDP + (MODE == 0 ? C_DK + h * 128 : C_SK);
  const bf16* Vh = PROJ + tokb * LDP + (MODE == 0 ? C_DV + h * 128 : C_SV);
  const int NT = MODE == 0 ? 2 * (qb + 1) : 2 * ((q0 + 32 + 127) >> 7);
  const float slope2 = (MODE == 0 ? exp2f(-0.5f * (float)(2 * h + 1)) : exp2f(-(float)(wid + 1))) * LOG2E;
  const float Cs = (MODE == 0 ? 0.125f : 0.08838834764831845f) * LOG2E / slope2;
  const float thr = THR2 / slope2, c32 = 32.f * slope2;
  char* V_lds = lds + L_V; char* K_lds = lds + L_K;
  float* ws = (float*)(lds + L_WS) + wid * 64; float* li_l = ws; float* al_l = ws + 32;
  unsigned* SEL = (unsigned*)(lds + L_SEL);
  const char* selrow = (const char*)(SEL + r32 * 64);

  float m_reg = -1e30f, l_reg = 0; f32x16 o[4] = {}; bf16x8 qr[ND0];
#pragma unroll
  for (int d0 = 0; d0 < ND0; ++d0) qr[d0] = ld8(Qw + d0 * 16);
  const int sr = tid >> 4, sc = (tid & 15) * 8, vst0 = v_st(sr, sc), vst1 = v_st(32 + sr, sc);
  const int vb0 = (int)(uintptr_t)V_lds + v_rd_base(lane);
  struct { bf16x8 vs0, vs1, ks0, ks1; } sr_[SDEPTH];
#define SLOAD(i, k0) do { sr_[i].vs0 = ld8(&Vh[(size_t)((k0) + sr) * LDP + sc]); sr_[i].vs1 = ld8(&Vh[(size_t)((k0) + 32 + sr) * LDP + sc]); \
    sr_[i].ks0 = ld8(&Kh[(size_t)((k0) + sr) * LDP + sc]); sr_[i].ks1 = ld8(&Kh[(size_t)((k0) + 32 + sr) * LDP + sc]); } while (0)
#define SWRITE(bb, i) do { *(bf16x8*)(V_lds + (bb) * SHM_V + vst0) = sr_[i].vs0;          \
    *(bf16x8*)(V_lds + (bb) * SHM_V + vst1) = sr_[i].vs1; const int kc = sc * 2;               \
    *(bf16x8*)(K_lds + (bb) * SHM_K + KSWZ(sr, kc)) = sr_[i].ks0;                       \
    *(bf16x8*)(K_lds + (bb) * SHM_K + KSWZ(32 + sr, kc)) = sr_[i].ks1; } while (0)
#define SWAIT() do { if constexpr (SDEPTH == 2) asm volatile("s_waitcnt vmcnt(4)" ::: "memory"); else asm volatile("s_waitcnt vmcnt(0)" ::: "memory"); } while (0)
#define RESC(a) do { if (__any((a) < 1.f)) { if (hi == 0) al_l[r32] = (a); asm volatile("s_waitcnt lgkmcnt(0)" ::: "memory"); \
    _Pragma("unroll") for (int d = 0; d < 4; ++d) _Pragma("unroll") for (int r = 0; r < 16; ++r) o[d][r] *= al_l[crow(r, hi)]; } } while (0)
#define DIAG(k0) ((k0) + 63 > q0 + wq)
  f32x16 pA0, pA1, pB0, pB1; float ofA, ofB, alA, alB; bool deadA = false, deadB = false; bf16x8 pa0, pa1, pa2, pa3;
  constexpr int SE = 0, SO = SDEPTH - 1;
  static_assert(SDEPTH == 1, "the tile loop below is written for one staging register set");
#define KT(i) ((MODE == 0 ? (NT - 1 - (i)) : (i)) * 64)
  SLOAD(SE, KT(0)); asm volatile("s_waitcnt vmcnt(0)" ::: "memory"); SWRITE(0, SE); SLOAD(SE, KT(1)); __syncthreads();
  qkt<ND0>(pA0, pA1, K_lds, qr, r32, hi, c * 4); partialSM<MODE>(pA0, pA1, Cs, slope2, thr, KT(0), qpos, hi, selrow, DIAG(KT(0)), m_reg, ofA, alA, deadA);
  SWAIT(); SWRITE(1, SO); if (2 < NT) SLOAD(SE, KT(2)); __syncthreads();
  for (int j = 1; j + 1 < NT; j += 2) {
    SBAR(); qkt<ND0>(pB0, pB1, K_lds + SHM_K, qr, r32, hi, c * 4);
    if (!deadA) { finishSM(pA0, pA1, slope2, ofA + c32, alA, l_reg, pa0, pa1, pa2, pa3); } SBAR();
    if (!deadA) { pv_d0(o, vb0, pa0, pa1, pa2, pa3); } partialSM<MODE>(pB0, pB1, Cs, slope2, thr, KT(j), qpos, hi, selrow, DIAG(KT(j)), m_reg, ofB, alB, deadB);
    __syncthreads(); SWAIT(); SWRITE(0, SE); SLOAD(SE, KT(j + 2));
    RESC(alB); __syncthreads();
    SBAR(); qkt<ND0>(pA0, pA1, K_lds, qr, r32, hi, c * 4);
    if (!deadB) { finishSM(pB0, pB1, slope2, ofB + c32, alB, l_reg, pa0, pa1, pa2, pa3); } SBAR();
    if (!deadB) { pv_d0(o, vb0 + SHM_V, pa0, pa1, pa2, pa3); } partialSM<MODE>(pA0, pA1, Cs, slope2, thr, KT(j + 1), qpos, hi, selrow, DIAG(KT(j + 1)), m_reg, ofA, alA, deadA);
    __syncthreads(); SWAIT(); SWRITE(1, SO); if (j + 3 < NT) SLOAD(SO, KT(j + 3));
    RESC(alA); __syncthreads();
  }
  SBAR(); qkt<ND0>(pB0, pB1, K_lds + SHM_K, qr, r32, hi, c * 4);
  if (!deadA) { finishSM(pA0, pA1, slope2, ofA + c32, alA, l_reg, pa0, pa1, pa2, pa3); } SBAR();
  if (!deadA) { pv_d0(o, vb0, pa0, pa1, pa2, pa3); } partialSM<MODE>(pB0, pB1, Cs, slope2, thr, KT(NT - 1), qpos, hi, selrow, DIAG(KT(NT - 1)), m_reg, ofB, alB, deadB);
  __syncthreads(); RESC(alB);
  if (!deadB) { finishSM(pB0, pB1, slope2, ofB + c32, alB, l_reg, pa0, pa1, pa2, pa3); } SBAR();
  if (!deadB) { pv_d0(o, vb0 + SHM_V, pa0, pa1, pa2, pa3); }
#undef KT
#undef SLOAD
#undef SWRITE
#undef SWAIT
#undef RESC
#undef DIAG
  if (hi == 0) li_l[r32] = l_reg; asm volatile("s_waitcnt lgkmcnt(0)" ::: "memory");
  {
    float rli[16];
#pragma unroll
    for (int r = 0; r < 16; ++r) rli[r] = __builtin_amdgcn_rcpf(li_l[crow(r, hi)]);
#pragma unroll
    for (int d0 = 0; d0 < 4; ++d0)
#pragma unroll
      for (int r = 0; r < 16; ++r) o[d0][r] *= rli[r];
  }
  __syncthreads();
  if (MODE == 0) {
    float* X = (float*)lds;
    if (wid >= 4) {
#pragma unroll
      for (int d0 = 0; d0 < 4; ++d0)
#pragma unroll
        for (int r = 0; r < 16; ++r) X[(wid - 4) * 4096 + crow(r, hi) * 128 + d0 * 32 + r32] = o[d0][r];
    }
    __syncthreads();
    if (wid < 4) {
#pragma unroll
      for (int d0 = 0; d0 < 4; ++d0)
#pragma unroll
        for (int r = 0; r < 16; ++r) o[d0][r] -= lam * X[wid * 4096 + crow(r, hi) * 128 + d0 * 32 + r32];
    }
    __syncthreads();
  }
  if (MODE == 1 || wid < 4) {
    bf16* stg = (bf16*)(lds + wid * 8704);
#pragma unroll
    for (int d0 = 0; d0 < 4; ++d0)
#pragma unroll
      for (int r = 0; r < 16; r += 2) {
        const unsigned pk = cvtpk(o[d0][r], o[d0][r + 1]);
        stg[crow(r, hi) * 136 + d0 * 32 + r32] = (bf16)(pk & 0xffffu);
        stg[crow(r + 1, hi) * 136 + d0 * 32 + r32] = (bf16)(pk >> 16);
      }
    asm volatile("s_waitcnt lgkmcnt(0)" ::: "memory");
    bf16x8 v[8];
#pragma unroll
    for (int j = 0; j < 8; ++j) v[j] = *reinterpret_cast<const bf16x8*>(stg + r32 * 136 + hi * 64 + j * 8);
    unsigned char* orow = ATT + (tokb + q0 + wq + r32) * DM + (MODE == 0 ? h * 128 : 1024 + wid * 128) + hi * 64;
    float rs = 1.0f;
    if (MODE == 0) {
      float ss = 0.f;
#pragma unroll
      for (int j = 0; j < 8; ++j)
#pragma unroll
        for (int e = 0; e < 8; ++e) { const float x = bf2f((bf16)v[j][e]); ss = fmaf(x, x, ss); }
      { auto rr = __builtin_amdgcn_permlane32_swap(__float_as_uint(ss), __float_as_uint(ss), false, false);
        ss = __uint_as_float(rr[0]) + __uint_as_float(rr[1]); }
      rs = __builtin_amdgcn_rsqf(ss * (1.0f / 128.0f) + RMS_EPS) * (1.0f - LAM_INIT);
    }
#pragma unroll
    for (int jj = 0; jj < 4; ++jj) { u32x4 w;
#pragma unroll
      for (int q = 0; q < 4; ++q) { float y[4];
#pragma unroll
        for (int e = 0; e < 4; ++e) { const int idx = 16 * jj + 4 * q + e; float x = bf2f((bf16)v[idx >> 3][idx & 7]); if (MODE == 0) x = x * rs * subln_g[hi * 64 + idx]; y[e] = x; }
        int p = __builtin_amdgcn_cvt_pk_fp8_f32(y[0], y[1], 0, false); p = __builtin_amdgcn_cvt_pk_fp8_f32(y[2], y[3], p, true); w[q] = (unsigned)p; }
      *reinterpret_cast<u32x4*>(orow + jj * 16) = w; }
  }
  __syncthreads();
}
}

typedef float f32x4 __attribute__((ext_vector_type(4)));
typedef unsigned u32x4 __attribute__((ext_vector_type(4)));
typedef unsigned u32x2 __attribute__((ext_vector_type(2)));
__device__ __forceinline__ unsigned cvt_pk(float lo, float hi) { unsigned r; asm volatile("v_cvt_pk_bf16_f32 %0, %1, %2" : "=v"(r) : "v"(lo), "v"(hi)); return r; }
__device__ __forceinline__ float bf_lo(unsigned w) { return __uint_as_float(w << 16); }
__device__ __forceinline__ float bf_hi(unsigned w) { return __uint_as_float(w & 0xffff0000u); }
__device__ __forceinline__ float wave_sum(float v) {
#pragma unroll
  for (int o = 1; o < 64; o <<= 1) v += __shfl_xor(v, o);
  return v;
}

__device__ __forceinline__ void cvt_stream(const float* __restrict__ src, bf16* __restrict__ dst, size_t n8, size_t gtid, size_t gsz) {
  for (size_t i = gtid; i < n8; i += gsz) {
    const f32x4 a = *reinterpret_cast<const f32x4*>(src + i * 8), b = *reinterpret_cast<const f32x4*>(src + i * 8 + 4);
    u32x4 w = {cvt_pk(a[0], a[1]), cvt_pk(a[2], a[3]), cvt_pk(b[0], b[1]), cvt_pk(b[2], b[3])};
    *reinterpret_cast<u32x4*>(dst + i * 8) = w;
  }
}
__device__ __forceinline__ void cvt_stream2(const float* __restrict__ src, bf16* __restrict__ dst, unsigned char* __restrict__ dst8, size_t n8, size_t gtid, size_t gsz) {
  for (size_t i0 = gtid; i0 < n8; i0 += 4 * gsz) {
    f32x4 a[4], b[4];
#pragma unroll
    for (int q = 0; q < 4; ++q) { const size_t i = i0 + q * gsz; if (i < n8) { a[q] = *reinterpret_cast<const f32x4*>(src + i * 8); b[q] = *reinterpret_cast<const f32x4*>(src + i * 8 + 4); } }
#pragma unroll
    for (int q = 0; q < 4; ++q) { const size_t i = i0 + q * gsz; if (i < n8) {
      u32x4 w = {cvt_pk(a[q][0], a[q][1]), cvt_pk(a[q][2], a[q][3]), cvt_pk(b[q][0], b[q][1]), cvt_pk(b[q][2], b[q][3])};
      *reinterpret_cast<u32x4*>(dst + i * 8) = w;
      int p0 = __builtin_amdgcn_cvt_pk_fp8_f32(a[q][0], a[q][1], 0, false); p0 = __builtin_amdgcn_cvt_pk_fp8_f32(a[q][2], a[q][3], p0, true);
      int p1 = __builtin_amdgcn_cvt_pk_fp8_f32(b[q][0], b[q][1], 0, false); p1 = __builtin_amdgcn_cvt_pk_fp8_f32(b[q][2], b[q][3], p1, true);
      *reinterpret_cast<u32x2*>(dst8 + i * 8) = (u32x2){(unsigned)p0, (unsigned)p1}; } }
  }
}
__device__ __forceinline__ void transpose_item(const float* __restrict__ W, int K, int N, bf16* __restrict__ WT, LAS float* scr, int kb, int nb, int lane) {
  const int k0 = 64 * kb, n0 = 32 * nb; const int nn = n0 + (lane & 31); const bool ok = nn < N;
  float tv[32];
#pragma unroll
  for (int i = 0; i < 32; ++i) { const int kk = 2 * i + (lane >> 5); tv[i] = ok ? W[(size_t)(k0 + kk) * N + nn] : 0.f; }
#pragma unroll
  for (int i = 0; i < 32; ++i) { const int kk = 2 * i + (lane >> 5); scr[kk * 33 + (lane & 31)] = tv[i]; }
  asm volatile("s_waitcnt lgkmcnt(0)" ::: "memory");
  const int c = lane & 7;
#pragma unroll
  for (int j = 0; j < 4; ++j) { const int n = (lane >> 3) + 8 * j; const LAS float* s = scr + (8 * c) * 33 + n;
    u32x4 o; o.x = cvt_pk(s[0 * 33], s[1 * 33]); o.y = cvt_pk(s[2 * 33], s[3 * 33]); o.z = cvt_pk(s[4 * 33], s[5 * 33]); o.w = cvt_pk(s[6 * 33], s[7 * 33]);
    *reinterpret_cast<u32x4*>(WT + (size_t)(n0 + n) * K + k0 + 8 * c) = o; }
  asm volatile("s_waitcnt lgkmcnt(0)" ::: "memory");
}

__device__ __forceinline__ void transpose_item_fp8(const float* __restrict__ W, int K, int N, unsigned char* __restrict__ WT, LAS float* scr, int kb, int nb, int lane, float scale) {
  const int k0 = 64 * kb, n0 = 32 * nb; const int nn = n0 + (lane & 31); const bool ok = nn < N;
  float tv[32];
#pragma unroll
  for (int i = 0; i < 32; ++i) { const int kk = 2 * i + (lane >> 5); tv[i] = ok ? W[(size_t)(k0 + kk) * N + nn] * scale : 0.f; }
#pragma unroll
  for (int i = 0; i < 32; ++i) { const int kk = 2 * i + (lane >> 5); scr[kk * 33 + (lane & 31)] = tv[i]; }
  asm volatile("s_waitcnt lgkmcnt(0)" ::: "memory");
  const int c = lane & 7;
#pragma unroll
  for (int j = 0; j < 4; ++j) { const int n = (lane >> 3) + 8 * j; const LAS float* s = scr + (8 * c) * 33 + n;
    int p0 = __builtin_amdgcn_cvt_pk_fp8_f32(s[0 * 33], s[1 * 33], 0, false); p0 = __builtin_amdgcn_cvt_pk_fp8_f32(s[2 * 33], s[3 * 33], p0, true);
    int p1 = __builtin_amdgcn_cvt_pk_fp8_f32(s[4 * 33], s[5 * 33], 0, false); p1 = __builtin_amdgcn_cvt_pk_fp8_f32(s[6 * 33], s[7 * 33], p1, true);
    *reinterpret_cast<u32x2*>(WT + (size_t)(n0 + n) * K + k0 + 8 * c) = (u32x2){(unsigned)p0, (unsigned)p1}; }
  asm volatile("s_waitcnt lgkmcnt(0)" ::: "memory");
}

__device__ __forceinline__ void ln1_phase(const bf16* __restrict__ Z, const float* __restrict__ g, const float* __restrict__ bta, bf16* __restrict__ OB, unsigned char* __restrict__ O8, int gw, int ngw, int lane) {
  f32x4 gv[8], bv[8];
#pragma unroll
  for (int j = 0; j < 4; ++j) { const int e0 = 512 * j + 8 * lane;
    gv[2 * j] = *reinterpret_cast<const f32x4*>(g + e0); gv[2 * j + 1] = *reinterpret_cast<const f32x4*>(g + e0 + 4);
    bv[2 * j] = *reinterpret_cast<const f32x4*>(bta + e0); bv[2 * j + 1] = *reinterpret_cast<const f32x4*>(bta + e0 + 4); }
  u32x4 nx[4];
  if (gw < NTOK) {
#pragma unroll
    for (int j = 0; j < 4; ++j) nx[j] = *reinterpret_cast<const u32x4*>(Z + (size_t)gw * DM + 512 * j + 8 * lane); }
  for (int m = gw; m < NTOK; m += ngw) {
    float v[32]; float s = 0.f;
#pragma unroll
    for (int j = 0; j < 4; ++j) {
#pragma unroll
      for (int q = 0; q < 4; ++q) { v[8 * j + 2 * q] = bf_lo(nx[j][q]); v[8 * j + 2 * q + 1] = bf_hi(nx[j][q]); } }
    if (m + ngw < NTOK) {
#pragma unroll
      for (int j = 0; j < 4; ++j) nx[j] = *reinterpret_cast<const u32x4*>(Z + (size_t)(m + ngw) * DM + 512 * j + 8 * lane); }
#pragma unroll
    for (int i = 0; i < 32; ++i) s += v[i];
    const float mean = wave_sum(s) * (1.f / DM); float s2 = 0.f;
#pragma unroll
    for (int i = 0; i < 32; ++i) { v[i] -= mean; s2 = fmaf(v[i], v[i], s2); }
    const float rstd = 1.0f / sqrtf(wave_sum(s2) * (1.f / DM) + LN_EPS);
    bf16* obrow = OB + (size_t)m * DM; unsigned char* o8row = O8 + (size_t)m * DM;
#pragma unroll
    for (int j = 0; j < 4; ++j) {
      const int e0 = 512 * j + 8 * lane;
      float y[8];
#pragma unroll
      for (int e = 0; e < 4; ++e) { y[e] = v[8 * j + e] * rstd * gv[2 * j][e] + bv[2 * j][e]; y[4 + e] = v[8 * j + 4 + e] * rstd * gv[2 * j + 1][e] + bv[2 * j + 1][e]; }
      u32x4 w = {cvt_pk(y[0], y[1]), cvt_pk(y[2], y[3]), cvt_pk(y[4], y[5]), cvt_pk(y[6], y[7])}; *reinterpret_cast<u32x4*>(obrow + e0) = w;
      int p0 = __builtin_amdgcn_cvt_pk_fp8_f32(y[0], y[1], 0, false); p0 = __builtin_amdgcn_cvt_pk_fp8_f32(y[2], y[3], p0, true);
      int p1 = __builtin_amdgcn_cvt_pk_fp8_f32(y[4], y[5], 0, false); p1 = __builtin_amdgcn_cvt_pk_fp8_f32(y[6], y[7], p1, true);
      *reinterpret_cast<u32x2*>(o8row + e0) = (u32x2){(unsigned)p0, (unsigned)p1};
    }
  }
}

namespace peer {
using bf16x8 = att::bf16x8; using f32x16 = att::f32x16;
constexpr int L_K1 = 0, L_K2 = 32768, L_SCR = 65536;
__device__ __forceinline__ unsigned srt(float x) { const unsigned b = __float_as_uint(x); return b ^ ((unsigned)((int)b >> 31) | 0x80000000u); }
__device__ __forceinline__ float unsrt(unsigned u) { const unsigned b = (u & 0x80000000u) ? (u ^ 0x80000000u) : ~u; return __uint_as_float(b); }
__device__ __forceinline__ unsigned umax(unsigned a, unsigned b) { return a > b ? a : b; }
__device__ __forceinline__ unsigned pair_max(unsigned m) {
  auto rr = __builtin_amdgcn_permlane32_swap(m, m, false, false); return umax(rr[0], rr[1]);
}
__device__ __forceinline__ void load_keys(const float* __restrict__ k1, const float* __restrict__ k2, char* lds) {
  for (int i = my_tid(); i < 2 * 128 * 16; i += 512) {
    const int t = i >> 11, row = (i >> 4) & 127, ch = i & 15; const float* src = (t ? k2 : k1) + row * 128 + ch * 8;
    const f32x4 a = *reinterpret_cast<const f32x4*>(src), b = *reinterpret_cast<const f32x4*>(src + 4);
    u32x4 w = {cvt_pk(a[0], a[1]), cvt_pk(a[2], a[3]), cvt_pk(b[0], b[1]), cvt_pk(b[2], b[3])};
    *reinterpret_cast<u32x4*>(lds + (t ? L_K2 : L_K1) + KSWZ(row, ch * 16)) = w;
  }
}
#define PK_CE(a, b) do { const unsigned hi_ = (a) > (b) ? (a) : (b), lo_ = (a) > (b) ? (b) : (a); (a) = hi_; (b) = lo_; } while (0)
__device__ __forceinline__ void sort16_desc(unsigned (&v)[64], const int base) {
  PK_CE(v[base + 0], v[base + 1]);
  PK_CE(v[base + 2], v[base + 3]);
  PK_CE(v[base + 0], v[base + 2]);
  PK_CE(v[base + 1], v[base + 3]);
  PK_CE(v[base + 1], v[base + 2]);
  PK_CE(v[base + 4], v[base + 5]);
  PK_CE(v[base + 6], v[base + 7]);
  PK_CE(v[base + 4], v[base + 6]);
  PK_CE(v[base + 5], v[base + 7]);
  PK_CE(v[base + 5], v[base + 6]);
  PK_CE(v[base + 0], v[base + 4]);
  PK_CE(v[base + 2], v[base + 6]);
  PK_CE(v[base + 2], v[base + 4]);
  PK_CE(v[base + 1], v[base + 5]);
  PK_CE(v[base + 3], v[base + 7]);
  PK_CE(v[base + 3], v[base + 5]);
  PK_CE(v[base + 1], v[base + 2]);
  PK_CE(v[base + 3], v[base + 4]);
  PK_CE(v[base + 5], v[base + 6]);
  PK_CE(v[base + 8], v[base + 9]);
  PK_CE(v[base + 10], v[base + 11]);
  PK_CE(v[base + 8], v[base + 10]);
  PK_CE(v[base + 9], v[base + 11]);
  PK_CE(v[base + 9], v[base + 10]);
  PK_CE(v[base + 12], v[base + 13]);
  PK_CE(v[base + 14], v[base + 15]);
  PK_CE(v[base + 12], v[base + 14]);
  PK_CE(v[base + 13], v[base + 15]);
  PK_CE(v[base + 13], v[base + 14]);
  PK_CE(v[base + 8], v[base + 12]);
  PK_CE(v[base + 10], v[base + 14]);
  PK_CE(v[base + 10], v[base + 12]);
  PK_CE(v[base + 9], v[base + 13]);
  PK_CE(v[base + 11], v[base + 15]);
  PK_CE(v[base + 11], v[base + 13]);
  PK_CE(v[base + 9], v[base + 10]);
  PK_CE(v[base + 11], v[base + 12]);
  PK_CE(v[base + 13], v[base + 14]);
  PK_CE(v[base + 0], v[base + 8]);
  PK_CE(v[base + 4], v[base + 12]);
  PK_CE(v[base + 4], v[base + 8]);
  PK_CE(v[base + 2], v[base + 10]);
  PK_CE(v[base + 6], v[base + 14]);
  PK_CE(v[base + 6], v[base + 10]);
  PK_CE(v[base + 2], v[base + 4]);
  PK_CE(v[base + 6], v[base + 8]);
  PK_CE(v[base + 10], v[base + 12]);
  PK_CE(v[base + 1], v[base + 9]);
  PK_CE(v[base + 5], v[base + 13]);
  PK_CE(v[base + 5], v[base + 9]);
  PK_CE(v[base + 3], v[base + 11]);
  PK_CE(v[base + 7], v[base + 15]);
  PK_CE(v[base + 7], v[base + 11]);
  PK_CE(v[base + 3], v[base + 5]);
  PK_CE(v[base + 7], v[base + 9]);
  PK_CE(v[base + 11], v[base + 13]);
  PK_CE(v[base + 1], v[base + 2]);
  PK_CE(v[base + 3], v[base + 4]);
  PK_CE(v[base + 5], v[base + 6]);
  PK_CE(v[base + 7], v[base + 8]);
  PK_CE(v[base + 9], v[base + 10]);
  PK_CE(v[base + 11], v[base + 12]);
  PK_CE(v[base + 13], v[base + 14]);
}
__device__ __forceinline__ void merge_top16(unsigned (&a)[16], const unsigned (&b)[16]) {
#pragma unroll
  for (int i = 0; i < 16; ++i) a[i] = a[i] > b[15 - i] ? a[i] : b[15 - i];
  PK_CE(a[0], a[8]);
  PK_CE(a[1], a[9]);
  PK_CE(a[2], a[10]);
  PK_CE(a[3], a[11]);
  PK_CE(a[4], a[12]);
  PK_CE(a[5], a[13]);
  PK_CE(a[6], a[14]);
  PK_CE(a[7], a[15]);
  PK_CE(a[0], a[4]);
  PK_CE(a[1], a[5]);
  PK_CE(a[2], a[6]);
  PK_CE(a[3], a[7]);
  PK_CE(a[8], a[12]);
  PK_CE(a[9], a[13]);
  PK_CE(a[10], a[14]);
  PK_CE(a[11], a[15]);
  PK_CE(a[0], a[2]);
  PK_CE(a[1], a[3]);
  PK_CE(a[4], a[6]);
  PK_CE(a[5], a[7]);
  PK_CE(a[8], a[10]);
  PK_CE(a[9], a[11]);
  PK_CE(a[12], a[14]);
  PK_CE(a[13], a[15]);
  PK_CE(a[0], a[1]);
  PK_CE(a[2], a[3]);
  PK_CE(a[4], a[5]);
  PK_CE(a[6], a[7]);
  PK_CE(a[8], a[9]);
  PK_CE(a[10], a[11]);
  PK_CE(a[12], a[13]);
  PK_CE(a[14], a[15]);
}
__device__ __forceinline__ void top16_of_128(const bf16x8* qf, const char* Kt, int r32, int hi, unsigned (&win)[16]) {
  unsigned pk[64];
#pragma unroll
  for (int t = 0; t < 4; ++t) {
    f32x16 c = f32x16{};
#pragma unroll
    for (int ks = 0; ks < 8; ++ks) { const bf16x8 a = *reinterpret_cast<const bf16x8*>(Kt + KSWZ(32 * t + r32, (ks * 16 + hi * 8) * 2));
      c = __builtin_amdgcn_mfma_f32_32x32x16_bf16(a, qf[ks], c, 0, 0, 0); }
#pragma unroll
    for (int r = 0; r < 16; ++r) { const int n = 32 * t + att::crow(r, hi); pk[t * 16 + r] = (srt(c[r]) & 0xffffff80u) | (unsigned)(127 - n); }
  }
  sort16_desc(pk, 0); sort16_desc(pk, 16); sort16_desc(pk, 32); sort16_desc(pk, 48);
  unsigned a[16], b[16];
#pragma unroll
  for (int i = 0; i < 16; ++i) { a[i] = pk[i]; b[i] = pk[16 + i]; }
  merge_top16(a, b);
  unsigned c[16];
#pragma unroll
  for (int i = 0; i < 16; ++i) { c[i] = pk[32 + i]; b[i] = pk[48 + i]; }
  merge_top16(c, b);
  merge_top16(a, c);
#pragma unroll
  for (int i = 0; i < 16; ++i) { auto rr = __builtin_amdgcn_permlane32_swap(a[i], a[i], false, false); b[i] = hi ? rr[0] : rr[1]; }
  merge_top16(a, b);
#pragma unroll
  for (int i = 0; i < 16; ++i) win[i] = a[i];
}
__device__ __forceinline__ void score_unit(const bf16* __restrict__ PQ, int* __restrict__ EIDX, float* __restrict__ EG, int t0, char* lds) {
  const int wid = my_wave(), lane = my_lane(), r32 = lane & 31, hi = lane >> 5;
  const bf16* qp = PQ + (size_t)(t0 + r32) * DM + wid * 256 + hi * 8;
  unsigned w1[16], w2[16];
  { bf16x8 qf[8];
#pragma unroll
    for (int ks = 0; ks < 8; ++ks) qf[ks] = att::ld8(qp + ks * 16);
    top16_of_128(qf, lds + L_K1, r32, hi, w1); }
  { bf16x8 qf[8];
#pragma unroll
    for (int ks = 0; ks < 8; ++ks) qf[ks] = att::ld8(qp + 128 + ks * 16);
    top16_of_128(qf, lds + L_K2, r32, hi, w2); }
  unsigned char* scr = (unsigned char*)(lds + L_SCR + wid * 1024) + r32 * 32;
  if (hi == 0) {
#pragma unroll
    for (int k = 0; k < 16; ++k) { scr[k] = (unsigned char)(127u - (w1[k] & 127u)); scr[16 + k] = (unsigned char)(127u - (w2[k] & 127u)); }
  }
  float v1[16], v2[16];
#pragma unroll
  for (int k = 0; k < 16; ++k) { v1[k] = unsrt(w1[k] & 0xffffff80u); v2[k] = unsrt(w2[k] & 0xffffff80u); }
  unsigned cd[25]; const unsigned hm0 = 0u - (unsigned)hi;
  { const unsigned e_ = (srt(v1[0] + v2[0]) & 0xffffff00u) | 255u, o_ = (srt(v1[0] + v2[1]) & 0xffffff00u) | 254u; cd[0] = (e_ & ~hm0) | (o_ & hm0); }
  { const unsigned e_ = (srt(v1[0] + v2[2]) & 0xffffff00u) | 253u, o_ = (srt(v1[0] + v2[3]) & 0xffffff00u) | 252u; cd[1] = (e_ & ~hm0) | (o_ & hm0); }
  { const unsigned e_ = (srt(v1[0] + v2[4]) & 0xffffff00u) | 251u, o_ = (srt(v1[0] + v2[5]) & 0xffffff00u) | 250u; cd[2] = (e_ & ~hm0) | (o_ & hm0); }
  { const unsigned e_ = (srt(v1[0] + v2[6]) & 0xffffff00u) | 249u, o_ = (srt(v1[0] + v2[7]) & 0xffffff00u) | 248u; cd[3] = (e_ & ~hm0) | (o_ & hm0); }
  { const unsigned e_ = (srt(v1[0] + v2[8]) & 0xffffff00u) | 247u, o_ = (srt(v1[0] + v2[9]) & 0xffffff00u) | 246u; cd[4] = (e_ & ~hm0) | (o_ & hm0); }
  { const unsigned e_ = (srt(v1[0] + v2[10]) & 0xffffff00u) | 245u, o_ = (srt(v1[0] + v2[11]) & 0xffffff00u) | 244u; cd[5] = (e_ & ~hm0) | (o_ & hm0); }
  { const unsigned e_ = (srt(v1[0] + v2[12]) & 0xffffff00u) | 243u, o_ = (srt(v1[0] + v2[13]) & 0xffffff00u) | 242u; cd[6] = (e_ & ~hm0) | (o_ & hm0); }
  { const unsigned e_ = (srt(v1[0] + v2[14]) & 0xffffff00u) | 241u, o_ = (srt(v1[0] + v2[15]) & 0xffffff00u) | 240u; cd[7] = (e_ & ~hm0) | (o_ & hm0); }
  { const unsigned e_ = (srt(v1[1] + v2[0]) & 0xffffff00u) | 239u, o_ = (srt(v1[1] + v2[1]) & 0xffffff00u) | 238u; cd[8] = (e_ & ~hm0) | (o_ & hm0); }
  { const unsigned e_ = (srt(v1[1] + v2[2]) & 0xffffff00u) | 237u, o_ = (srt(v1[1] + v2[3]) & 0xffffff00u) | 236u; cd[9] = (e_ & ~hm0) | (o_ & hm0); }
  { const unsigned e_ = (srt(v1[1] + v2[4]) & 0xffffff00u) | 235u, o_ = (srt(v1[1] + v2[5]) & 0xffffff00u) | 234u; cd[10] = (e_ & ~hm0) | (o_ & hm0); }
  { const unsigned e_ = (srt(v1[1] + v2[6]) & 0xffffff00u) | 233u, o_ = (srt(v1[1] + v2[7]) & 0xffffff00u) | 232u; cd[11] = (e_ & ~hm0) | (o_ & hm0); }
  { const unsigned e_ = (srt(v1[2] + v2[0]) & 0xffffff00u) | 223u, o_ = (srt(v1[2] + v2[1]) & 0xffffff00u) | 222u; cd[12] = (e_ & ~hm0) | (o_ & hm0); }
  { const unsigned e_ = (srt(v1[2] + v2[2]) & 0xffffff00u) | 221u, o_ = (srt(v1[2] + v2[3]) & 0xffffff00u) | 220u; cd[13] = (e_ & ~hm0) | (o_ & hm0); }
  { const unsigned e_ = (srt(v1[2] + v2[4]) & 0xffffff00u) | 219u, o_ = (srt(v1[3] + v2[0]) & 0xffffff00u) | 207u; cd[14] = (e_ & ~hm0) | (o_ & hm0); }
  { const unsigned e_ = (srt(v1[3] + v2[1]) & 0xffffff00u) | 206u, o_ = (srt(v1[3] + v2[2]) & 0xffffff00u) | 205u; cd[15] = (e_ & ~hm0) | (o_ & hm0); }
  { const unsigned e_ = (srt(v1[3] + v2[3]) & 0xffffff00u) | 204u, o_ = (srt(v1[4] + v2[0]) & 0xffffff00u) | 191u; cd[16] = (e_ & ~hm0) | (o_ & hm0); }
  { const unsigned e_ = (srt(v1[4] + v2[1]) & 0xffffff00u) | 190u, o_ = (srt(v1[4] + v2[2]) & 0xffffff00u) | 189u; cd[17] = (e_ & ~hm0) | (o_ & hm0); }
  { const unsigned e_ = (srt(v1[5] + v2[0]) & 0xffffff00u) | 175u, o_ = (srt(v1[5] + v2[1]) & 0xffffff00u) | 174u; cd[18] = (e_ & ~hm0) | (o_ & hm0); }
  { const unsigned e_ = (srt(v1[6] + v2[0]) & 0xffffff00u) | 159u, o_ = (srt(v1[6] + v2[1]) & 0xffffff00u) | 158u; cd[19] = (e_ & ~hm0) | (o_ & hm0); }
  { const unsigned e_ = (srt(v1[7] + v2[0]) & 0xffffff00u) | 143u, o_ = (srt(v1[7] + v2[1]) & 0xffffff00u) | 142u; cd[20] = (e_ & ~hm0) | (o_ & hm0); }
  { const unsigned e_ = (srt(v1[8] + v2[0]) & 0xffffff00u) | 127u, o_ = (srt(v1[9] + v2[0]) & 0xffffff00u) | 111u; cd[21] = (e_ & ~hm0) | (o_ & hm0); }
  { const unsigned e_ = (srt(v1[10] + v2[0]) & 0xffffff00u) | 95u, o_ = (srt(v1[11] + v2[0]) & 0xffffff00u) | 79u; cd[22] = (e_ & ~hm0) | (o_ & hm0); }
  { const unsigned e_ = (srt(v1[12] + v2[0]) & 0xffffff00u) | 63u, o_ = (srt(v1[13] + v2[0]) & 0xffffff00u) | 47u; cd[23] = (e_ & ~hm0) | (o_ & hm0); }
  { const unsigned e_ = (srt(v1[14] + v2[0]) & 0xffffff00u) | 31u, o_ = (srt(v1[15] + v2[0]) & 0xffffff00u) | 15u; cd[24] = (e_ & ~hm0) | (o_ & hm0); }
  unsigned win[16];
#pragma unroll
  for (int k = 0; k < 16; ++k) {
    unsigned m = cd[0];
#pragma unroll
    for (int i = 1; i < 25; ++i) m = umax(m, cd[i]);
    m = pair_max(m); win[k] = m;
#pragma unroll
    for (int i = 0; i < 25; ++i) cd[i] = (cd[i] == m) ? 0u : cd[i];
  }
  asm volatile("s_waitcnt lgkmcnt(0)" ::: "memory");
  const float smax = unsrt(win[0] & 0xffffff00u);
  float ex[16], den = 0.f;
#pragma unroll
  for (int k = 0; k < 16; ++k) { ex[k] = __builtin_amdgcn_exp2f((unsrt(win[k] & 0xffffff00u) - smax) * LOG2E); den += ex[k]; }
  const float rden = 1.0f / den; const unsigned hm = 0u - (unsigned)hi;
  int* eo = EIDX + (size_t)(t0 + r32) * 128 + wid * 2 + hi; float* go = EG + (size_t)(t0 + r32) * 128 + wid * 2 + hi;
#pragma unroll
  for (int kk = 0; kk < 8; ++kk) {
    const unsigned wv = (win[kk] & ~hm) | (win[8 + kk] & hm); const float gv = __uint_as_float((__float_as_uint(ex[kk]) & ~hm) | (__float_as_uint(ex[8 + kk]) & hm)) * rden;
    const int flat = 255 - (int)(wv & 255u), a = flat >> 4, bq = flat & 15;
    eo[kk * 16] = (int)scr[a] * 128 + (int)scr[16 + bq]; go[kk * 16] = gv;
  }
  asm volatile("s_waitcnt lgkmcnt(0)" ::: "memory");
}
}

typedef float f32x2 __attribute__((ext_vector_type(2)));
typedef int i32x4 __attribute__((ext_vector_type(4)));
constexpr float U_SCALE = 128.f, V_SCALE = 4.f;
constexpr int NSLICE = 8, SLICE_COLS = 256;
template <int CTRL> __device__ __forceinline__ float dpp_mov(float v) { return __int_as_float(__builtin_amdgcn_update_dpp(0, __float_as_int(v), CTRL, 0xf, 0xf, false)); }
__device__ __forceinline__ void pe_load_ids(const int* __restrict__ EIDX, int t, int g, int (&id)[16]) {
#pragma unroll
  for (int q = 0; q < 4; ++q) { const i32x4 v = *reinterpret_cast<const i32x4*>(EIDX + (size_t)t * 128 + g * 16 + 4 * q); id[4 * q] = v[0]; id[4 * q + 1] = v[1]; id[4 * q + 2] = v[2]; id[4 * q + 3] = v[3]; }
}
__device__ __forceinline__ void pe_issue_segs(const unsigned char* __restrict__ TB, const int (&id)[16], int coff, u32x4 (&seg)[16]) {
#pragma unroll
  for (int i = 0; i < 16; ++i) { const unsigned off = (unsigned)id[i] * 128u + (unsigned)coff; seg[i] = *reinterpret_cast<const u32x4*>(TB + off); }
}
typedef int v8i __attribute__((ext_vector_type(8)));
__device__ __forceinline__ void pe_x8_load(const unsigned char* __restrict__ X8, int t, unsigned xoff, u32x4 (&xw)[4]) {
  const unsigned char* xp = X8 + (size_t)t * DM + xoff;
  xw[0] = *reinterpret_cast<const u32x4*>(xp); xw[1] = *reinterpret_cast<const u32x4*>(xp + 64); xw[2] = *reinterpret_cast<const u32x4*>(xp + 128); xw[3] = *reinterpret_cast<const u32x4*>(xp + 192);
}
__device__ __forceinline__ void peer_u_pass(const unsigned char* __restrict__ X8, const unsigned char* __restrict__ U4, const int* __restrict__ EIDX, float* __restrict__ HPs, char* wlds, int t0, int dt, int n, int s, int lane) {
  const int g = lane >> 3, j = lane & 7, e16 = lane & 15, g4 = lane >> 4, c = lane & 15;
  const int coff = s * (NEXP * 128) + 16 * j; const unsigned xoff = (unsigned)(s * SLICE_COLS + 16 * g4);
  int idn[16]; u32x4 seg[16]; u32x4 xC[4], xN[4];
  pe_load_ids(EIDX, t0, g, idn); pe_issue_segs(U4, idn, coff, seg); pe_x8_load(X8, t0, xoff, xN);
  pe_load_ids(EIDX, t0 + (n > 1 ? dt : 0), g, idn);
#pragma unroll 1
  for (int it = 0; it < n; ++it) {
    const int t = t0 + it * dt, tn = t0 + (it + 1 < n ? it + 1 : n - 1) * dt, tnn = t0 + (it + 2 < n ? it + 2 : n - 1) * dt;
#pragma unroll
    for (int i = 0; i < 16; ++i) { const int row = 16 * g + i; *reinterpret_cast<u32x4*>(wlds + row * 128 + ((j ^ (row & 7)) << 4)) = seg[i]; }
#pragma unroll
    for (int p = 0; p < 4; ++p) xC[p] = xN[p];
    pe_issue_segs(U4, idn, coff, seg); pe_x8_load(X8, tn, xoff, xN);
    pe_load_ids(EIDX, tnn, g, idn);
    asm volatile("s_waitcnt lgkmcnt(0)" ::: "memory");
    f32x4 acc[8];
#pragma unroll
    for (int G = 0; G < 8; ++G) acc[G] = (f32x4){0.f, 0.f, 0.f, 0.f};
#pragma unroll
    for (int kh = 0; kh < 2; ++kh) {
      const v8i b = {(int)xC[2 * kh][0], (int)xC[2 * kh][1], (int)xC[2 * kh][2], (int)xC[2 * kh][3], (int)xC[2 * kh + 1][0], (int)xC[2 * kh + 1][1], (int)xC[2 * kh + 1][2], (int)xC[2 * kh + 1][3]};
#pragma unroll
      for (int G = 0; G < 8; ++G) { const int row = 16 * G + e16; const u32x4 sw = *reinterpret_cast<const u32x4*>(wlds + row * 128 + (((4 * kh + g4) ^ (row & 7)) << 4));
        const v8i a = {(int)sw[0], (int)sw[1], (int)sw[2], (int)sw[3], 0, 0, 0, 0};
        acc[G] = __builtin_amdgcn_mfma_scale_f32_16x16x128_f8f6f4(a, b, acc[G], 4  , 0  , 0, 0x7F7F7F7F  , 0, 0x7F7F7F7F); }
    }
    float s0[8], s1[8];
#pragma unroll
    for (int G = 0; G < 8; ++G) { s0[G] = (c & 1) ? acc[G][2] : acc[G][0]; s1[G] = (c & 1) ? acc[G][3] : acc[G][1]; }
    const int Gs = c >> 1;
    const float a0 = (Gs & 4) ? ((Gs & 2) ? ((Gs & 1) ? s0[7] : s0[6]) : ((Gs & 1) ? s0[5] : s0[4])) : ((Gs & 2) ? ((Gs & 1) ? s0[3] : s0[2]) : ((Gs & 1) ? s0[1] : s0[0]));
    const float a1 = (Gs & 4) ? ((Gs & 2) ? ((Gs & 1) ? s1[7] : s1[6]) : ((Gs & 1) ? s1[5] : s1[4])) : ((Gs & 2) ? ((Gs & 1) ? s1[3] : s1[2]) : ((Gs & 1) ? s1[1] : s1[0]));
    *reinterpret_cast<f32x2*>(HPs + (size_t)t * 128 + 16 * Gs + 4 * g4 + 2 * (c & 1)) = (f32x2){a0, a1};
  }
}
typedef int v2i __attribute__((ext_vector_type(2)));
__device__ __forceinline__ void peer_v_pass(const unsigned char* __restrict__ A8, const unsigned char* __restrict__ V4, const int* __restrict__ EIDX, bf16* __restrict__ Y, char* wlds, int t0, int dt, int n, int s, int lane) {
  const int g = lane >> 3, j = lane & 7, e16 = lane & 15, g4 = lane >> 4;
  const int coff = s * (NEXP * 128) + 16 * j;
  int idn[16]; u32x4 seg[16]; u32x4 aC[2], aN[2];
#define PE_ALOAD(t, aw) do { const unsigned char* ap_ = A8 + (size_t)(t) * 128 + 16 * g4; aw[0] = *reinterpret_cast<const u32x4*>(ap_); aw[1] = *reinterpret_cast<const u32x4*>(ap_ + 64); } while (0)
  pe_load_ids(EIDX, t0, g, idn); pe_issue_segs(V4, idn, coff, seg); PE_ALOAD(t0, aN);
  pe_load_ids(EIDX, t0 + (n > 1 ? dt : 0), g, idn);
#pragma unroll 1
  for (int it = 0; it < n; ++it) {
    const int t = t0 + it * dt, tn = t0 + (it + 1 < n ? it + 1 : n - 1) * dt, tnn = t0 + (it + 2 < n ? it + 2 : n - 1) * dt;
#pragma unroll
    for (int i = 0; i < 16; ++i) { const int row = 16 * g + i; *reinterpret_cast<u32x4*>(wlds + row * 128 + ((j ^ (row & 7)) << 4)) = seg[i]; }
    aC[0] = aN[0]; aC[1] = aN[1];
    pe_issue_segs(V4, idn, coff, seg); PE_ALOAD(tn, aN);
    pe_load_ids(EIDX, tnn, g, idn);
    asm volatile("s_waitcnt lgkmcnt(0)" ::: "memory");
    const v8i a = {(int)aC[0][0], (int)aC[0][1], (int)aC[0][2], (int)aC[0][3], (int)aC[1][0], (int)aC[1][1], (int)aC[1][2], (int)aC[1][3]};
    const int r0 = 32 * g4 + e16, r1 = r0 + 16;
    float yv[4];
#pragma unroll
    for (int q = 0; q < 4; ++q) yv[q] = 0.f;
#pragma unroll
    for (int cb = 0; cb < 16; ++cb) {
      const v2i b0 = __builtin_amdgcn_ds_read_tr4_b64_v2i32((LAS v2i*)(wlds + r0 * 128 + ((((cb >> 1) ^ (r0 & 7)) << 4) | ((cb & 1) << 3))));
      const v2i b1 = __builtin_amdgcn_ds_read_tr4_b64_v2i32((LAS v2i*)(wlds + r1 * 128 + ((((cb >> 1) ^ (r1 & 7)) << 4) | ((cb & 1) << 3))));
      const v8i b = {b0[0], b0[1], b1[0], b1[1], 0, 0, 0, 0};
      const f32x4 d = __builtin_amdgcn_mfma_scale_f32_16x16x128_f8f6f4(a, b, (f32x4){0.f, 0.f, 0.f, 0.f}, 0  , 4  , 0, 0x79797979  , 0, 0x7D7D7D7D  );
      if ((cb & 3) == 0) yv[cb >> 2] = d[0];
      else yv[cb >> 2] = ((cb & 3) == g4) ? d[0] : yv[cb >> 2];
    }
#pragma unroll
    for (int q = 0; q < 4; ++q) Y[(size_t)t * DM + s * SLICE_COLS + 16 * (4 * q + g4) + e16] = (bf16)(cvt_pk(yv[q], 0.f) & 0xffffu);
  }
#undef PE_ALOAD
}
__device__ __forceinline__ void v4c_relayout_item(const unsigned char* __restrict__ V4, unsigned char* __restrict__ V4C, int s, int eb, int lane) {
  const int e = 64 * eb + lane; const unsigned char* src = V4 + (size_t)s * (NEXP * 128) + (size_t)e * 128;
  u32x4 w[8];
#pragma unroll
  for (int q = 0; q < 8; ++q) w[q] = *reinterpret_cast<const u32x4*>(src + 16 * q);
#pragma unroll
  for (int q = 0; q < 8; ++q) {
    *reinterpret_cast<u32x2*>(V4C + (size_t)(16 * s + 2 * q) * (NEXP * 8) + (size_t)e * 8) = (u32x2){w[q][0], w[q][1]};
    *reinterpret_cast<u32x2*>(V4C + (size_t)(16 * s + 2 * q + 1) * (NEXP * 8) + (size_t)e * 8) = (u32x2){w[q][2], w[q][3]}; }
}
__device__ __forceinline__ void eidp_item(const int* __restrict__ EIDX, unsigned* __restrict__ EIDP, int t4, int lane) {
  const int i16 = lane & 15, g4 = lane >> 4; u32x4 w;
#pragma unroll
  for (int e = 0; e < 4; ++e) { const int* r = EIDX + (size_t)(4 * t4 + e) * 128 + 32 * g4 + i16; const unsigned ia = (unsigned)r[0], ib = (unsigned)r[16]; w[e] = (ia ^ ((ia >> 7) & 31u)) | ((ib ^ ((ib >> 7) & 31u)) << 16); }
  *reinterpret_cast<u32x4*>(EIDP + ((size_t)t4 * 64 + lane) * 4) = w;
}
__device__ __forceinline__ void peer_v_pass2(const unsigned char* __restrict__ A8, const unsigned char* __restrict__ V4C, const unsigned* __restrict__ EIDP, bf16* __restrict__ Y, char* lds, int c, int tbeg, int ntok, int wave, int lane) {
  { const int tid = wave * 64 + lane; const unsigned char* tb = V4C + (size_t)c * (NEXP * 8);
#pragma unroll
    for (int i = 0; i < 16; ++i) { const int r2 = i * 512 + tid; const u32x4 w = *reinterpret_cast<const u32x4*>(tb + r2 * 16); const int m = (r2 >> 6) & 31;
      *reinterpret_cast<u32x2*>(lds + ((2 * r2) ^ m) * 8) = (u32x2){w[0], w[1]}; *reinterpret_cast<u32x2*>(lds + ((2 * r2 + 1) ^ m) * 8) = (u32x2){w[2], w[3]}; } }
  __syncthreads();
  const int i16 = lane & 15, g4 = lane >> 4;
  const int nstep = ntok / (16 * 8);
  const unsigned char* abase = A8 + (size_t)i16 * 128 + 16 * g4;
  const unsigned* ibase = EIDP + (size_t)lane * 4;
  bf16* ybase = Y + (size_t)(4 * g4) * DM + 16 * c + i16;
#define PV_LOAD(AW, ID, step) do { const int t0_ = tbeg + 16 * (wave + 8 * ((step) < nstep ? (step) : nstep - 1)); \
    AW[0] = *reinterpret_cast<const u32x4*>(abase + (size_t)t0_ * 128); AW[1] = *reinterpret_cast<const u32x4*>(abase + (size_t)t0_ * 128 + 64); \
    _Pragma("unroll") for (int j = 0; j < 4; ++j) ID[j] = *reinterpret_cast<const u32x4*>(ibase + ((size_t)(t0_ >> 2) + j) * 256); } while (0)
#define PV_READ(ID, j) do { _Pragma("unroll") for (int e = 0; e < 4; ++e) { const unsigned pk = ID[j][e]; \
      b0[j][e] = __builtin_amdgcn_ds_read_tr4_b64_v2i32((LAS v2i*)(lds + ((pk & 0xffffu) << 3))); \
      b1[j][e] = __builtin_amdgcn_ds_read_tr4_b64_v2i32((LAS v2i*)(lds + ((pk >> 16) << 3))); } __builtin_amdgcn_sched_barrier(0); } while (0)
#define PV_MMA(j) do { f32x4 d[4]; _Pragma("unroll") for (int e = 0; e < 4; ++e) { const v8i b = {b0[j][e][0], b0[j][e][1], b1[j][e][0], b1[j][e][1], 0, 0, 0, 0}; \
      d[e] = __builtin_amdgcn_mfma_scale_f32_16x16x128_f8f6f4(a, b, (f32x4){0.f, 0.f, 0.f, 0.f}, 0  , 4  , 0, 0x79797979  , 0, 0x7D7D7D7D  ); } \
    _Pragma("unroll") for (int e = 0; e < 4; ++e) y[e] = (g4 == j) ? d[e][e] : y[e]; __builtin_amdgcn_sched_barrier(0); } while (0)
#define PV_COMPUTE(AW, ID, step) do { const int t0_ = tbeg + 16 * (wave + 8 * (step)); \
    const v8i a = {(int)AW[0][0], (int)AW[0][1], (int)AW[0][2], (int)AW[0][3], (int)AW[1][0], (int)AW[1][1], (int)AW[1][2], (int)AW[1][3]}; \
    float y[4] = {0.f, 0.f, 0.f, 0.f}; v2i b0[4][4], b1[4][4]; \
    PV_READ(ID, 0); PV_READ(ID, 1); PV_MMA(0); PV_READ(ID, 2); PV_MMA(1); PV_READ(ID, 3); PV_MMA(2); PV_MMA(3); \
    _Pragma("unroll") for (int e = 0; e < 4; ++e) { const __bf16 yh = (__bf16)y[e]; ybase[(size_t)(t0_ + e) * DM] = __builtin_bit_cast(unsigned short, yh); } } while (0)
  u32x4 A0[2], A1[2], A2[2], A3[2], I0[4], I1[4], I2[4], I3[4];
  PV_LOAD(A0, I0, 0); PV_LOAD(A1, I1, 1); PV_LOAD(A2, I2, 2);
#pragma unroll 1
  for (int k = 0; k < nstep; k += 4) {
    PV_LOAD(A3, I3, k + 3); PV_COMPUTE(A0, I0, k);
    PV_LOAD(A0, I0, k + 4); PV_COMPUTE(A1, I1, k + 1);
    PV_LOAD(A1, I1, k + 5); PV_COMPUTE(A2, I2, k + 2);
    PV_LOAD(A2, I2, k + 6); PV_COMPUTE(A3, I3, k + 3);
  }
#undef PV_LOAD
#undef PV_COMPUTE
#undef PV_READ
#undef PV_MMA
  __syncthreads();
}
__device__ __forceinline__ void ln2_phase(const bf16* __restrict__ X1, const bf16* __restrict__ Y, const float* __restrict__ g, const float* __restrict__ bta, float* __restrict__ O, int gw, int ngw, int lane) {
  f32x4 gv[8], bv[8];
#pragma unroll
  for (int j = 0; j < 4; ++j) { const int e0 = 512 * j + 8 * lane;
    gv[2 * j] = *reinterpret_cast<const f32x4*>(g + e0); gv[2 * j + 1] = *reinterpret_cast<const f32x4*>(g + e0 + 4);
    bv[2 * j] = *reinterpret_cast<const f32x4*>(bta + e0); bv[2 * j + 1] = *reinterpret_cast<const f32x4*>(bta + e0 + 4); }
  u32x4 na[4], nb[4];
  if (gw < NTOK) {
#pragma unroll
    for (int j = 0; j < 4; ++j) { na[j] = *reinterpret_cast<const u32x4*>(X1 + (size_t)gw * DM + 512 * j + 8 * lane); nb[j] = *reinterpret_cast<const u32x4*>(Y + (size_t)gw * DM + 512 * j + 8 * lane); } }
  for (int m = gw; m < NTOK; m += ngw) {
    float v[32]; float s = 0.f;
#pragma unroll
    for (int j = 0; j < 4; ++j) {
#pragma unroll
      for (int q = 0; q < 4; ++q) { v[8 * j + 2 * q] = fmaf(ALPHA, bf_lo(na[j][q]), bf_lo(nb[j][q])); v[8 * j + 2 * q + 1] = fmaf(ALPHA, bf_hi(na[j][q]), bf_hi(nb[j][q])); } }
    if (m + ngw < NTOK) {
#pragma unroll
      for (int j = 0; j < 4; ++j) { na[j] = *reinterpret_cast<const u32x4*>(X1 + (size_t)(m + ngw) * DM + 512 * j + 8 * lane); nb[j] = *reinterpret_cast<const u32x4*>(Y + (size_t)(m + ngw) * DM + 512 * j + 8 * lane); } }
#pragma unroll
    for (int i = 0; i < 32; ++i) s += v[i];
    const float mean = wave_sum(s) * (1.f / DM); float s2 = 0.f;
#pragma unroll
    for (int i = 0; i < 32; ++i) { v[i] -= mean; s2 = fmaf(v[i], v[i], s2); }
    const float rstd = 1.0f / sqrtf(wave_sum(s2) * (1.f / DM) + LN_EPS);
    float* orow = O + (size_t)m * DM;
#pragma unroll
    for (int j = 0; j < 4; ++j) { const int e0 = 512 * j + 8 * lane;
      f32x4 o0, o1;
#pragma unroll
      for (int e = 0; e < 4; ++e) { o0[e] = v[8 * j + e] * rstd * gv[2 * j][e] + bv[2 * j][e]; o1[e] = v[8 * j + 4 + e] * rstd * gv[2 * j + 1][e] + bv[2 * j + 1][e]; }
      *reinterpret_cast<f32x4*>(orow + e0) = o0; *reinterpret_cast<f32x4*>(orow + e0 + 4) = o1; }
  }
}
__device__ __forceinline__ void cvt_stream_fp4(const float* __restrict__ src, unsigned char* __restrict__ dst, size_t n32, float scale, size_t gtid, size_t gsz) {
  for (size_t i0 = gtid; i0 < n32; i0 += 2 * gsz) {
    f32x4 a[2][8];
#pragma unroll
    for (int h = 0; h < 2; ++h) { const size_t i = i0 + h * gsz; if (i < n32) {
#pragma unroll
      for (int q = 0; q < 8; ++q) a[h][q] = *reinterpret_cast<const f32x4*>(src + i * 32 + 4 * q); } }
#pragma unroll
    for (int h = 0; h < 2; ++h) { const size_t i = i0 + h * gsz; if (i < n32) {
      u32x4 w;
#pragma unroll
      for (int q = 0; q < 4; ++q) { const f32x4 x = a[h][2 * q] * scale, y = a[h][2 * q + 1] * scale;
        unsigned p = __builtin_amdgcn_cvt_scalef32_pk_fp4_f32(0u, x[0], x[1], 1.0f, 0); p = __builtin_amdgcn_cvt_scalef32_pk_fp4_f32(p, x[2], x[3], 1.0f, 1);
        p = __builtin_amdgcn_cvt_scalef32_pk_fp4_f32(p, y[0], y[1], 1.0f, 2); p = __builtin_amdgcn_cvt_scalef32_pk_fp4_f32(p, y[2], y[3], 1.0f, 3); w[q] = p; }
      const size_t e = i >> 6, c16 = i & 63;
      *reinterpret_cast<u32x4*>(dst + (c16 >> 3) * ((size_t)NEXP * 128) + e * 128 + (c16 & 7) * 16) = w; } }
  }
}
__device__ __forceinline__ void peer_tables_share(const float* __restrict__ u, const float* __restrict__ v, unsigned char* __restrict__ U4, unsigned char* __restrict__ V4, int bx, int G) {
  int t = my_tid(); asm volatile("" : "+v"(t));
  const size_t gtid = (size_t)bx * 512 + t, gsz = (size_t)G * 512;
  cvt_stream_fp4(u, U4, (size_t)NEXP * DM / 32, U_SCALE, gtid, gsz);
  cvt_stream_fp4(v, V4, (size_t)NEXP * DM / 32, V_SCALE, gtid, gsz);
}

#define XB_TMO      128
#define XB_XCNT(j)  (256  + 64 * (j))
#define XB_XSUB(j)  (1280 + 64 * (j))
#define XB_XGEN(j)  (2304 + 64 * (j))
#define XB_TOP      3328
#define XB_TOPGEN   3392
#define XCD_BAR_WORDS 3456
#define XB_SPIN_CAP (1u << 18)

__device__ __forceinline__ unsigned xb_ld(unsigned* p)              { return __hip_atomic_load(p, __ATOMIC_RELAXED, __HIP_MEMORY_SCOPE_AGENT); }
__device__ __forceinline__ unsigned xb_add(unsigned* p, unsigned v) { return __hip_atomic_fetch_add(p, v, __ATOMIC_RELAXED, __HIP_MEMORY_SCOPE_AGENT); }
__device__ __forceinline__ unsigned xb_xcc_id() { return (unsigned)__builtin_amdgcn_s_getreg((3 << 11) | 20) & 0xFu; }
#define XB_SPIN(cond, bar) do { unsigned _sp = 0; while (cond) { __builtin_amdgcn_s_sleep(1); \
    if ((++_sp & 255u) == 0u) { if (xb_ld(&(bar)[XB_TMO])) break; if (_sp > XB_SPIN_CAP) { atomicAdd(&(bar)[XB_TMO], 1u); break; } } } } while (0)

struct XcdBarrier {
    unsigned* bar; unsigned x;
    volatile LAS unsigned* st;
};

__device__ __forceinline__ XcdBarrier xcd_barrier_post(unsigned* bar, volatile LAS unsigned* st) {
    XcdBarrier b; b.bar = bar; b.x = xb_xcc_id(); b.st = st;
    if (threadIdx.x == 0) (void)xb_add(&bar[XB_XCNT(b.x)], 1u);
    return b;
}
__device__ __forceinline__ void xcd_barrier_complete(unsigned* bar, unsigned x, unsigned& nloc, unsigned& nx) {
    const unsigned G = gridDim.x * gridDim.y * gridDim.z;
    unsigned sum, cnt, mine, sp = 0u;
    for (;;) {
        sum = 0u; cnt = 0u; mine = 0u;
#pragma unroll
        for (unsigned j = 0; j < 16; ++j) { const unsigned c = xb_ld(&bar[XB_XCNT(j)]); sum += c; cnt += (c > 0u) ? 1u : 0u; mine = (j == x) ? c : mine; }
        if (sum == G) break;
        __builtin_amdgcn_s_sleep(1);
        if ((++sp & 255u) == 0u) { if (xb_ld(&bar[XB_TMO])) break; if (sp > XB_SPIN_CAP) { atomicAdd(&bar[XB_TMO], 1u); break; } }
    }
    nloc = mine > 0u ? mine : 1u; nx = cnt > 0u ? cnt : 1u;
}

__device__ __forceinline__ void xcd_barrier(const XcdBarrier& b) {
    asm volatile("s_waitcnt vmcnt(0)" ::: "memory");
    __syncthreads();
    if (my_tid() == 0) {
        unsigned* bar = b.bar;
        __builtin_amdgcn_s_waitcnt(0);
        unsigned nloc = b.st[0], nx = b.st[1];
        if (nloc == 0u) { xcd_barrier_complete(bar, b.x, nloc, nx); b.st[0] = nloc; b.st[1] = nx; }
        const unsigned old = xb_add(&bar[XB_XSUB(b.x)], 1u);
        const unsigned gen = old / nloc;
        if (old + 1u == (gen + 1u) * nloc) {
            __builtin_amdgcn_fence(__ATOMIC_RELEASE, "agent");
            asm volatile("s_waitcnt vmcnt(0)" ::: "memory");
            const unsigned og = xb_add(&bar[XB_TOP], 1u);
            const unsigned tg = og / nx;
            if (og + 1u == (tg + 1u) * nx) xb_add(&bar[XB_TOPGEN], 1u);
            else XB_SPIN(xb_ld(&bar[XB_TOPGEN]) == tg, bar);
            __builtin_amdgcn_fence(__ATOMIC_ACQUIRE, "agent");
            asm volatile("s_waitcnt vmcnt(0)" ::: "memory");
        } else {
            XB_SPIN(xb_ld(&bar[XB_TOPGEN]) == gen, bar);
            __builtin_amdgcn_fence(__ATOMIC_ACQUIRE, "agent");
            asm volatile("s_waitcnt vmcnt(0)" ::: "memory");
        }
    }
    __syncthreads();
}


__device__ __forceinline__ void flat_barrier(unsigned* bar) {
    asm volatile("s_waitcnt vmcnt(0)" ::: "memory");
    __syncthreads();
    if (threadIdx.x == 0) {
        const unsigned G = gridDim.x;
        __builtin_amdgcn_fence(__ATOMIC_RELEASE, "agent");
        asm volatile("s_waitcnt vmcnt(0)" ::: "memory");
        const unsigned old = xb_add(&bar[XB_TOP], 1u);
        const unsigned target = (old / G + 1u) * G;
        XB_SPIN(xb_ld(&bar[XB_TOP]) < target, bar);
        __builtin_amdgcn_fence(__ATOMIC_ACQUIRE, "agent");
        asm volatile("s_waitcnt vmcnt(0)" ::: "memory");
    }
    __syncthreads();
}
struct Args {
  const float* in[17];
  float* out; unsigned char* ws; int ph_lo, ph_hi;
};
constexpr int N_PHASES = 12;

__global__ void __launch_bounds__(512, 2) mega_fwd(Args args) {
  extern __shared__ __attribute__((aligned(16))) unsigned char lds_raw[];
  LAS unsigned char* ldsl = (LAS unsigned char*)lds_raw;
  char* lds = (char*)lds_raw;
  { const int t0_ = threadIdx.x; if ((t0_ & 63) == 0) ((volatile unsigned char*)lds_raw)[HWTAB_OFF + hw_slot()] = (unsigned char)(t0_ >> 6); }
  __syncthreads();
  const int wave = my_wave();
#define lane (my_lane())
#define tid (wave * 64 + my_lane())
  const int G = gridDim.x, bx = blockIdx.x;
  unsigned char* ws = args.ws;
  const float* x = args.in[0];
  bf16* XB = (bf16*)(ws + WS_XB); unsigned char* ATT = ws + WS_X1F8; bf16* PQ = XB;
  bf16* PROJ = (bf16*)(ws + WS_PROJ); bf16* ZB = (bf16*)(ws + WS_PROJ); bf16* YB = (bf16*)(ws + WS_PROJ + 128 * MiB);
  int* EIDX = (int*)(ws + WS_EIDX); float* EG = (float*)(ws + WS_EG);
  bf16* X1B = (bf16*)(ws + WS_X1B); unsigned char* U8 = ws + WS_U8; unsigned char* V8 = ws + WS_V8; unsigned char* V4C = ws + WS_V4C; unsigned char* XB8 = ws + WS_X1F8; unsigned char* WIN8 = ws + WS_WIN; constexpr int N_F8 = C_SK;     unsigned* EIDP = (unsigned*)(ws + WS_EIDP);
  unsigned char* A8 = ws + WS_A8; unsigned* ctl = (unsigned*)(ws + WS_CTL); unsigned char* X1F8 = ws + WS_X1F8;
  bf16* WIN = (bf16*)(ws + WS_WIN); unsigned char* WO = ws + WS_WO; bf16* WQ = (bf16*)(ws + WS_WQ);
  const int lo = args.ph_lo, hi_ph = args.ph_hi;
#if MK_ONE_LAUNCH
  volatile LAS unsigned* misc = (volatile LAS unsigned*)(ldsl + LDS_BYTES - 64);
  XcdBarrier xbar; xbar.bar = ctl; xbar.x = xb_xcc_id(); xbar.st = misc + 2;
  if (tid == 0) { misc[2] = 0u; misc[3] = 0u; misc[0] = xb_add(&ctl[XB_XCNT(xbar.x)], 1u); }
  __syncthreads();
  const int my_xcc = (int)xbar.x, my_rank = __builtin_amdgcn_readfirstlane((int)misc[0]);
#endif
#if MK_ONE_LAUNCH
  cg::grid_group grid = cg::this_grid();
#define GRID_SYNC() xcd_barrier(xbar)
#else
#define GRID_SYNC() do {} while (0)
#endif
#ifndef PH_MASK
#define PH_MASK 0xfff
#endif
#ifndef REP_MASK
#define REP_MASK 0
#endif
#define IN(k) (((PH_MASK >> (k)) & 1) && lo <= (k) && (k) < hi_ph)
#define REP(k)
#define SEAM(k) do { if (IN(k) && IN((k) + 1)) GRID_SYNC(); } while (0)

  REP(0) if (IN(0)) {
    const size_t gtid = (size_t)bx * 512 + tid, gsz = (size_t)G * 512;
    cvt_stream2(x, XB, XB8, (size_t)NTOK * DM / 8, gtid, gsz);
    LAS float* scr = (LAS float*)(ldsl + wave * 8704);
    const int gw = bx * 8 + wave, NGW = G * 8;
    constexpr int I_IN = (DM / 64) * (LDP / 32), I_SQ = (DM / 64) * (DM / 32);
    for (int it = gw; it < I_IN + 2 * I_SQ; it += NGW) {
      if (it < I_IN) { const int kb = it / (LDP / 32), nb = it % (LDP / 32);
        if (nb < N_F8 / 32) transpose_item_fp8(args.in[1], DM, NPROJ, WIN8, scr, kb, nb, lane, 64.f);
        else transpose_item(args.in[1], DM, NPROJ, WIN, scr, kb, nb, lane); }
      else if (it < I_IN + I_SQ) { const int r = it - I_IN; transpose_item_fp8(args.in[2], DM, DM, WO, scr, r / (DM / 32), r % (DM / 32), lane, 64.f); }
      else { const int r = it - I_IN - I_SQ; transpose_item(args.in[10], DM, DM, WQ, scr, r / (DM / 32), r % (DM / 32), lane); }
    }
    __syncthreads();
  }
#if MK_ONE_LAUNCH
  if (IN(0) && IN(1)) grid.sync();
#endif
  int vx = bx & 7, vrank = bx >> 3; const int nloc = G >> 3;
#if MK_ONE_LAUNCH
  {
    int npop = 0, before = 0; bool regular = true;
#pragma unroll
    for (int q = 0; q < 16; ++q) { const int cq = (int)__hip_atomic_load(ctl + XB_XCNT(q), __ATOMIC_RELAXED, __HIP_MEMORY_SCOPE_AGENT); if (cq > 0) { ++npop; if (q < my_xcc) ++before; if (cq != nloc) regular = false; } }
    if (regular && npop == 8 && (G & 7) == 0) { vx = before; vrank = my_rank; }
  }
#endif
  const int vcu = vrank * 8 + vx;
  REP(1) if (IN(1)) {
    { pg8::Gemm g{(const pg8::bf16_t*)XB8, (const pg8::bf16_t*)WIN8, NTOK, N_F8, DM}; pg8::StaticOrder S; S.init(NTOK, N_F8, G, vcu);
      pg8::EpiBf16<0> E{PROJ, LDP, nullptr, N_F8, 0, 1.0f / 64.0f};
      pg8::gemm_phase<pg8::EpiBf16<0>, pg8::StaticOrder, true, true, true, 0x7F7F7F7F>(ldsl, g, S, E); }
    __syncthreads();
    { pg8::Gemm g{XB, WIN + (size_t)N_F8 * DM, NTOK, LDP - N_F8, DM}; pg8::StaticOrder S; S.init(NTOK, LDP - N_F8, G, vcu);
      pg8::EpiBf16<0> E{PROJ + N_F8, LDP, nullptr, 0, 0, 1.f};
      pg8::gemm_phase<pg8::EpiBf16<0>, pg8::StaticOrder, true, true>(ldsl, g, S, E); }
    __syncthreads();
  }
  SEAM(1);
  const int cslot = (G * 8 >= 2048) ? (bx & 7) : 0;
  REP(2) if (IN(2)) {
    float lam;
    { const float a = args.in[3][lane] * args.in[4][lane], b = args.in[5][lane] * args.in[6][lane];
      lam = __expf(wave_sum(a)) - __expf(wave_sum(b)) + LAM_INIT; }
    for (int rnd = 0; rnd * G < 1024; ++rnd) {
      const int i = rnd * G + ((rnd & 1) ? (G - 1 - bx) : bx);
      if (i < 1024) { const int qb = 63 - (i >> 4), b = i & 15; att::attn_unit<1>(PROJ, ATT, b, 0, qb, lds, lam, args.in[7]); }
    }
  }
  REP(3) if (IN(3)) {
    float lam;
    { const float a = args.in[3][lane] * args.in[4][lane], b = args.in[5][lane] * args.in[6][lane];
      lam = __expf(wave_sum(a)) - __expf(wave_sum(b)) + LAM_INIT; }
    for (int rnd = 0; rnd * G < 2048; ++rnd) {
      if (rnd == cslot) peer_tables_share(args.in[13], args.in[14], U8, V8, bx, G);
      const int j = rnd * G + ((rnd & 1) ? (G - 1 - bx) : bx);
      if (j < 2048) { const int qb = 15 - (j >> 7), bh = j & 127; att::attn_unit<0>(PROJ, ATT, bh >> 3, (bh + rnd) & 7, qb, lds, lam, args.in[7]); }
    }
  }
  SEAM(3);
  REP(4) if (IN(4)) {
    pg8::Gemm g{(const pg8::bf16_t*)ATT, (const pg8::bf16_t*)WO, NTOK, DM, DM}; pg8::StaticOrder S; S.init(NTOK, DM, G, vcu);
    pg8::EpiResid E{(const pg8::bf16_t*)XB, ZB, DM, ALPHA, 1.0f / 64.0f};
    pg8::gemm_phase<pg8::EpiResid, pg8::StaticOrder, true, true, true, 0x7F7F7F7F>(ldsl, g, S, E);
    __syncthreads();
  }
  SEAM(4);
  REP(5) if (IN(5)) {
    const int gw = bx * 8 + wave, NGW = G * 8;
    ln1_phase(ZB, args.in[8], args.in[9], X1B, X1F8, gw, NGW, lane);
  }
  SEAM(5);
  REP(6) if (IN(6)) {
    pg8::Gemm g{X1B, WQ, NTOK, DM, DM}; pg8::StaticOrder S; S.init(NTOK, DM, G, vcu);
    pg8::EpiBf16<0> E{PQ, DM, nullptr, 0, 0, 1.f};
    pg8::gemm_phase<pg8::EpiBf16<0>, pg8::StaticOrder, true, true>(ldsl, g, S, E);
    __syncthreads();
  }
  SEAM(6);
  REP(7) if (IN(7)) {
    peer::load_keys(args.in[11], args.in[12], lds);
    __syncthreads();
    for (int u = bx; u < NTOK / 32; u += G) peer::score_unit(PQ, EIDX, EG, u * 32, lds);
    __syncthreads();
  }
  SEAM(7);
  float* HPA = (float*)(ws + WS_HPA);
  REP(8) if (IN(8)) {
    const int wv = vrank * 8 + wave, nwv = nloc * 8;
    peer_u_pass(X1F8, U8, EIDX, HPA + (size_t)vx * NTOK * 128, lds + wave * 16384, wv, nwv, NTOK / nwv, vx, lane);
  }
  SEAM(8);
  REP(9) if (IN(9)) {
    const size_t gtid = (size_t)bx * 512 + tid, gsz = (size_t)G * 512;
    for (size_t i = gtid; i < (size_t)NTOK * 32; i += gsz) {
      f32x4 h = *reinterpret_cast<const f32x4*>(HPA + i * 4);
#pragma unroll
      for (int sl = 1; sl < NSLICE; ++sl) h += *reinterpret_cast<const f32x4*>(HPA + (size_t)sl * NTOK * 128 + i * 4);
      const f32x4 gg = *reinterpret_cast<const f32x4*>(EG + i * 4); float a[4];
#pragma unroll
      for (int e = 0; e < 4; ++e) { const float hv = h[e] * (1.0f / U_SCALE); a[e] = 0.5f * hv * (1.0f + erff(hv * 0.70710678118654752f)) * gg[e] * 64.0f; }
      int p = __builtin_amdgcn_cvt_pk_fp8_f32(a[0], a[1], 0, false); p = __builtin_amdgcn_cvt_pk_fp8_f32(a[2], a[3], p, true);
      *reinterpret_cast<int*>(A8 + i * 4) = p;
    }
    for (int it = bx * 8 + wave; it < NTOK / 4; it += G * 8) eidp_item(EIDX, EIDP, it, lane);
    for (int it = bx * 8 + wave; it < 8 * (NEXP / 64); it += G * 8) v4c_relayout_item(V8, V4C, it / (NEXP / 64), it % (NEXP / 64), lane);
  }
  SEAM(9);
  REP(10) if (IN(10)) {
    for (int u = ((G & 7) == 0) ? vx * nloc + vrank : bx; u < 256; u += G) peer_v_pass2(A8, V4C, EIDP, YB, lds, u >> 1, (u & 1) * (NTOK / 2), NTOK / 2, wave, lane);
  }
  SEAM(10);
  REP(11) if (IN(11)) {
    const int gw = bx * 8 + wave, NGW = G * 8;
    ln2_phase(X1B, YB, args.in[15], args.in[16], args.out, gw, NGW, lane);
  }
#undef IN
#undef SEAM
#undef lane
#undef tid
}

#ifndef REP_MASK
#define REP_MASK 0
#endif
extern "C" void kernel_launch(void* const* d_in, const int* in_sizes, int n_in, void* d_out, int out_size, void* d_ws, size_t ws_size, hipStream_t stream) {
  static int grid = 0;
  if (grid == 0) {
    if (n_in != 17 || in_sizes[0] != NTOK * DM || out_size != NTOK * DM || ws_size < WS_END) {
      fprintf(stderr, "kernel_launch: unexpected shapes: n_in %d in0 %d out %d ws %zu (need >= %zu)\n", n_in, n_in > 0 ? in_sizes[0] : -1, out_size, ws_size, (size_t)WS_END); grid = -1; return; }
    int dev = 0, cus = 0, per_cu = 0;
    if (hipGetDevice(&dev) != hipSuccess || hipDeviceGetAttribute(&cus, hipDeviceAttributeMultiprocessorCount, dev) != hipSuccess) { grid = -1; return; }
    if (hipFuncSetAttribute((const void*)mega_fwd, hipFuncAttributeMaxDynamicSharedMemorySize, LDS_BYTES) != hipSuccess) { fprintf(stderr, "kernel_launch: hipFuncSetAttribute failed\n"); grid = -1; return; }
    if (hipOccupancyMaxActiveBlocksPerMultiprocessor(&per_cu, (const void*)mega_fwd, 512, LDS_BYTES) != hipSuccess || per_cu < 1) { fprintf(stderr, "kernel_launch: occupancy query says %d\n", per_cu); per_cu = 1; }
    (void)hipGetLastError();
    grid = cus * (per_cu > 1 ? 1 : per_cu);
  }
  if (grid < 0) return;
  Args a{};
  for (int i = 0; i < 17; ++i) a.in[i] = (const float*)d_in[i];
  a.out = (float*)d_out; a.ws = (unsigned char*)d_ws;
  if (hipMemsetAsync((char*)d_ws + WS_CTL, 0, 16384, stream) != hipSuccess) { fprintf(stderr, "kernel_launch: memset failed\n"); return; }
#if MK_ONE_LAUNCH
  a.ph_lo = 0; a.ph_hi = N_PHASES;
  void* kargs[] = {&a};
  hipError_t e = hipLaunchCooperativeKernel((const void*)mega_fwd, dim3(grid), dim3(512), kargs, LDS_BYTES, stream);
  if (e != hipSuccess) fprintf(stderr, "kernel_launch: cooperative launch failed: %s (grid %d)\n", hipGetErrorString(e), grid);
#else
  for (int p = 0; p < N_PHASES; ++p) {
    a.ph_lo = p; a.ph_hi = p + 1;
    for (int rep = 0; rep < (((REP_MASK >> p) & 1) ? 2 : 1); ++rep)
      hipLaunchKernelGGL(mega_fwd, dim3(grid), dim3(512), LDS_BYTES, stream, a);
  }
  const hipError_t le = hipPeekAtLastError();
  if (le != hipSuccess) fprintf(stderr, "kernel_launch: launch failed: %s\n", hipGetErrorName(le));
#endif
}
```

```cpp
#include <hip/hip_runtime.h>
#include <hip/hip_cooperative_groups.h>
#include <cstdio>
#include <cstdint>
namespace cg = cooperative_groups;

#ifndef MK_ONE_LAUNCH
#define MK_ONE_LAUNCH 1
#endif

constexpr int NB = 16, SEQ = 2048, DM = 2048, NTOK = NB * SEQ;
constexpr int NPROJ = 5456, LDP = 5632;
constexpr int C_DQ = 0, C_DK = 1024, C_DV = 2048, C_SQ = 3072, C_SK = 4096, C_SV = 4224, C_IQ = 4352, C_IK = 5376, C_IW = 5440;
constexpr int NEXP = 16384;
constexpr float LN_EPS = 1e-5f, RMS_EPS = 1e-5f;
constexpr float ALPHA = 1.189207115002721f;
constexpr float LAM_INIT = 0.2f;
constexpr float LOG2E = 1.4426950408889634f;

constexpr size_t MiB = (size_t)1 << 20;
constexpr size_t WS_XB = 0;
constexpr size_t WS_PROJ = 128 * MiB;
constexpr size_t WS_EIDX = 384 * MiB;
constexpr size_t WS_EG = 400 * MiB;
constexpr size_t WS_X1B = 480 * MiB;
constexpr size_t WS_V4C = 416 * MiB;
constexpr size_t WS_EIDP = 432 * MiB;
constexpr size_t WS_CTL = 774 * MiB;
constexpr size_t WS_U8 = 608 * MiB;
constexpr size_t WS_V8 = 640 * MiB;
constexpr size_t WS_HPA = 0;
constexpr size_t WS_X1F8 = 672 * MiB;
constexpr size_t WS_WIN = 736 * MiB;
constexpr size_t WS_WO = 758 * MiB;
constexpr size_t WS_WQ = 766 * MiB;
constexpr size_t WS_A8 = 775 * MiB;
constexpr size_t WS_END = 779 * MiB;

constexpr int LDS_BYTES = 147456;

typedef unsigned short bf16;
#define LAS __attribute__((address_space(3)))


constexpr int HWTAB_OFF = LDS_BYTES - 128;
__device__ __forceinline__ int hw_slot() { return (int)(__builtin_amdgcn_s_getreg((6 << 11) | 4  ) & 63u); }
__device__ __forceinline__ int my_lane() { int r; asm volatile("v_mbcnt_lo_u32_b32 %0, -1, 0\n\tv_mbcnt_hi_u32_b32 %0, -1, %0" : "=v"(r)); return r; }
__device__ __forceinline__ int my_wave() { extern __shared__ __attribute__((aligned(16))) unsigned char lds_raw[]; return __builtin_amdgcn_readfirstlane((int)((volatile unsigned char*)lds_raw)[HWTAB_OFF + hw_slot()]); }
__device__ __forceinline__ int my_tid() { return my_wave() * 64 + my_lane(); }
namespace pg8 {
#define PG8_LAS __attribute__((address_space(3)))
typedef unsigned short bf16_t;
typedef short bf16x8 __attribute__((ext_vector_type(8)));
typedef float f32x4 __attribute__((ext_vector_type(4)));
typedef unsigned u32x4 __attribute__((ext_vector_type(4)));
typedef int v8i_t __attribute__((ext_vector_type(8)));
typedef int i32x4_t __attribute__((ext_vector_type(4)));
__device__ __forceinline__ v8i_t cat8(bf16x8 lo, bf16x8 hi) { return __builtin_shufflevector(__builtin_bit_cast(i32x4_t, lo), __builtin_bit_cast(i32x4_t, hi), 0, 1, 2, 3, 4, 5, 6, 7); }
constexpr int BM = 256, BK = 64, HALF = 128, HTB = HALF * BK * 2  , STAGE_BYTES = 8 * HTB, NXCD = 8, WGM = 8;

__host__ __device__ __forceinline__ int lds_byte(int r, int c) { const int st = (r >> 4) * 2 + (c >> 5), rr = r & 15, cc = c & 31, ob = rr * 64 + cc * 2; return st * 1024 + (ob ^ (((ob >> 9) & 1) << 5)); }
__host__ __device__ __forceinline__ void stage_rc(int b, int& R, int& C) { const int st = b / 1024, sb = b % 1024, swz = sb ^ (((sb >> 9) & 1) << 5); R = (st >> 1) * 16 + swz / 64; C = (st & 1) * 32 + (swz % 64) / 2; }
__host__ __device__ __forceinline__ int perm32(int rho) { const int n = rho >> 4, i = rho & 15; return 8 * (i >> 2) + 4 * n + (i & 3); }

struct Unit { int pm, pn; };
struct Gemm { const bf16_t* A; const bf16_t* Bt; int M, N, K; };

struct StaticOrder {
    int nM, nN, nwg, G, c;
    __host__ __device__ void init(int M, int N, int G_, int c_) { nM = M / BM; nN = N / BM; nwg = nM * nN; G = G_; c = c_; }
    __host__ __device__ bool next(int i, Unit& u) const {
        const long L = (long)i * G + c; if (L >= nwg) return false;
        int wgid = (int)L; { const int q = nwg / NXCD, r = nwg % NXCD, xcd = wgid % NXCD, off = wgid / NXCD; wgid = (xcd < r ? xcd * (q + 1) : r * (q + 1) + (xcd - r) * q) + off; }
        const int nig = WGM * nN, gid = wgid / nig, fm = gid * WGM, gsz = (nM - fm) < WGM ? (nM - fm) : WGM;
        u.pm = fm + ((wgid % nig) % gsz); u.pn = (wgid % nig) / gsz; return true;
    }
    __device__ __forceinline__ void a_ready(const Unit&) const {}
    __device__ __forceinline__ void done(const Unit&) const {}
};
__device__ __forceinline__ unsigned cvt_pk_bf16(float lo, float hi) { unsigned r; asm volatile("v_cvt_pk_bf16_f32 %0, %1, %2" : "=v"(r) : "v"(lo), "v"(hi)); return r; }
typedef float f32x2 __attribute__((ext_vector_type(2)));
__device__ __forceinline__ f32x2 gelu_pk(f32x2 v) {
    const f32x2 av = __builtin_elementwise_abs(v), d = av * 0.2316418882f + 1.0f;
    f32x2 t; t.x = __builtin_amdgcn_rcpf(d.x); t.y = __builtin_amdgcn_rcpf(d.y);
    f32x2 q = t * 0.5307027145f + (-0.7265760135f); q = q * t + 0.7107068705f; q = q * t + (-0.142248368f); q = q * t + 0.127414796f; q = q * t;
    const f32x2 s = (v * v) * (-0.72134752044f);
    f32x2 e; e.x = __builtin_amdgcn_exp2f(s.x); e.y = __builtin_amdgcn_exp2f(s.y);
    const f32x2 m = v * (q * e), r = v - m;
    f32x2 o; o.x = v.x < 0.f ? m.x : r.x; o.y = v.y < 0.f ? m.y : r.y; return o;
}

template <int ACT  > struct EpiBf16 {
    static constexpr bool PERM = true, AFTER_DRAIN = false; static_assert(ACT == 0 || ACT == 1, "EpiBf16: ACT is 0 (none) or 1 (gelu_pk)");
    bf16_t* O; int ldc; const float* bias; int split_cols; size_t split_stride; float scale0;
    __device__ __forceinline__ void operator()(const f32x4 (&acc)[2][2][4][2], const Unit& u, int wr, int wc, int fr, int fq) const {
        const int row0 = u.pm * BM + wr * 64 + fr; int colt = u.pn * BM; bf16_t* base = O;
        float sc = 1.f; if (split_cols) { const int t = colt / split_cols; base += (size_t)t * split_stride; colt -= t * split_cols; if (t == 0) sc = scale0; }
        const int col0 = colt + wc * 32 + 8 * fq, bcol0 = u.pn * BM + wc * 32 + 8 * fq;
        f32x4 bv[2][2];
#pragma unroll
        for (int bj = 0; bj < 2; ++bj)
#pragma unroll
            for (int n = 0; n < 2; ++n) bv[bj][n] = bias ? *(const f32x4*)(bias + bcol0 + bj * HALF + 4 * n) : (f32x4){0.f, 0.f, 0.f, 0.f};
#pragma unroll
        for (int ai = 0; ai < 2; ++ai)
#pragma unroll
            for (int m = 0; m < 4; ++m) { bf16_t* rowp = base + (size_t)(row0 + ai * HALF + m * 16) * ldc + col0;
#pragma unroll
                for (int bj = 0; bj < 2; ++bj) { f32x4 v0 = acc[ai][bj][m][0] + bv[bj][0], v1 = acc[ai][bj][m][1] + bv[bj][1];
                    if (ACT == 1) { f32x2 a = gelu_pk((f32x2){v0[0], v0[1]}), b = gelu_pk((f32x2){v0[2], v0[3]}), c = gelu_pk((f32x2){v1[0], v1[1]}), d = gelu_pk((f32x2){v1[2], v1[3]});
                        v0 = (f32x4){a.x, a.y, b.x, b.y}; v1 = (f32x4){c.x, c.y, d.x, d.y}; }
                    v0 = v0 * sc; v1 = v1 * sc; u32x4 w; w.x = cvt_pk_bf16(v0[0], v0[1]); w.y = cvt_pk_bf16(v0[2], v0[3]); w.z = cvt_pk_bf16(v1[0], v1[1]); w.w = cvt_pk_bf16(v1[2], v1[3]);
                    *(u32x4*)(rowp + bj * HALF) = w; } }
    }
};
struct EpiResid {
    static constexpr bool PERM = true, AFTER_DRAIN = false;
    const bf16_t* X; bf16_t* Z; int ldc; float alpha; float accscale;
    __device__ __forceinline__ void operator()(const f32x4 (&acc)[2][2][4][2], const Unit& u, int wr_, int wc_, int fr_, int fq_) const {
        int t = my_lane(); asm volatile("" : "+v"(t));
        const int wv = my_wave(), wr = wv >> 2, wc = wv & 3, fr = t & 15, fq = t >> 4; (void)wr_; (void)wc_; (void)fr_; (void)fq_;
        const int row0 = u.pm * BM + wr * 64 + fr, col0 = u.pn * BM + wc * 32 + 8 * fq;
#pragma unroll
        for (int ai = 0; ai < 2; ++ai)
#pragma unroll
            for (int m = 0; m < 4; ++m) { const unsigned off = (unsigned)(row0 + ai * HALF + m * 16) * (unsigned)ldc + (unsigned)col0;
#pragma unroll
                for (int bj = 0; bj < 2; ++bj) { const u32x4 xw = *(const u32x4*)(X + off + bj * HALF);
                    const f32x4 x0 = {__uint_as_float(xw.x << 16), __uint_as_float(xw.x & 0xffff0000u), __uint_as_float(xw.y << 16), __uint_as_float(xw.y & 0xffff0000u)};
                    const f32x4 x1 = {__uint_as_float(xw.z << 16), __uint_as_float(xw.z & 0xffff0000u), __uint_as_float(xw.w << 16), __uint_as_float(xw.w & 0xffff0000u)};
                    const f32x4 v0 = x0 * alpha + acc[ai][bj][m][0] * accscale, v1 = x1 * alpha + acc[ai][bj][m][1] * accscale;
                    u32x4 w; w.x = cvt_pk_bf16(v0[0], v0[1]); w.y = cvt_pk_bf16(v0[2], v0[3]); w.z = cvt_pk_bf16(v1[0], v1[1]); w.w = cvt_pk_bf16(v1[2], v1[3]);
                    *(u32x4*)(Z + off + bj * HALF) = w; }
                asm volatile("" ::: "memory"); }
    }
};

template <class Epi, class Sched, bool ALIGN_EPI = false, bool SP2 = false, bool FP8 = false, int SCALE_B = 0x7F7F7F7F>
__device__ __forceinline__ void gemm_phase(PG8_LAS unsigned char* lds, const Gemm g, const Sched& S, const Epi& E) {
    const int tid = my_tid(), wid = __builtin_amdgcn_readfirstlane(tid >> 6), lane = tid & 63, wr = wid >> 2, wc = wid & 3, fr = lane & 15, fq = lane >> 4;
    const int K = g.K, nt = FP8 ? K / 128 : K / BK;
    unsigned voffA[2], voffB[2];
#pragma unroll
    for (int i = 0; i < 2; ++i) { int R, C; stage_rc(tid * 16 + i * 8192, R, C); const int Rb = Epi::PERM ? ((R & ~31) + perm32(R & 31)) : R;
        voffA[i] = FP8 ? (unsigned)(R * K + C * 2) : (unsigned)(R * K + C) * 2u; voffB[i] = FP8 ? (unsigned)(Rb * K + C * 2) : (unsigned)(Rb * K + C) * 2u; }
    const unsigned kstep = (unsigned)(BK * 2);
    const unsigned hstep = (unsigned)HALF * (unsigned)K * (FP8 ? 1u : 2u);
    const unsigned tstep = 2u * hstep;
    const unsigned ldsw = (unsigned)wid * 1024u;
    const int aoff = lds_byte(wr * 64 + fr, fq * 8), boff = lds_byte(wc * 32 + fr, fq * 8);
#define PG8_SA(b, h) (((b) * 2 + (h)) * HTB)
#define PG8_SB(b, h) ((4 + (b) * 2 + (h)) * HTB)
    const __amdgpu_buffer_rsrc_t rsrc_voffA = __builtin_amdgcn_make_buffer_rsrc((void*)g.A, (short)0, -1, 0x00020000), rsrc_voffB = __builtin_amdgcn_make_buffer_rsrc((void*)g.Bt, (short)0, -1, 0x00020000);
    const char* const base_voffA = (const char*)g.A; const char* const base_voffB = (const char*)g.Bt;
#define PG8_STAGE(bufoff, goff, voff) do { _Pragma("unroll") for (int _i = 0; _i < 2; ++_i) { \
        if constexpr (FP8) __builtin_amdgcn_raw_ptr_buffer_load_lds(rsrc_##voff, (PG8_LAS void*)(lds + (bufoff) + ldsw + _i * 8192), 16, (int)(voff)[_i], (int)(goff), 0, 0); \
        else __builtin_amdgcn_global_load_lds((const unsigned*)(base_##voff + (size_t)(goff) + (voff)[_i]), (PG8_LAS unsigned*)(lds + (bufoff) + ldsw + _i * 8192), 16, 0, 0); } } while (0)
#define PG8_LDA(dst, b, h) do { _Pragma("unroll") for (int m = 0; m < 4; ++m) _Pragma("unroll") for (int k = 0; k < 2; ++k) dst[m][k] = *(const PG8_LAS bf16x8*)(lds + PG8_SA(b, h) + aoff + m * 2048 + k * 1024); } while (0)
#define PG8_LDB(dst, b, h) do { _Pragma("unroll") for (int n = 0; n < 2; ++n) _Pragma("unroll") for (int k = 0; k < 2; ++k) dst[n][k] = *(const PG8_LAS bf16x8*)(lds + PG8_SB(b, h) + boff + n * 2048 + k * 1024); } while (0)
#define PG8_MMA(ai, bj, At, Bt) do { __builtin_amdgcn_s_setprio(1); _Pragma("unroll") for (int m = 0; m < 4; ++m) _Pragma("unroll") for (int n = 0; n < 2; ++n) { \
        if constexpr (FP8) acc[ai][bj][m][n] = __builtin_amdgcn_mfma_scale_f32_16x16x128_f8f6f4(cat8(Bt[n][0], Bt[n][1]), cat8(At[m][0], At[m][1]), acc[ai][bj][m][n], 0, 0, 0, SCALE_B, 0, 0x7F7F7F7F); \
        else { _Pragma("unroll") for (int k = 0; k < 2; ++k) acc[ai][bj][m][n] = __builtin_amdgcn_mfma_f32_16x16x32_bf16(Bt[n][k], At[m][k], acc[ai][bj][m][n], 0, 0, 0); } } \
        __builtin_amdgcn_s_setprio(0); } while (0)
#define PG8_WAIT_V(n) asm volatile("s_waitcnt vmcnt(" #n ")" ::: "memory")
#define PG8_WAIT_L(n) asm volatile("s_waitcnt lgkmcnt(" #n ")" ::: "memory")
#define PG8_BAR __builtin_amdgcn_s_barrier()
#define PG8_SCHED __builtin_amdgcn_sched_barrier(0)
    Unit cur, nxt; int ui = 0;
    if (!S.next(0, cur)) return;
    f32x4 acc[2][2][4][2];
#pragma unroll
    for (int a = 0; a < 2; ++a)
#pragma unroll
        for (int b = 0; b < 2; ++b)
#pragma unroll
            for (int m = 0; m < 4; ++m)
#pragma unroll
                for (int n = 0; n < 2; ++n) acc[a][b][m][n] = (f32x4){0.f, 0.f, 0.f, 0.f};
    bf16x8 At[4][2], B0[2][2], B1[2][2];
    unsigned cA = (unsigned)cur.pm * tstep, cB = (unsigned)cur.pn * tstep;
    S.a_ready(cur);
    if constexpr (SP2) {
        PG8_STAGE(PG8_SB(0, 0), cB, voffB); PG8_STAGE(PG8_SB(0, 1), cB + hstep, voffB); PG8_STAGE(PG8_SA(0, 0), cA, voffA); PG8_STAGE(PG8_SA(0, 1), cA + hstep, voffA);
        if (wr == 1) PG8_BAR;
        PG8_WAIT_V(2); PG8_BAR;
        PG8_STAGE(PG8_SB(1, 0), cB + kstep, voffB); PG8_STAGE(PG8_SA(1, 0), cA + kstep, voffA); PG8_STAGE(PG8_SB(1, 1), cB + hstep + kstep, voffB);
        PG8_WAIT_V(6); PG8_BAR;
    } else {
        PG8_STAGE(PG8_SB(0, 0), cB, voffB); PG8_STAGE(PG8_SA(0, 0), cA, voffA); PG8_STAGE(PG8_SB(0, 1), cB + hstep, voffB); PG8_STAGE(PG8_SA(0, 1), cA + hstep, voffA);
        if (wr == 1) PG8_BAR;
        PG8_WAIT_V(4); PG8_BAR;
        PG8_STAGE(PG8_SB(1, 0), cB + kstep, voffB); PG8_STAGE(PG8_SA(1, 0), cA + kstep, voffA); PG8_STAGE(PG8_SB(1, 1), cB + hstep + kstep, voffB);
        PG8_WAIT_V(6); PG8_BAR;
    }
    for (;;) {
        const bool has_next = S.next(ui + 1, nxt);
        const unsigned nA = has_next ? (unsigned)nxt.pm * tstep : cA, nB = has_next ? (unsigned)nxt.pn * tstep : cB;
        for (int t = 0; t < nt; t += 2) {
            const bool last = (t == nt - 2);
            const unsigned a1 = cA + (unsigned)(t + 1) * kstep;
            const unsigned a2 = last ? nA : cA + (unsigned)(t + 2) * kstep, b2 = last ? nB : cB + (unsigned)(t + 2) * kstep;
            const unsigned a3 = a2 + kstep, b3 = b2 + kstep;
            if (last && has_next) S.a_ready(nxt);
            if constexpr (SP2) {
            PG8_LDB(B0, 0, 0); PG8_LDB(B1, 0, 1); PG8_SCHED; PG8_LDA(At, 0, 0); PG8_STAGE(PG8_SA(1, 1), a1 + hstep, voffA);
            PG8_WAIT_V(8); PG8_WAIT_L(0); PG8_BAR; PG8_MMA(0, 0, At, B0); PG8_MMA(0, 1, At, B1); PG8_BAR; PG8_SCHED;
            PG8_LDA(At, 0, 1); PG8_STAGE(PG8_SB(0, 0), b2, voffB); PG8_STAGE(PG8_SB(0, 1), b2 + hstep, voffB); PG8_STAGE(PG8_SA(0, 0), a2, voffA);
            PG8_WAIT_V(8); PG8_WAIT_L(0); PG8_BAR; PG8_MMA(1, 0, At, B0); PG8_MMA(1, 1, At, B1); PG8_BAR; PG8_SCHED;
            PG8_LDB(B0, 1, 0); PG8_LDB(B1, 1, 1); PG8_SCHED; PG8_LDA(At, 1, 0); PG8_STAGE(PG8_SA(0, 1), a2 + hstep, voffA);
            PG8_WAIT_V(8); PG8_WAIT_L(0); PG8_BAR; PG8_MMA(0, 0, At, B0); PG8_MMA(0, 1, At, B1); PG8_BAR; PG8_SCHED;
            PG8_LDA(At, 1, 1); PG8_STAGE(PG8_SB(1, 0), b3, voffB); PG8_STAGE(PG8_SB(1, 1), b3 + hstep, voffB); PG8_STAGE(PG8_SA(1, 0), a3, voffA);
            PG8_WAIT_V(8); PG8_WAIT_L(0); PG8_BAR; PG8_MMA(1, 0, At, B0); PG8_MMA(1, 1, At, B1); PG8_BAR; PG8_SCHED;
            } else {
            PG8_LDB(B0, 0, 0); PG8_SCHED; PG8_LDA(At, 0, 0); PG8_STAGE(PG8_SA(1, 1), a1 + hstep, voffA);
            PG8_WAIT_L(8); PG8_BAR; PG8_WAIT_L(0); PG8_MMA(0, 0, At, B0); PG8_BAR; PG8_SCHED;
            PG8_LDB(B1, 0, 1); PG8_STAGE(PG8_SB(0, 0), b2, voffB);
            PG8_BAR; PG8_WAIT_L(0); PG8_MMA(0, 1, At, B1); PG8_BAR;
            PG8_LDA(At, 0, 1); PG8_STAGE(PG8_SA(0, 0), a2, voffA);
            PG8_BAR; PG8_WAIT_L(0); PG8_MMA(1, 0, At, B0); PG8_BAR; PG8_SCHED;
            PG8_STAGE(PG8_SB(0, 1), b2 + hstep, voffB);
            PG8_WAIT_V(6); PG8_BAR; PG8_MMA(1, 1, At, B1); PG8_BAR;
            PG8_LDB(B0, 1, 0); PG8_SCHED; PG8_LDA(At, 1, 0); PG8_STAGE(PG8_SA(0, 1), a2 + hstep, voffA);
            PG8_WAIT_L(8); PG8_BAR; PG8_WAIT_L(0); PG8_MMA(0, 0, At, B0); PG8_BAR; PG8_SCHED;
            PG8_LDB(B1, 1, 1); PG8_STAGE(PG8_SB(1, 0), b3, voffB);
            PG8_BAR; PG8_WAIT_L(0); PG8_MMA(0, 1, At, B1); PG8_BAR;
            PG8_LDA(At, 1, 1); PG8_STAGE(PG8_SA(1, 0), a3, voffA);
            PG8_BAR; PG8_WAIT_L(0); PG8_MMA(1, 0, At, B0); PG8_BAR; PG8_SCHED;
            PG8_STAGE(PG8_SB(1, 1), b3 + hstep, voffB);
            PG8_WAIT_V(6); PG8_BAR; PG8_MMA(1, 1, At, B1); PG8_BAR;
            }
        }
        if constexpr (ALIGN_EPI) { if (wr == 0) PG8_BAR; }
        if constexpr (!Epi::AFTER_DRAIN) { E(acc, cur, wr, wc, fr, fq); S.done(cur); }
        if (!has_next) break;
#pragma unroll
        for (int a = 0; a < 2; ++a)
#pragma unroll
            for (int b = 0; b < 2; ++b)
#pragma unroll
                for (int m = 0; m < 4; ++m)
#pragma unroll
                    for (int n = 0; n < 2; ++n) acc[a][b][m][n] = (f32x4){0.f, 0.f, 0.f, 0.f};
        cur = nxt; cA = nA; cB = nB; ++ui;
        if constexpr (ALIGN_EPI) { if (wr == 1) PG8_BAR; }
    }
    PG8_WAIT_V(0);
    if constexpr (!ALIGN_EPI) { if (wr == 0) PG8_BAR; }
    PG8_BAR;
    if constexpr (Epi::AFTER_DRAIN) { E.fused(acc, cur, wr, wc, fr, fq, lds, wid, lane); S.done(cur); }
#undef PG8_SA
#undef PG8_SB
#undef PG8_STAGE
#undef PG8_LDA
#undef PG8_LDB
#undef PG8_MMA
#undef PG8_WAIT_V
#undef PG8_WAIT_L
#undef PG8_BAR
#undef PG8_SCHED
}
}


namespace att {
using bf16x8 = __attribute__((ext_vector_type(8))) short;
using s16x4  = __attribute__((ext_vector_type(4))) short;
using f32x16 = __attribute__((ext_vector_type(16))) float;
using u32x4  = __attribute__((ext_vector_type(4))) unsigned;
using u32x2  = __attribute__((ext_vector_type(2))) unsigned;
constexpr int SHM_V = 16384, SHM_K = 16384;
constexpr int L_V = 0, L_K = 32768, L_WS = 69632, L_SEL = 131072, L_END = 139264;
#ifndef ATT_SDEPTH
#define ATT_SDEPTH 1
#endif
constexpr int SDEPTH = ATT_SDEPTH;
constexpr float THR2 = 11.0f;
#define KSWZ(row, colB) ((row) * 256 + ((colB) ^ (((row) & 7) << 4)))
#define SBAR() __builtin_amdgcn_sched_barrier(0)
__device__ __forceinline__ int crow(int r, int hi) { return (r & 3) + 8 * (r >> 2) + 4 * hi; }
__device__ __forceinline__ unsigned cvtpk(float lo, float hi) { unsigned r; asm volatile("v_cvt_pk_bf16_f32 %0, %1, %2" : "=v"(r) : "v"(lo), "v"(hi)); return r; }
__device__ __forceinline__ bf16x8 ld8(const bf16* p) { return *reinterpret_cast<const bf16x8*>(p); }
__device__ __forceinline__ float bf2f(bf16 v) { return __uint_as_float((unsigned)v << 16); }
__device__ __forceinline__ float ninf() { return __uint_as_float(0xff800000u); }

template <int ND0> __device__ __forceinline__ void qkt(f32x16& p0, f32x16& p1, const char* Ks, const bf16x8* qr, int r32, int hi, int d0base) {
  p0 = f32x16{}; p1 = f32x16{};
#pragma unroll
  for (int d0 = 0; d0 < ND0; ++d0) { const int cb = ((d0base + d0) * 16 + hi * 8) * 2;
    bf16x8 b0 = *reinterpret_cast<const bf16x8*>(Ks + KSWZ(r32, cb));
    bf16x8 b1 = *reinterpret_cast<const bf16x8*>(Ks + KSWZ(32 + r32, cb));
    p0 = __builtin_amdgcn_mfma_f32_32x32x16_bf16(b0, qr[d0], p0, 0, 0, 0);
    p1 = __builtin_amdgcn_mfma_f32_32x32x16_bf16(b1, qr[d0], p1, 0, 0, 0); }
}
__device__ __forceinline__ int v_st(int k, int c) { const int kk = (k & ~0xC) | ((k & 4) << 1) | ((k & 8) >> 1); return ((kk >> 3) * 4 + (c >> 5)) * 512 + ((kk & 7) * 32 + (c & 31)) * 2; }
__device__ __forceinline__ int v_rd_base(int lane) { return ((lane & 3) << 3) | (((lane >> 2) & 3) << 6) | (((lane >> 4) & 1) << 5) | (((lane >> 5) & 1) << 8); }
constexpr int v_rd_off(int d0, int ks, int half) { return d0 * 512 + ks * 4096 + half * 2048; }
template <int OFF> __device__ __forceinline__ s16x4 tr_read(int vb) {
  s16x4 r; asm volatile("ds_read_b64_tr_b16 %0, %1 offset:%2" : "=&v"(r) : "v"(vb), "i"(OFF) : "memory"); return r;
}
template <int D0> __device__ __forceinline__ void pv_one(f32x16& od, int vb, bf16x8 pa0, bf16x8 pa1, bf16x8 pa2, bf16x8 pa3) {
#define PK(L, H) (bf16x8){L[0], L[1], L[2], L[3], H[0], H[1], H[2], H[3]}
  { const s16x4 l0 = tr_read<v_rd_off(D0, 0, 0)>(vb), h0 = tr_read<v_rd_off(D0, 0, 1)>(vb), l1 = tr_read<v_rd_off(D0, 1, 0)>(vb), h1 = tr_read<v_rd_off(D0, 1, 1)>(vb);
    asm volatile("s_waitcnt lgkmcnt(0)" ::: "memory"); SBAR();
    od = __builtin_amdgcn_mfma_f32_32x32x16_bf16(pa0, PK(l0, h0), od, 0, 0, 0);
    od = __builtin_amdgcn_mfma_f32_32x32x16_bf16(pa1, PK(l1, h1), od, 0, 0, 0); }
  { const s16x4 l2 = tr_read<v_rd_off(D0, 2, 0)>(vb), h2 = tr_read<v_rd_off(D0, 2, 1)>(vb), l3 = tr_read<v_rd_off(D0, 3, 0)>(vb), h3 = tr_read<v_rd_off(D0, 3, 1)>(vb);
    asm volatile("s_waitcnt lgkmcnt(0)" ::: "memory"); SBAR();
    od = __builtin_amdgcn_mfma_f32_32x32x16_bf16(pa2, PK(l2, h2), od, 0, 0, 0);
    od = __builtin_amdgcn_mfma_f32_32x32x16_bf16(pa3, PK(l3, h3), od, 0, 0, 0); }
#undef PK
}
__device__ __forceinline__ void pv_d0(f32x16* o, int vb, bf16x8 pa0, bf16x8 pa1, bf16x8 pa2, bf16x8 pa3) {
  pv_one<0>(o[0], vb, pa0, pa1, pa2, pa3); pv_one<1>(o[1], vb, pa0, pa1, pa2, pa3); pv_one<2>(o[2], vb, pa0, pa1, pa2, pa3); pv_one<3>(o[3], vb, pa0, pa1, pa2, pa3);
}

template <int MODE> __device__ __forceinline__ void partialSM(f32x16& p0, f32x16& p1, float Cs, float slope2, float thr, int k0, int qpos, int hi,
                                                              const char* selrow, bool diag, float& m_reg, float& off, float& alpha, bool& dead) {
#pragma unroll
  for (int r = 0; r < 16; ++r) { const float cr = (float)((r & 3) + 8 * (r >> 2)); p0[r] = fmaf(p0[r], Cs, cr); p1[r] = fmaf(p1[r], Cs, cr); }
  if (MODE == 0) {
    if (diag) { const int dqh = qpos - k0 - 4 * hi;
#pragma unroll
      for (int r = 0; r < 16; ++r) { const int cr = (r & 3) + 8 * (r >> 2); if (cr > dqh) p0[r] = ninf(); if (cr + 32 > dqh) p1[r] = ninf(); } }
  } else {
    const u32x2 w = *reinterpret_cast<const u32x2*>(selrow + (k0 >> 5) * 4);
    const unsigned w0 = w.x >> (4 * hi), w1 = w.y >> (4 * hi);
    const float ninf_ = ninf();
#pragma unroll
    for (int r = 0; r < 16; ++r) { const int cr = (r & 3) + 8 * (r >> 2); unsigned t0, t1;
      asm("v_bfe_i32 %0, %1, %2, 1" : "=v"(t0) : "v"(w0), "n"(cr)); asm("v_bfi_b32 %0, %1, %2, %0" : "+v"(p0[r]) : "v"(t0), "s"(ninf_));
      asm("v_bfe_i32 %0, %1, %2, 1" : "=v"(t1) : "v"(w1), "n"(cr)); asm("v_bfi_b32 %0, %1, %2, %0" : "+v"(p1[r]) : "v"(t1), "s"(ninf_)); }
  }
  float pm0 = p0[0], pm1 = p1[0];
#pragma unroll
  for (int r = 1; r < 16; ++r) { pm0 = fmaxf(pm0, p0[r]); pm1 = fmaxf(pm1, p1[r]); }
  const float tb = (float)(k0 + 4 * hi - qpos);
  float tmax = fmaxf(pm0, pm1 + 32.f) + tb;
  { auto rr = __builtin_amdgcn_permlane32_swap(__float_as_uint(tmax), __float_as_uint(tmax), false, false);
    tmax = fmaxf(__uint_as_float(rr[0]), __uint_as_float(rr[1])); }
  dead = (MODE == 0) && __all((tmax - m_reg) * slope2 < -150.f);
  if (dead) { alpha = 1.f; off = 0.f; return; }
  if (__builtin_expect(__all(tmax - m_reg <= thr), 1)) { alpha = 1.f; }
  else { const float mn = fmaxf(m_reg, tmax); alpha = __builtin_amdgcn_exp2f((m_reg - mn) * slope2); m_reg = mn; }
  off = (tb - m_reg) * slope2;
#pragma unroll
  for (int r = 0; r < 16; ++r) p0[r] = __builtin_amdgcn_exp2f(fmaf(p0[r], slope2, off));
}
__device__ __forceinline__ void finishSM(f32x16& p0, f32x16& p1, float slope2, float off1, float alpha, float& l_reg, bf16x8& pa0, bf16x8& pa1, bf16x8& pa2, bf16x8& pa3) {
#pragma unroll
  for (int r = 0; r < 16; ++r) p1[r] = __builtin_amdgcn_exp2f(fmaf(p1[r], slope2, off1));
  float ps = 0;
#pragma unroll
  for (int r = 0; r < 16; ++r) ps += p0[r];
#pragma unroll
  for (int r = 0; r < 16; ++r) ps += p1[r];
  { auto rr = __builtin_amdgcn_permlane32_swap(__float_as_uint(ps), __float_as_uint(ps), false, false);
    ps = __uint_as_float(rr[0]) + __uint_as_float(rr[1]); }
  l_reg = l_reg * alpha + ps;
#define PK4(P, BASE, OUT) do { unsigned a0 = cvtpk(P[BASE + 0], P[BASE + 1]), a1 = cvtpk(P[BASE + 2], P[BASE + 3]);   \
    unsigned b0 = cvtpk(P[BASE + 4], P[BASE + 5]), b1 = cvtpk(P[BASE + 6], P[BASE + 7]);                              \
    auto r0 = __builtin_amdgcn_permlane32_swap(a0, b0, false, false); auto r1 = __builtin_amdgcn_permlane32_swap(a1, b1, false, false); \
    u32x4 w = {r0[0], r1[0], r0[1], r1[1]}; OUT = *reinterpret_cast<bf16x8*>(&w); } while (0)
  PK4(p0, 0, pa0); PK4(p0, 8, pa1); PK4(p1, 0, pa2); PK4(p1, 8, pa3);
#undef PK4
}

typedef float f32x2v __attribute__((ext_vector_type(2)));
__device__ __forceinline__ void cnt_ge(int& cnt, unsigned a, unsigned b) { asm volatile("v_cmp_ge_u32_e32 vcc, %1, %2\n\tv_addc_co_u32_e32 %0, vcc, 0, %0, vcc" : "+v"(cnt) : "v"(a), "v"(b) : "vcc"); }
__device__ __forceinline__ void cnt_gt(int& cnt, unsigned a, unsigned b) { asm volatile("v_cmp_gt_u32_e32 vcc, %1, %2\n\tv_addc_co_u32_e32 %0, vcc, 0, %0, vcc" : "+v"(cnt) : "v"(a), "v"(b) : "vcc"); }
__device__ __forceinline__ void cnt_ge4(int& c0, int& c1, int& c2, int& c3, unsigned k0, unsigned k1, unsigned k2, unsigned k3, unsigned b) {
  unsigned long long m0, m1, m2, m3;
  asm volatile("v_cmp_ge_u32_e64 %4, %8, %12\n\tv_cmp_ge_u32_e64 %5, %9, %12\n\tv_cmp_ge_u32_e64 %6, %10, %12\n\tv_cmp_ge_u32_e64 %7, %11, %12\n\t"
               "v_addc_co_u32_e64 %0, %4, 0, %0, %4\n\tv_addc_co_u32_e64 %1, %5, 0, %1, %5\n\tv_addc_co_u32_e64 %2, %6, 0, %2, %6\n\tv_addc_co_u32_e64 %3, %7, 0, %3, %7"
               : "+v"(c0), "+v"(c1), "+v"(c2), "+v"(c3), "=&s"(m0), "=&s"(m1), "=&s"(m2), "=&s"(m3) : "v"(k0), "v"(k1), "v"(k2), "v"(k3), "v"(b));
}
__device__ __forceinline__ unsigned wlane(unsigned val, int ln, unsigned old) { asm volatile("v_writelane_b32 %0, %1, %2" : "+v"(old) : "s"(val), "s"(ln)); return old; }
__device__ __forceinline__ int half_sum(int x, int hi) {
  x += __builtin_amdgcn_update_dpp(0, x, 0x111, 0xf, 0xf, true);
  x += __builtin_amdgcn_update_dpp(0, x, 0x112, 0xf, 0xf, true);
  x += __builtin_amdgcn_update_dpp(0, x, 0x114, 0xf, 0xf, true);
  x += __builtin_amdgcn_update_dpp(0, x, 0x118, 0xf, 0xf, true);
  const int a = __builtin_amdgcn_readlane(x, 15) + __builtin_amdgcn_readlane(x, 31);
  const int b = __builtin_amdgcn_readlane(x, 47) + __builtin_amdgcn_readlane(x, 63);
  return hi ? b : a;
}
__device__ __forceinline__ unsigned take_low(unsigned m, int k) {
  while (__builtin_popcount(m) > k) m &= ~(0x80000000u >> __builtin_clz(m));
  return m;
}

__device__ __forceinline__ void dsa_select(const bf16* __restrict__ PROJ, int b, int q0, unsigned* SEL, char* lds) {
  int tid = my_tid(); asm volatile("" : "+v"(tid));
  const int wid = __builtin_amdgcn_readfirstlane(tid >> 6), lane = tid & 63, r32 = lane & 31, hi = lane >> 5;
  const size_t tokb = (size_t)b * SEQ;
  const int nt32 = (q0 >> 5) + 1, nch = (nt32 + 15) >> 4;
  const int srow = wid * 64 + (lane >> 3), spc = lane & 7;
  const unsigned sloff = (unsigned)((srow * LDP + 8 * spc) * 2);
  const __amdgpu_buffer_rsrc_t srd = __builtin_amdgcn_make_buffer_rsrc((void*)(PROJ + tokb * LDP + C_IK), (short)0, (int)(SEQ * LDP * 2), 0x00020000);
  bf16x8 af[4]; float w[16]; bf16x8 st[8];
#define DSA_LOADS(RD) do { const int tA_ = q0 + (RD) * 16 + wid * 2; \
    const bf16* ap_ = PROJ + (tokb + tA_ + (r32 >> 4)) * LDP + C_IQ + (r32 & 15) * 64 + hi * 8; \
    _Pragma("unroll") for (int ks = 0; ks < 4; ++ks) af[ks] = ld8(ap_ + ks * 16); \
    _Pragma("unroll") for (int r = 0; r < 16; ++r) { const int head = (r & 3) + 8 * ((r >> 2) & 1) + 4 * hi; w[r] = bf2f(PROJ[(tokb + tA_ + (r >> 3)) * LDP + C_IW + head]); } \
    _Pragma("unroll") for (int i = 0; i < 8; ++i) st[i] = __builtin_bit_cast(bf16x8, __builtin_amdgcn_raw_buffer_load_b128(srd, (int)(sloff + (unsigned)(8 * i * LDP * 2)), 0, 0)); } while (0)
  DSA_LOADS(0);
  for (int rd = 0; rd < 2; ++rd) {
    const int tl = rd * 16 + wid * 2, tA = q0 + tl;
#pragma unroll
    for (int r = 0; r < 16; ++r) w[r] *= 0.5f;
    const int myq = tA + hi;
    unsigned key[64];
#pragma unroll
    for (int c = 0; c < 4; ++c) {
      if (c < nch) {
        char* buf = lds + (c & 1) * 65536;
#pragma unroll
        for (int i = 0; i < 8; ++i) { const int row = srow + 8 * i; *reinterpret_cast<bf16x8*>(buf + row * 128 + ((spc ^ ((row >> 1) & 7)) << 4)) = st[i]; }
        if (c + 1 < nch) {
#pragma unroll
          for (int i = 0; i < 8; ++i) st[i] = __builtin_bit_cast(bf16x8, __builtin_amdgcn_raw_buffer_load_b128(srd, (int)(sloff + (unsigned)(8 * i * LDP * 2)), 512 * (c + 1) * LDP * 2, 0));
        }
        __syncthreads();
#define IDX_MMA(CC, U) do { const int row_ = 32 * (U) + r32; CC = f32x16{}; _Pragma("unroll") for (int ks = 0; ks < 4; ++ks) { \
            const bf16x8 bfr = *reinterpret_cast<const bf16x8*>(buf + row_ * 128 + (((2 * ks + hi) ^ ((row_ >> 1) & 7)) << 4)); CC = __builtin_amdgcn_mfma_f32_32x32x16_bf16(af[ks], bfr, CC, 0, 0, 0); } } while (0)
#define IDX_RED(CC, U) do { const int j_ = 16 * c + (U); f32x2v l0 = {0.f, 0.f}, l1 = {0.f, 0.f}; \
          _Pragma("unroll") for (int i = 0; i < 4; ++i) { l0 = __builtin_elementwise_fma((f32x2v){w[2 * i], w[2 * i + 1]}, (f32x2v){CC[2 * i], CC[2 * i + 1]}, l0); \
                                                          l1 = __builtin_elementwise_fma((f32x2v){w[8 + 2 * i], w[9 + 2 * i]}, (f32x2v){CC[8 + 2 * i], CC[9 + 2 * i]}, l1); } \
          float s0 = l0[0] + l0[1], s1 = l1[0] + l1[1]; \
          _Pragma("unroll") for (int r = 0; r < 8; ++r) { asm("v_fma_f32 %0, %1, |%2|, %0" : "+v"(s0) : "v"(w[r]), "v"(CC[r])); asm("v_fma_f32 %0, %1, |%2|, %0" : "+v"(s1) : "v"(w[8 + r]), "v"(CC[8 + r])); } \
          auto rr = __builtin_amdgcn_permlane32_swap(__float_as_uint(s0), __float_as_uint(s1), false, false); \
          const float tot = __uint_as_float(rr[0]) + __uint_as_float(rr[1]); \
          const unsigned bits = __float_as_uint(tot); \
          const unsigned srt = bits ^ ((unsigned)((int)bits >> 31) | 0x80000000u); \
          key[j_] = (j_ * 32 + r32 <= myq) ? srt : 0u; } while (0)
#if defined(DSK) && DSK == 3
        { f32x16 ccA, ccB; IDX_MMA(ccA, 0);
#pragma unroll
          for (int u = 0; u < 16; u += 2) { IDX_MMA(ccB, u + 1); IDX_RED(ccA, u); __builtin_amdgcn_sched_barrier(0); if (u + 2 < 16) IDX_MMA(ccA, u + 2); IDX_RED(ccB, u + 1); __builtin_amdgcn_sched_barrier(0); } }
        _Pragma("unroll") for (int u = 0; u < 16; ++u) asm volatile("" :: "v"(key[16 * c + u]));
#endif
        { f32x16 ccA, ccB; IDX_MMA(ccA, 0);
#pragma unroll
          for (int u = 0; u < 16; u += 2) { IDX_MMA(ccB, u + 1); IDX_RED(ccA, u); __builtin_amdgcn_sched_barrier(0); if (u + 2 < 16) IDX_MMA(ccA, u + 2); IDX_RED(ccB, u + 1); __builtin_amdgcn_sched_barrier(0); } }
#undef IDX_MMA
#undef IDX_RED
      } else {
#pragma unroll
        for (int u = 0; u < 16; ++u) key[16 * c + u] = 0u;
      }
    }
    __syncthreads();
    if (rd == 0) DSA_LOADS(1);
    unsigned T = 0u;
    if (tA + 2 > 256) {
      for (int bit = 31; bit >= 0; --bit) {
        const unsigned cand = T | (1u << bit);
        int cnt = 0;
#pragma unroll
        for (int cc = 0; cc < 8; ++cc) { if (cc * 8 < nt32) {
#pragma unroll
          for (int e = 0; e < 8; ++e) cnt_ge(cnt, key[cc * 8 + e], cand); } }
        const int tot = half_sum(cnt, hi);
        if (tot >= 256) T = cand;
        if (__all(tot == 256)) break;
      }
    }
    const unsigned Tm = T > 1u ? T : 1u;
    int cge = 0;
#pragma unroll
    for (int cc = 0; cc < 8; ++cc) { if (cc * 8 < nt32) {
#pragma unroll
      for (int e = 0; e < 8; ++e) cnt_ge(cge, key[cc * 8 + e], Tm); } }
    cge = half_sum(cge, hi);
    int ln = lane; asm volatile("" : "+v"(ln));
    unsigned m0 = 0xffffffffu, m1 = 0xffffffffu;
    if (__all(cge <= 256)) {
#pragma unroll
      for (int j = 0; j < 64; ++j) {
        const unsigned long long bal = __ballot(!(key[j] >= Tm));
        m0 = (ln == j) ? (unsigned)bal : m0; m1 = (ln == j) ? (unsigned)(bal >> 32) : m1; }
    } else {
      unsigned* kst = (unsigned*)(lds + wid * 16384);
#pragma unroll
      for (int j = 0; j < 64; ++j) kst[j * 64 + lane] = key[j];
      int cgt = 0;
#pragma unroll
      for (int cc = 0; cc < 8; ++cc) { if (cc * 8 < nt32) {
#pragma unroll
        for (int e = 0; e < 8; ++e) cnt_gt(cgt, key[cc * 8 + e], Tm); } }
      cgt = half_sum(cgt, hi);
      int need_lo = 256 - __builtin_amdgcn_readlane(cgt, 0), need_hi = 256 - __builtin_amdgcn_readlane(cgt, 32);
#pragma unroll 1
      for (int j = 0; j < 64; ++j) {
        const unsigned kj = kst[j * 64 + lane];
        const unsigned long long eqm = __ballot(kj == Tm), gtm = __ballot(kj > Tm);
        const unsigned tl_ = take_low((unsigned)eqm, need_lo > 0 ? need_lo : 0), th_ = take_low((unsigned)(eqm >> 32), need_hi > 0 ? need_hi : 0);
        need_lo -= __builtin_popcount(tl_); need_hi -= __builtin_popcount(th_);
        const unsigned sl = (unsigned)gtm | tl_, sh = (unsigned)(gtm >> 32) | th_;
        m0 = (ln == j) ? ~sl : m0; m1 = (ln == j) ? ~sh : m1; }
    }
    SEL[tl * 64 + lane] = m0; SEL[(tl + 1) * 64 + lane] = m1;
    __syncthreads();
  }
#undef DSA_LOADS
}

template <int MODE>
__device__ __forceinline__ void attn_unit(const bf16* __restrict__ PROJ, unsigned char* __restrict__ ATT, int b, int h, int qb, char* lds, float lam, const float* __restrict__ subln_g) {
  if (MODE == 1) { dsa_select(PROJ, b, qb * 32, (unsigned*)(lds + L_SEL), lds); __syncthreads(); }
  int tid = my_tid(); asm volatile("" : "+v"(tid));
  const int wid = __builtin_amdgcn_readfirstlane(tid >> 6), lane = tid & 63, r32 = lane & 31, hi = lane >> 5;
  constexpr int ND0 = MODE == 0 ? 4 : 8;
  const int q0 = MODE == 0 ? qb * 128 : qb * 32;
  const int wq = MODE == 0 ? (wid & 3) * 32 : 0;
  const int c = MODE == 0 ? (wid >> 2) : 0;
  const int qpos = q0 + wq + r32;
  const size_t tokb = (size_t)b * SEQ;
  const bf16* Qw = PROJ + (tokb + qpos) * LDP + (MODE == 0 ? C_DQ + h * 128 + c * 64 : C_SQ + wid * 128) + hi * 8;
  const bf16* Kh = PROJ + tokb * LDP + (MODE == 0 ? C_DK + h * 128 : C_SK);
  const bf16* Vh = PROJ + tokb * LDP + (MODE == 0 ? C_DV + h * 128 : C_SV);
  const int NT = MODE == 0 ? 2 * (qb + 1) : 2 * ((q0 + 32 + 127) >> 7);
  const float slope2 = (MODE == 0 ? exp2f(-0.5f * (float)(2 * h + 1)) : exp2f(-(float)(wid + 1))) * LOG2E;
  const float Cs = (MODE == 0 ? 0.125f : 0.08838834764831845f) * LOG2E / slope2;
  const float thr = THR2 / slope2, c32 = 32.f * slope2;
  char* V_lds = lds + L_V; char* K_lds = lds + L_K;
  float* ws = (float*)(lds + L_WS) + wid * 64; float* li_l = ws; float* al_l = ws + 32;
  unsigned* SEL = (unsigned*)(lds + L_SEL);
  const char* selrow = (const char*)(SEL + r32 * 64);

  float m_reg = -1e30f, l_reg = 0; f32x16 o[4] = {}; bf16x8 qr[ND0];
#pragma unroll
  for (int d0 = 0; d0 < ND0; ++d0) qr[d0] = ld8(Qw + d0 * 16);
  const int sr = tid >> 4, sc = (tid & 15) * 8, vst0 = v_st(sr, sc), vst1 = v_st(32 + sr, sc);
  const int vb0 = (int)(uintptr_t)V_lds + v_rd_base(lane);
  struct { bf16x8 vs0, vs1, ks0, ks1; } sr_[SDEPTH];
#define SLOAD(i, k0) do { sr_[i].vs0 = ld8(&Vh[(size_t)((k0) + sr) * LDP + sc]); sr_[i].vs1 = ld8(&Vh[(size_t)((k0) + 32 + sr) * LDP + sc]); \
    sr_[i].ks0 = ld8(&Kh[(size_t)((k0) + sr) * LDP + sc]); sr_[i].ks1 = ld8(&Kh[(size_t)((k0) + 32 + sr) * LDP + sc]); } while (0)
#define SWRITE(bb, i) do { *(bf16x8*)(V_lds + (bb) * SHM_V + vst0) = sr_[i].vs0;          \
    *(bf16x8*)(V_lds + (bb) * SHM_V + vst1) = sr_[i].vs1; const int kc = sc * 2;               \
    *(bf16x8*)(K_lds + (bb) * SHM_K + KSWZ(sr, kc)) = sr_[i].ks0;                       \
    *(bf16x8*)(K_lds + (bb) * SHM_K + KSWZ(32 + sr, kc)) = sr_[i].ks1; } while (0)
#define SWAIT() do { if constexpr (SDEPTH == 2) asm volatile("s_waitcnt vmcnt(4)" ::: "memory"); else asm volatile("s_waitcnt vmcnt(0)" ::: "memory"); } while (0)
#define RESC(a) do { if (__any((a) < 1.f)) { if (hi == 0) al_l[r32] = (a); asm volatile("s_waitcnt lgkmcnt(0)" ::: "memory"); \
    _Pragma("unroll") for (int d = 0; d < 4; ++d) _Pragma("unroll") for (int r = 0; r < 16; ++r) o[d][r] *= al_l[crow(r, hi)]; } } while (0)
#define DIAG(k0) ((k0) + 63 > q0 + wq)
  f32x16 pA0, pA1, pB0, pB1; float ofA, ofB, alA, alB; bool deadA = false, deadB = false; bf16x8 pa0, pa1, pa2, pa3;
  constexpr int SE = 0, SO = SDEPTH - 1;
  static_assert(SDEPTH == 1, "the tile loop below is written for one staging register set");
#define KT(i) ((MODE == 0 ? (NT - 1 - (i)) : (i)) * 64)
  SLOAD(SE, KT(0)); asm volatile("s_waitcnt vmcnt(0)" ::: "memory"); SWRITE(0, SE); SLOAD(SE, KT(1)); __syncthreads();
  qkt<ND0>(pA0, pA1, K_lds, qr, r32, hi, c * 4); partialSM<MODE>(pA0, pA1, Cs, slope2, thr, KT(0), qpos, hi, selrow, DIAG(KT(0)), m_reg, ofA, alA, deadA);
  SWAIT(); SWRITE(1, SO); if (2 < NT) SLOAD(SE, KT(2)); __syncthreads();
  for (int j = 1; j + 1 < NT; j += 2) {
    SBAR(); qkt<ND0>(pB0, pB1, K_lds + SHM_K, qr, r32, hi, c * 4);
    if (!deadA) { finishSM(pA0, pA1, slope2, ofA + c32, alA, l_reg, pa0, pa1, pa2, pa3); } SBAR();
    if (!deadA) { pv_d0(o, vb0, pa0, pa1, pa2, pa3); } partialSM<MODE>(pB0, pB1, Cs, slope2, thr, KT(j), qpos, hi, selrow, DIAG(KT(j)), m_reg, ofB, alB, deadB);
    __syncthreads(); SWAIT(); SWRITE(0, SE); SLOAD(SE, KT(j + 2));
    RESC(alB); __syncthreads();
    SBAR(); qkt<ND0>(pA0, pA1, K_lds, qr, r32, hi, c * 4);
    if (!deadB) { finishSM(pB0, pB1, slope2, ofB + c32, alB, l_reg, pa0, pa1, pa2, pa3); } SBAR();
    if (!deadB) { pv_d0(o, vb0 + SHM_V, pa0, pa1, pa2, pa3); } partialSM<MODE>(pA0, pA1, Cs, slope2, thr, KT(j + 1), qpos, hi, selrow, DIAG(KT(j + 1)), m_reg, ofA, alA, deadA);
    __syncthreads(); SWAIT(); SWRITE(1, SO); if (j + 3 < NT) SLOAD(SO, KT(j + 3));
    RESC(alA); __syncthreads();
  }
  SBAR(); qkt<ND0>(pB0, pB1, K_lds + SHM_K, qr, r32, hi, c * 4);
  if (!deadA) { finishSM(pA0, pA1, slope2, ofA + c32, alA, l_reg, pa0, pa1, pa2, pa3); } SBAR();
  if (!deadA) { pv_d0(o, vb0, pa0, pa1, pa2, pa3); } partialSM<MODE>(pB0, pB1, Cs, slope2, thr, KT(NT - 1), qpos, hi, selrow, DIAG(KT(NT - 1)), m_reg, ofB, alB, deadB);
  __syncthreads(); RESC(alB);
  if (!deadB) { finishSM(pB0, pB1, slope2, ofB + c32, alB, l_reg, pa0, pa1, pa2, pa3); } SBAR();
  if (!deadB) { pv_d0(o, vb0 + SHM_V, pa0, pa1, pa2, pa3); }
#undef KT
#undef SLOAD
#undef SWRITE
#undef SWAIT
#undef RESC
#undef DIAG
  if (hi == 0) li_l[r32] = l_reg; asm volatile("s_waitcnt lgkmcnt(0)" ::: "memory");
  {
    float rli[16];
#pragma unroll
    for (int r = 0; r < 16; ++r) rli[r] = __builtin_amdgcn_rcpf(li_l[crow(r, hi)]);
#pragma unroll
    for (int d0 = 0; d0 < 4; ++d0)
#pragma unroll
      for (int r = 0; r < 16; ++r) o[d0][r] *= rli[r];
  }
  __syncthreads();
  if (MODE == 0) {
    float* X = (float*)lds;
    if (wid >= 4) {
#pragma unroll
      for (int d0 = 0; d0 < 4; ++d0)
#pragma unroll
        for (int r = 0; r < 16; ++r) X[(wid - 4) * 4096 + crow(r, hi) * 128 + d0 * 32 + r32] = o[d0][r];
    }
    __syncthreads();
    if (wid < 4) {
#pragma unroll
      for (int d0 = 0; d0 < 4; ++d0)
#pragma unroll
        for (int r = 0; r < 16; ++r) o[d0][r] -= lam * X[wid * 4096 + crow(r, hi) * 128 + d0 * 32 + r32];
    }
    __syncthreads();
  }
  if (MODE == 1 || wid < 4) {
    bf16* stg = (bf16*)(lds + wid * 8704);
#pragma unroll
    for (int d0 = 0; d0 < 4; ++d0)
#pragma unroll
      for (int r = 0; r < 16; r += 2) {
        const unsigned pk = cvtpk(o[d0][r], o[d0][r + 1]);
        stg[crow(r, hi) * 136 + d0 * 32 + r32] = (bf16)(pk & 0xffffu);
        stg[crow(r + 1, hi) * 136 + d0 * 32 + r32] = (bf16)(pk >> 16);
      }
    asm volatile("s_waitcnt lgkmcnt(0)" ::: "memory");
    bf16x8 v[8];
#pragma unroll
    for (int j = 0; j < 8; ++j) v[j] = *reinterpret_cast<const bf16x8*>(stg + r32 * 136 + hi * 64 + j * 8);
    unsigned char* orow = ATT + (tokb + q0 + wq + r32) * DM + (MODE == 0 ? h * 128 : 1024 + wid * 128) + hi * 64;
    float rs = 1.0f;
    if (MODE == 0) {
      float ss = 0.f;
#pragma unroll
      for (int j = 0; j < 8; ++j)
#pragma unroll
        for (int e = 0; e < 8; ++e) { const float x = bf2f((bf16)v[j][e]); ss = fmaf(x, x, ss); }
      { auto rr = __builtin_amdgcn_permlane32_swap(__float_as_uint(ss), __float_as_uint(ss), false, false);
        ss = __uint_as_float(rr[0]) + __uint_as_float(rr[1]); }
      rs = __builtin_amdgcn_rsqf(ss * (1.0f / 128.0f) + RMS_EPS) * (1.0f - LAM_INIT);
    }
#pragma unroll
    for (int jj = 0; jj < 4; ++jj) { u32x4 w;
#pragma unroll
      for (int q = 0; q < 4; ++q) { float y[4];
#pragma unroll
        for (int e = 0; e < 4; ++e) { const int idx = 16 * jj + 4 * q + e; float x = bf2f((bf16)v[idx >> 3][idx & 7]); if (MODE == 0) x = x * rs * subln_g[hi * 64 + idx]; y[e] = x; }
        int p = __builtin_amdgcn_cvt_pk_fp8_f32(y[0], y[1], 0, false); p = __builtin_amdgcn_cvt_pk_fp8_f32(y[2], y[3], p, true); w[q] = (unsigned)p; }
      *reinterpret_cast<u32x4*>(orow + jj * 16) = w; }
  }
  __syncthreads();
}
}

typedef float f32x4 __attribute__((ext_vector_type(4)));
typedef unsigned u32x4 __attribute__((ext_vector_type(4)));
typedef unsigned u32x2 __attribute__((ext_vector_type(2)));
__device__ __forceinline__ unsigned cvt_pk(float lo, float hi) { unsigned r; asm volatile("v_cvt_pk_bf16_f32 %0, %1, %2" : "=v"(r) : "v"(lo), "v"(hi)); return r; }
__device__ __forceinline__ float bf_lo(unsigned w) { return __uint_as_float(w << 16); }
__device__ __forceinline__ float bf_hi(unsigned w) { return __uint_as_float(w & 0xffff0000u); }
__device__ __forceinline__ float wave_sum(float v) {
#pragma unroll
  for (int o = 1; o < 64; o <<= 1) v += __shfl_xor(v, o);
  return v;
}

__device__ __forceinline__ void cvt_stream(const float* __restrict__ src, bf16* __restrict__ dst, size_t n8, size_t gtid, size_t gsz) {
  for (size_t i = gtid; i < n8; i += gsz) {
    const f32x4 a = *reinterpret_cast<const f32x4*>(src + i * 8), b = *reinterpret_cast<const f32x4*>(src + i * 8 + 4);
    u32x4 w = {cvt_pk(a[0], a[1]), cvt_pk(a[2], a[3]), cvt_pk(b[0], b[1]), cvt_pk(b[2], b[3])};
    *reinterpret_cast<u32x4*>(dst + i * 8) = w;
  }
}
__device__ __forceinline__ void cvt_stream2(const float* __restrict__ src, bf16* __restrict__ dst, unsigned char* __restrict__ dst8, size_t n8, size_t gtid, size_t gsz) {
  for (size_t i0 = gtid; i0 < n8; i0 += 4 * gsz) {
    f32x4 a[4], b[4];
#pragma unroll
    for (int q = 0; q < 4; ++q) { const size_t i = i0 + q * gsz; if (i < n8) { a[q] = *reinterpret_cast<const f32x4*>(src + i * 8); b[q] = *reinterpret_cast<const f32x4*>(src + i * 8 + 4); } }
#pragma unroll
    for (int q = 0; q < 4; ++q) { const size_t i = i0 + q * gsz; if (i < n8) {
      u32x4 w = {cvt_pk(a[q][0], a[q][1]), cvt_pk(a[q][2], a[q][3]), cvt_pk(b[q][0], b[q][1]), cvt_pk(b[q][2], b[q][3])};
      *reinterpret_cast<u32x4*>(dst + i * 8) = w;
      int p0 = __builtin_amdgcn_cvt_pk_fp8_f32(a[q][0], a[q][1], 0, false); p0 = __builtin_amdgcn_cvt_pk_fp8_f32(a[q][2], a[q][3], p0, true);
      int p1 = __builtin_amdgcn_cvt_pk_fp8_f32(b[q][0], b[q][1], 0, false); p1 = __builtin_amdgcn_cvt_pk_fp8_f32(b[q][2], b[q][3], p1, true);
      *reinterpret_cast<u32x2*>(dst8 + i * 8) = (u32x2){(unsigned)p0, (unsigned)p1}; } }
  }
}
__device__ __forceinline__ void transpose_item(const float* __restrict__ W, int K, int N, bf16* __restrict__ WT, LAS float* scr, int kb, int nb, int lane) {
  const int k0 = 64 * kb, n0 = 32 * nb; const int nn = n0 + (lane & 31); const bool ok = nn < N;
  float tv[32];
#pragma unroll
  for (int i = 0; i < 32; ++i) { const int kk = 2 * i + (lane >> 5); tv[i] = ok ? W[(size_t)(k0 + kk) * N + nn] : 0.f; }
#pragma unroll
  for (int i = 0; i < 32; ++i) { const int kk = 2 * i + (lane >> 5); scr[kk * 33 + (lane & 31)] = tv[i]; }
  asm volatile("s_waitcnt lgkmcnt(0)" ::: "memory");
  const int c = lane & 7;
#pragma unroll
  for (int j = 0; j < 4; ++j) { const int n = (lane >> 3) + 8 * j; const LAS float* s = scr + (8 * c) * 33 + n;
    u32x4 o; o.x = cvt_pk(s[0 * 33], s[1 * 33]); o.y = cvt_pk(s[2 * 33], s[3 * 33]); o.z = cvt_pk(s[4 * 33], s[5 * 33]); o.w = cvt_pk(s[6 * 33], s[7 * 33]);
    *reinterpret_cast<u32x4*>(WT + (size_t)(n0 + n) * K + k0 + 8 * c) = o; }
  asm volatile("s_waitcnt lgkmcnt(0)" ::: "memory");
}

__device__ __forceinline__ void transpose_item_fp8(const float* __restrict__ W, int K, int N, unsigned char* __restrict__ WT, LAS float* scr, int kb, int nb, int lane, float scale) {
  const int k0 = 64 * kb, n0 = 32 * nb; const int nn = n0 + (lane & 31); const bool ok = nn < N;
  float tv[32];
#pragma unroll
  for (int i = 0; i < 32; ++i) { const int kk = 2 * i + (lane >> 5); tv[i] = ok ? W[(size_t)(k0 + kk) * N + nn] * scale : 0.f; }
#pragma unroll
  for (int i = 0; i < 32; ++i) { const int kk = 2 * i + (lane >> 5); scr[kk * 33 + (lane & 31)] = tv[i]; }
  asm volatile("s_waitcnt lgkmcnt(0)" ::: "memory");
  const int c = lane & 7;
#pragma unroll
  for (int j = 0; j < 4; ++j) { const int n = (lane >> 3) + 8 * j; const LAS float* s = scr + (8 * c) * 33 + n;
    int p0 = __builtin_amdgcn_cvt_pk_fp8_f32(s[0 * 33], s[1 * 33], 0, false); p0 = __builtin_amdgcn_cvt_pk_fp8_f32(s[2 * 33], s[3 * 33], p0, true);
    int p1 = __builtin_amdgcn_cvt_pk_fp8_f32(s[4 * 33], s[5 * 33], 0, false); p1 = __builtin_amdgcn_cvt_pk_fp8_f32(s[6 * 33], s[7 * 33], p1, true);
    *reinterpret_cast<u32x2*>(WT + (size_t)(n0 + n) * K + k0 + 8 * c) = (u32x2){(unsigned)p0, (unsigned)p1}; }
  asm volatile("s_waitcnt lgkmcnt(0)" ::: "memory");
}

__device__ __forceinline__ void ln1_phase(const bf16* __restrict__ Z, const float* __restrict__ g, const float* __restrict__ bta, bf16* __restrict__ OB, unsigned char* __restrict__ O8, int gw, int ngw, int lane) {
  f32x4 gv[8], bv[8];
#pragma unroll
  for (int j = 0; j < 4; ++j) { const int e0 = 512 * j + 8 * lane;
    gv[2 * j] = *reinterpret_cast<const f32x4*>(g + e0); gv[2 * j + 1] = *reinterpret_cast<const f32x4*>(g + e0 + 4);
    bv[2 * j] = *reinterpret_cast<const f32x4*>(bta + e0); bv[2 * j + 1] = *reinterpret_cast<const f32x4*>(bta + e0 + 4); }
  u32x4 nx[4];
  if (gw < NTOK) {
#pragma unroll
    for (int j = 0; j < 4; ++j) nx[j] = *reinterpret_cast<const u32x4*>(Z + (size_t)gw * DM + 512 * j + 8 * lane); }
  for (int m = gw; m < NTOK; m += ngw) {
    float v[32]; float s = 0.f;
#pragma unroll
    for (int j = 0; j < 4; ++j) {
#pragma unroll
      for (int q = 0; q < 4; ++q) { v[8 * j + 2 * q] = bf_lo(nx[j][q]); v[8 * j + 2 * q + 1] = bf_hi(nx[j][q]); } }
    if (m + ngw < NTOK) {
#pragma unroll
      for (int j = 0; j < 4; ++j) nx[j] = *reinterpret_cast<const u32x4*>(Z + (size_t)(m + ngw) * DM + 512 * j + 8 * lane); }
#pragma unroll
    for (int i = 0; i < 32; ++i) s += v[i];
    const float mean = wave_sum(s) * (1.f / DM); float s2 = 0.f;
#pragma unroll
    for (int i = 0; i < 32; ++i) { v[i] -= mean; s2 = fmaf(v[i], v[i], s2); }
    const float rstd = 1.0f / sqrtf(wave_sum(s2) * (1.f / DM) + LN_EPS);
    bf16* obrow = OB + (size_t)m * DM; unsigned char* o8row = O8 + (size_t)m * DM;
#pragma unroll
    for (int j = 0; j < 4; ++j) {
      const int e0 = 512 * j + 8 * lane;
      float y[8];
#pragma unroll
      for (int e = 0; e < 4; ++e) { y[e] = v[8 * j + e] * rstd * gv[2 * j][e] + bv[2 * j][e]; y[4 + e] = v[8 * j + 4 + e] * rstd * gv[2 * j + 1][e] + bv[2 * j + 1][e]; }
      u32x4 w = {cvt_pk(y[0], y[1]), cvt_pk(y[2], y[3]), cvt_pk(y[4], y[5]), cvt_pk(y[6], y[7])}; *reinterpret_cast<u32x4*>(obrow + e0) = w;
      int p0 = __builtin_amdgcn_cvt_pk_fp8_f32(y[0], y[1], 0, false); p0 = __builtin_amdgcn_cvt_pk_fp8_f32(y[2], y[3], p0, true);
      int p1 = __builtin_amdgcn_cvt_pk_fp8_f32(y[4], y[5], 0, false); p1 = __builtin_amdgcn_cvt_pk_fp8_f32(y[6], y[7], p1, true);
      *reinterpret_cast<u32x2*>(o8row + e0) = (u32x2){(unsigned)p0, (unsigned)p1};
    }
  }
}

namespace peer {
using bf16x8 = att::bf16x8; using f32x16 = att::f32x16;
constexpr int L_K1 = 0, L_K2 = 32768, L_SCR = 65536;
__device__ __forceinline__ unsigned srt(float x) { const unsigned b = __float_as_uint(x); return b ^ ((unsigned)((int)b >> 31) | 0x80000000u); }
__device__ __forceinline__ float unsrt(unsigned u) { const unsigned b = (u & 0x80000000u) ? (u ^ 0x80000000u) : ~u; return __uint_as_float(b); }
__device__ __forceinline__ unsigned umax(unsigned a, unsigned b) { return a > b ? a : b; }
__device__ __forceinline__ unsigned pair_max(unsigned m) {
  auto rr = __builtin_amdgcn_permlane32_swap(m, m, false, false); return umax(rr[0], rr[1]);
}
__device__ __forceinline__ void load_keys(const float* __restrict__ k1, const float* __restrict__ k2, char* lds) {
  for (int i = my_tid(); i < 2 * 128 * 16; i += 512) {
    const int t = i >> 11, row = (i >> 4) & 127, ch = i & 15; const float* src = (t ? k2 : k1) + row * 128 + ch * 8;
    const f32x4 a = *reinterpret_cast<const f32x4*>(src), b = *reinterpret_cast<const f32x4*>(src + 4);
    u32x4 w = {cvt_pk(a[0], a[1]), cvt_pk(a[2], a[3]), cvt_pk(b[0], b[1]), cvt_pk(b[2], b[3])};
    *reinterpret_cast<u32x4*>(lds + (t ? L_K2 : L_K1) + KSWZ(row, ch * 16)) = w;
  }
}
#define PK_CE(a, b) do { const unsigned hi_ = (a) > (b) ? (a) : (b), lo_ = (a) > (b) ? (b) : (a); (a) = hi_; (b) = lo_; } while (0)
__device__ __forceinline__ void sort16_desc(unsigned (&v)[64], const int base) {
  PK_CE(v[base + 0], v[base + 1]);
  PK_CE(v[base + 2], v[base + 3]);
  PK_CE(v[base + 0], v[base + 2]);
  PK_CE(v[base + 1], v[base + 3]);
  PK_CE(v[base + 1], v[base + 2]);
  PK_CE(v[base + 4], v[base + 5]);
  PK_CE(v[base + 6], v[base + 7]);
  PK_CE(v[base + 4], v[base + 6]);
  PK_CE(v[base + 5], v[base + 7]);
  PK_CE(v[base + 5], v[base + 6]);
  PK_CE(v[base + 0], v[base + 4]);
  PK_CE(v[base + 2], v[base + 6]);
  PK_CE(v[base + 2], v[base + 4]);
  PK_CE(v[base + 1], v[base + 5]);
  PK_CE(v[base + 3], v[base + 7]);
  PK_CE(v[base + 3], v[base + 5]);
  PK_CE(v[base + 1], v[base + 2]);
  PK_CE(v[base + 3], v[base + 4]);
  PK_CE(v[base + 5], v[base + 6]);
  PK_CE(v[base + 8], v[base + 9]);
  PK_CE(v[base + 10], v[base + 11]);
  PK_CE(v[base + 8], v[base + 10]);
  PK_CE(v[base + 9], v[base + 11]);
  PK_CE(v[base + 9], v[base + 10]);
  PK_CE(v[base + 12], v[base + 13]);
  PK_CE(v[base + 14], v[base + 15]);
  PK_CE(v[base + 12], v[base + 14]);
  PK_CE(v[base + 13], v[base + 15]);
  PK_CE(v[base + 13], v[base + 14]);
  PK_CE(v[base + 8], v[base + 12]);
  PK_CE(v[base + 10], v[base + 14]);
  PK_CE(v[base + 10], v[base + 12]);
  PK_CE(v[base + 9], v[base + 13]);
  PK_CE(v[base + 11], v[base + 15]);
  PK_CE(v[base + 11], v[base + 13]);
  PK_CE(v[base + 9], v[base + 10]);
  PK_CE(v[base + 11], v[base + 12]);
  PK_CE(v[base + 13], v[base + 14]);
  PK_CE(v[base + 0], v[base + 8]);
  PK_CE(v[base + 4], v[base + 12]);
  PK_CE(v[base + 4], v[base + 8]);
  PK_CE(v[base + 2], v[base + 10]);
  PK_CE(v[base + 6], v[base + 14]);
  PK_CE(v[base + 6], v[base + 10]);
  PK_CE(v[base + 2], v[base + 4]);
  PK_CE(v[base + 6], v[base + 8]);
  PK_CE(v[base + 10], v[base + 12]);
  PK_CE(v[base + 1], v[base + 9]);
  PK_CE(v[base + 5], v[base + 13]);
  PK_CE(v[base + 5], v[base + 9]);
  PK_CE(v[base + 3], v[base + 11]);
  PK_CE(v[base + 7], v[base + 15]);
  PK_CE(v[base + 7], v[base + 11]);
  PK_CE(v[base + 3], v[base + 5]);
  PK_CE(v[base + 7], v[base + 9]);
  PK_CE(v[base + 11], v[base + 13]);
  PK_CE(v[base + 1], v[base + 2]);
  PK_CE(v[base + 3], v[base + 4]);
  PK_CE(v[base + 5], v[base + 6]);
  PK_CE(v[base + 7], v[base + 8]);
  PK_CE(v[base + 9], v[base + 10]);
  PK_CE(v[base + 11], v[base + 12]);
  PK_CE(v[base + 13], v[base + 14]);
}
__device__ __forceinline__ void merge_top16(unsigned (&a)[16], const unsigned (&b)[16]) {
#pragma unroll
  for (int i = 0; i < 16; ++i) a[i] = a[i] > b[15 - i] ? a[i] : b[15 - i];
  PK_CE(a[0], a[8]);
  PK_CE(a[1], a[9]);
  PK_CE(a[2], a[10]);
  PK_CE(a[3], a[11]);
  PK_CE(a[4], a[12]);
  PK_CE(a[5], a[13]);
  PK_CE(a[6], a[14]);
  PK_CE(a[7], a[15]);
  PK_CE(a[0], a[4]);
  PK_CE(a[1], a[5]);
  PK_CE(a[2], a[6]);
  PK_CE(a[3], a[7]);
  PK_CE(a[8], a[12]);
  PK_CE(a[9], a[13]);
  PK_CE(a[10], a[14]);
  PK_CE(a[11], a[15]);
  PK_CE(a[0], a[2]);
  PK_CE(a[1], a[3]);
  PK_CE(a[4], a[6]);
  PK_CE(a[5], a[7]);
  PK_CE(a[8], a[10]);
  PK_CE(a[9], a[11]);
  PK_CE(a[12], a[14]);
  PK_CE(a[13], a[15]);
  PK_CE(a[0], a[1]);
  PK_CE(a[2], a[3]);
  PK_CE(a[4], a[5]);
  PK_CE(a[6], a[7]);
  PK_CE(a[8], a[9]);
  PK_CE(a[10], a[11]);
  PK_CE(a[12], a[13]);
  PK_CE(a[14], a[15]);
}
__device__ __forceinline__ void top16_of_128(const bf16x8* qf, const char* Kt, int r32, int hi, unsigned (&win)[16]) {
  unsigned pk[64];
#pragma unroll
  for (int t = 0; t < 4; ++t) {
    f32x16 c = f32x16{};
#pragma unroll
    for (int ks = 0; ks < 8; ++ks) { const bf16x8 a = *reinterpret_cast<const bf16x8*>(Kt + KSWZ(32 * t + r32, (ks * 16 + hi * 8) * 2));
      c = __builtin_amdgcn_mfma_f32_32x32x16_bf16(a, qf[ks], c, 0, 0, 0); }
#pragma unroll
    for (int r = 0; r < 16; ++r) { const int n = 32 * t + att::crow(r, hi); pk[t * 16 + r] = (srt(c[r]) & 0xffffff80u) | (unsigned)(127 - n); }
  }
  sort16_desc(pk, 0); sort16_desc(pk, 16); sort16_desc(pk, 32); sort16_desc(pk, 48);
  unsigned a[16], b[16];
#pragma unroll
  for (int i = 0; i < 16; ++i) { a[i] = pk[i]; b[i] = pk[16 + i]; }
  merge_top16(a, b);
  unsigned c[16];
#pragma unroll
  for (int i = 0; i < 16; ++i) { c[i] = pk[32 + i]; b[i] = pk[48 + i]; }
  merge_top16(c, b);
  merge_top16(a, c);
#pragma unroll
  for (int i = 0; i < 16; ++i) { auto rr = __builtin_amdgcn_permlane32_swap(a[i], a[i], false, false); b[i] = hi ? rr[0] : rr[1]; }
  merge_top16(a, b);
#pragma unroll
  for (int i = 0; i < 16; ++i) win[i] = a[i];
}
__device__ __forceinline__ void score_unit(const bf16* __restrict__ PQ, int* __restrict__ EIDX, float* __restrict__ EG, int t0, char* lds) {
  const int wid = my_wave(), lane = my_lane(), r32 = lane & 31, hi = lane >> 5;
  const bf16* qp = PQ + (size_t)(t0 + r32) * DM + wid * 256 + hi * 8;
  unsigned w1[16], w2[16];
  { bf16x8 qf[8];
#pragma unroll
    for (int ks = 0; ks < 8; ++ks) qf[ks] = att::ld8(qp + ks * 16);
    top16_of_128(qf, lds + L_K1, r32, hi, w1); }
  { bf16x8 qf[8];
#pragma unroll
    for (int ks = 0; ks < 8; ++ks) qf[ks] = att::ld8(qp + 128 + ks * 16);
    top16_of_128(qf, lds + L_K2, r32, hi, w2); }
  unsigned char* scr = (unsigned char*)(lds + L_SCR + wid * 1024) + r32 * 32;
  if (hi == 0) {
#pragma unroll
    for (int k = 0; k < 16; ++k) { scr[k] = (unsigned char)(127u - (w1[k] & 127u)); scr[16 + k] = (unsigned char)(127u - (w2[k] & 127u)); }
  }
  float v1[16], v2[16];
#pragma unroll
  for (int k = 0; k < 16; ++k) { v1[k] = unsrt(w1[k] & 0xffffff80u); v2[k] = unsrt(w2[k] & 0xffffff80u); }
  unsigned cd[25]; const unsigned hm0 = 0u - (unsigned)hi;
  { const unsigned e_ = (srt(v1[0] + v2[0]) & 0xffffff00u) | 255u, o_ = (srt(v1[0] + v2[1]) & 0xffffff00u) | 254u; cd[0] = (e_ & ~hm0) | (o_ & hm0); }
  { const unsigned e_ = (srt(v1[0] + v2[2]) & 0xffffff00u) | 253u, o_ = (srt(v1[0] + v2[3]) & 0xffffff00u) | 252u; cd[1] = (e_ & ~hm0) | (o_ & hm0); }
  { const unsigned e_ = (srt(v1[0] + v2[4]) & 0xffffff00u) | 251u, o_ = (srt(v1[0] + v2[5]) & 0xffffff00u) | 250u; cd[2] = (e_ & ~hm0) | (o_ & hm0); }
  { const unsigned e_ = (srt(v1[0] + v2[6]) & 0xffffff00u) | 249u, o_ = (srt(v1[0] + v2[7]) & 0xffffff00u) | 248u; cd[3] = (e_ & ~hm0) | (o_ & hm0); }
  { const unsigned e_ = (srt(v1[0] + v2[8]) & 0xffffff00u) | 247u, o_ = (srt(v1[0] + v2[9]) & 0xffffff00u) | 246u; cd[4] = (e_ & ~hm0) | (o_ & hm0); }
  { const unsigned e_ = (srt(v1[0] + v2[10]) & 0xffffff00u) | 245u, o_ = (srt(v1[0] + v2[11]) & 0xffffff00u) | 244u; cd[5] = (e_ & ~hm0) | (o_ & hm0); }
  { const unsigned e_ = (srt(v1[0] + v2[12]) & 0xffffff00u) | 243u, o_ = (srt(v1[0] + v2[13]) & 0xffffff00u) | 242u; cd[6] = (e_ & ~hm0) | (o_ & hm0); }
  { const unsigned e_ = (srt(v1[0] + v2[14]) & 0xffffff00u) | 241u, o_ = (srt(v1[0] + v2[15]) & 0xffffff00u) | 240u; cd[7] = (e_ & ~hm0) | (o_ & hm0); }
  { const unsigned e_ = (srt(v1[1] + v2[0]) & 0xffffff00u) | 239u, o_ = (srt(v1[1] + v2[1]) & 0xffffff00u) | 238u; cd[8] = (e_ & ~hm0) | (o_ & hm0); }
  { const unsigned e_ = (srt(v1[1] + v2[2]) & 0xffffff00u) | 237u, o_ = (srt(v1[1] + v2[3]) & 0xffffff00u) | 236u; cd[9] = (e_ & ~hm0) | (o_ & hm0); }
  { const unsigned e_ = (srt(v1[1] + v2[4]) & 0xffffff00u) | 235u, o_ = (srt(v1[1] + v2[5]) & 0xffffff00u) | 234u; cd[10] = (e_ & ~hm0) | (o_ & hm0); }
  { const unsigned e_ = (srt(v1[1] + v2[6]) & 0xffffff00u) | 233u, o_ = (srt(v1[1] + v2[7]) & 0xffffff00u) | 232u; cd[11] = (e_ & ~hm0) | (o_ & hm0); }
  { const unsigned e_ = (srt(v1[2] + v2[0]) & 0xffffff00u) | 223u, o_ = (srt(v1[2] + v2[1]) & 0xffffff00u) | 222u; cd[12] = (e_ & ~hm0) | (o_ & hm0); }
  { const unsigned e_ = (srt(v1[2] + v2[2]) & 0xffffff00u) | 221u, o_ = (srt(v1[2] + v2[3]) & 0xffffff00u) | 220u; cd[13] = (e_ & ~hm0) | (o_ & hm0); }
  { const unsigned e_ = (srt(v1[2] + v2[4]) & 0xffffff00u) | 219u, o_ = (srt(v1[3] + v2[0]) & 0xffffff00u) | 207u; cd[14] = (e_ & ~hm0) | (o_ & hm0); }
  { const unsigned e_ = (srt(v1[3] + v2[1]) & 0xffffff00u) | 206u, o_ = (srt(v1[3] + v2[2]) & 0xffffff00u) | 205u; cd[15] = (e_ & ~hm0) | (o_ & hm0); }
  { const unsigned e_ = (srt(v1[3] + v2[3]) & 0xffffff00u) | 204u, o_ = (srt(v1[4] + v2[0]) & 0xffffff00u) | 191u; cd[16] = (e_ & ~hm0) | (o_ & hm0); }
  { const unsigned e_ = (srt(v1[4] + v2[1]) & 0xffffff00u) | 190u, o_ = (srt(v1[4] + v2[2]) & 0xffffff00u) | 189u; cd[17] = (e_ & ~hm0) | (o_ & hm0); }
  { const unsigned e_ = (srt(v1[5] + v2[0]) & 0xffffff00u) | 175u, o_ = (srt(v1[5] + v2[1]) & 0xffffff00u) | 174u; cd[18] = (e_ & ~hm0) | (o_ & hm0); }
  { const unsigned e_ = (srt(v1[6] + v2[0]) & 0xffffff00u) | 159u, o_ = (srt(v1[6] + v2[1]) & 0xffffff00u) | 158u; cd[19] = (e_ & ~hm0) | (o_ & hm0); }
  { const unsigned e_ = (srt(v1[7] + v2[0]) & 0xffffff00u) | 143u, o_ = (srt(v1[7] + v2[1]) & 0xffffff00u) | 142u; cd[20] = (e_ & ~hm0) | (o_ & hm0); }
  { const unsigned e_ = (srt(v1[8] + v2[0]) & 0xffffff00u) | 127u, o_ = (srt(v1[9] + v2[0]) & 0xffffff00u) | 111u; cd[21] = (e_ & ~hm0) | (o_ & hm0); }
  { const unsigned e_ = (srt(v1[10] + v2[0]) & 0xffffff00u) | 95u, o_ = (srt(v1[11] + v2[0]) & 0xffffff00u) | 79u; cd[22] = (e_ & ~hm0) | (o_ & hm0); }
  { const unsigned e_ = (srt(v1[12] + v2[0]) & 0xffffff00u) | 63u, o_ = (srt(v1[13] + v2[0]) & 0xffffff00u) | 47u; cd[23] = (e_ & ~hm0) | (o_ & hm0); }
  { const unsigned e_ = (srt(v1[14] + v2[0]) & 0xffffff00u) | 31u, o_ = (srt(v1[15] + v2[0]) & 0xffffff00u) | 15u; cd[24] = (e_ & ~hm0) | (o_ & hm0); }
  unsigned win[16];
#pragma unroll
  for (int k = 0; k < 16; ++k) {
    unsigned m = cd[0];
#pragma unroll
    for (int i = 1; i < 25; ++i) m = umax(m, cd[i]);
    m = pair_max(m); win[k] = m;
#pragma unroll
    for (int i = 0; i < 25; ++i) cd[i] = (cd[i] == m) ? 0u : cd[i];
  }
  asm volatile("s_waitcnt lgkmcnt(0)" ::: "memory");
  const float smax = unsrt(win[0] & 0xffffff00u);
  float ex[16], den = 0.f;
#pragma unroll
  for (int k = 0; k < 16; ++k) { ex[k] = __builtin_amdgcn_exp2f((unsrt(win[k] & 0xffffff00u) - smax) * LOG2E); den += ex[k]; }
  const float rden = 1.0f / den; const unsigned hm = 0u - (unsigned)hi;
  int* eo = EIDX + (size_t)(t0 + r32) * 128 + wid * 2 + hi; float* go = EG + (size_t)(t0 + r32) * 128 + wid * 2 + hi;
#pragma unroll
  for (int kk = 0; kk < 8; ++kk) {
    const unsigned wv = (win[kk] & ~hm) | (win[8 + kk] & hm); const float gv = __uint_as_float((__float_as_uint(ex[kk]) & ~hm) | (__float_as_uint(ex[8 + kk]) & hm)) * rden;
    const int flat = 255 - (int)(wv & 255u), a = flat >> 4, bq = flat & 15;
    eo[kk * 16] = (int)scr[a] * 128 + (int)scr[16 + bq]; go[kk * 16] = gv;
  }
  asm volatile("s_waitcnt lgkmcnt(0)" ::: "memory");
}
}

typedef float f32x2 __attribute__((ext_vector_type(2)));
typedef int i32x4 __attribute__((ext_vector_type(4)));
constexpr float U_SCALE = 128.f, V_SCALE = 4.f;
constexpr int NSLICE = 8, SLICE_COLS = 256;
template <int CTRL> __device__ __forceinline__ float dpp_mov(float v) { return __int_as_float(__builtin_amdgcn_update_dpp(0, __float_as_int(v), CTRL, 0xf, 0xf, false)); }
__device__ __forceinline__ void pe_load_ids(const int* __restrict__ EIDX, int t, int g, int (&id)[16]) {
#pragma unroll
  for (int q = 0; q < 4; ++q) { const i32x4 v = *reinterpret_cast<const i32x4*>(EIDX + (size_t)t * 128 + g * 16 + 4 * q); id[4 * q] = v[0]; id[4 * q + 1] = v[1]; id[4 * q + 2] = v[2]; id[4 * q + 3] = v[3]; }
}
__device__ __forceinline__ void pe_issue_segs(const unsigned char* __restrict__ TB, const int (&id)[16], int coff, u32x4 (&seg)[16]) {
#pragma unroll
  for (int i = 0; i < 16; ++i) { const unsigned off = (unsigned)id[i] * 128u + (unsigned)coff; seg[i] = *reinterpret_cast<const u32x4*>(TB + off); }
}
typedef int v8i __attribute__((ext_vector_type(8)));
__device__ __forceinline__ void pe_x8_load(const unsigned char* __restrict__ X8, int t, unsigned xoff, u32x4 (&xw)[4]) {
  const unsigned char* xp = X8 + (size_t)t * DM + xoff;
  xw[0] = *reinterpret_cast<const u32x4*>(xp); xw[1] = *reinterpret_cast<const u32x4*>(xp + 64); xw[2] = *reinterpret_cast<const u32x4*>(xp + 128); xw[3] = *reinterpret_cast<const u32x4*>(xp + 192);
}
__device__ __forceinline__ void peer_u_pass(const unsigned char* __restrict__ X8, const unsigned char* __restrict__ U4, const int* __restrict__ EIDX, float* __restrict__ HPs, char* wlds, int t0, int dt, int n, int s, int lane) {
  const int g = lane >> 3, j = lane & 7, e16 = lane & 15, g4 = lane >> 4, c = lane & 15;
  const int coff = s * (NEXP * 128) + 16 * j; const unsigned xoff = (unsigned)(s * SLICE_COLS + 16 * g4);
  int idn[16]; u32x4 seg[16]; u32x4 xC[4], xN[4];
  pe_load_ids(EIDX, t0, g, idn); pe_issue_segs(U4, idn, coff, seg); pe_x8_load(X8, t0, xoff, xN);
  pe_load_ids(EIDX, t0 + (n > 1 ? dt : 0), g, idn);
#pragma unroll 1
  for (int it = 0; it < n; ++it) {
    const int t = t0 + it * dt, tn = t0 + (it + 1 < n ? it + 1 : n - 1) * dt, tnn = t0 + (it + 2 < n ? it + 2 : n - 1) * dt;
#pragma unroll
    for (int i = 0; i < 16; ++i) { const int row = 16 * g + i; *reinterpret_cast<u32x4*>(wlds + row * 128 + ((j ^ (row & 7)) << 4)) = seg[i]; }
#pragma unroll
    for (int p = 0; p < 4; ++p) xC[p] = xN[p];
    pe_issue_segs(U4, idn, coff, seg); pe_x8_load(X8, tn, xoff, xN);
    pe_load_ids(EIDX, tnn, g, idn);
    asm volatile("s_waitcnt lgkmcnt(0)" ::: "memory");
    f32x4 acc[8];
#pragma unroll
    for (int G = 0; G < 8; ++G) acc[G] = (f32x4){0.f, 0.f, 0.f, 0.f};
#pragma unroll
    for (int kh = 0; kh < 2; ++kh) {
      const v8i b = {(int)xC[2 * kh][0], (int)xC[2 * kh][1], (int)xC[2 * kh][2], (int)xC[2 * kh][3], (int)xC[2 * kh + 1][0], (int)xC[2 * kh + 1][1], (int)xC[2 * kh + 1][2], (int)xC[2 * kh + 1][3]};
#pragma unroll
      for (int G = 0; G < 8; ++G) { const int row = 16 * G + e16; const u32x4 sw = *reinterpret_cast<const u32x4*>(wlds + row * 128 + (((4 * kh + g4) ^ (row & 7)) << 4));
        const v8i a = {(int)sw[0], (int)sw[1], (int)sw[2], (int)sw[3], 0, 0, 0, 0};
        acc[G] = __builtin_amdgcn_mfma_scale_f32_16x16x128_f8f6f4(a, b, acc[G], 4  , 0  , 0, 0x7F7F7F7F  , 0, 0x7F7F7F7F); }
    }
    float s0[8], s1[8];
#pragma unroll
    for (int G = 0; G < 8; ++G) { s0[G] = (c & 1) ? acc[G][2] : acc[G][0]; s1[G] = (c & 1) ? acc[G][3] : acc[G][1]; }
    const int Gs = c >> 1;
    const float a0 = (Gs & 4) ? ((Gs & 2) ? ((Gs & 1) ? s0[7] : s0[6]) : ((Gs & 1) ? s0[5] : s0[4])) : ((Gs & 2) ? ((Gs & 1) ? s0[3] : s0[2]) : ((Gs & 1) ? s0[1] : s0[0]));
    const float a1 = (Gs & 4) ? ((Gs & 2) ? ((Gs & 1) ? s1[7] : s1[6]) : ((Gs & 1) ? s1[5] : s1[4])) : ((Gs & 2) ? ((Gs & 1) ? s1[3] : s1[2]) : ((Gs & 1) ? s1[1] : s1[0]));
    *reinterpret_cast<f32x2*>(HPs + (size_t)t * 128 + 16 * Gs + 4 * g4 + 2 * (c & 1)) = (f32x2){a0, a1};
  }
}
typedef int v2i __attribute__((ext_vector_type(2)));
__device__ __forceinline__ void peer_v_pass(const unsigned char* __restrict__ A8, const unsigned char* __restrict__ V4, const int* __restrict__ EIDX, bf16* __restrict__ Y, char* wlds, int t0, int dt, int n, int s, int lane) {
  const int g = lane >> 3, j = lane & 7, e16 = lane & 15, g4 = lane >> 4;
  const int coff = s * (NEXP * 128) + 16 * j;
  int idn[16]; u32x4 seg[16]; u32x4 aC[2], aN[2];
#define PE_ALOAD(t, aw) do { const unsigned char* ap_ = A8 + (size_t)(t) * 128 + 16 * g4; aw[0] = *reinterpret_cast<const u32x4*>(ap_); aw[1] = *reinterpret_cast<const u32x4*>(ap_ + 64); } while (0)
  pe_load_ids(EIDX, t0, g, idn); pe_issue_segs(V4, idn, coff, seg); PE_ALOAD(t0, aN);
  pe_load_ids(EIDX, t0 + (n > 1 ? dt : 0), g, idn);
#pragma unroll 1
  for (int it = 0; it < n; ++it) {
    const int t = t0 + it * dt, tn = t0 + (it + 1 < n ? it + 1 : n - 1) * dt, tnn = t0 + (it + 2 < n ? it + 2 : n - 1) * dt;
#pragma unroll
    for (int i = 0; i < 16; ++i) { const int row = 16 * g + i; *reinterpret_cast<u32x4*>(wlds + row * 128 + ((j ^ (row & 7)) << 4)) = seg[i]; }
    aC[0] = aN[0]; aC[1] = aN[1];
    pe_issue_segs(V4, idn, coff, seg); PE_ALOAD(tn, aN);
    pe_load_ids(EIDX, tnn, g, idn);
    asm volatile("s_waitcnt lgkmcnt(0)" ::: "memory");
    const v8i a = {(int)aC[0][0], (int)aC[0][1], (int)aC[0][2], (int)aC[0][3], (int)aC[1][0], (int)aC[1][1], (int)aC[1][2], (int)aC[1][3]};
    const int r0 = 32 * g4 + e16, r1 = r0 + 16;
    float yv[4];
#pragma unroll
    for (int q = 0; q < 4; ++q) yv[q] = 0.f;
#pragma unroll
    for (int cb = 0; cb < 16; ++cb) {
      const v2i b0 = __builtin_amdgcn_ds_read_tr4_b64_v2i32((LAS v2i*)(wlds + r0 * 128 + ((((cb >> 1) ^ (r0 & 7)) << 4) | ((cb & 1) << 3))));
      const v2i b1 = __builtin_amdgcn_ds_read_tr4_b64_v2i32((LAS v2i*)(wlds + r1 * 128 + ((((cb >> 1) ^ (r1 & 7)) << 4) | ((cb & 1) << 3))));
      const v8i b = {b0[0], b0[1], b1[0], b1[1], 0, 0, 0, 0};
      const f32x4 d = __builtin_amdgcn_mfma_scale_f32_16x16x128_f8f6f4(a, b, (f32x4){0.f, 0.f, 0.f, 0.f}, 0  , 4  , 0, 0x79797979  , 0, 0x7D7D7D7D  );
      if ((cb & 3) == 0) yv[cb >> 2] = d[0];
      else yv[cb >> 2] = ((cb & 3) == g4) ? d[0] : yv[cb >> 2];
    }
#pragma unroll
    for (int q = 0; q < 4; ++q) Y[(size_t)t * DM + s * SLICE_COLS + 16 * (4 * q + g4) + e16] = (bf16)(cvt_pk(yv[q], 0.f) & 0xffffu);
  }
#undef PE_ALOAD
}
__device__ __forceinline__ void v4c_relayout_item(const unsigned char* __restrict__ V4, unsigned char* __restrict__ V4C, int s, int eb, int lane) {
  const int e = 64 * eb + lane; const unsigned char* src = V4 + (size_t)s * (NEXP * 128) + (size_t)e * 128;
  u32x4 w[8];
#pragma unroll
  for (int q = 0; q < 8; ++q) w[q] = *reinterpret_cast<const u32x4*>(src + 16 * q);
#pragma unroll
  for (int q = 0; q < 8; ++q) {
    *reinterpret_cast<u32x2*>(V4C + (size_t)(16 * s + 2 * q) * (NEXP * 8) + (size_t)e * 8) = (u32x2){w[q][0], w[q][1]};
    *reinterpret_cast<u32x2*>(V4C + (size_t)(16 * s + 2 * q + 1) * (NEXP * 8) + (size_t)e * 8) = (u32x2){w[q][2], w[q][3]}; }
}
__device__ __forceinline__ void eidp_item(const int* __restrict__ EIDX, unsigned* __restrict__ EIDP, int t4, int lane) {
  const int i16 = lane & 15, g4 = lane >> 4; u32x4 w;
#pragma unroll
  for (int e = 0; e < 4; ++e) { const int* r = EIDX + (size_t)(4 * t4 + e) * 128 + 32 * g4 + i16; const unsigned ia = (unsigned)r[0], ib = (unsigned)r[16]; w[e] = (ia ^ ((ia >> 7) & 31u)) | ((ib ^ ((ib >> 7) & 31u)) << 16); }
  *reinterpret_cast<u32x4*>(EIDP + ((size_t)t4 * 64 + lane) * 4) = w;
}
__device__ __forceinline__ void peer_v_pass2(const unsigned char* __restrict__ A8, const unsigned char* __restrict__ V4C, const unsigned* __restrict__ EIDP, bf16* __restrict__ Y, char* lds, int c, int tbeg, int ntok, int wave, int lane) {
  { const int tid = wave * 64 + lane; const unsigned char* tb = V4C + (size_t)c * (NEXP * 8);
#pragma unroll
    for (int i = 0; i < 16; ++i) { const int r2 = i * 512 + tid; const u32x4 w = *reinterpret_cast<const u32x4*>(tb + r2 * 16); const int m = (r2 >> 6) & 31;
      *reinterpret_cast<u32x2*>(lds + ((2 * r2) ^ m) * 8) = (u32x2){w[0], w[1]}; *reinterpret_cast<u32x2*>(lds + ((2 * r2 + 1) ^ m) * 8) = (u32x2){w[2], w[3]}; } }
  __syncthreads();
  const int i16 = lane & 15, g4 = lane >> 4;
  const int nstep = ntok / (16 * 8);
  const unsigned char* abase = A8 + (size_t)i16 * 128 + 16 * g4;
  const unsigned* ibase = EIDP + (size_t)lane * 4;
  bf16* ybase = Y + (size_t)(4 * g4) * DM + 16 * c + i16;
#define PV_LOAD(AW, ID, step) do { const int t0_ = tbeg + 16 * (wave + 8 * ((step) < nstep ? (step) : nstep - 1)); \
    AW[0] = *reinterpret_cast<const u32x4*>(abase + (size_t)t0_ * 128); AW[1] = *reinterpret_cast<const u32x4*>(abase + (size_t)t0_ * 128 + 64); \
    _Pragma("unroll") for (int j = 0; j < 4; ++j) ID[j] = *reinterpret_cast<const u32x4*>(ibase + ((size_t)(t0_ >> 2) + j) * 256); } while (0)
#define PV_READ(ID, j) do { _Pragma("unroll") for (int e = 0; e < 4; ++e) { const unsigned pk = ID[j][e]; \
      b0[j][e] = __builtin_amdgcn_ds_read_tr4_b64_v2i32((LAS v2i*)(lds + ((pk & 0xffffu) << 3))); \
      b1[j][e] = __builtin_amdgcn_ds_read_tr4_b64_v2i32((LAS v2i*)(lds + ((pk >> 16) << 3))); } __builtin_amdgcn_sched_barrier(0); } while (0)
#define PV_MMA(j) do { f32x4 d[4]; _Pragma("unroll") for (int e = 0; e < 4; ++e) { const v8i b = {b0[j][e][0], b0[j][e][1], b1[j][e][0], b1[j][e][1], 0, 0, 0, 0}; \
      d[e] = __builtin_amdgcn_mfma_scale_f32_16x16x128_f8f6f4(a, b, (f32x4){0.f, 0.f, 0.f, 0.f}, 0  , 4  , 0, 0x79797979  , 0, 0x7D7D7D7D  ); } \
    _Pragma("unroll") for (int e = 0; e < 4; ++e) y[e] = (g4 == j) ? d[e][e] : y[e]; __builtin_amdgcn_sched_barrier(0); } while (0)
#define PV_COMPUTE(AW, ID, step) do { const int t0_ = tbeg + 16 * (wave + 8 * (step)); \
    const v8i a = {(int)AW[0][0], (int)AW[0][1], (int)AW[0][2], (int)AW[0][3], (int)AW[1][0], (int)AW[1][1], (int)AW[1][2], (int)AW[1][3]}; \
    float y[4] = {0.f, 0.f, 0.f, 0.f}; v2i b0[4][4], b1[4][4]; \
    PV_READ(ID, 0); PV_READ(ID, 1); PV_MMA(0); PV_READ(ID, 2); PV_MMA(1); PV_READ(ID, 3); PV_MMA(2); PV_MMA(3); \
    _Pragma("unroll") for (int e = 0; e < 4; ++e) { const __bf16 yh = (__bf16)y[e]; ybase[(size_t)(t0_ + e) * DM] = __builtin_bit_cast(unsigned short, yh); } } while (0)
  u32x4 A0[2], A1[2], A2[2], A3[2], I0[4], I1[4], I2[4], I3[4];
  PV_LOAD(A0, I0, 0); PV_LOAD(A1, I1, 1); PV_LOAD(A2, I2, 2);
#pragma unroll 1
  for (int k = 0; k < nstep; k += 4) {
    PV_LOAD(A3, I3, k + 3); PV_COMPUTE(A0, I0, k);
    PV_LOAD(A0, I0, k + 4); PV_COMPUTE(A1, I1, k + 1);
    PV_LOAD(A1, I1, k + 5); PV_COMPUTE(A2, I2, k + 2);
    PV_LOAD(A2, I2, k + 6); PV_COMPUTE(A3, I3, k + 3);
  }
#undef PV_LOAD
#undef PV_COMPUTE
#undef PV_READ
#undef PV_MMA
  __syncthreads();
}
__device__ __forceinline__ void ln2_phase(const bf16* __restrict__ X1, const bf16* __restrict__ Y, const float* __restrict__ g, const float* __restrict__ bta, float* __restrict__ O, int gw, int ngw, int lane) {
  f32x4 gv[8], bv[8];
#pragma unroll
  for (int j = 0; j < 4; ++j) { const int e0 = 512 * j + 8 * lane;
    gv[2 * j] = *reinterpret_cast<const f32x4*>(g + e0); gv[2 * j + 1] = *reinterpret_cast<const f32x4*>(g + e0 + 4);
    bv[2 * j] = *reinterpret_cast<const f32x4*>(bta + e0); bv[2 * j + 1] = *reinterpret_cast<const f32x4*>(bta + e0 + 4); }
  u32x4 na[4], nb[4];
  if (gw < NTOK) {
#pragma unroll
    for (int j = 0; j < 4; ++j) { na[j] = *reinterpret_cast<const u32x4*>(X1 + (size_t)gw * DM + 512 * j + 8 * lane); nb[j] = *reinterpret_cast<const u32x4*>(Y + (size_t)gw * DM + 512 * j + 8 * lane); } }
  for (int m = gw; m < NTOK; m += ngw) {
    float v[32]; float s = 0.f;
#pragma unroll
    for (int j = 0; j < 4; ++j) {
#pragma unroll
      for (int q = 0; q < 4; ++q) { v[8 * j + 2 * q] = fmaf(ALPHA, bf_lo(na[j][q]), bf_lo(nb[j][q])); v[8 * j + 2 * q + 1] = fmaf(ALPHA, bf_hi(na[j][q]), bf_hi(nb[j][q])); } }
    if (m + ngw < NTOK) {
#pragma unroll
      for (int j = 0; j < 4; ++j) { na[j] = *reinterpret_cast<const u32x4*>(X1 + (size_t)(m + ngw) * DM + 512 * j + 8 * lane); nb[j] = *reinterpret_cast<const u32x4*>(Y + (size_t)(m + ngw) * DM + 512 * j + 8 * lane); } }
#pragma unroll
    for (int i = 0; i < 32; ++i) s += v[i];
    const float mean = wave_sum(s) * (1.f / DM); float s2 = 0.f;
#pragma unroll
    for (int i = 0; i < 32; ++i) { v[i] -= mean; s2 = fmaf(v[i], v[i], s2); }
    const float rstd = 1.0f / sqrtf(wave_sum(s2) * (1.f / DM) + LN_EPS);
    float* orow = O + (size_t)m * DM;
#pragma unroll
    for (int j = 0; j < 4; ++j) { const int e0 = 512 * j + 8 * lane;
      f32x4 o0, o1;
#pragma unroll
      for (int e = 0; e < 4; ++e) { o0[e] = v[8 * j + e] * rstd * gv[2 * j][e] + bv[2 * j][e]; o1[e] = v[8 * j + 4 + e] * rstd * gv[2 * j + 1][e] + bv[2 * j + 1][e]; }
      *reinterpret_cast<f32x4*>(orow + e0) = o0; *reinterpret_cast<f32x4*>(orow + e0 + 4) = o1; }
  }
}
__device__ __forceinline__ void cvt_stream_fp4(const float* __restrict__ src, unsigned char* __restrict__ dst, size_t n32, float scale, size_t gtid, size_t gsz) {
  for (size_t i0 = gtid; i0 < n32; i0 += 2 * gsz) {
    f32x4 a[2][8];
#pragma unroll
    for (int h = 0; h < 2; ++h) { const size_t i = i0 + h * gsz; if (i < n32) {
#pragma unroll
      for (int q = 0; q < 8; ++q) a[h][q] = *reinterpret_cast<const f32x4*>(src + i * 32 + 4 * q); } }
#pragma unroll
    for (int h = 0; h < 2; ++h) { const size_t i = i0 + h * gsz; if (i < n32) {
      u32x4 w;
#pragma unroll
      for (int q = 0; q < 4; ++q) { const f32x4 x = a[h][2 * q] * scale, y = a[h][2 * q + 1] * scale;
        unsigned p = __builtin_amdgcn_cvt_scalef32_pk_fp4_f32(0u, x[0], x[1], 1.0f, 0); p = __builtin_amdgcn_cvt_scalef32_pk_fp4_f32(p, x[2], x[3], 1.0f, 1);
        p = __builtin_amdgcn_cvt_scalef32_pk_fp4_f32(p, y[0], y[1], 1.0f, 2); p = __builtin_amdgcn_cvt_scalef32_pk_fp4_f32(p, y[2], y[3], 1.0f, 3); w[q] = p; }
      const size_t e = i >> 6, c16 = i & 63;
      *reinterpret_cast<u32x4*>(dst + (c16 >> 3) * ((size_t)NEXP * 128) + e * 128 + (c16 & 7) * 16) = w; } }
  }
}
__device__ __forceinline__ void peer_tables_share(const float* __restrict__ u, const float* __restrict__ v, unsigned char* __restrict__ U4, unsigned char* __restrict__ V4, int bx, int G) {
  int t = my_tid(); asm volatile("" : "+v"(t));
  const size_t gtid = (size_t)bx * 512 + t, gsz = (size_t)G * 512;
  cvt_stream_fp4(u, U4, (size_t)NEXP * DM / 32, U_SCALE, gtid, gsz);
  cvt_stream_fp4(v, V4, (size_t)NEXP * DM / 32, V_SCALE, gtid, gsz);
}

#define XB_TMO      128
#define XB_XCNT(j)  (256  + 64 * (j))
#define XB_XSUB(j)  (1280 + 64 * (j))
#define XB_XGEN(j)  (2304 + 64 * (j))
#define XB_TOP      3328
#define XB_TOPGEN   3392
#define XCD_BAR_WORDS 3456
#define XB_SPIN_CAP (1u << 18)

__device__ __forceinline__ unsigned xb_ld(unsigned* p)              { return __hip_atomic_load(p, __ATOMIC_RELAXED, __HIP_MEMORY_SCOPE_AGENT); }
__device__ __forceinline__ unsigned xb_add(unsigned* p, unsigned v) { return __hip_atomic_fetch_add(p, v, __ATOMIC_RELAXED, __HIP_MEMORY_SCOPE_AGENT); }
__device__ __forceinline__ unsigned xb_xcc_id() { return (unsigned)__builtin_amdgcn_s_getreg((3 << 11) | 20) & 0xFu; }
#define XB_SPIN(cond, bar) do { unsigned _sp = 0; while (cond) { __builtin_amdgcn_s_sleep(1); \
    if ((++_sp & 255u) == 0u) { if (xb_ld(&(bar)[XB_TMO])) break; if (_sp > XB_SPIN_CAP) { atomicAdd(&(bar)[XB_TMO], 1u); break; } } } } while (0)

struct XcdBarrier {
    unsigned* bar; unsigned x;
    volatile LAS unsigned* st;
};

__device__ __forceinline__ XcdBarrier xcd_barrier_post(unsigned* bar, volatile LAS unsigned* st) {
    XcdBarrier b; b.bar = bar; b.x = xb_xcc_id(); b.st = st;
    if (threadIdx.x == 0) (void)xb_add(&bar[XB_XCNT(b.x)], 1u);
    return b;
}
__device__ __forceinline__ void xcd_barrier_complete(unsigned* bar, unsigned x, unsigned& nloc, unsigned& nx) {
    const unsigned G = gridDim.x * gridDim.y * gridDim.z;
    unsigned sum, cnt, mine, sp = 0u;
    for (;;) {
        sum = 0u; cnt = 0u; mine = 0u;
#pragma unroll
        for (unsigned j = 0; j < 16; ++j) { const unsigned c = xb_ld(&bar[XB_XCNT(j)]); sum += c; cnt += (c > 0u) ? 1u : 0u; mine = (j == x) ? c : mine; }
        if (sum == G) break;
        __builtin_amdgcn_s_sleep(1);
        if ((++sp & 255u) == 0u) { if (xb_ld(&bar[XB_TMO])) break; if (sp > XB_SPIN_CAP) { atomicAdd(&bar[XB_TMO], 1u); break; } }
    }
    nloc = mine > 0u ? mine : 1u; nx = cnt > 0u ? cnt : 1u;
}

__device__ __forceinline__ void xcd_barrier(const XcdBarrier& b) {
    asm volatile("s_waitcnt vmcnt(0)" ::: "memory");
    __syncthreads();
    if (my_tid() == 0) {
        unsigned* bar = b.bar;
        __builtin_amdgcn_s_waitcnt(0);
        unsigned nloc = b.st[0], nx = b.st[1];
        if (nloc == 0u) { xcd_barrier_complete(bar, b.x, nloc, nx); b.st[0] = nloc; b.st[1] = nx; }
        const unsigned old = xb_add(&bar[XB_XSUB(b.x)], 1u);
        const unsigned gen = old / nloc;
        if (old + 1u == (gen + 1u) * nloc) {
            __builtin_amdgcn_fence(__ATOMIC_RELEASE, "agent");
            asm volatile("s_waitcnt vmcnt(0)" ::: "memory");
            const unsigned og = xb_add(&bar[XB_TOP], 1u);
            const unsigned tg = og / nx;
            if (og + 1u == (tg + 1u) * nx) xb_add(&bar[XB_TOPGEN], 1u);
            else XB_SPIN(xb_ld(&bar[XB_TOPGEN]) == tg, bar);
            __builtin_amdgcn_fence(__ATOMIC_ACQUIRE, "agent");
            asm volatile("s_waitcnt vmcnt(0)" ::: "memory");
        } else {
            XB_SPIN(xb_ld(&bar[XB_TOPGEN]) == gen, bar);
            __builtin_amdgcn_fence(__ATOMIC_ACQUIRE, "agent");
            asm volatile("s_waitcnt vmcnt(0)" ::: "memory");
        }
    }
    __syncthreads();
}


__device__ __forceinline__ void flat_barrier(unsigned* bar) {
    asm volatile("s_waitcnt vmcnt(0)" ::: "memory");
    __syncthreads();
    if (threadIdx.x == 0) {
        const unsigned G = gridDim.x;
        __builtin_amdgcn_fence(__ATOMIC_RELEASE, "agent");
        asm volatile("s_waitcnt vmcnt(0)" ::: "memory");
        const unsigned old = xb_add(&bar[XB_TOP], 1u);
        const unsigned target = (old / G + 1u) * G;
        XB_SPIN(xb_ld(&bar[XB_TOP]) < target, bar);
        __builtin_amdgcn_fence(__ATOMIC_ACQUIRE, "agent");
        asm volatile("s_waitcnt vmcnt(0)" ::: "memory");
    }
    __syncthreads();
}
struct Args {
  const float* in[17];
  float* out; unsigned char* ws; int ph_lo, ph_hi;
};
constexpr int N_PHASES = 12;

__global__ void __launch_bounds__(512, 2) mega_fwd(Args args) {
  extern __shared__ __attribute__((aligned(16))) unsigned char lds_raw[];
  LAS unsigned char* ldsl = (LAS unsigned char*)lds_raw;
  char* lds = (char*)lds_raw;
  { const int t0_ = threadIdx.x; if ((t0_ & 63) == 0) ((volatile unsigned char*)lds_raw)[HWTAB_OFF + hw_slot()] = (unsigned char)(t0_ >> 6); }
  __syncthreads();
  const int wave = my_wave();
#define lane (my_lane())
#define tid (wave * 64 + my_lane())
  const int G = gridDim.x, bx = blockIdx.x;
  unsigned char* ws = args.ws;
  const float* x = args.in[0];
  bf16* XB = (bf16*)(ws + WS_XB); unsigned char* ATT = ws + WS_X1F8; bf16* PQ = XB;
  bf16* PROJ = (bf16*)(ws + WS_PROJ); bf16* ZB = (bf16*)(ws + WS_PROJ); bf16* YB = (bf16*)(ws + WS_PROJ + 128 * MiB);
  int* EIDX = (int*)(ws + WS_EIDX); float* EG = (float*)(ws + WS_EG);
  bf16* X1B = (bf16*)(ws + WS_X1B); unsigned char* U8 = ws + WS_U8; unsigned char* V8 = ws + WS_V8; unsigned char* V4C = ws + WS_V4C; unsigned char* XB8 = ws + WS_X1F8; unsigned char* WIN8 = ws + WS_WIN; constexpr int N_F8 = C_SK;     unsigned* EIDP = (unsigned*)(ws + WS_EIDP);
  unsigned char* A8 = ws + WS_A8; unsigned* ctl = (unsigned*)(ws + WS_CTL); unsigned char* X1F8 = ws + WS_X1F8;
  bf16* WIN = (bf16*)(ws + WS_WIN); unsigned char* WO = ws + WS_WO; bf16* WQ = (bf16*)(ws + WS_WQ);
  const int lo = args.ph_lo, hi_ph = args.ph_hi;
#if MK_ONE_LAUNCH
  volatile LAS unsigned* misc = (volatile LAS unsigned*)(ldsl + LDS_BYTES - 64);
  XcdBarrier xbar; xbar.bar = ctl; xbar.x = xb_xcc_id(); xbar.st = misc + 2;
  if (tid == 0) { misc[2] = 0u; misc[3] = 0u; misc[0] = xb_add(&ctl[XB_XCNT(xbar.x)], 1u); }
  __syncthreads();
  const int my_xcc = (int)xbar.x, my_rank = __builtin_amdgcn_readfirstlane((int)misc[0]);
#endif
#if MK_ONE_LAUNCH
#define GRID_SYNC() xcd_barrier(xbar)
#else
#define GRID_SYNC() do {} while (0)
#endif
#ifndef PH_MASK
#define PH_MASK 0xfff
#endif
#ifndef REP_MASK
#define REP_MASK 0
#endif
#define IN(k) (((PH_MASK >> (k)) & 1) && lo <= (k) && (k) < hi_ph)
#define REP(k)
#define SEAM(k) do { if (IN(k) && IN((k) + 1)) GRID_SYNC(); } while (0)

  REP(0) if (IN(0)) {
    const size_t gtid = (size_t)bx * 512 + tid, gsz = (size_t)G * 512;
    cvt_stream2(x, XB, XB8, (size_t)NTOK * DM / 8, gtid, gsz);
    LAS float* scr = (LAS float*)(ldsl + wave * 8704);
    const int gw = bx * 8 + wave, NGW = G * 8;
    constexpr int I_IN = (DM / 64) * (LDP / 32), I_SQ = (DM / 64) * (DM / 32);
    for (int it = gw; it < I_IN + 2 * I_SQ; it += NGW) {
      if (it < I_IN) { const int kb = it / (LDP / 32), nb = it % (LDP / 32);
        if (nb < N_F8 / 32) transpose_item_fp8(args.in[1], DM, NPROJ, WIN8, scr, kb, nb, lane, 64.f);
        else transpose_item(args.in[1], DM, NPROJ, WIN, scr, kb, nb, lane); }
      else if (it < I_IN + I_SQ) { const int r = it - I_IN; transpose_item_fp8(args.in[2], DM, DM, WO, scr, r / (DM / 32), r % (DM / 32), lane, 64.f); }
      else { const int r = it - I_IN - I_SQ; transpose_item(args.in[10], DM, DM, WQ, scr, r / (DM / 32), r % (DM / 32), lane); }
    }
    __syncthreads();
  }
  SEAM(0);
  int vx = bx & 7, vrank = bx >> 3; const int nloc = G >> 3;
#if MK_ONE_LAUNCH
  {
    int npop = 0, before = 0; bool regular = true;
#pragma unroll
    for (int q = 0; q < 16; ++q) { const int cq = (int)__hip_atomic_load(ctl + XB_XCNT(q), __ATOMIC_RELAXED, __HIP_MEMORY_SCOPE_AGENT); if (cq > 0) { ++npop; if (q < my_xcc) ++before; if (cq != nloc) regular = false; } }
    if (regular && npop == 8 && (G & 7) == 0) { vx = before; vrank = my_rank; }
  }
#endif
  const int vcu = vrank * 8 + vx;
  REP(1) if (IN(1)) {
    { pg8::Gemm g{(const pg8::bf16_t*)XB8, (const pg8::bf16_t*)WIN8, NTOK, N_F8, DM}; pg8::StaticOrder S; S.init(NTOK, N_F8, G, vcu);
      pg8::EpiBf16<0> E{PROJ, LDP, nullptr, N_F8, 0, 1.0f / 64.0f};
      pg8::gemm_phase<pg8::EpiBf16<0>, pg8::StaticOrder, true, true, true, 0x7F7F7F7F>(ldsl, g, S, E); }
    __syncthreads();
    { pg8::Gemm g{XB, WIN + (size_t)N_F8 * DM, NTOK, LDP - N_F8, DM}; pg8::StaticOrder S; S.init(NTOK, LDP - N_F8, G, vcu);
      pg8::EpiBf16<0> E{PROJ + N_F8, LDP, nullptr, 0, 0, 1.f};
      pg8::gemm_phase<pg8::EpiBf16<0>, pg8::StaticOrder, true, true>(ldsl, g, S, E); }
    __syncthreads();
  }
  SEAM(1);
  const int cslot = (G * 8 >= 2048) ? (bx & 7) : 0;
  REP(2) if (IN(2)) {
    float lam;
    { const float a = args.in[3][lane] * args.in[4][lane], b = args.in[5][lane] * args.in[6][lane];
      lam = __expf(wave_sum(a)) - __expf(wave_sum(b)) + LAM_INIT; }
    for (int rnd = 0; rnd * G < 1024; ++rnd) {
      const int i = rnd * G + ((rnd & 1) ? (G - 1 - bx) : bx);
      if (i < 1024) { const int qb = 63 - (i >> 4), b = i & 15; att::attn_unit<1>(PROJ, ATT, b, 0, qb, lds, lam, args.in[7]); }
    }
  }
  REP(3) if (IN(3)) {
    float lam;
    { const float a = args.in[3][lane] * args.in[4][lane], b = args.in[5][lane] * args.in[6][lane];
      lam = __expf(wave_sum(a)) - __expf(wave_sum(b)) + LAM_INIT; }
    for (int rnd = 0; rnd * G < 2048; ++rnd) {
      if (rnd == cslot) peer_tables_share(args.in[13], args.in[14], U8, V8, bx, G);
      const int j = rnd * G + ((rnd & 1) ? (G - 1 - bx) : bx);
      if (j < 2048) { const int qb = 15 - (j >> 7), bh = j & 127; att::attn_unit<0>(PROJ, ATT, bh >> 3, (bh + rnd) & 7, qb, lds, lam, args.in[7]); }
    }
  }
  SEAM(3);
  REP(4) if (IN(4)) {
    pg8::Gemm g{(const pg8::bf16_t*)ATT, (const pg8::bf16_t*)WO, NTOK, DM, DM}; pg8::StaticOrder S; S.init(NTOK, DM, G, vcu);
    pg8::EpiResid E{(const pg8::bf16_t*)XB, ZB, DM, ALPHA, 1.0f / 64.0f};
    pg8::gemm_phase<pg8::EpiResid, pg8::StaticOrder, true, true, true, 0x7F7F7F7F>(ldsl, g, S, E);
    __syncthreads();
  }
  SEAM(4);
  REP(5) if (IN(5)) {
    const int gw = bx * 8 + wave, NGW = G * 8;
    ln1_phase(ZB, args.in[8], args.in[9], X1B, X1F8, gw, NGW, lane);
  }
  SEAM(5);
  REP(6) if (IN(6)) {
    pg8::Gemm g{X1B, WQ, NTOK, DM, DM}; pg8::StaticOrder S; S.init(NTOK, DM, G, vcu);
    pg8::EpiBf16<0> E{PQ, DM, nullptr, 0, 0, 1.f};
    pg8::gemm_phase<pg8::EpiBf16<0>, pg8::StaticOrder, true, true>(ldsl, g, S, E);
    __syncthreads();
  }
  SEAM(6);
  REP(7) if (IN(7)) {
    peer::load_keys(args.in[11], args.in[12], lds);
    __syncthreads();
    for (int u = bx; u < NTOK / 32; u += G) peer::score_unit(PQ, EIDX, EG, u * 32, lds);
    __syncthreads();
  }
  SEAM(7);
  float* HPA = (float*)(ws + WS_HPA);
  REP(8) if (IN(8)) {
    const int wv = vrank * 8 + wave, nwv = nloc * 8;
    peer_u_pass(X1F8, U8, EIDX, HPA + (size_t)vx * NTOK * 128, lds + wave * 16384, wv, nwv, NTOK / nwv, vx, lane);
  }
  SEAM(8);
  REP(9) if (IN(9)) {
    const size_t gtid = (size_t)bx * 512 + tid, gsz = (size_t)G * 512;
    for (size_t i = gtid; i < (size_t)NTOK * 32; i += gsz) {
      f32x4 h = *reinterpret_cast<const f32x4*>(HPA + i * 4);
#pragma unroll
      for (int sl = 1; sl < NSLICE; ++sl) h += *reinterpret_cast<const f32x4*>(HPA + (size_t)sl * NTOK * 128 + i * 4);
      const f32x4 gg = *reinterpret_cast<const f32x4*>(EG + i * 4); float a[4];
#pragma unroll
      for (int e = 0; e < 4; ++e) { const float hv = h[e] * (1.0f / U_SCALE); a[e] = 0.5f * hv * (1.0f + erff(hv * 0.70710678118654752f)) * gg[e] * 64.0f; }
      int p = __builtin_amdgcn_cvt_pk_fp8_f32(a[0], a[1], 0, false); p = __builtin_amdgcn_cvt_pk_fp8_f32(a[2], a[3], p, true);
      *reinterpret_cast<int*>(A8 + i * 4) = p;
    }
    for (int it = bx * 8 + wave; it < NTOK / 4; it += G * 8) eidp_item(EIDX, EIDP, it, lane);
    for (int it = bx * 8 + wave; it < 8 * (NEXP / 64); it += G * 8) v4c_relayout_item(V8, V4C, it / (NEXP / 64), it % (NEXP / 64), lane);
  }
  SEAM(9);
  REP(10) if (IN(10)) {
    for (int u = ((G & 7) == 0) ? vx * nloc + vrank : bx; u < 256; u += G) peer_v_pass2(A8, V4C, EIDP, YB, lds, u >> 1, (u & 1) * (NTOK / 2), NTOK / 2, wave, lane);
  }
  SEAM(10);
  REP(11) if (IN(11)) {
    const int gw = bx * 8 + wave, NGW = G * 8;
    ln2_phase(X1B, YB, args.in[15], args.in[16], args.out, gw, NGW, lane);
  }
#undef IN
#undef SEAM
#undef lane
#undef tid
}

#ifndef REP_MASK
#define REP_MASK 0
#endif
extern "C" void kernel_launch(void* const* d_in, const int* in_sizes, int n_in, void* d_out, int out_size, void* d_ws, size_t ws_size, hipStream_t stream) {
  static int grid = 0;
  if (grid == 0) {
    if (n_in != 17 || in_sizes[0] != NTOK * DM || out_size != NTOK * DM || ws_size < WS_END) {
      fprintf(stderr, "kernel_launch: unexpected shapes: n_in %d in0 %d out %d ws %zu (need >= %zu)\n", n_in, n_in > 0 ? in_sizes[0] : -1, out_size, ws_size, (size_t)WS_END); grid = -1; return; }
    int dev = 0, cus = 0, per_cu = 0;
    if (hipGetDevice(&dev) != hipSuccess || hipDeviceGetAttribute(&cus, hipDeviceAttributeMultiprocessorCount, dev) != hipSuccess) { grid = -1; return; }
    if (hipFuncSetAttribute((const void*)mega_fwd, hipFuncAttributeMaxDynamicSharedMemorySize, LDS_BYTES) != hipSuccess) { fprintf(stderr, "kernel_launch: hipFuncSetAttribute failed\n"); grid = -1; return; }
    if (hipOccupancyMaxActiveBlocksPerMultiprocessor(&per_cu, (const void*)mega_fwd, 512, LDS_BYTES) != hipSuccess || per_cu < 1) { fprintf(stderr, "kernel_launch: occupancy query says %d\n", per_cu); per_cu = 1; }
    (void)hipGetLastError();
    grid = cus * (per_cu > 1 ? 1 : per_cu);
  }
  if (grid < 0) return;
  Args a{};
  for (int i = 0; i < 17; ++i) a.in[i] = (const float*)d_in[i];
  a.out = (float*)d_out; a.ws = (unsigned char*)d_ws;
  if (hipMemsetAsync((char*)d_ws + WS_CTL, 0, 16384, stream) != hipSuccess) { fprintf(stderr, "kernel_launch: memset failed\n"); return; }
#if MK_ONE_LAUNCH
  a.ph_lo = 0; a.ph_hi = N_PHASES;
  void* kargs[] = {&a};
  hipError_t e = hipLaunchCooperativeKernel((const void*)mega_fwd, dim3(grid), dim3(512), kargs, LDS_BYTES, stream);
  if (e != hipSuccess) fprintf(stderr, "kernel_launch: cooperative launch failed: %s (grid %d)\n", hipGetErrorString(e), grid);
#else
  for (int p = 0; p < N_PHASES; ++p) {
    a.ph_lo = p; a.ph_hi = p + 1;
    for (int rep = 0; rep < (((REP_MASK >> p) & 1) ? 2 : 1); ++rep)
      hipLaunchKernelGGL(mega_fwd, dim3(grid), dim3(512), LDS_BYTES, stream, a);
  }
  const hipError_t le = hipPeekAtLastError();
  if (le != hipSuccess) fprintf(stderr, "kernel_launch: launch failed: %s\n", hipGetErrorName(le));
#endif
}
```

```cpp
#include <hip/hip_runtime.h>
#include <hip/hip_cooperative_groups.h>
#include <cstdio>
#include <cstdint>
namespace cg = cooperative_groups;

#ifndef MK_ONE_LAUNCH
#define MK_ONE_LAUNCH 1
#endif

constexpr int NB = 16, SEQ = 2048, DM = 2048, NTOK = NB * SEQ;
constexpr int NPROJ = 5456, LDP = 5632;
constexpr int C_DQ = 0, C_DK = 1024, C_DV = 2048, C_SQ = 3072, C_SK = 4096, C_SV = 4224, C_IQ = 4352, C_IK = 5376, C_IW = 5440;
constexpr int NEXP = 16384;
constexpr float LN_EPS = 1e-5f, RMS_EPS = 1e-5f;
constexpr float ALPHA = 1.189207115002721f;
constexpr float LAM_INIT = 0.2f;
constexpr float LOG2E = 1.4426950408889634f;

constexpr size_t MiB = (size_t)1 << 20;
constexpr size_t WS_XB = 0;
constexpr size_t WS_PROJ = 128 * MiB;
constexpr size_t WS_EIDX = 384 * MiB;
constexpr size_t WS_EG = 400 * MiB;
constexpr size_t WS_X1B = 480 * MiB;
constexpr size_t WS_V4C = 416 * MiB;
constexpr size_t WS_EIDP = 432 * MiB;
constexpr size_t WS_CTL = 774 * MiB;
constexpr size_t WS_U8 = 608 * MiB;
constexpr size_t WS_V8 = 640 * MiB;
constexpr size_t WS_HPA = 0;
constexpr size_t WS_X1F8 = 672 * MiB;
constexpr size_t WS_WIN = 736 * MiB;
constexpr size_t WS_WO = 758 * MiB;
constexpr size_t WS_WQ = 766 * MiB;
constexpr size_t WS_A8 = 775 * MiB;
constexpr size_t WS_END = 779 * MiB;

constexpr int LDS_BYTES = 147456;

typedef unsigned short bf16;
#define LAS __attribute__((address_space(3)))


constexpr int HWTAB_OFF = LDS_BYTES - 128;
__device__ __forceinline__ int hw_slot() { return (int)(__builtin_amdgcn_s_getreg((6 << 11) | 4  ) & 63u); }
__device__ __forceinline__ int my_lane() { int r; asm volatile("v_mbcnt_lo_u32_b32 %0, -1, 0\n\tv_mbcnt_hi_u32_b32 %0, -1, %0" : "=v"(r)); return r; }
__device__ __forceinline__ int my_wave() { extern __shared__ __attribute__((aligned(16))) unsigned char lds_raw[]; return __builtin_amdgcn_readfirstlane((int)((volatile unsigned char*)lds_raw)[HWTAB_OFF + hw_slot()]); }
__device__ __forceinline__ int my_tid() { return my_wave() * 64 + my_lane(); }
namespace pg8 {
#define PG8_LAS __attribute__((address_space(3)))
typedef unsigned short bf16_t;
typedef short bf16x8 __attribute__((ext_vector_type(8)));
typedef float f32x4 __attribute__((ext_vector_type(4)));
typedef unsigned u32x4 __attribute__((ext_vector_type(4)));
typedef int v8i_t __attribute__((ext_vector_type(8)));
typedef int i32x4_t __attribute__((ext_vector_type(4)));
__device__ __forceinline__ v8i_t cat8(bf16x8 lo, bf16x8 hi) { return __builtin_shufflevector(__builtin_bit_cast(i32x4_t, lo), __builtin_bit_cast(i32x4_t, hi), 0, 1, 2, 3, 4, 5, 6, 7); }
constexpr int BM = 256, BK = 64, HALF = 128, HTB = HALF * BK * 2  , STAGE_BYTES = 8 * HTB, NXCD = 8, WGM = 8;

__host__ __device__ __forceinline__ int lds_byte(int r, int c) { const int st = (r >> 4) * 2 + (c >> 5), rr = r & 15, cc = c & 31, ob = rr * 64 + cc * 2; return st * 1024 + (ob ^ (((ob >> 9) & 1) << 5)); }
__host__ __device__ __forceinline__ void stage_rc(int b, int& R, int& C) { const int st = b / 1024, sb = b % 1024, swz = sb ^ (((sb >> 9) & 1) << 5); R = (st >> 1) * 16 + swz / 64; C = (st & 1) * 32 + (swz % 64) / 2; }
__host__ __device__ __forceinline__ int perm32(int rho) { const int n = rho >> 4, i = rho & 15; return 8 * (i >> 2) + 4 * n + (i & 3); }

struct Unit { int pm, pn; };
struct Gemm { const bf16_t* A; const bf16_t* Bt; int M, N, K; };

struct StaticOrder {
    int nM, nN, nwg, G, c;
    __host__ __device__ void init(int M, int N, int G_, int c_) { nM = M / BM; nN = N / BM; nwg = nM * nN; G = G_; c = c_; }
    __host__ __device__ bool next(int i, Unit& u) const {
        const long L = (long)i * G + c; if (L >= nwg) return false;
        int wgid = (int)L; { const int q = nwg / NXCD, r = nwg % NXCD, xcd = wgid % NXCD, off = wgid / NXCD; wgid = (xcd < r ? xcd * (q + 1) : r * (q + 1) + (xcd - r) * q) + off; }
        const int nig = WGM * nN, gid = wgid / nig, fm = gid * WGM, gsz = (nM - fm) < WGM ? (nM - fm) : WGM;
        u.pm = fm + ((wgid % nig) % gsz); u.pn = (wgid % nig) / gsz; return true;
    }
    __device__ __forceinline__ void a_ready(const Unit&) const {}
    __device__ __forceinline__ void done(const Unit&) const {}
};
__device__ __forceinline__ unsigned cvt_pk_bf16(float lo, float hi) { unsigned r; asm volatile("v_cvt_pk_bf16_f32 %0, %1, %2" : "=v"(r) : "v"(lo), "v"(hi)); return r; }
typedef float f32x2 __attribute__((ext_vector_type(2)));
__device__ __forceinline__ f32x2 gelu_pk(f32x2 v) {
    const f32x2 av = __builtin_elementwise_abs(v), d = av * 0.2316418882f + 1.0f;
    f32x2 t; t.x = __builtin_amdgcn_rcpf(d.x); t.y = __builtin_amdgcn_rcpf(d.y);
    f32x2 q = t * 0.5307027145f + (-0.7265760135f); q = q * t + 0.7107068705f; q = q * t + (-0.142248368f); q = q * t + 0.127414796f; q = q * t;
    const f32x2 s = (v * v) * (-0.72134752044f);
    f32x2 e; e.x = __builtin_amdgcn_exp2f(s.x); e.y = __builtin_amdgcn_exp2f(s.y);
    const f32x2 m = v * (q * e), r = v - m;
    f32x2 o; o.x = v.x < 0.f ? m.x : r.x; o.y = v.y < 0.f ? m.y : r.y; return o;
}

template <int ACT  > struct EpiBf16 {
    static constexpr bool PERM = true, AFTER_DRAIN = false; static_assert(ACT == 0 || ACT == 1, "EpiBf16: ACT is 0 (none) or 1 (gelu_pk)");
    bf16_t* O; int ldc; const float* bias; int split_cols; size_t split_stride; float scale0;
    __device__ __forceinline__ void operator()(const f32x4 (&acc)[2][2][4][2], const Unit& u, int wr, int wc, int fr, int fq) const {
        const int row0 = u.pm * BM + wr * 64 + fr; int colt = u.pn * BM; bf16_t* base = O;
        float sc = 1.f; if (split_cols) { const int t = colt / split_cols; base += (size_t)t * split_stride; colt -= t * split_cols; if (t == 0) sc = scale0; }
        const int col0 = colt + wc * 32 + 8 * fq, bcol0 = u.pn * BM + wc * 32 + 8 * fq;
        f32x4 bv[2][2];
#pragma unroll
        for (int bj = 0; bj < 2; ++bj)
#pragma unroll
            for (int n = 0; n < 2; ++n) bv[bj][n] = bias ? *(const f32x4*)(bias + bcol0 + bj * HALF + 4 * n) : (f32x4){0.f, 0.f, 0.f, 0.f};
#pragma unroll
        for (int ai = 0; ai < 2; ++ai)
#pragma unroll
            for (int m = 0; m < 4; ++m) { bf16_t* rowp = base + (size_t)(row0 + ai * HALF + m * 16) * ldc + col0;
#pragma unroll
                for (int bj = 0; bj < 2; ++bj) { f32x4 v0 = acc[ai][bj][m][0] + bv[bj][0], v1 = acc[ai][bj][m][1] + bv[bj][1];
                    if (ACT == 1) { f32x2 a = gelu_pk((f32x2){v0[0], v0[1]}), b = gelu_pk((f32x2){v0[2], v0[3]}), c = gelu_pk((f32x2){v1[0], v1[1]}), d = gelu_pk((f32x2){v1[2], v1[3]});
                        v0 = (f32x4){a.x, a.y, b.x, b.y}; v1 = (f32x4){c.x, c.y, d.x, d.y}; }
                    v0 = v0 * sc; v1 = v1 * sc; u32x4 w; w.x = cvt_pk_bf16(v0[0], v0[1]); w.y = cvt_pk_bf16(v0[2], v0[3]); w.z = cvt_pk_bf16(v1[0], v1[1]); w.w = cvt_pk_bf16(v1[2], v1[3]);
                    *(u32x4*)(rowp + bj * HALF) = w; } }
    }
};
struct EpiResid {
    static constexpr bool PERM = true, AFTER_DRAIN = false;
    const bf16_t* X; bf16_t* Z; int ldc; float alpha; float accscale;
    __device__ __forceinline__ void operator()(const f32x4 (&acc)[2][2][4][2], const Unit& u, int wr_, int wc_, int fr_, int fq_) const {
        int t = my_lane(); asm volatile("" : "+v"(t));
        const int wv = my_wave(), wr = wv >> 2, wc = wv & 3, fr = t & 15, fq = t >> 4; (void)wr_; (void)wc_; (void)fr_; (void)fq_;
        const int row0 = u.pm * BM + wr * 64 + fr, col0 = u.pn * BM + wc * 32 + 8 * fq;
#pragma unroll
        for (int ai = 0; ai < 2; ++ai)
#pragma unroll
            for (int m = 0; m < 4; ++m) { const unsigned off = (unsigned)(row0 + ai * HALF + m * 16) * (unsigned)ldc + (unsigned)col0;
#pragma unroll
                for (int bj = 0; bj < 2; ++bj) { const u32x4 xw = *(const u32x4*)(X + off + bj * HALF);
                    const f32x4 x0 = {__uint_as_float(xw.x << 16), __uint_as_float(xw.x & 0xffff0000u), __uint_as_float(xw.y << 16), __uint_as_float(xw.y & 0xffff0000u)};
                    const f32x4 x1 = {__uint_as_float(xw.z << 16), __uint_as_float(xw.z & 0xffff0000u), __uint_as_float(xw.w << 16), __uint_as_float(xw.w & 0xffff0000u)};
                    const f32x4 v0 = x0 * alpha + acc[ai][bj][m][0] * accscale, v1 = x1 * alpha + acc[ai][bj][m][1] * accscale;
                    u32x4 w; w.x = cvt_pk_bf16(v0[0], v0[1]); w.y = cvt_pk_bf16(v0[2], v0[3]); w.z = cvt_pk_bf16(v1[0], v1[1]); w.w = cvt_pk_bf16(v1[2], v1[3]);
                    *(u32x4*)(Z + off + bj * HALF) = w; }
                asm volatile("" ::: "memory"); }
    }
};

template <class Epi, class Sched, bool ALIGN_EPI = false, bool SP2 = false, bool FP8 = false, int SCALE_B = 0x7F7F7F7F>
__device__ __forceinline__ void gemm_phase(PG8_LAS unsigned char* lds, const Gemm g, const Sched& S, const Epi& E) {
    const int tid = my_tid(), wid = __builtin_amdgcn_readfirstlane(tid >> 6), lane = tid & 63, wr = wid >> 2, wc = wid & 3, fr = lane & 15, fq = lane >> 4;
    const int K = g.K, nt = FP8 ? K / 128 : K / BK;
    unsigned voffA[2], voffB[2];
#pragma unroll
    for (int i = 0; i < 2; ++i) { int R, C; stage_rc(tid * 16 + i * 8192, R, C); const int Rb = Epi::PERM ? ((R & ~31) + perm32(R & 31)) : R;
        voffA[i] = FP8 ? (unsigned)(R * K + C * 2) : (unsigned)(R * K + C) * 2u; voffB[i] = FP8 ? (unsigned)(Rb * K + C * 2) : (unsigned)(Rb * K + C) * 2u; }
    const unsigned kstep = (unsigned)(BK * 2);
    const unsigned hstep = (unsigned)HALF * (unsigned)K * (FP8 ? 1u : 2u);
    const unsigned tstep = 2u * hstep;
    const unsigned ldsw = (unsigned)wid * 1024u;
    const int aoff = lds_byte(wr * 64 + fr, fq * 8), boff = lds_byte(wc * 32 + fr, fq * 8);
#define PG8_SA(b, h) (((b) * 2 + (h)) * HTB)
#define PG8_SB(b, h) ((4 + (b) * 2 + (h)) * HTB)
    const __amdgpu_buffer_rsrc_t rsrc_voffA = __builtin_amdgcn_make_buffer_rsrc((void*)g.A, (short)0, -1, 0x00020000), rsrc_voffB = __builtin_amdgcn_make_buffer_rsrc((void*)g.Bt, (short)0, -1, 0x00020000);
    const char* const base_voffA = (const char*)g.A; const char* const base_voffB = (const char*)g.Bt;
#define PG8_STAGE(bufoff, goff, voff) do { _Pragma("unroll") for (int _i = 0; _i < 2; ++_i) { \
        if constexpr (FP8) __builtin_amdgcn_raw_ptr_buffer_load_lds(rsrc_##voff, (PG8_LAS void*)(lds + (bufoff) + ldsw + _i * 8192), 16, (int)(voff)[_i], (int)(goff), 0, 0); \
        else __builtin_amdgcn_global_load_lds((const unsigned*)(base_##voff + (size_t)(goff) + (voff)[_i]), (PG8_LAS unsigned*)(lds + (bufoff) + ldsw + _i * 8192), 16, 0, 0); } } while (0)
#define PG8_LDA(dst, b, h) do { _Pragma("unroll") for (int m = 0; m < 4; ++m) _Pragma("unroll") for (int k = 0; k < 2; ++k) dst[m][k] = *(const PG8_LAS bf16x8*)(lds + PG8_SA(b, h) + aoff + m * 2048 + k * 1024); } while (0)
#define PG8_LDB(dst, b, h) do { _Pragma("unroll") for (int n = 0; n < 2; ++n) _Pragma("unroll") for (int k = 0; k < 2; ++k) dst[n][k] = *(const PG8_LAS bf16x8*)(lds + PG8_SB(b, h) + boff + n * 2048 + k * 1024); } while (0)
#define PG8_MMA(ai, bj, At, Bt) do { __builtin_amdgcn_s_setprio(1); _Pragma("unroll") for (int m = 0; m < 4; ++m) _Pragma("unroll") for (int n = 0; n < 2; ++n) { \
        if constexpr (FP8) acc[ai][bj][m][n] = __builtin_amdgcn_mfma_scale_f32_16x16x128_f8f6f4(cat8(Bt[n][0], Bt[n][1]), cat8(At[m][0], At[m][1]), acc[ai][bj][m][n], 0, 0, 0, SCALE_B, 0, 0x7F7F7F7F); \
        else { _Pragma("unroll") for (int k = 0; k < 2; ++k) acc[ai][bj][m][n] = __builtin_amdgcn_mfma_f32_16x16x32_bf16(Bt[n][k], At[m][k], acc[ai][bj][m][n], 0, 0, 0); } } \
        __builtin_amdgcn_s_setprio(0); } while (0)
#define PG8_WAIT_V(n) asm volatile("s_waitcnt vmcnt(" #n ")" ::: "memory")
#define PG8_WAIT_L(n) asm volatile("s_waitcnt lgkmcnt(" #n ")" ::: "memory")
#define PG8_BAR __builtin_amdgcn_s_barrier()
#define PG8_SCHED __builtin_amdgcn_sched_barrier(0)
    Unit cur, nxt; int ui = 0;
    if (!S.next(0, cur)) return;
    f32x4 acc[2][2][4][2];
#pragma unroll
    for (int a = 0; a < 2; ++a)
#pragma unroll
        for (int b = 0; b < 2; ++b)
#pragma unroll
            for (int m = 0; m < 4; ++m)
#pragma unroll
                for (int n = 0; n < 2; ++n) acc[a][b][m][n] = (f32x4){0.f, 0.f, 0.f, 0.f};
    bf16x8 At[4][2], B0[2][2], B1[2][2];
    unsigned cA = (unsigned)cur.pm * tstep, cB = (unsigned)cur.pn * tstep;
    S.a_ready(cur);
    if constexpr (SP2) {
        PG8_STAGE(PG8_SB(0, 0), cB, voffB); PG8_STAGE(PG8_SB(0, 1), cB + hstep, voffB); PG8_STAGE(PG8_SA(0, 0), cA, voffA); PG8_STAGE(PG8_SA(0, 1), cA + hstep, voffA);
        if (wr == 1) PG8_BAR;
        PG8_WAIT_V(2); PG8_BAR;
        PG8_STAGE(PG8_SB(1, 0), cB + kstep, voffB); PG8_STAGE(PG8_SA(1, 0), cA + kstep, voffA); PG8_STAGE(PG8_SB(1, 1), cB + hstep + kstep, voffB);
        PG8_WAIT_V(6); PG8_BAR;
    } else {
        PG8_STAGE(PG8_SB(0, 0), cB, voffB); PG8_STAGE(PG8_SA(0, 0), cA, voffA); PG8_STAGE(PG8_SB(0, 1), cB + hstep, voffB); PG8_STAGE(PG8_SA(0, 1), cA + hstep, voffA);
        if (wr == 1) PG8_BAR;
        PG8_WAIT_V(4); PG8_BAR;
        PG8_STAGE(PG8_SB(1, 0), cB + kstep, voffB); PG8_STAGE(PG8_SA(1, 0), cA + kstep, voffA); PG8_STAGE(PG8_SB(1, 1), cB + hstep + kstep, voffB);
        PG8_WAIT_V(6); PG8_BAR;
    }
    for (;;) {
        const bool has_next = S.next(ui + 1, nxt);
        const unsigned nA = has_next ? (unsigned)nxt.pm * tstep : cA, nB = has_next ? (unsigned)nxt.pn * tstep : cB;
        for (int t = 0; t < nt; t += 2) {
            const bool last = (t == nt - 2);
            const unsigned a1 = cA + (unsigned)(t + 1) * kstep;
            const unsigned a2 = last ? nA : cA + (unsigned)(t + 2) * kstep, b2 = last ? nB : cB + (unsigned)(t + 2) * kstep;
            const unsigned a3 = a2 + kstep, b3 = b2 + kstep;
            if (last && has_next) S.a_ready(nxt);
            if constexpr (SP2) {
            PG8_LDB(B0, 0, 0); PG8_LDB(B1, 0, 1); PG8_SCHED; PG8_LDA(At, 0, 0); PG8_STAGE(PG8_SA(1, 1), a1 + hstep, voffA);
            PG8_WAIT_V(8); PG8_WAIT_L(0); PG8_BAR; PG8_MMA(0, 0, At, B0); PG8_MMA(0, 1, At, B1); PG8_BAR; PG8_SCHED;
            PG8_LDA(At, 0, 1); PG8_STAGE(PG8_SB(0, 0), b2, voffB); PG8_STAGE(PG8_SB(0, 1), b2 + hstep, voffB); PG8_STAGE(PG8_SA(0, 0), a2, voffA);
            PG8_WAIT_V(8); PG8_WAIT_L(0); PG8_BAR; PG8_MMA(1, 0, At, B0); PG8_MMA(1, 1, At, B1); PG8_BAR; PG8_SCHED;
            PG8_LDB(B0, 1, 0); PG8_LDB(B1, 1, 1); PG8_SCHED; PG8_LDA(At, 1, 0); PG8_STAGE(PG8_SA(0, 1), a2 + hstep, voffA);
            PG8_WAIT_V(8); PG8_WAIT_L(0); PG8_BAR; PG8_MMA(0, 0, At, B0); PG8_MMA(0, 1, At, B1); PG8_BAR; PG8_SCHED;
            PG8_LDA(At, 1, 1); PG8_STAGE(PG8_SB(1, 0), b3, voffB); PG8_STAGE(PG8_SB(1, 1), b3 + hstep, voffB); PG8_STAGE(PG8_SA(1, 0), a3, voffA);
            PG8_WAIT_V(8); PG8_WAIT_L(0); PG8_BAR; PG8_MMA(1, 0, At, B0); PG8_MMA(1, 1, At, B1); PG8_BAR; PG8_SCHED;
            } else {
            PG8_LDB(B0, 0, 0); PG8_SCHED; PG8_LDA(At, 0, 0); PG8_STAGE(PG8_SA(1, 1), a1 + hstep, voffA);
            PG8_WAIT_L(8); PG8_BAR; PG8_WAIT_L(0); PG8_MMA(0, 0, At, B0); PG8_BAR; PG8_SCHED;
            PG8_LDB(B1, 0, 1); PG8_STAGE(PG8_SB(0, 0), b2, voffB);
            PG8_BAR; PG8_WAIT_L(0); PG8_MMA(0, 1, At, B1); PG8_BAR;
            PG8_LDA(At, 0, 1); PG8_STAGE(PG8_SA(0, 0), a2, voffA);
            PG8_BAR; PG8_WAIT_L(0); PG8_MMA(1, 0, At, B0); PG8_BAR; PG8_SCHED;
            PG8_STAGE(PG8_SB(0, 1), b2 + hstep, voffB);
            PG8_WAIT_V(6); PG8_BAR; PG8_MMA(1, 1, At, B1); PG8_BAR;
            PG8_LDB(B0, 1, 0); PG8_SCHED; PG8_LDA(At, 1, 0); PG8_STAGE(PG8_SA(0, 1), a2 + hstep, voffA);
            PG8_WAIT_L(8); PG8_BAR; PG8_WAIT_L(0); PG8_MMA(0, 0, At, B0); PG8_BAR; PG8_SCHED;
            PG8_LDB(B1, 1, 1); PG8_STAGE(PG8_SB(1, 0), b3, voffB);
            PG8_BAR; PG8_WAIT_L(0); PG8_MMA(0, 1, At, B1); PG8_BAR;
            PG8_LDA(At, 1, 1); PG8_STAGE(PG8_SA(1, 0), a3, voffA);
            PG8_BAR; PG8_WAIT_L(0); PG8_MMA(1, 0, At, B0); PG8_BAR; PG8_SCHED;
            PG8_STAGE(PG8_SB(1, 1), b3 + hstep, voffB);
            PG8_WAIT_V(6); PG8_BAR; PG8_MMA(1, 1, At, B1); PG8_BAR;
            }
        }
        if constexpr (ALIGN_EPI) { if (wr == 0) PG8_BAR; }
        if constexpr (!Epi::AFTER_DRAIN) { E(acc, cur, wr, wc, fr, fq); S.done(cur); }
        if (!has_next) break;
#pragma unroll
        for (int a = 0; a < 2; ++a)
#pragma unroll
            for (int b = 0; b < 2; ++b)
#pragma unroll
                for (int m = 0; m < 4; ++m)
#pragma unroll
                    for (int n = 0; n < 2; ++n) acc[a][b][m][n] = (f32x4){0.f, 0.f, 0.f, 0.f};
        cur = nxt; cA = nA; cB = nB; ++ui;
        if constexpr (ALIGN_EPI) { if (wr == 1) PG8_BAR; }
    }
    PG8_WAIT_V(0);
    if constexpr (!ALIGN_EPI) { if (wr == 0) PG8_BAR; }
    PG8_BAR;
    if constexpr (Epi::AFTER_DRAIN) { E.fused(acc, cur, wr, wc, fr, fq, lds, wid, lane); S.done(cur); }
#undef PG8_SA
#undef PG8_SB
#undef PG8_STAGE
#undef PG8_LDA
#undef PG8_LDB
#undef PG8_MMA
#undef PG8_WAIT_V
#undef PG8_WAIT_L
#undef PG8_BAR
#undef PG8_SCHED
}
}


namespace att {
using bf16x8 = __attribute__((ext_vector_type(8))) short;
using s16x4  = __attribute__((ext_vector_type(4))) short;
using f32x16 = __attribute__((ext_vector_type(16))) float;
using u32x4  = __attribute__((ext_vector_type(4))) unsigned;
using u32x2  = __attribute__((ext_vector_type(2))) unsigned;
constexpr int SHM_V = 16384, SHM_K = 16384;
constexpr int L_V = 0, L_K = 32768, L_WS = 69632, L_SEL = 131072, L_END = 139264;
#ifndef ATT_SDEPTH
#define ATT_SDEPTH 1
#endif
constexpr int SDEPTH = ATT_SDEPTH;
constexpr float THR2 = 11.0f;
#define KSWZ(row, colB) ((row) * 256 + ((colB) ^ (((row) & 7) << 4)))
#define SBAR() __builtin_amdgcn_sched_barrier(0)
__device__ __forceinline__ int crow(int r, int hi) { return (r & 3) + 8 * (r >> 2) + 4 * hi; }
__device__ __forceinline__ unsigned cvtpk(float lo, float hi) { unsigned r; asm volatile("v_cvt_pk_bf16_f32 %0, %1, %2" : "=v"(r) : "v"(lo), "v"(hi)); return r; }
__device__ __forceinline__ bf16x8 ld8(const bf16* p) { return *reinterpret_cast<const bf16x8*>(p); }
__device__ __forceinline__ float bf2f(bf16 v) { return __uint_as_float((unsigned)v << 16); }
__device__ __forceinline__ float ninf() { return __uint_as_float(0xff800000u); }

template <int ND0> __device__ __forceinline__ void qkt(f32x16& p0, f32x16& p1, const char* Ks, const bf16x8* qr, int r32, int hi, int d0base) {
  p0 = f32x16{}; p1 = f32x16{};
#pragma unroll
  for (int d0 = 0; d0 < ND0; ++d0) { const int cb = ((d0base + d0) * 16 + hi * 8) * 2;
    bf16x8 b0 = *reinterpret_cast<const bf16x8*>(Ks + KSWZ(r32, cb));
    bf16x8 b1 = *reinterpret_cast<const bf16x8*>(Ks + KSWZ(32 + r32, cb));
    p0 = __builtin_amdgcn_mfma_f32_32x32x16_bf16(b0, qr[d0], p0, 0, 0, 0);
    p1 = __builtin_amdgcn_mfma_f32_32x32x16_bf16(b1, qr[d0], p1, 0, 0, 0); }
}
__device__ __forceinline__ int v_st(int k, int c) { const int kk = (k & ~0xC) | ((k & 4) << 1) | ((k & 8) >> 1); return ((kk >> 3) * 4 + (c >> 5)) * 512 + ((kk & 7) * 32 + (c & 31)) * 2; }
__device__ __forceinline__ int v_rd_base(int lane) { return ((lane & 3) << 3) | (((lane >> 2) & 3) << 6) | (((lane >> 4) & 1) << 5) | (((lane >> 5) & 1) << 8); }
constexpr int v_rd_off(int d0, int ks, int half) { return d0 * 512 + ks * 4096 + half * 2048; }
template <int OFF> __device__ __forceinline__ s16x4 tr_read(int vb) {
  s16x4 r; asm volatile("ds_read_b64_tr_b16 %0, %1 offset:%2" : "=&v"(r) : "v"(vb), "i"(OFF) : "memory"); return r;
}
template <int D0> __device__ __forceinline__ void pv_one(f32x16& od, int vb, bf16x8 pa0, bf16x8 pa1, bf16x8 pa2, bf16x8 pa3) {
#define PK(L, H) (bf16x8){L[0], L[1], L[2], L[3], H[0], H[1], H[2], H[3]}
  { const s16x4 l0 = tr_read<v_rd_off(D0, 0, 0)>(vb), h0 = tr_read<v_rd_off(D0, 0, 1)>(vb), l1 = tr_read<v_rd_off(D0, 1, 0)>(vb), h1 = tr_read<v_rd_off(D0, 1, 1)>(vb);
    asm volatile("s_waitcnt lgkmcnt(0)" ::: "memory"); SBAR();
    od = __builtin_amdgcn_mfma_f32_32x32x16_bf16(pa0, PK(l0, h0), od, 0, 0, 0);
    od = __builtin_amdgcn_mfma_f32_32x32x16_bf16(pa1, PK(l1, h1), od, 0, 0, 0); }
  { const s16x4 l2 = tr_read<v_rd_off(D0, 2, 0)>(vb), h2 = tr_read<v_rd_off(D0, 2, 1)>(vb), l3 = tr_read<v_rd_off(D0, 3, 0)>(vb), h3 = tr_read<v_rd_off(D0, 3, 1)>(vb);
    asm volatile("s_waitcnt lgkmcnt(0)" ::: "memory"); SBAR();
    od = __builtin_amdgcn_mfma_f32_32x32x16_bf16(pa2, PK(l2, h2), od, 0, 0, 0);
    od = __builtin_amdgcn_mfma_f32_32x32x16_bf16(pa3, PK(l3, h3), od, 0, 0, 0); }
#undef PK
}
__device__ __forceinline__ void pv_d0(f32x16* o, int vb, bf16x8 pa0, bf16x8 pa1, bf16x8 pa2, bf16x8 pa3) {
  pv_one<0>(o[0], vb, pa0, pa1, pa2, pa3); pv_one<1>(o[1], vb, pa0, pa1, pa2, pa3); pv_one<2>(o[2], vb, pa0, pa1, pa2, pa3); pv_one<3>(o[3], vb, pa0, pa1, pa2, pa3);
}

template <int MODE> __device__ __forceinline__ void partialSM(f32x16& p0, f32x16& p1, float Cs, float slope2, float thr, int k0, int qpos, int hi,
                                                              const char* selrow, bool diag, float& m_reg, float& off, float& alpha, bool& dead) {
#pragma unroll
  for (int r = 0; r < 16; ++r) { const float cr = (float)((r & 3) + 8 * (r >> 2)); p0[r] = fmaf(p0[r], Cs, cr); p1[r] = fmaf(p1[r], Cs, cr); }
  if (MODE == 0) {
    if (diag) { const int dqh = qpos - k0 - 4 * hi;
#pragma unroll
      for (int r = 0; r < 16; ++r) { const int cr = (r & 3) + 8 * (r >> 2); if (cr > dqh) p0[r] = ninf(); if (cr + 32 > dqh) p1[r] = ninf(); } }
  } else {
    const u32x2 w = *reinterpret_cast<const u32x2*>(selrow + (k0 >> 5) * 4);
    const unsigned w0 = w.x >> (4 * hi), w1 = w.y >> (4 * hi);
    const float ninf_ = ninf();
#pragma unroll
    for (int r = 0; r < 16; ++r) { const int cr = (r & 3) + 8 * (r >> 2); unsigned t0, t1;
      asm("v_bfe_i32 %0, %1, %2, 1" : "=v"(t0) : "v"(w0), "n"(cr)); asm("v_bfi_b32 %0, %1, %2, %0" : "+v"(p0[r]) : "v"(t0), "s"(ninf_));
      asm("v_bfe_i32 %0, %1, %2, 1" : "=v"(t1) : "v"(w1), "n"(cr)); asm("v_bfi_b32 %0, %1, %2, %0" : "+v"(p1[r]) : "v"(t1), "s"(ninf_)); }
  }
  float pm0 = p0[0], pm1 = p1[0];
#pragma unroll
  for (int r = 1; r < 16; ++r) { pm0 = fmaxf(pm0, p0[r]); pm1 = fmaxf(pm1, p1[r]); }
  const float tb = (float)(k0 + 4 * hi - qpos);
  float tmax = fmaxf(pm0, pm1 + 32.f) + tb;
  { auto rr = __builtin_amdgcn_permlane32_swap(__float_as_uint(tmax), __float_as_uint(tmax), false, false);
    tmax = fmaxf(__uint_as_float(rr[0]), __uint_as_float(rr[1])); }
  dead = (MODE == 0) && __all((tmax - m_reg) * slope2 < -150.f);
  if (dead) { alpha = 1.f; off = 0.f; return; }
  if (__builtin_expect(__all(tmax - m_reg <= thr), 1)) { alpha = 1.f; }
  else { const float mn = fmaxf(m_reg, tmax); alpha = __builtin_amdgcn_exp2f((m_reg - mn) * slope2); m_reg = mn; }
  off = (tb - m_reg) * slope2;
#pragma unroll
  for (int r = 0; r < 16; ++r) p0[r] = __builtin_amdgcn_exp2f(fmaf(p0[r], slope2, off));
}
__device__ __forceinline__ void finishSM(f32x16& p0, f32x16& p1, float slope2, float off1, float alpha, float& l_reg, bf16x8& pa0, bf16x8& pa1, bf16x8& pa2, bf16x8& pa3) {
#pragma unroll
  for (int r = 0; r < 16; ++r) p1[r] = __builtin_amdgcn_exp2f(fmaf(p1[r], slope2, off1));
  float ps = 0;
#pragma unroll
  for (int r = 0; r < 16; ++r) ps += p0[r];
#pragma unroll
  for (int r = 0; r < 16; ++r) ps += p1[r];
  { auto rr = __builtin_amdgcn_permlane32_swap(__float_as_uint(ps), __float_as_uint(ps), false, false);
    ps = __uint_as_float(rr[0]) + __uint_as_float(rr[1]); }
  l_reg = l_reg * alpha + ps;
#define PK4(P, BASE, OUT) do { unsigned a0 = cvtpk(P[BASE + 0], P[BASE + 1]), a1 = cvtpk(P[BASE + 2], P[BASE + 3]);   \
    unsigned b0 = cvtpk(P[BASE + 4], P[BASE + 5]), b1 = cvtpk(P[BASE + 6], P[BASE + 7]);                              \
    auto r0 = __builtin_amdgcn_permlane32_swap(a0, b0, false, false); auto r1 = __builtin_amdgcn_permlane32_swap(a1, b1, false, false); \
    u32x4 w = {r0[0], r1[0], r0[1], r1[1]}; OUT = *reinterpret_cast<bf16x8*>(&w); } while (0)
  PK4(p0, 0, pa0); PK4(p0, 8, pa1); PK4(p1, 0, pa2); PK4(p1, 8, pa3);
#undef PK4
}

typedef float f32x2v __attribute__((ext_vector_type(2)));
__device__ __forceinline__ void cnt_ge(int& cnt, unsigned a, unsigned b) { asm volatile("v_cmp_ge_u32_e32 vcc, %1, %2\n\tv_addc_co_u32_e32 %0, vcc, 0, %0, vcc" : "+v"(cnt) : "v"(a), "v"(b) : "vcc"); }
__device__ __forceinline__ void cnt_gt(int& cnt, unsigned a, unsigned b) { asm volatile("v_cmp_gt_u32_e32 vcc, %1, %2\n\tv_addc_co_u32_e32 %0, vcc, 0, %0, vcc" : "+v"(cnt) : "v"(a), "v"(b) : "vcc"); }
__device__ __forceinline__ void cnt_ge4(int& c0, int& c1, int& c2, int& c3, unsigned k0, unsigned k1, unsigned k2, unsigned k3, unsigned b) {
  unsigned long long m0, m1, m2, m3;
  asm volatile("v_cmp_ge_u32_e64 %4, %8, %12\n\tv_cmp_ge_u32_e64 %5, %9, %12\n\tv_cmp_ge_u32_e64 %6, %10, %12\n\tv_cmp_ge_u32_e64 %7, %11, %12\n\t"
               "v_addc_co_u32_e64 %0, %4, 0, %0, %4\n\tv_addc_co_u32_e64 %1, %5, 0, %1, %5\n\tv_addc_co_u32_e64 %2, %6, 0, %2, %6\n\tv_addc_co_u32_e64 %3, %7, 0, %3, %7"
               : "+v"(c0), "+v"(c1), "+v"(c2), "+v"(c3), "=&s"(m0), "=&s"(m1), "=&s"(m2), "=&s"(m3) : "v"(k0), "v"(k1), "v"(k2), "v"(k3), "v"(b));
}
__device__ __forceinline__ unsigned wlane(unsigned val, int ln, unsigned old) { asm volatile("v_writelane_b32 %0, %1, %2" : "+v"(old) : "s"(val), "s"(ln)); return old; }
__device__ __forceinline__ int half_sum(int x, int hi) {
  x += __builtin_amdgcn_update_dpp(0, x, 0x111, 0xf, 0xf, true);
  x += __builtin_amdgcn_update_dpp(0, x, 0x112, 0xf, 0xf, true);
  x += __builtin_amdgcn_update_dpp(0, x, 0x114, 0xf, 0xf, true);
  x += __builtin_amdgcn_update_dpp(0, x, 0x118, 0xf, 0xf, true);
  const int a = __builtin_amdgcn_readlane(x, 15) + __builtin_amdgcn_readlane(x, 31);
  const int b = __builtin_amdgcn_readlane(x, 47) + __builtin_amdgcn_readlane(x, 63);
  return hi ? b : a;
}
__device__ __forceinline__ unsigned take_low(unsigned m, int k) {
  while (__builtin_popcount(m) > k) m &= ~(0x80000000u >> __builtin_clz(m));
  return m;
}

__device__ __forceinline__ void dsa_select(const bf16* __restrict__ PROJ, int b, int q0, unsigned* SEL, char* lds) {
  int tid = my_tid(); asm volatile("" : "+v"(tid));
  const int wid = __builtin_amdgcn_readfirstlane(tid >> 6), lane = tid & 63, r32 = lane & 31, hi = lane >> 5;
  const size_t tokb = (size_t)b * SEQ;
  const int nt32 = (q0 >> 5) + 1, nch = (nt32 + 15) >> 4;
  const int srow = wid * 64 + (lane >> 3), spc = lane & 7;
  const unsigned sloff = (unsigned)((srow * LDP + 8 * spc) * 2);
  const __amdgpu_buffer_rsrc_t srd = __builtin_amdgcn_make_buffer_rsrc((void*)(PROJ + tokb * LDP + C_IK), (short)0, (int)(SEQ * LDP * 2), 0x00020000);
  bf16x8 af[4]; float w[16]; bf16x8 st[8];
#define DSA_LOADS(RD) do { const int tA_ = q0 + (RD) * 16 + wid * 2; \
    const bf16* ap_ = PROJ + (tokb + tA_ + (r32 >> 4)) * LDP + C_IQ + (r32 & 15) * 64 + hi * 8; \
    _Pragma("unroll") for (int ks = 0; ks < 4; ++ks) af[ks] = ld8(ap_ + ks * 16); \
    _Pragma("unroll") for (int r = 0; r < 16; ++r) { const int head = (r & 3) + 8 * ((r >> 2) & 1) + 4 * hi; w[r] = bf2f(PROJ[(tokb + tA_ + (r >> 3)) * LDP + C_IW + head]); } \
    _Pragma("unroll") for (int i = 0; i < 8; ++i) st[i] = __builtin_bit_cast(bf16x8, __builtin_amdgcn_raw_buffer_load_b128(srd, (int)(sloff + (unsigned)(8 * i * LDP * 2)), 0, 0)); } while (0)
  DSA_LOADS(0);
  for (int rd = 0; rd < 2; ++rd) {
    const int tl = rd * 16 + wid * 2, tA = q0 + tl;
#pragma unroll
    for (int r = 0; r < 16; ++r) w[r] *= 0.5f;
    const int myq = tA + hi;
    unsigned key[64];
#pragma unroll
    for (int c = 0; c < 4; ++c) {
      if (c < nch) {
        char* buf = lds + (c & 1) * 65536;
#pragma unroll
        for (int i = 0; i < 8; ++i) { const int row = srow + 8 * i; *reinterpret_cast<bf16x8*>(buf + row * 128 + ((spc ^ ((row >> 1) & 7)) << 4)) = st[i]; }
        if (c + 1 < nch) {
#pragma unroll
          for (int i = 0; i < 8; ++i) st[i] = __builtin_bit_cast(bf16x8, __builtin_amdgcn_raw_buffer_load_b128(srd, (int)(sloff + (unsigned)(8 * i * LDP * 2)), 512 * (c + 1) * LDP * 2, 0));
        }
        __syncthreads();
#define IDX_MMA(CC, U) do { const int row_ = 32 * (U) + r32; CC = f32x16{}; _Pragma("unroll") for (int ks = 0; ks < 4; ++ks) { \
            const bf16x8 bfr = *reinterpret_cast<const bf16x8*>(buf + row_ * 128 + (((2 * ks + hi) ^ ((row_ >> 1) & 7)) << 4)); CC = __builtin_amdgcn_mfma_f32_32x32x16_bf16(af[ks], bfr, CC, 0, 0, 0); } } while (0)
#define IDX_RED(CC, U) do { const int j_ = 16 * c + (U); f32x2v l0 = {0.f, 0.f}, l1 = {0.f, 0.f}; \
          _Pragma("unroll") for (int i = 0; i < 4; ++i) { l0 = __builtin_elementwise_fma((f32x2v){w[2 * i], w[2 * i + 1]}, (f32x2v){CC[2 * i], CC[2 * i + 1]}, l0); \
                                                          l1 = __builtin_elementwise_fma((f32x2v){w[8 + 2 * i], w[9 + 2 * i]}, (f32x2v){CC[8 + 2 * i], CC[9 + 2 * i]}, l1); } \
          float s0 = l0[0] + l0[1], s1 = l1[0] + l1[1]; \
          _Pragma("unroll") for (int r = 0; r < 8; ++r) { asm("v_fma_f32 %0, %1, |%2|, %0" : "+v"(s0) : "v"(w[r]), "v"(CC[r])); asm("v_fma_f32 %0, %1, |%2|, %0" : "+v"(s1) : "v"(w[8 + r]), "v"(CC[8 + r])); } \
          auto rr = __builtin_amdgcn_permlane32_swap(__float_as_uint(s0), __float_as_uint(s1), false, false); \
          const float tot = __uint_as_float(rr[0]) + __uint_as_float(rr[1]); \
          const unsigned bits = __float_as_uint(tot); \
          const unsigned srt = bits ^ ((unsigned)((int)bits >> 31) | 0x80000000u); \
          key[j_] = (j_ * 32 + r32 <= myq) ? srt : 0u; } while (0)
#if defined(DSK) && DSK == 3
        { f32x16 ccA, ccB; IDX_MMA(ccA, 0);
#pragma unroll
          for (int u = 0; u < 16; u += 2) { IDX_MMA(ccB, u + 1); IDX_RED(ccA, u); __builtin_amdgcn_sched_barrier(0); if (u + 2 < 16) IDX_MMA(ccA, u + 2); IDX_RED(ccB, u + 1); __builtin_amdgcn_sched_barrier(0); } }
        _Pragma("unroll") for (int u = 0; u < 16; ++u) asm volatile("" :: "v"(key[16 * c + u]));
#endif
        { f32x16 ccA, ccB; IDX_MMA(ccA, 0);
#pragma unroll
          for (int u = 0; u < 16; u += 2) { IDX_MMA(ccB, u + 1); IDX_RED(ccA, u); __builtin_amdgcn_sched_barrier(0); if (u + 2 < 16) IDX_MMA(ccA, u + 2); IDX_RED(ccB, u + 1); __builtin_amdgcn_sched_barrier(0); } }
#undef IDX_MMA
#undef IDX_RED
      } else {
#pragma unroll
        for (int u = 0; u < 16; ++u) key[16 * c + u] = 0u;
      }
    }
    __syncthreads();
    if (rd == 0) DSA_LOADS(1);
    unsigned T = 0u;
    if (tA + 2 > 256) {
      for (int bit = 31; bit >= 0; --bit) {
        const unsigned cand = T | (1u << bit);
        int cnt = 0;
#pragma unroll
        for (int cc = 0; cc < 8; ++cc) { if (cc * 8 < nt32) {
#pragma unroll
          for (int e = 0; e < 8; ++e) cnt_ge(cnt, key[cc * 8 + e], cand); } }
        const int tot = half_sum(cnt, hi);
        if (tot >= 256) T = cand;
        if (__all(tot == 256)) break;
      }
    }
    const unsigned Tm = T > 1u ? T : 1u;
    int cge = 0;
#pragma unroll
    for (int cc = 0; cc < 8; ++cc) { if (cc * 8 < nt32) {
#pragma unroll
      for (int e = 0; e < 8; ++e) cnt_ge(cge, key[cc * 8 + e], Tm); } }
    cge = half_sum(cge, hi);
    int ln = lane; asm volatile("" : "+v"(ln));
    unsigned m0 = 0xffffffffu, m1 = 0xffffffffu;
    if (__all(cge <= 256)) {
#pragma unroll
      for (int j = 0; j < 64; ++j) {
        const unsigned long long bal = __ballot(!(key[j] >= Tm));
        m0 = (ln == j) ? (unsigned)bal : m0; m1 = (ln == j) ? (unsigned)(bal >> 32) : m1; }
    } else {
      unsigned* kst = (unsigned*)(lds + wid * 16384);
#pragma unroll
      for (int j = 0; j < 64; ++j) kst[j * 64 + lane] = key[j];
      int cgt = 0;
#pragma unroll
      for (int cc = 0; cc < 8; ++cc) { if (cc * 8 < nt32) {
#pragma unroll
        for (int e = 0; e < 8; ++e) cnt_gt(cgt, key[cc * 8 + e], Tm); } }
      cgt = half_sum(cgt, hi);
      int need_lo = 256 - __builtin_amdgcn_readlane(cgt, 0), need_hi = 256 - __builtin_amdgcn_readlane(cgt, 32);
#pragma unroll 1
      for (int j = 0; j < 64; ++j) {
        const unsigned kj = kst[j * 64 + lane];
        const unsigned long long eqm = __ballot(kj == Tm), gtm = __ballot(kj > Tm);
        const unsigned tl_ = take_low((unsigned)eqm, need_lo > 0 ? need_lo : 0), th_ = take_low((unsigned)(eqm >> 32), need_hi > 0 ? need_hi : 0);
        need_lo -= __builtin_popcount(tl_); need_hi -= __builtin_popcount(th_);
        const unsigned sl = (unsigned)gtm | tl_, sh = (unsigned)(gtm >> 32) | th_;
        m0 = (ln == j) ? ~sl : m0; m1 = (ln == j) ? ~sh : m1; }
    }
    SEL[tl * 64 + lane] = m0; SEL[(tl + 1) * 64 + lane] = m1;
    __syncthreads();
  }
#undef DSA_LOADS
}

template <int MODE>
__device__ __forceinline__ void attn_unit(const bf16* __restrict__ PROJ, unsigned char* __restrict__ ATT, int b, int h, int qb, char* lds, float lam, const float* __restrict__ subln_g) {
  if (MODE == 1) { dsa_select(PROJ, b, qb * 32, (unsigned*)(lds + L_SEL), lds); __syncthreads(); }
  int tid = my_tid(); asm volatile("" : "+v"(tid));
  const int wid = __builtin_amdgcn_readfirstlane(tid >> 6), lane = tid & 63, r32 = lane & 31, hi = lane >> 5;
  constexpr int ND0 = MODE == 0 ? 4 : 8;
  const int q0 = MODE == 0 ? qb * 128 : qb * 32;
  const int wq = MODE == 0 ? (wid & 3) * 32 : 0;
  const int c = MODE == 0 ? (wid >> 2) : 0;
  const int qpos = q0 + wq + r32;
  const size_t tokb = (size_t)b * SEQ;
  const bf16* Qw = PROJ + (tokb + qpos) * LDP + (MODE == 0 ? C_DQ + h * 128 + c * 64 : C_SQ + wid * 128) + hi * 8;
  const bf16* Kh = PROJ + tokb * LDP + (MODE == 0 ? C_DK + h * 128 : C_SK);
  const bf16* Vh = PROJ + tokb * LDP + (MODE == 0 ? C_DV + h * 128 : C_SV);
  const int NT = MODE == 0 ? 2 * (qb + 1) : 2 * ((q0 + 32 + 127) >> 7);
  const float slope2 = (MODE == 0 ? exp2f(-0.5f * (float)(2 * h + 1)) : exp2f(-(float)(wid + 1))) * LOG2E;
  const float Cs = (MODE == 0 ? 0.125f : 0.08838834764831845f) * LOG2E / slope2;
  const float thr = THR2 / slope2, c32 = 32.f * slope2;
  char* V_lds = lds + L_V; char* K_lds = lds + L_K;
  float* ws = (float*)(lds + L_WS) + wid * 64; float* li_l = ws; float* al_l = ws + 32;
  unsigned* SEL = (unsigned*)(lds + L_SEL);
  const char* selrow = (const char*)(SEL + r32 * 64);

  float m_reg = -1e30f, l_reg = 0; f32x16 o[4] = {}; bf16x8 qr[ND0];
#pragma unroll
  for (int d0 = 0; d0 < ND0; ++d0) qr[d0] = ld8(Qw + d0 * 16);
  const int sr = tid >> 4, sc = (tid & 15) * 8, vst0 = v_st(sr, sc), vst1 = v_st(32 + sr, sc);
  const int vb0 = (int)(uintptr_t)V_lds + v_rd_base(lane);
  struct { bf16x8 vs0, vs1, ks0, ks1; } sr_[SDEPTH];
#define SLOAD(i, k0) do { sr_[i].vs0 = ld8(&Vh[(size_t)((k0) + sr) * LDP + sc]); sr_[i].vs1 = ld8(&Vh[(size_t)((k0) + 32 + sr) * LDP + sc]); \
    sr_[i].ks0 = ld8(&Kh[(size_t)((k0) + sr) * LDP + sc]); sr_[i].ks1 = ld8(&Kh[(size_t)((k0) + 32 + sr) * LDP + sc]); } while (0)
#define SWRITE(bb, i) do { *(bf16x8*)(V_lds + (bb) * SHM_V + vst0) = sr_[i].vs0;          \
    *(bf16x8*)(V_lds + (bb) * SHM_V + vst1) = sr_[i].vs1; const int kc = sc * 2;               \
    *(bf16x8*)(K_lds + (bb) * SHM_K + KSWZ(sr, kc)) = sr_[i].ks0;                       \
    *(bf16x8*)(K_lds + (bb) * SHM_K + KSWZ(32 + sr, kc)) = sr_[i].ks1; } while (0)
#define SWAIT() do { if constexpr (SDEPTH == 2) asm volatile("s_waitcnt vmcnt(4)" ::: "memory"); else asm volatile("s_waitcnt vmcnt(0)" ::: "memory"); } while (0)
#define RESC(a) do { if (__any((a) < 1.f)) { if (hi == 0) al_l[r32] = (a); asm volatile("s_waitcnt lgkmcnt(0)" ::: "memory"); \
    _Pragma("unroll") for (int d = 0; d < 4; ++d) _Pragma("unroll") for (int r = 0; r < 16; ++r) o[d][r] *= al_l[crow(r, hi)]; } } while (0)
#define DIAG(k0) ((k0) + 63 > q0 + wq)
  f32x16 pA0, pA1, pB0, pB1; float ofA, ofB, alA, alB; bool deadA = false, deadB = false; bf16x8 pa0, pa1, pa2, pa3;
  constexpr int SE = 0, SO = SDEPTH - 1;
  static_assert(SDEPTH == 1, "the tile loop below is written for one staging register set");
#define KT(i) ((MODE == 0 ? (NT - 1 - (i)) : (i)) * 64)
  SLOAD(SE, KT(0)); asm volatile("s_waitcnt vmcnt(0)" ::: "memory"); SWRITE(0, SE); SLOAD(SE, KT(1)); __syncthreads();
  qkt<ND0>(pA0, pA1, K_lds, qr, r32, hi, c * 4); partialSM<MODE>(pA0, pA1, Cs, slope2, thr, KT(0), qpos, hi, selrow, DIAG(KT(0)), m_reg, ofA, alA, deadA);
  SWAIT(); SWRITE(1, SO); if (2 < NT) SLOAD(SE, KT(2)); __syncthreads();
  for (int j = 1; j + 1 < NT; j += 2) {
    SBAR(); qkt<ND0>(pB0, pB1, K_lds + SHM_K, qr, r32, hi, c * 4);
    if (!deadA) { finishSM(pA0, pA1, slope2, ofA + c32, alA, l_reg, pa0, pa1, pa2, pa3); } SBAR();
    if (!deadA) { pv_d0(o, vb0, pa0, pa1, pa2, pa3); } partialSM<MODE>(pB0, pB1, Cs, slope2, thr, KT(j), qpos, hi, selrow, DIAG(KT(j)), m_reg, ofB, alB, deadB);
    __syncthreads(); SWAIT(); SWRITE(0, SE); SLOAD(SE, KT(j + 2));
    RESC(alB); __syncthreads();
    SBAR(); qkt<ND0>(pA0, pA1, K_lds, qr, r32, hi, c * 4);
    if (!deadB) { finishSM(pB0, pB1, slope2, ofB + c32, alB, l_reg, pa0, pa1, pa2, pa3); } SBAR();
    if (!deadB) { pv_d0(o, vb0 + SHM_V, pa0, pa1, pa2, pa3); } partialSM<MODE>(pA0, pA1, Cs, slope2, thr, KT(j + 1), qpos, hi, selrow, DIAG(KT(j + 1)), m_reg, ofA, alA, deadA);
    __syncthreads(); SWAIT(); SWRITE(1, SO); if (j + 3 < NT) SLOAD(SO, KT(j + 3));
    RESC(alA); __syncthreads();
  }
  SBAR(); qkt<ND0>(pB0, pB1, K_lds + SHM_K, qr, r32, hi, c * 4);
  if (!deadA) { finishSM(pA0, pA1, slope2, ofA + c32, alA, l_reg, pa0, pa1, pa2, pa3); } SBAR();
  if (!deadA) { pv_d0(o, vb0, pa0, pa1, pa2, pa3); } partialSM<MODE>(pB0, pB1, Cs, slope2, thr, KT(NT - 1), qpos, hi, selrow, DIAG(KT(NT - 1)), m_reg, ofB, alB, deadB);
  __syncthreads(); RESC(alB);
  if (!deadB) { finishSM(pB0, pB1, slope2, ofB + c32, alB, l_reg, pa0, pa1, pa2, pa3); } SBAR();
  if (!deadB) { pv_d0(o, vb0 + SHM_V, pa0, pa1, pa2, pa3); }
#undef KT
#undef SLOAD
#undef SWRITE
#undef SWAIT
#undef RESC
#undef DIAG
  if (hi == 0) li_l[r32] = l_reg; asm volatile("s_waitcnt lgkmcnt(0)" ::: "memory");
  {
    float rli[16];
#pragma unroll
    for (int r = 0; r < 16; ++r) rli[r] = __builtin_amdgcn_rcpf(li_l[crow(r, hi)]);
#pragma unroll
    for (int d0 = 0; d0 < 4; ++d0)
#pragma unroll
      for (int r = 0; r < 16; ++r) o[d0][r] *= rli[r];
  }
  __syncthreads();
  if (MODE == 0) {
    float* X = (float*)lds;
    if (wid >= 4) {
#pragma unroll
      for (int d0 = 0; d0 < 4; ++d0)
#pragma unroll
        for (int r = 0; r < 16; ++r) X[(wid - 4) * 4096 + crow(r, hi) * 128 + d0 * 32 + r32] = o[d0][r];
    }
    __syncthreads();
    if (wid < 4) {
#pragma unroll
      for (int d0 = 0; d0 < 4; ++d0)
#pragma unroll
        for (int r = 0; r < 16; ++r) o[d0][r] -= lam * X[wid * 4096 + crow(r, hi) * 128 + d0 * 32 + r32];
    }
    __syncthreads();
  }
  if (MODE == 1 || wid < 4) {
    bf16* stg = (bf16*)(lds + wid * 8704);
#pragma unroll
    for (int d0 = 0; d0 < 4; ++d0)
#pragma unroll
      for (int r = 0; r < 16; r += 2) {
        const unsigned pk = cvtpk(o[d0][r], o[d0][r + 1]);
        stg[crow(r, hi) * 136 + d0 * 32 + r32] = (bf16)(pk & 0xffffu);
        stg[crow(r + 1, hi) * 136 + d0 * 32 + r32] = (bf16)(pk >> 16);
      }
    asm volatile("s_waitcnt lgkmcnt(0)" ::: "memory");
    bf16x8 v[8];
#pragma unroll
    for (int j = 0; j < 8; ++j) v[j] = *reinterpret_cast<const bf16x8*>(stg + r32 * 136 + hi * 64 + j * 8);
    unsigned char* orow = ATT + (tokb + q0 + wq + r32) * DM + (MODE == 0 ? h * 128 : 1024 + wid * 128) + hi * 64;
    float rs = 1.0f;
    if (MODE == 0) {
      float ss = 0.f;
#pragma unroll
      for (int j = 0; j < 8; ++j)
#pragma unroll
        for (int e = 0; e < 8; ++e) { const float x = bf2f((bf16)v[j][e]); ss = fmaf(x, x, ss); }
      { auto rr = __builtin_amdgcn_permlane32_swap(__float_as_uint(ss), __float_as_uint(ss), false, false);
        ss = __uint_as_float(rr[0]) + __uint_as_float(rr[1]); }
      rs = __builtin_amdgcn_rsqf(ss * (1.0f / 128.0f) + RMS_EPS) * (1.0f - LAM_INIT);
    }
#pragma unroll
    for (int jj = 0; jj < 4; ++jj) { u32x4 w;
#pragma unroll
      for (int q = 0; q < 4; ++q) { float y[4];
#pragma unroll
        for (int e = 0; e < 4; ++e) { const int idx = 16 * jj + 4 * q + e; float x = bf2f((bf16)v[idx >> 3][idx & 7]); if (MODE == 0) x = x * rs * subln_g[hi * 64 + idx]; y[e] = x; }
        int p = __builtin_amdgcn_cvt_pk_fp8_f32(y[0], y[1], 0, false); p = __builtin_amdgcn_cvt_pk_fp8_f32(y[2], y[3], p, true); w[q] = (unsigned)p; }
      *reinterpret_cast<u32x4*>(orow + jj * 16) = w; }
  }
  __syncthreads();
}
}

typedef float f32x4 __attribute__((ext_vector_type(4)));
typedef unsigned u32x4 __attribute__((ext_vector_type(4)));
typedef unsigned u32x2 __attribute__((ext_vector_type(2)));
__device__ __forceinline__ unsigned cvt_pk(float lo, float hi) { unsigned r; asm volatile("v_cvt_pk_bf16_f32 %0, %1, %2" : "=v"(r) : "v"(lo), "v"(hi)); return r; }
__device__ __forceinline__ float bf_lo(unsigned w) { return __uint_as_float(w << 16); }
__device__ __forceinline__ float bf_hi(unsigned w) { return __uint_as_float(w & 0xffff0000u); }
__device__ __forceinline__ float wave_sum(float v) {
#pragma unroll
  for (int o = 1; o < 64; o <<= 1) v += __shfl_xor(v, o);
  return v;
}

__device__ __forceinline__ void cvt_stream(const float* __restrict__ src, bf16* __restrict__ dst, size_t n8, size_t gtid, size_t gsz) {
  for (size_t i = gtid; i < n8; i += gsz) {
    const f32x4 a = *reinterpret_cast<const f32x4*>(src + i * 8), b = *reinterpret_cast<const f32x4*>(src + i * 8 + 4);
    u32x4 w = {cvt_pk(a[0], a[1]), cvt_pk(a[2], a[3]), cvt_pk(b[0], b[1]), cvt_pk(b[2], b[3])};
    *reinterpret_cast<u32x4*>(dst + i * 8) = w;
  }
}
__device__ __forceinline__ void cvt_stream2(const float* __restrict__ src, bf16* __restrict__ dst, unsigned char* __restrict__ dst8, size_t n8, size_t gtid, size_t gsz) {
  for (size_t i0 = gtid; i0 < n8; i0 += 4 * gsz) {
    f32x4 a[4], b[4];
#pragma unroll
    for (int q = 0; q < 4; ++q) { const size_t i = i0 + q * gsz; if (i < n8) { a[q] = *reinterpret_cast<const f32x4*>(src + i * 8); b[q] = *reinterpret_cast<const f32x4*>(src + i * 8 + 4); } }
#pragma unroll
    for (int q = 0; q < 4; ++q) { const size_t i = i0 + q * gsz; if (i < n8) {
      u32x4 w = {cvt_pk(a[q][0], a[q][1]), cvt_pk(a[q][2], a[q][3]), cvt_pk(b[q][0], b[q][1]), cvt_pk(b[q][2], b[q][3])};
      *reinterpret_cast<u32x4*>(dst + i * 8) = w;
      int p0 = __builtin_amdgcn_cvt_pk_fp8_f32(a[q][0], a[q][1], 0, false); p0 = __builtin_amdgcn_cvt_pk_fp8_f32(a[q][2], a[q][3], p0, true);
      int p1 = __builtin_amdgcn_cvt_pk_fp8_f32(b[q][0], b[q][1], 0, false); p1 = __builtin_amdgcn_cvt_pk_fp8_f32(b[q][2], b[q][3], p1, true);
      *reinterpret_cast<u32x2*>(dst8 + i * 8) = (u32x2){(unsigned)p0, (unsigned)p1}; } }
  }
}
__device__ __forceinline__ void transpose_item(const float* __restrict__ W, int K, int N, bf16* __restrict__ WT, LAS float* scr, int kb, int nb, int lane) {
  const int k0 = 64 * kb, n0 = 32 * nb; const int nn = n0 + (lane & 31); const bool ok = nn < N;
  float tv[32];
#pragma unroll
  for (int i = 0; i < 32; ++i) { const int kk = 2 * i + (lane >> 5); tv[i] = ok ? W[(size_t)(k0 + kk) * N + nn] : 0.f; }
#pragma unroll
  for (int i = 0; i < 32; ++i) { const int kk = 2 * i + (lane >> 5); scr[kk * 33 + (lane & 31)] = tv[i]; }
  asm volatile("s_waitcnt lgkmcnt(0)" ::: "memory");
  const int c = lane & 7;
#pragma unroll
  for (int j = 0; j < 4; ++j) { const int n = (lane >> 3) + 8 * j; const LAS float* s = scr + (8 * c) * 33 + n;
    u32x4 o; o.x = cvt_pk(s[0 * 33], s[1 * 33]); o.y = cvt_pk(s[2 * 33], s[3 * 33]); o.z = cvt_pk(s[4 * 33], s[5 * 33]); o.w = cvt_pk(s[6 * 33], s[7 * 33]);
    *reinterpret_cast<u32x4*>(WT + (size_t)(n0 + n) * K + k0 + 8 * c) = o; }
  asm volatile("s_waitcnt lgkmcnt(0)" ::: "memory");
}

__device__ __forceinline__ void transpose_item_fp8(const float* __restrict__ W, int K, int N, unsigned char* __restrict__ WT, LAS float* scr, int kb, int nb, int lane, float scale) {
  const int k0 = 64 * kb, n0 = 32 * nb; const int nn = n0 + (lane & 31); const bool ok = nn < N;
  float tv[32];
#pragma unroll
  for (int i = 0; i < 32; ++i) { const int kk = 2 * i + (lane >> 5); tv[i] = ok ? W[(size_t)(k0 + kk) * N + nn] * scale : 0.f; }
#pragma unroll
  for (int i = 0; i < 32; ++i) { const int kk = 2 * i + (lane >> 5); scr[kk * 33 + (lane & 31)] = tv[i]; }
  asm volatile("s_waitcnt lgkmcnt(0)" ::: "memory");
  const int c = lane & 7;
#pragma unroll
  for (int j = 0; j < 4; ++j) { const int n = (lane >> 3) + 8 * j; const LAS float* s = scr + (8 * c) * 33 + n;
    int p0 = __builtin_amdgcn_cvt_pk_fp8_f32(s[0 * 33], s[1 * 33], 0, false); p0 = __builtin_amdgcn_cvt_pk_fp8_f32(s[2 * 33], s[3 * 33], p0, true);
    int p1 = __builtin_amdgcn_cvt_pk_fp8_f32(s[4 * 33], s[5 * 33], 0, false); p1 = __builtin_amdgcn_cvt_pk_fp8_f32(s[6 * 33], s[7 * 33], p1, true);
    *reinterpret_cast<u32x2*>(WT + (size_t)(n0 + n) * K + k0 + 8 * c) = (u32x2){(unsigned)p0, (unsigned)p1}; }
  asm volatile("s_waitcnt lgkmcnt(0)" ::: "memory");
}

__device__ __forceinline__ void ln1_phase(const bf16* __restrict__ Z, const float* __restrict__ g, const float* __restrict__ bta, bf16* __restrict__ OB, unsigned char* __restrict__ O8, int gw, int ngw, int lane) {
  f32x4 gv[8], bv[8];
#pragma unroll
  for (int j = 0; j < 4; ++j) { const int e0 = 512 * j + 8 * lane;
    gv[2 * j] = *reinterpret_cast<const f32x4*>(g + e0); gv[2 * j + 1] = *reinterpret_cast<const f32x4*>(g + e0 + 4);
    bv[2 * j] = *reinterpret_cast<const f32x4*>(bta + e0); bv[2 * j + 1] = *reinterpret_cast<const f32x4*>(bta + e0 + 4); }
  u32x4 nx[4];
  if (gw < NTOK) {
#pragma unroll
    for (int j = 0; j < 4; ++j) nx[j] = *reinterpret_cast<const u32x4*>(Z + (size_t)gw * DM + 512 * j + 8 * lane); }
  for (int m = gw; m < NTOK; m += ngw) {
    float v[32]; float s = 0.f;
#pragma unroll
    for (int j = 0; j < 4; ++j) {
#pragma unroll
      for (int q = 0; q < 4; ++q) { v[8 * j + 2 * q] = bf_lo(nx[j][q]); v[8 * j + 2 * q + 1] = bf_hi(nx[j][q]); } }
    if (m + ngw < NTOK) {
#pragma unroll
      for (int j = 0; j < 4; ++j) nx[j] = *reinterpret_cast<const u32x4*>(Z + (size_t)(m + ngw) * DM + 512 * j + 8 * lane); }
#pragma unroll
    for (int i = 0; i < 32; ++i) s += v[i];
    const float mean = wave_sum(s) * (1.f / DM); float s2 = 0.f;
#pragma unroll
    for (int i = 0; i < 32; ++i) { v[i] -= mean; s2 = fmaf(v[i], v[i], s2); }
    const float rstd = 1.0f / sqrtf(wave_sum(s2) * (1.f / DM) + LN_EPS);
    bf16* obrow = OB + (size_t)m * DM; unsigned char* o8row = O8 + (size_t)m * DM;
#pragma unroll
    for (int j = 0; j < 4; ++j) {
      const int e0 = 512 * j + 8 * lane;
      float y[8];
#pragma unroll
      for (int e = 0; e < 4; ++e) { y[e] = v[8 * j + e] * rstd * gv[2 * j][e] + bv[2 * j][e]; y[4 + e] = v[8 * j + 4 + e] * rstd * gv[2 * j + 1][e] + bv[2 * j + 1][e]; }
      u32x4 w = {cvt_pk(y[0], y[1]), cvt_pk(y[2], y[3]), cvt_pk(y[4], y[5]), cvt_pk(y[6], y[7])}; *reinterpret_cast<u32x4*>(obrow + e0) = w;
      int p0 = __builtin_amdgcn_cvt_pk_fp8_f32(y[0], y[1], 0, false); p0 = __builtin_amdgcn_cvt_pk_fp8_f32(y[2], y[3], p0, true);
      int p1 = __builtin_amdgcn_cvt_pk_fp8_f32(y[4], y[5], 0, false); p1 = __builtin_amdgcn_cvt_pk_fp8_f32(y[6], y[7], p1, true);
      *reinterpret_cast<u32x2*>(o8row + e0) = (u32x2){(unsigned)p0, (unsigned)p1};
    }
  }
}

namespace peer {
using bf16x8 = att::bf16x8; using f32x16 = att::f32x16;
constexpr int L_K1 = 0, L_K2 = 32768, L_SCR = 65536;
__device__ __forceinline__ unsigned srt(float x) { const unsigned b = __float_as_uint(x); return b ^ ((unsigned)((int)b >> 31) | 0x80000000u); }
__device__ __forceinline__ float unsrt(unsigned u) { const unsigned b = (u & 0x80000000u) ? (u ^ 0x80000000u) : ~u; return __uint_as_float(b); }
__device__ __forceinline__ unsigned umax(unsigned a, unsigned b) { return a > b ? a : b; }
__device__ __forceinline__ unsigned pair_max(unsigned m) {
  auto rr = __builtin_amdgcn_permlane32_swap(m, m, false, false); return umax(rr[0], rr[1]);
}
__device__ __forceinline__ void load_keys(const float* __restrict__ k1, const float* __restrict__ k2, char* lds) {
  for (int i = my_tid(); i < 2 * 128 * 16; i += 512) {
    const int t = i >> 11, row = (i >> 4) & 127, ch = i & 15; const float* src = (t ? k2 : k1) + row * 128 + ch * 8;
    const f32x4 a = *reinterpret_cast<const f32x4*>(src), b = *reinterpret_cast<const f32x4*>(src + 4);
    u32x4 w = {cvt_pk(a[0], a[1]), cvt_pk(a[2], a[3]), cvt_pk(b[0], b[1]), cvt_pk(b[2], b[3])};
    *reinterpret_cast<u32x4*>(lds + (t ? L_K2 : L_K1) + KSWZ(row, ch * 16)) = w;
  }
}
#define PK_CE(a, b) do { const unsigned hi_ = (a) > (b) ? (a) : (b), lo_ = (a) > (b) ? (b) : (a); (a) = hi_; (b) = lo_; } while (0)
__device__ __forceinline__ void sort16_desc(unsigned (&v)[64], const int base) {
  PK_CE(v[base + 0], v[base + 1]);
  PK_CE(v[base + 2], v[base + 3]);
  PK_CE(v[base + 0], v[base + 2]);
  PK_CE(v[base + 1], v[base + 3]);
  PK_CE(v[base + 1], v[base + 2]);
  PK_CE(v[base + 4], v[base + 5]);
  PK_CE(v[base + 6], v[base + 7]);
  PK_CE(v[base + 4], v[base + 6]);
  PK_CE(v[base + 5], v[base + 7]);
  PK_CE(v[base + 5], v[base + 6]);
  PK_CE(v[base + 0], v[base + 4]);
  PK_CE(v[base + 2], v[base + 6]);
  PK_CE(v[base + 2], v[base + 4]);
  PK_CE(v[base + 1], v[base + 5]);
  PK_CE(v[base + 3], v[base + 7]);
  PK_CE(v[base + 3], v[base + 5]);
  PK_CE(v[base + 1], v[base + 2]);
  PK_CE(v[base + 3], v[base + 4]);
  PK_CE(v[base + 5], v[base + 6]);
  PK_CE(v[base + 8], v[base + 9]);
  PK_CE(v[base + 10], v[base + 11]);
  PK_CE(v[base + 8], v[base + 10]);
  PK_CE(v[base + 9], v[base + 11]);
  PK_CE(v[base + 9], v[base + 10]);
  PK_CE(v[base + 12], v[base + 13]);
  PK_CE(v[base + 14], v[base + 15]);
  PK_CE(v[base + 12], v[base + 14]);
  PK_CE(v[base + 13], v[base + 15]);
  PK_CE(v[base + 13], v[base + 14]);
  PK_CE(v[base + 8], v[base + 12]);
  PK_CE(v[base + 10], v[base + 14]);
  PK_CE(v[base + 10], v[base + 12]);
  PK_CE(v[base + 9], v[base + 13]);
  PK_CE(v[base + 11], v[base + 15]);
  PK_CE(v[base + 11], v[base + 13]);
  PK_CE(v[base + 9], v[base + 10]);
  PK_CE(v[base + 11], v[base + 12]);
  PK_CE(v[base + 13], v[base + 14]);
  PK_CE(v[base + 0], v[base + 8]);
  PK_CE(v[base + 4], v[base + 12]);
  PK_CE(v[base + 4], v[base + 8]);
  PK_CE(v[base + 2], v[base + 10]);
  PK_CE(v[base + 6], v[base + 14]);
  PK_CE(v[base + 6], v[base + 10]);
  PK_CE(v[base + 2], v[base + 4]);
  PK_CE(v[base + 6], v[base + 8]);
  PK_CE(v[base + 10], v[base + 12]);
  PK_CE(v[base + 1], v[base + 9]);
  PK_CE(v[base + 5], v[base + 13]);
  PK_CE(v[base + 5], v[base + 9]);
  PK_CE(v[base + 3], v[base + 11]);
  PK_CE(v[base + 7], v[base + 15]);
  PK_CE(v[base + 7], v[base + 11]);
  PK_CE(v[base + 3], v[base + 5]);
  PK_CE(v[base + 7], v[base + 9]);
  PK_CE(v[base + 11], v[base + 13]);
  PK_CE(v[base + 1], v[base + 2]);
  PK_CE(v[base + 3], v[base + 4]);
  PK_CE(v[base + 5], v[base + 6]);
  PK_CE(v[base + 7], v[base + 8]);
  PK_CE(v[base + 9], v[base + 10]);
  PK_CE(v[base + 11], v[base + 12]);
  PK_CE(v[base + 13], v[base + 14]);
}
__device__ __forceinline__ void merge_top16(unsigned (&a)[16], const unsigned (&b)[16]) {
#pragma unroll
  for (int i = 0; i < 16; ++i) a[i] = a[i] > b[15 - i] ? a[i] : b[15 - i];
  PK_CE(a[0], a[8]);
  PK_CE(a[1], a[9]);
  PK_CE(a[2], a[10]);
  PK_CE(a[3], a[11]);
  PK_CE(a[4], a[12]);
  PK_CE(a[5], a[13]);
  PK_CE(a[6], a[14]);
  PK_CE(a[7], a[15]);
  PK_CE(a[0], a[4]);
  PK_CE(a[1], a[5]);
  PK_CE(a[2], a[6]);
  PK_CE(a[3], a[7]);
  PK_CE(a[8], a[12]);
  PK_CE(a[9], a[13]);
  PK_CE(a[10], a[14]);
  PK_CE(a[11], a[15]);
  PK_CE(a[0], a[2]);
  PK_CE(a[1], a[3]);
  PK_CE(a[4], a[6]);
  PK_CE(a[5], a[7]);
  PK_CE(a[8], a[10]);
  PK_CE(a[9], a[11]);
  PK_CE(a[12], a[14]);
  PK_CE(a[13], a[15]);
  PK_CE(a[0], a[1]);
  PK_CE(a[2], a[3]);
  PK_CE(a[4], a[5]);
  PK_CE(a[6], a[7]);
  PK_CE(a[8], a[9]);
  PK_CE(a[10], a[11]);
  PK_CE(a[12], a[13]);
  PK_CE(a[14], a[15]);
}
__device__ __forceinline__ void top16_of_128(const bf16x8* qf, const char* Kt, int r32, int hi, unsigned (&win)[16]) {
  unsigned pk[64];
#pragma unroll
  for (int t = 0; t < 4; ++t) {
    f32x16 c = f32x16{};
#pragma unroll
    for (int ks = 0; ks < 8; ++ks) { const bf16x8 a = *reinterpret_cast<const bf16x8*>(Kt + KSWZ(32 * t + r32, (ks * 16 + hi * 8) * 2));
      c = __builtin_amdgcn_mfma_f32_32x32x16_bf16(a, qf[ks], c, 0, 0, 0); }
#pragma unroll
    for (int r = 0; r < 16; ++r) { const int n = 32 * t + att::crow(r, hi); pk[t * 16 + r] = (srt(c[r]) & 0xffffff80u) | (unsigned)(127 - n); }
  }
  sort16_desc(pk, 0); sort16_desc(pk, 16); sort16_desc(pk, 32); sort16_desc(pk, 48);
  unsigned a[16], b[16];
#pragma unroll
  for (int i = 0; i < 16; ++i) { a[i] = pk[i]; b[i] = pk[16 + i]; }
  merge_top16(a, b);
  unsigned c[16];
#pragma unroll
  for (int i = 0; i < 16; ++i) { c[i] = pk[32 + i]; b[i] = pk[48 + i]; }
  merge_top16(c, b);
  merge_top16(a, c);
#pragma unroll
  for (int i = 0; i < 16; ++i) { auto rr = __builtin_amdgcn_permlane32_swap(a[i], a[i], false, false); b[i] = hi ? rr[0] : rr[1]; }
  merge_top16(a, b);
#pragma unroll
  for (int i = 0; i < 16; ++i) win[i] = a[i];
}
__device__ __forceinline__ void score_unit(const bf16* __restrict__ PQ, int* __restrict__ EIDX, float* __restrict__ EG, int t0, char* lds) {
  const int wid = my_wave(), lane = my_lane(), r32 = lane & 31, hi = lane >> 5;
  const bf16* qp = PQ + (size_t)(t0 + r32) * DM + wid * 256 + hi * 8;
  unsigned w1[16], w2[16];
  { bf16x8 qf[8];
#pragma unroll
    for (int ks = 0; ks < 8; ++ks) qf[ks] = att::ld8(qp + ks * 16);
    top16_of_128(qf, lds + L_K1, r32, hi, w1); }
  { bf16x8 qf[8];
#pragma unroll
    for (int ks = 0; ks < 8; ++ks) qf[ks] = att::ld8(qp + 128 + ks * 16);
    top16_of_128(qf, lds + L_K2, r32, hi, w2); }
  unsigned char* scr = (unsigned char*)(lds + L_SCR + wid * 1024) + r32 * 32;
  if (hi == 0) {
#pragma unroll
    for (int k = 0; k < 16; ++k) { scr[k] = (unsigned char)(127u - (w1[k] & 127u)); scr[16 + k] = (unsigned char)(127u - (w2[k] & 127u)); }
  }
  float v1[16], v2[16];
#pragma unroll
  for (int k = 0; k < 16; ++k) { v1[k] = unsrt(w1[k] & 0xffffff80u); v2[k] = unsrt(w2[k] & 0xffffff80u); }
  unsigned cd[25]; const unsigned hm0 = 0u - (unsigned)hi;
  { const unsigned e_ = (srt(v1[0] + v2[0]) & 0xffffff00u) | 255u, o_ = (srt(v1[0] + v2[1]) & 0xffffff00u) | 254u; cd[0] = (e_ & ~hm0) | (o_ & hm0); }
  { const unsigned e_ = (srt(v1[0] + v2[2]) & 0xffffff00u) | 253u, o_ = (srt(v1[0] + v2[3]) & 0xffffff00u) | 252u; cd[1] = (e_ & ~hm0) | (o_ & hm0); }
  { const unsigned e_ = (srt(v1[0] + v2[4]) & 0xffffff00u) | 251u, o_ = (srt(v1[0] + v2[5]) & 0xffffff00u) | 250u; cd[2] = (e_ & ~hm0) | (o_ & hm0); }
  { const unsigned e_ = (srt(v1[0] + v2[6]) & 0xffffff00u) | 249u, o_ = (srt(v1[0] + v2[7]) & 0xffffff00u) | 248u; cd[3] = (e_ & ~hm0) | (o_ & hm0); }
  { const unsigned e_ = (srt(v1[0] + v2[8]) & 0xffffff00u) | 247u, o_ = (srt(v1[0] + v2[9]) & 0xffffff00u) | 246u; cd[4] = (e_ & ~hm0) | (o_ & hm0); }
  { const unsigned e_ = (srt(v1[0] + v2[10]) & 0xffffff00u) | 245u, o_ = (srt(v1[0] + v2[11]) & 0xffffff00u) | 244u; cd[5] = (e_ & ~hm0) | (o_ & hm0); }
  { const unsigned e_ = (srt(v1[0] + v2[12]) & 0xffffff00u) | 243u, o_ = (srt(v1[0] + v2[13]) & 0xffffff00u) | 242u; cd[6] = (e_ & ~hm0) | (o_ & hm0); }
  { const unsigned e_ = (srt(v1[0] + v2[14]) & 0xffffff00u) | 241u, o_ = (srt(v1[0] + v2[15]) & 0xffffff00u) | 240u; cd[7] = (e_ & ~hm0) | (o_ & hm0); }
  { const unsigned e_ = (srt(v1[1] + v2[0]) & 0xffffff00u) | 239u, o_ = (srt(v1[1] + v2[1]) & 0xffffff00u) | 238u; cd[8] = (e_ & ~hm0) | (o_ & hm0); }
  { const unsigned e_ = (srt(v1[1] + v2[2]) & 0xffffff00u) | 237u, o_ = (srt(v1[1] + v2[3]) & 0xffffff00u) | 236u; cd[9] = (e_ & ~hm0) | (o_ & hm0); }
  { const unsigned e_ = (srt(v1[1] + v2[4]) & 0xffffff00u) | 235u, o_ = (srt(v1[1] + v2[5]) & 0xffffff00u) | 234u; cd[10] = (e_ & ~hm0) | (o_ & hm0); }
  { const unsigned e_ = (srt(v1[1] + v2[6]) & 0xffffff00u) | 233u, o_ = (srt(v1[1] + v2[7]) & 0xffffff00u) | 232u; cd[11] = (e_ & ~hm0) | (o_ & hm0); }
  { const unsigned e_ = (srt(v1[2] + v2[0]) & 0xffffff00u) | 223u, o_ = (srt(v1[2] + v2[1]) & 0xffffff00u) | 222u; cd[12] = (e_ & ~hm0) | (o_ & hm0); }
  { const unsigned e_ = (srt(v1[2] + v2[2]) & 0xffffff00u) | 221u, o_ = (srt(v1[2] + v2[3]) & 0xffffff00u) | 220u; cd[13] = (e_ & ~hm0) | (o_ & hm0); }
  { const unsigned e_ = (srt(v1[2] + v2[4]) & 0xffffff00u) | 219u, o_ = (srt(v1[3] + v2[0]) & 0xffffff00u) | 207u; cd[14] = (e_ & ~hm0) | (o_ & hm0); }
  { const unsigned e_ = (srt(v1[3] + v2[1]) & 0xffffff00u) | 206u, o_ = (srt(v1[3] + v2[2]) & 0xffffff00u) | 205u; cd[15] = (e_ & ~hm0) | (o_ & hm0); }
  { const unsigned e_ = (srt(v1[3] + v2[3]) & 0xffffff00u) | 204u, o_ = (srt(v1[4] + v2[0]) & 0xffffff00u) | 191u; cd[16] = (e_ & ~hm0) | (o_ & hm0); }
  { const unsigned e_ = (srt(v1[4] + v2[1]) & 0xffffff00u) | 190u, o_ = (srt(v1[4] + v2[2]) & 0xffffff00u) | 189u; cd[17] = (e_ & ~hm0) | (o_ & hm0); }
  { const unsigned e_ = (srt(v1[5] + v2[0]) & 0xffffff00u) | 175u, o_ = (srt(v1[5] + v2[1]) & 0xffffff00u) | 174u; cd[18] = (e_ & ~hm0) | (o_ & hm0); }
  { const unsigned e_ = (srt(v1[6] + v2[0]) & 0xffffff00u) | 159u, o_ = (srt(v1[6] + v2[1]) & 0xffffff00u) | 158u; cd[19] = (e_ & ~hm0) | (o_ & hm0); }
  { const unsigned e_ = (srt(v1[7] + v2[0]) & 0xffffff00u) | 143u, o_ = (srt(v1[7] + v2[1]) & 0xffffff00u) | 142u; cd[20] = (e_ & ~hm0) | (o_ & hm0); }
  { const unsigned e_ = (srt(v1[8] + v2[0]) & 0xffffff00u) | 127u, o_ = (srt(v1[9] + v2[0]) & 0xffffff00u) | 111u; cd[21] = (e_ & ~hm0) | (o_ & hm0); }
  { const unsigned e_ = (srt(v1[10] + v2[0]) & 0xffffff00u) | 95u, o_ = (srt(v1[11] + v2[0]) & 0xffffff00u) | 79u; cd[22] = (e_ & ~hm0) | (o_ & hm0); }
  { const unsigned e_ = (srt(v1[12] + v2[0]) & 0xffffff00u) | 63u, o_ = (srt(v1[13] + v2[0]) & 0xffffff00u) | 47u; cd[23] = (e_ & ~hm0) | (o_ & hm0); }
  { const unsigned e_ = (srt(v1[14] + v2[0]) & 0xffffff00u) | 31u, o_ = (srt(v1[15] + v2[0]) & 0xffffff00u) | 15u; cd[24] = (e_ & ~hm0) | (o_ & hm0); }
  unsigned win[16];
#pragma unroll
  for (int k = 0; k < 16; ++k) {
    unsigned m = cd[0];
#pragma unroll
    for (int i = 1; i < 25; ++i) m = umax(m, cd[i]);
    m = pair_max(m); win[k] = m;
#pragma unroll
    for (int i = 0; i < 25; ++i) cd[i] = (cd[i] == m) ? 0u : cd[i];
  }
  asm volatile("s_waitcnt lgkmcnt(0)" ::: "memory");
  const float smax = unsrt(win[0] & 0xffffff00u);
  float ex[16], den = 0.f;
#pragma unroll
  for (int k = 0; k < 16; ++k) { ex[k] = __builtin_amdgcn_exp2f((unsrt(win[k] & 0xffffff00u) - smax) * LOG2E); den += ex[k]; }
  const float rden = 1.0f / den; const unsigned hm = 0u - (unsigned)hi;
  int* eo = EIDX + (size_t)(t0 + r32) * 128 + wid * 2 + hi; float* go = EG + (size_t)(t0 + r32) * 128 + wid * 2 + hi;
#pragma unroll
  for (int kk = 0; kk < 8; ++kk) {
    const unsigned wv = (win[kk] & ~hm) | (win[8 + kk] & hm); const float gv = __uint_as_float((__float_as_uint(ex[kk]) & ~hm) | (__float_as_uint(ex[8 + kk]) & hm)) * rden;
    const int flat = 255 - (int)(wv & 255u), a = flat >> 4, bq = flat & 15;
    eo[kk * 16] = (int)scr[a] * 128 + (int)scr[16 + bq]; go[kk * 16] = gv;
  }
  asm volatile("s_waitcnt lgkmcnt(0)" ::: "memory");
}
}

typedef float f32x2 __attribute__((ext_vector_type(2)));
typedef int i32x4 __attribute__((ext_vector_type(4)));
constexpr float U_SCALE = 128.f, V_SCALE = 4.f;
constexpr int NSLICE = 8, SLICE_COLS = 256;
template <int CTRL> __device__ __forceinline__ float dpp_mov(float v) { return __int_as_float(__builtin_amdgcn_update_dpp(0, __float_as_int(v), CTRL, 0xf, 0xf, false)); }
__device__ __forceinline__ void pe_load_ids(const int* __restrict__ EIDX, int t, int g, int (&id)[16]) {
#pragma unroll
  for (int q = 0; q < 4; ++q) { const i32x4 v = *reinterpret_cast<const i32x4*>(EIDX + (size_t)t * 128 + g * 16 + 4 * q); id[4 * q] = v[0]; id[4 * q + 1] = v[1]; id[4 * q + 2] = v[2]; id[4 * q + 3] = v[3]; }
}
__device__ __forceinline__ void pe_issue_segs(const unsigned char* __restrict__ TB, const int (&id)[16], int coff, u32x4 (&seg)[16]) {
#pragma unroll
  for (int i = 0; i < 16; ++i) { const unsigned off = (unsigned)id[i] * 128u + (unsigned)coff; seg[i] = *reinterpret_cast<const u32x4*>(TB + off); }
}
typedef int v8i __attribute__((ext_vector_type(8)));
__device__ __forceinline__ void pe_x8_load(const unsigned char* __restrict__ X8, int t, unsigned xoff, u32x4 (&xw)[4]) {
  const unsigned char* xp = X8 + (size_t)t * DM + xoff;
  xw[0] = *reinterpret_cast<const u32x4*>(xp); xw[1] = *reinterpret_cast<const u32x4*>(xp + 64); xw[2] = *reinterpret_cast<const u32x4*>(xp + 128); xw[3] = *reinterpret_cast<const u32x4*>(xp + 192);
}
__device__ __forceinline__ void peer_u_pass(const unsigned char* __restrict__ X8, const unsigned char* __restrict__ U4, const int* __restrict__ EIDX, float* __restrict__ HPs, char* wlds, int t0, int dt, int n, int s, int lane) {
  const int g = lane >> 3, j = lane & 7, e16 = lane & 15, g4 = lane >> 4, c = lane & 15;
  const int coff = s * (NEXP * 128) + 16 * j; const unsigned xoff = (unsigned)(s * SLICE_COLS + 16 * g4);
  int idn[16]; u32x4 seg[16]; u32x4 xC[4], xN[4];
  pe_load_ids(EIDX, t0, g, idn); pe_issue_segs(U4, idn, coff, seg); pe_x8_load(X8, t0, xoff, xN);
  pe_load_ids(EIDX, t0 + (n > 1 ? dt : 0), g, idn);
#pragma unroll 1
  for (int it = 0; it < n; ++it) {
    const int t = t0 + it * dt, tn = t0 + (it + 1 < n ? it + 1 : n - 1) * dt, tnn = t0 + (it + 2 < n ? it + 2 : n - 1) * dt;
#pragma unroll
    for (int i = 0; i < 16; ++i) { const int row = 16 * g + i; *reinterpret_cast<u32x4*>(wlds + row * 128 + ((j ^ (row & 7)) << 4)) = seg[i]; }
#pragma unroll
    for (int p = 0; p < 4; ++p) xC[p] = xN[p];
    pe_issue_segs(U4, idn, coff, seg); pe_x8_load(X8, tn, xoff, xN);
    pe_load_ids(EIDX, tnn, g, idn);
    asm volatile("s_waitcnt lgkmcnt(0)" ::: "memory");
    f32x4 acc[8];
#pragma unroll
    for (int G = 0; G < 8; ++G) acc[G] = (f32x4){0.f, 0.f, 0.f, 0.f};
#pragma unroll
    for (int kh = 0; kh < 2; ++kh) {
      const v8i b = {(int)xC[2 * kh][0], (int)xC[2 * kh][1], (int)xC[2 * kh][2], (int)xC[2 * kh][3], (int)xC[2 * kh + 1][0], (int)xC[2 * kh + 1][1], (int)xC[2 * kh + 1][2], (int)xC[2 * kh + 1][3]};
#pragma unroll
      for (int G = 0; G < 8; ++G) { const int row = 16 * G + e16; const u32x4 sw = *reinterpret_cast<const u32x4*>(wlds + row * 128 + (((4 * kh + g4) ^ (row & 7)) << 4));
        const v8i a = {(int)sw[0], (int)sw[1], (int)sw[2], (int)sw[3], 0, 0, 0, 0};
        acc[G] = __builtin_amdgcn_mfma_scale_f32_16x16x128_f8f6f4(a, b, acc[G], 4  , 0  , 0, 0x7F7F7F7F  , 0, 0x7F7F7F7F); }
    }
    float s0[8], s1[8];
#pragma unroll
    for (int G = 0; G < 8; ++G) { s0[G] = (c & 1) ? acc[G][2] : acc[G][0]; s1[G] = (c & 1) ? acc[G][3] : acc[G][1]; }
    const int Gs = c >> 1;
    const float a0 = (Gs & 4) ? ((Gs & 2) ? ((Gs & 1) ? s0[7] : s0[6]) : ((Gs & 1) ? s0[5] : s0[4])) : ((Gs & 2) ? ((Gs & 1) ? s0[3] : s0[2]) : ((Gs & 1) ? s0[1] : s0[0]));
    const float a1 = (Gs & 4) ? ((Gs & 2) ? ((Gs & 1) ? s1[7] : s1[6]) : ((Gs & 1) ? s1[5] : s1[4])) : ((Gs & 2) ? ((Gs & 1) ? s1[3] : s1[2]) : ((Gs & 1) ? s1[1] : s1[0]));
    *reinterpret_cast<f32x2*>(HPs + (size_t)t * 128 + 16 * Gs + 4 * g4 + 2 * (c & 1)) = (f32x2){a0, a1};
  }
}
typedef int v2i __attribute__((ext_vector_type(2)));
__device__ __forceinline__ void peer_v_pass(const unsigned char* __restrict__ A8, const unsigned char* __restrict__ V4, const int* __restrict__ EIDX, bf16* __restrict__ Y, char* wlds, int t0, int dt, int n, int s, int lane) {
  const int g = lane >> 3, j = lane & 7, e16 = lane & 15, g4 = lane >> 4;
  const int coff = s * (NEXP * 128) + 16 * j;
  int idn[16]; u32x4 seg[16]; u32x4 aC[2], aN[2];
#define PE_ALOAD(t, aw) do { const unsigned char* ap_ = A8 + (size_t)(t) * 128 + 16 * g4; aw[0] = *reinterpret_cast<const u32x4*>(ap_); aw[1] = *reinterpret_cast<const u32x4*>(ap_ + 64); } while (0)
  pe_load_ids(EIDX, t0, g, idn); pe_issue_segs(V4, idn, coff, seg); PE_ALOAD(t0, aN);
  pe_load_ids(EIDX, t0 + (n > 1 ? dt : 0), g, idn);
#pragma unroll 1
  for (int it = 0; it < n; ++it) {
    const int t = t0 + it * dt, tn = t0 + (it + 1 < n ? it + 1 : n - 1) * dt, tnn = t0 + (it + 2 < n ? it + 2 : n - 1) * dt;
#pragma unroll
    for (int i = 0; i < 16; ++i) { const int row = 16 * g + i; *reinterpret_cast<u32x4*>(wlds + row * 128 + ((j ^ (row & 7)) << 4)) = seg[i]; }
    aC[0] = aN[0]; aC[1] = aN[1];
    pe_issue_segs(V4, idn, coff, seg); PE_ALOAD(tn, aN);
    pe_load_ids(EIDX, tnn, g, idn);
    asm volatile("s_waitcnt lgkmcnt(0)" ::: "memory");
    const v8i a = {(int)aC[0][0], (int)aC[0][1], (int)aC[0][2], (int)aC[0][3], (int)aC[1][0], (int)aC[1][1], (int)aC[1][2], (int)aC[1][3]};
    const int r0 = 32 * g4 + e16, r1 = r0 + 16;
    float yv[4];
#pragma unroll
    for (int q = 0; q < 4; ++q) yv[q] = 0.f;
#pragma unroll
    for (int cb = 0; cb < 16; ++cb) {
      const v2i b0 = __builtin_amdgcn_ds_read_tr4_b64_v2i32((LAS v2i*)(wlds + r0 * 128 + ((((cb >> 1) ^ (r0 & 7)) << 4) | ((cb & 1) << 3))));
      const v2i b1 = __builtin_amdgcn_ds_read_tr4_b64_v2i32((LAS v2i*)(wlds + r1 * 128 + ((((cb >> 1) ^ (r1 & 7)) << 4) | ((cb & 1) << 3))));
      const v8i b = {b0[0], b0[1], b1[0], b1[1], 0, 0, 0, 0};
      const f32x4 d = __builtin_amdgcn_mfma_scale_f32_16x16x128_f8f6f4(a, b, (f32x4){0.f, 0.f, 0.f, 0.f}, 0  , 4  , 0, 0x79797979  , 0, 0x7D7D7D7D  );
      if ((cb & 3) == 0) yv[cb >> 2] = d[0];
      else yv[cb >> 2] = ((cb & 3) == g4) ? d[0] : yv[cb >> 2];
    }
#pragma unroll
    for (int q = 0; q < 4; ++q) Y[(size_t)t * DM + s * SLICE_COLS + 16 * (4 * q + g4) + e16] = (bf16)(cvt_pk(yv[q], 0.f) & 0xffffu);
  }
#undef PE_ALOAD
}
__device__ __forceinline__ void v4c_relayout_item(const unsigned char* __restrict__ V4, unsigned char* __restrict__ V4C, int s, int eb, int lane) {
  const int e = 64 * eb + lane; const unsigned char* src = V4 + (size_t)s * (NEXP * 128) + (size_t)e * 128;
  u32x4 w[8];
#pragma unroll
  for (int q = 0; q < 8; ++q) w[q] = *reinterpret_cast<const u32x4*>(src + 16 * q);
#pragma unroll
  for (int q = 0; q < 8; ++q) {
    *reinterpret_cast<u32x2*>(V4C + (size_t)(16 * s + 2 * q) * (NEXP * 8) + (size_t)e * 8) = (u32x2){w[q][0], w[q][1]};
    *reinterpret_cast<u32x2*>(V4C + (size_t)(16 * s + 2 * q + 1) * (NEXP * 8) + (size_t)e * 8) = (u32x2){w[q][2], w[q][3]}; }
}
__device__ __forceinline__ void eidp_item(const int* __restrict__ EIDX, unsigned* __restrict__ EIDP, int t4, int lane) {
  const int i16 = lane & 15, g4 = lane >> 4; u32x4 w;
#pragma unroll
  for (int e = 0; e < 4; ++e) { const int* r = EIDX + (size_t)(4 * t4 + e) * 128 + 32 * g4 + i16; const unsigned ia = (unsigned)r[0], ib = (unsigned)r[16]; w[e] = (ia ^ ((ia >> 7) & 31u)) | ((ib ^ ((ib >> 7) & 31u)) << 16); }
  *reinterpret_cast<u32x4*>(EIDP + ((size_t)t4 * 64 + lane) * 4) = w;
}
__device__ __forceinline__ void peer_v_pass2(const unsigned char* __restrict__ A8, const unsigned char* __restrict__ V4C, const unsigned* __restrict__ EIDP, bf16* __restrict__ Y, char* lds, int c, int tbeg, int ntok, int wave, int lane) {
  { const int tid = wave * 64 + lane; const unsigned char* tb = V4C + (size_t)c * (NEXP * 8);
#pragma unroll
    for (int i = 0; i < 16; ++i) { const int r2 = i * 512 + tid; const u32x4 w = *reinterpret_cast<const u32x4*>(tb + r2 * 16); const int m = (r2 >> 6) & 31;
      *reinterpret_cast<u32x2*>(lds + ((2 * r2) ^ m) * 8) = (u32x2){w[0], w[1]}; *reinterpret_cast<u32x2*>(lds + ((2 * r2 + 1) ^ m) * 8) = (u32x2){w[2], w[3]}; } }
  __syncthreads();
  const int i16 = lane & 15, g4 = lane >> 4;
  const int nstep = ntok / (16 * 8);
  const unsigned char* abase = A8 + (size_t)i16 * 128 + 16 * g4;
  const unsigned* ibase = EIDP + (size_t)lane * 4;
  bf16* ybase = Y + (size_t)(4 * g4) * DM + 16 * c + i16;
#define PV_LOAD(AW, ID, step) do { const int t0_ = tbeg + 16 * (wave + 8 * ((step) < nstep ? (step) : nstep - 1)); \
    AW[0] = *reinterpret_cast<const u32x4*>(abase + (size_t)t0_ * 128); AW[1] = *reinterpret_cast<const u32x4*>(abase + (size_t)t0_ * 128 + 64); \
    _Pragma("unroll") for (int j = 0; j < 4; ++j) ID[j] = *reinterpret_cast<const u32x4*>(ibase + ((size_t)(t0_ >> 2) + j) * 256); } while (0)
#define PV_READ(ID, j) do { _Pragma("unroll") for (int e = 0; e < 4; ++e) { const unsigned pk = ID[j][e]; \
      b0[j][e] = __builtin_amdgcn_ds_read_tr4_b64_v2i32((LAS v2i*)(lds + ((pk & 0xffffu) << 3))); \
      b1[j][e] = __builtin_amdgcn_ds_read_tr4_b64_v2i32((LAS v2i*)(lds + ((pk >> 16) << 3))); } __builtin_amdgcn_sched_barrier(0); } while (0)
#define PV_MMA(j) do { f32x4 d[4]; _Pragma("unroll") for (int e = 0; e < 4; ++e) { const v8i b = {b0[j][e][0], b0[j][e][1], b1[j][e][0], b1[j][e][1], 0, 0, 0, 0}; \
      d[e] = __builtin_amdgcn_mfma_scale_f32_16x16x128_f8f6f4(a, b, (f32x4){0.f, 0.f, 0.f, 0.f}, 0  , 4  , 0, 0x79797979  , 0, 0x7D7D7D7D  ); } \
    _Pragma("unroll") for (int e = 0; e < 4; ++e) y[e] = (g4 == j) ? d[e][e] : y[e]; __builtin_amdgcn_sched_barrier(0); } while (0)
#define PV_COMPUTE(AW, ID, step) do { const int t0_ = tbeg + 16 * (wave + 8 * (step)); \
    const v8i a = {(int)AW[0][0], (int)AW[0][1], (int)AW[0][2], (int)AW[0][3], (int)AW[1][0], (int)AW[1][1], (int)AW[1][2], (int)AW[1][3]}; \
    float y[4] = {0.f, 0.f, 0.f, 0.f}; v2i b0[4][4], b1[4][4]; \
    PV_READ(ID, 0); PV_READ(ID, 1); PV_MMA(0); PV_READ(ID, 2); PV_MMA(1); PV_READ(ID, 3); PV_MMA(2); PV_MMA(3); \
    _Pragma("unroll") for (int e = 0; e < 4; ++e) { const __bf16 yh = (__bf16)y[e]; ybase[(size_t)(t0_ + e) * DM] = __builtin_bit_cast(unsigned short, yh); } } while (0)
  u32x4 A0[2], A1[2], A2[2], A3[2], I0[4], I1[4], I2[4], I3[4];
  PV_LOAD(A0, I0, 0); PV_LOAD(A1, I1, 1); PV_LOAD(A2, I2, 2);
#pragma unroll 1
  for (int k = 0; k < nstep; k += 4) {
    PV_LOAD(A3, I3, k + 3); PV_COMPUTE(A0, I0, k);
    PV_LOAD(A0, I0, k + 4); PV_COMPUTE(A1, I1, k + 1);
    PV_LOAD(A1, I1, k + 5); PV_COMPUTE(A2, I2, k + 2);
    PV_LOAD(A2, I2, k + 6); PV_COMPUTE(A3, I3, k + 3);
  }
#undef PV_LOAD
#undef PV_COMPUTE
#undef PV_READ
#undef PV_MMA
  __syncthreads();
}
__device__ __forceinline__ void ln2_phase(const bf16* __restrict__ X1, const bf16* __restrict__ Y, const float* __restrict__ g, const float* __restrict__ bta, float* __restrict__ O, int gw, int ngw, int lane) {
  f32x4 gv[8], bv[8];
#pragma unroll
  for (int j = 0; j < 4; ++j) { const int e0 = 512 * j + 8 * lane;
    gv[2 * j] = *reinterpret_cast<const f32x4*>(g + e0); gv[2 * j + 1] = *reinterpret_cast<const f32x4*>(g + e0 + 4);
    bv[2 * j] = *reinterpret_cast<const f32x4*>(bta + e0); bv[2 * j + 1] = *reinterpret_cast<const f32x4*>(bta + e0 + 4); }
  u32x4 na[4], nb[4];
  if (gw < NTOK) {
#pragma unroll
    for (int j = 0; j < 4; ++j) { na[j] = *reinterpret_cast<const u32x4*>(X1 + (size_t)gw * DM + 512 * j + 8 * lane); nb[j] = *reinterpret_cast<const u32x4*>(Y + (size_t)gw * DM + 512 * j + 8 * lane); } }
  for (int m = gw; m < NTOK; m += ngw) {
    float v[32]; float s = 0.f;
#pragma unroll
    for (int j = 0; j < 4; ++j) {
#pragma unroll
      for (int q = 0; q < 4; ++q) { v[8 * j + 2 * q] = fmaf(ALPHA, bf_lo(na[j][q]), bf_lo(nb[j][q])); v[8 * j + 2 * q + 1] = fmaf(ALPHA, bf_hi(na[j][q]), bf_hi(nb[j][q])); } }
    if (m + ngw < NTOK) {
#pragma unroll
      for (int j = 0; j < 4; ++j) { na[j] = *reinterpret_cast<const u32x4*>(X1 + (size_t)(m + ngw) * DM + 512 * j + 8 * lane); nb[j] = *reinterpret_cast<const u32x4*>(Y + (size_t)(m + ngw) * DM + 512 * j + 8 * lane); } }
#pragma unroll
    for (int i = 0; i < 32; ++i) s += v[i];
    const float mean = wave_sum(s) * (1.f / DM); float s2 = 0.f;
#pragma unroll
    for (int i = 0; i < 32; ++i) { v[i] -= mean; s2 = fmaf(v[i], v[i], s2); }
    const float rstd = 1.0f / sqrtf(wave_sum(s2) * (1.f / DM) + LN_EPS);
    float* orow = O + (size_t)m * DM;
#pragma unroll
    for (int j = 0; j < 4; ++j) { const int e0 = 512 * j + 8 * lane;
      f32x4 o0, o1;
#pragma unroll
      for (int e = 0; e < 4; ++e) { o0[e] = v[8 * j + e] * rstd * gv[2 * j][e] + bv[2 * j][e]; o1[e] = v[8 * j + 4 + e] * rstd * gv[2 * j + 1][e] + bv[2 * j + 1][e]; }
      *reinterpret_cast<f32x4*>(orow + e0) = o0; *reinterpret_cast<f32x4*>(orow + e0 + 4) = o1; }
  }
}
__device__ __forceinline__ void cvt_stream_fp4(const float* __restrict__ src, unsigned char* __restrict__ dst, size_t n32, float scale, size_t gtid, size_t gsz) {
  for (size_t i0 = gtid; i0 < n32; i0 += 2 * gsz) {
    f32x4 a[2][8];
#pragma unroll
    for (int h = 0; h < 2; ++h) { const size_t i = i0 + h * gsz; if (i < n32) {
#pragma unroll
      for (int q = 0; q < 8; ++q) a[h][q] = *reinterpret_cast<const f32x4*>(src + i * 32 + 4 * q); } }
#pragma unroll
    for (int h = 0; h < 2; ++h) { const size_t i = i0 + h * gsz; if (i < n32) {
      u32x4 w;
#pragma unroll
      for (int q = 0; q < 4; ++q) { const f32x4 x = a[h][2 * q] * scale, y = a[h][2 * q + 1] * scale;
        unsigned p = __builtin_amdgcn_cvt_scalef32_pk_fp4_f32(0u, x[0], x[1], 1.0f, 0); p = __builtin_amdgcn_cvt_scalef32_pk_fp4_f32(p, x[2], x[3], 1.0f, 1);
        p = __builtin_amdgcn_cvt_scalef32_pk_fp4_f32(p, y[0], y[1], 1.0f, 2); p = __builtin_amdgcn_cvt_scalef32_pk_fp4_f32(p, y[2], y[3], 1.0f, 3); w[q] = p; }
      const size_t e = i >> 6, c16 = i & 63;
      *reinterpret_cast<u32x4*>(dst + (c16 >> 3) * ((size_t)NEXP * 128) + e * 128 + (c16 & 7) * 16) = w; } }
  }
}
__device__ __forceinline__ void peer_tables_share(const float* __restrict__ u, const float* __restrict__ v, unsigned char* __restrict__ U4, unsigned char* __restrict__ V4, int bx, int G) {
  int t = my_tid(); asm volatile("" : "+v"(t));
  const size_t gtid = (size_t)bx * 512 + t, gsz = (size_t)G * 512;
  cvt_stream_fp4(u, U4, (size_t)NEXP * DM / 32, U_SCALE, gtid, gsz);
  cvt_stream_fp4(v, V4, (size_t)NEXP * DM / 32, V_SCALE, gtid, gsz);
}
constexpr int TBL_NCH = 256;
__device__ __forceinline__ void peer_tables_chunk(const float* __restrict__ u, const float* __restrict__ v, unsigned char* __restrict__ U4, unsigned char* __restrict__ V4, int c) {
  int t = my_tid(); asm volatile("" : "+v"(t));
  const bool isv = c >= TBL_NCH; const int cc = isv ? c - TBL_NCH : c;
  const size_t gtid = (size_t)cc * 512 + t, gsz = (size_t)TBL_NCH * 512;
  cvt_stream_fp4(isv ? v : u, isv ? V4 : U4, (size_t)NEXP * DM / 32, isv ? V_SCALE : U_SCALE, gtid, gsz);
}

#define XB_TMO      128
#define XB_XCNT(j)  (256  + 64 * (j))
#define XB_XSUB(j)  (1280 + 64 * (j))
#define XB_XGEN(j)  (2304 + 64 * (j))
#define XB_TOP      3328
#define XB_TOPGEN   3392
#define XCD_BAR_WORDS 3456
#define XQ_TBL      3584
#define XB_SPIN_CAP (1u << 18)

__device__ __forceinline__ unsigned xb_ld(unsigned* p)              { return __hip_atomic_load(p, __ATOMIC_RELAXED, __HIP_MEMORY_SCOPE_AGENT); }
__device__ __forceinline__ unsigned xb_add(unsigned* p, unsigned v) { return __hip_atomic_fetch_add(p, v, __ATOMIC_RELAXED, __HIP_MEMORY_SCOPE_AGENT); }
__device__ __forceinline__ unsigned xb_xcc_id() { return (unsigned)__builtin_amdgcn_s_getreg((3 << 11) | 20) & 0xFu; }
#define XB_SPIN(cond, bar) do { unsigned _sp = 0; while (cond) { __builtin_amdgcn_s_sleep(1); \
    if ((++_sp & 255u) == 0u) { if (xb_ld(&(bar)[XB_TMO])) break; if (_sp > XB_SPIN_CAP) { atomicAdd(&(bar)[XB_TMO], 1u); break; } } } } while (0)

struct XcdBarrier {
    unsigned* bar; unsigned x;
    volatile LAS unsigned* st;
};

__device__ __forceinline__ XcdBarrier xcd_barrier_post(unsigned* bar, volatile LAS unsigned* st) {
    XcdBarrier b; b.bar = bar; b.x = xb_xcc_id(); b.st = st;
    if (threadIdx.x == 0) (void)xb_add(&bar[XB_XCNT(b.x)], 1u);
    return b;
}
__device__ __forceinline__ void xcd_barrier_complete(unsigned* bar, unsigned x, unsigned& nloc, unsigned& nx) {
    const unsigned G = gridDim.x * gridDim.y * gridDim.z;
    unsigned sum, cnt, mine, sp = 0u;
    for (;;) {
        sum = 0u; cnt = 0u; mine = 0u;
#pragma unroll
        for (unsigned j = 0; j < 16; ++j) { const unsigned c = xb_ld(&bar[XB_XCNT(j)]); sum += c; cnt += (c > 0u) ? 1u : 0u; mine = (j == x) ? c : mine; }
        if (sum == G) break;
        __builtin_amdgcn_s_sleep(1);
        if ((++sp & 255u) == 0u) { if (xb_ld(&bar[XB_TMO])) break; if (sp > XB_SPIN_CAP) { atomicAdd(&bar[XB_TMO], 1u); break; } }
    }
    nloc = mine > 0u ? mine : 1u; nx = cnt > 0u ? cnt : 1u;
}

__device__ __forceinline__ void xcd_barrier(const XcdBarrier& b) {
    asm volatile("s_waitcnt vmcnt(0)" ::: "memory");
    __syncthreads();
    if (my_tid() == 0) {
        unsigned* bar = b.bar;
        __builtin_amdgcn_s_waitcnt(0);
        unsigned nloc = b.st[0], nx = b.st[1];
        if (nloc == 0u) { xcd_barrier_complete(bar, b.x, nloc, nx); b.st[0] = nloc; b.st[1] = nx; }
        const unsigned old = xb_add(&bar[XB_XSUB(b.x)], 1u);
        const unsigned gen = old / nloc;
        if (old + 1u == (gen + 1u) * nloc) {
            __builtin_amdgcn_fence(__ATOMIC_RELEASE, "agent");
            asm volatile("s_waitcnt vmcnt(0)" ::: "memory");
            const unsigned og = xb_add(&bar[XB_TOP], 1u);
            const unsigned tg = og / nx;
            if (og + 1u == (tg + 1u) * nx) xb_add(&bar[XB_TOPGEN], 1u);
            else XB_SPIN(xb_ld(&bar[XB_TOPGEN]) == tg, bar);
            __builtin_amdgcn_fence(__ATOMIC_ACQUIRE, "agent");
            asm volatile("s_waitcnt vmcnt(0)" ::: "memory");
        } else {
            XB_SPIN(xb_ld(&bar[XB_TOPGEN]) == gen, bar);
            __builtin_amdgcn_fence(__ATOMIC_ACQUIRE, "agent");
            asm volatile("s_waitcnt vmcnt(0)" ::: "memory");
        }
    }
    __syncthreads();
}


__device__ __forceinline__ void flat_barrier(unsigned* bar) {
    asm volatile("s_waitcnt vmcnt(0)" ::: "memory");
    __syncthreads();
    if (threadIdx.x == 0) {
        const unsigned G = gridDim.x;
        __builtin_amdgcn_fence(__ATOMIC_RELEASE, "agent");
        asm volatile("s_waitcnt vmcnt(0)" ::: "memory");
        const unsigned old = xb_add(&bar[XB_TOP], 1u);
        const unsigned target = (old / G + 1u) * G;
        XB_SPIN(xb_ld(&bar[XB_TOP]) < target, bar);
        __builtin_amdgcn_fence(__ATOMIC_ACQUIRE, "agent");
        asm volatile("s_waitcnt vmcnt(0)" ::: "memory");
    }
    __syncthreads();
}
struct Args {
  const float* in[17];
  float* out; unsigned char* ws; int ph_lo, ph_hi;
};
constexpr int N_PHASES = 12;

__global__ void __launch_bounds__(512, 2) mega_fwd(Args args) {
  extern __shared__ __attribute__((aligned(16))) unsigned char lds_raw[];
  LAS unsigned char* ldsl = (LAS unsigned char*)lds_raw;
  char* lds = (char*)lds_raw;
  { const int t0_ = threadIdx.x; if ((t0_ & 63) == 0) ((volatile unsigned char*)lds_raw)[HWTAB_OFF + hw_slot()] = (unsigned char)(t0_ >> 6); }
  __syncthreads();
  const int wave = my_wave();
#define lane (my_lane())
#define tid (wave * 64 + my_lane())
  const int G = gridDim.x, bx = blockIdx.x;
  unsigned char* ws = args.ws;
  const float* x = args.in[0];
  bf16* XB = (bf16*)(ws + WS_XB); unsigned char* ATT = ws + WS_X1F8; bf16* PQ = XB;
  bf16* PROJ = (bf16*)(ws + WS_PROJ); bf16* ZB = (bf16*)(ws + WS_PROJ); bf16* YB = (bf16*)(ws + WS_PROJ + 128 * MiB);
  int* EIDX = (int*)(ws + WS_EIDX); float* EG = (float*)(ws + WS_EG);
  bf16* X1B = (bf16*)(ws + WS_X1B); unsigned char* U8 = ws + WS_U8; unsigned char* V8 = ws + WS_V8; unsigned char* V4C = ws + WS_V4C; unsigned char* XB8 = ws + WS_X1F8; unsigned char* WIN8 = ws + WS_WIN; constexpr int N_F8 = C_SK;     unsigned* EIDP = (unsigned*)(ws + WS_EIDP);
  unsigned char* A8 = ws + WS_A8; unsigned* ctl = (unsigned*)(ws + WS_CTL); unsigned char* X1F8 = ws + WS_X1F8;
  bf16* WIN = (bf16*)(ws + WS_WIN); unsigned char* WO = ws + WS_WO; bf16* WQ = (bf16*)(ws + WS_WQ);
  const int lo = args.ph_lo, hi_ph = args.ph_hi;
#if MK_ONE_LAUNCH
  volatile LAS unsigned* misc = (volatile LAS unsigned*)(ldsl + LDS_BYTES - 64);
  XcdBarrier xbar; xbar.bar = ctl; xbar.x = xb_xcc_id(); xbar.st = misc + 2;
  if (tid == 0) { misc[2] = 0u; misc[3] = 0u; misc[0] = xb_add(&ctl[XB_XCNT(xbar.x)], 1u); }
  __syncthreads();
  const int my_xcc = (int)xbar.x, my_rank = __builtin_amdgcn_readfirstlane((int)misc[0]);
#endif
#if MK_ONE_LAUNCH
#define GRID_SYNC() xcd_barrier(xbar)
#else
#define GRID_SYNC() do {} while (0)
#endif
#ifndef PH_MASK
#define PH_MASK 0xfff
#endif
#ifndef REP_MASK
#define REP_MASK 0
#endif
#define IN(k) (((PH_MASK >> (k)) & 1) && lo <= (k) && (k) < hi_ph)
#define REP(k)
#define SEAM(k) do { if (IN(k) && IN((k) + 1)) GRID_SYNC(); } while (0)

  REP(0) if (IN(0)) {
    const size_t gtid = (size_t)bx * 512 + tid, gsz = (size_t)G * 512;
    cvt_stream2(x, XB, XB8, (size_t)NTOK * DM / 8, gtid, gsz);
    LAS float* scr = (LAS float*)(ldsl + wave * 8704);
    const int gw = bx * 8 + wave, NGW = G * 8;
    constexpr int I_IN = (DM / 64) * (LDP / 32), I_SQ = (DM / 64) * (DM / 32);
    for (int it = gw; it < I_IN + 2 * I_SQ; it += NGW) {
      if (it < I_IN) { const int kb = it / (LDP / 32), nb = it % (LDP / 32);
        if (nb < N_F8 / 32) transpose_item_fp8(args.in[1], DM, NPROJ, WIN8, scr, kb, nb, lane, 64.f);
        else transpose_item(args.in[1], DM, NPROJ, WIN, scr, kb, nb, lane); }
      else if (it < I_IN + I_SQ) { const int r = it - I_IN; transpose_item_fp8(args.in[2], DM, DM, WO, scr, r / (DM / 32), r % (DM / 32), lane, 64.f); }
      else { const int r = it - I_IN - I_SQ; transpose_item(args.in[10], DM, DM, WQ, scr, r / (DM / 32), r % (DM / 32), lane); }
    }
    __syncthreads();
  }
  SEAM(0);
  int vx = bx & 7, vrank = bx >> 3; const int nloc = G >> 3;
#if MK_ONE_LAUNCH
  {
    int npop = 0, before = 0; bool regular = true;
#pragma unroll
    for (int q = 0; q < 16; ++q) { const int cq = (int)__hip_atomic_load(ctl + XB_XCNT(q), __ATOMIC_RELAXED, __HIP_MEMORY_SCOPE_AGENT); if (cq > 0) { ++npop; if (q < my_xcc) ++before; if (cq != nloc) regular = false; } }
    if (regular && npop == 8 && (G & 7) == 0) { vx = before; vrank = my_rank; }
  }
#endif
  const int vcu = vrank * 8 + vx;
  REP(1) if (IN(1)) {
    { pg8::Gemm g{(const pg8::bf16_t*)XB8, (const pg8::bf16_t*)WIN8, NTOK, N_F8, DM}; pg8::StaticOrder S; S.init(NTOK, N_F8, G, vcu);
      pg8::EpiBf16<0> E{PROJ, LDP, nullptr, N_F8, 0, 1.0f / 64.0f};
      pg8::gemm_phase<pg8::EpiBf16<0>, pg8::StaticOrder, true, true, true, 0x7F7F7F7F>(ldsl, g, S, E); }
    __syncthreads();
    { pg8::Gemm g{XB, WIN + (size_t)N_F8 * DM, NTOK, LDP - N_F8, DM}; pg8::StaticOrder S; S.init(NTOK, LDP - N_F8, G, vcu);
      pg8::EpiBf16<0> E{PROJ + N_F8, LDP, nullptr, 0, 0, 1.f};
      pg8::gemm_phase<pg8::EpiBf16<0>, pg8::StaticOrder, true, true>(ldsl, g, S, E); }
    __syncthreads();
  }
  SEAM(1);
  REP(2) if (IN(2)) {
    float lam;
    { const float a = args.in[3][lane] * args.in[4][lane], b = args.in[5][lane] * args.in[6][lane];
      lam = __expf(wave_sum(a)) - __expf(wave_sum(b)) + LAM_INIT; }
    for (int rnd = 0; rnd * G < 1024; ++rnd) {
      const int i = rnd * G + ((rnd & 1) ? (G - 1 - bx) : bx);
      if (i < 1024) { const int qb = 63 - (i >> 4), b = i & 15; att::attn_unit<1>(PROJ, ATT, b, 0, qb, lds, lam, args.in[7]); }
    }
  }
  REP(3) if (IN(3)) {
    float lam;
    { const float a = args.in[3][lane] * args.in[4][lane], b = args.in[5][lane] * args.in[6][lane];
      lam = __expf(wave_sum(a)) - __expf(wave_sum(b)) + LAM_INIT; }
    for (int rnd = 0; rnd * G < 2048; ++rnd) {
      const int j = rnd * G + ((rnd & 1) ? (G - 1 - bx) : bx);
      if (j < 2048) { const int qb = 15 - (j >> 7), bh = j & 127; att::attn_unit<0>(PROJ, ATT, bh >> 3, (bh + rnd) & 7, qb, lds, lam, args.in[7]); }
    }
    { volatile LAS unsigned* qw = (volatile LAS unsigned*)(ldsl + LDS_BYTES - 64) + 4;
      for (;;) {
        __syncthreads();
        if (my_tid() == 0) { unsigned* qp = ctl + XQ_TBL; asm volatile("" : "+s"(qp)); qw[0] = xb_add(qp, 1u); }
        __syncthreads();
        const int c = __builtin_amdgcn_readfirstlane((int)qw[0]);
        if (c >= 2 * TBL_NCH) break;
        peer_tables_chunk(args.in[13], args.in[14], U8, V8, c);
      } }
  }
  SEAM(3);
  REP(4) if (IN(4)) {
    pg8::Gemm g{(const pg8::bf16_t*)ATT, (const pg8::bf16_t*)WO, NTOK, DM, DM}; pg8::StaticOrder S; S.init(NTOK, DM, G, vcu);
    pg8::EpiResid E{(const pg8::bf16_t*)XB, ZB, DM, ALPHA, 1.0f / 64.0f};
    pg8::gemm_phase<pg8::EpiResid, pg8::StaticOrder, true, true, true, 0x7F7F7F7F>(ldsl, g, S, E);
    __syncthreads();
  }
  SEAM(4);
  REP(5) if (IN(5)) {
    const int gw = bx * 8 + wave, NGW = G * 8;
    ln1_phase(ZB, args.in[8], args.in[9], X1B, X1F8, gw, NGW, lane);
  }
  SEAM(5);
  REP(6) if (IN(6)) {
    pg8::Gemm g{X1B, WQ, NTOK, DM, DM}; pg8::StaticOrder S; S.init(NTOK, DM, G, vcu);
    pg8::EpiBf16<0> E{PQ, DM, nullptr, 0, 0, 1.f};
    pg8::gemm_phase<pg8::EpiBf16<0>, pg8::StaticOrder, true, true>(ldsl, g, S, E);
    __syncthreads();
  }
  SEAM(6);
  REP(7) if (IN(7)) {
    peer::load_keys(args.in[11], args.in[12], lds);
    __syncthreads();
    for (int u = bx; u < NTOK / 32; u += G) peer::score_unit(PQ, EIDX, EG, u * 32, lds);
    __syncthreads();
  }
  SEAM(7);
  float* HPA = (float*)(ws + WS_HPA);
  REP(8) if (IN(8)) {
    const int wv = vrank * 8 + wave, nwv = nloc * 8;
    peer_u_pass(X1F8, U8, EIDX, HPA + (size_t)vx * NTOK * 128, lds + wave * 16384, wv, nwv, NTOK / nwv, vx, lane);
  }
  SEAM(8);
  REP(9) if (IN(9)) {
    const size_t gtid = (size_t)bx * 512 + tid, gsz = (size_t)G * 512;
    for (size_t i = gtid; i < (size_t)NTOK * 32; i += gsz) {
      f32x4 h = *reinterpret_cast<const f32x4*>(HPA + i * 4);
#pragma unroll
      for (int sl = 1; sl < NSLICE; ++sl) h += *reinterpret_cast<const f32x4*>(HPA + (size_t)sl * NTOK * 128 + i * 4);
      const f32x4 gg = *reinterpret_cast<const f32x4*>(EG + i * 4); float a[4];
#pragma unroll
      for (int e = 0; e < 4; ++e) { const float hv = h[e] * (1.0f / U_SCALE); a[e] = 0.5f * hv * (1.0f + erff(hv * 0.70710678118654752f)) * gg[e] * 64.0f; }
      int p = __builtin_amdgcn_cvt_pk_fp8_f32(a[0], a[1], 0, false); p = __builtin_amdgcn_cvt_pk_fp8_f32(a[2], a[3], p, true);
      *reinterpret_cast<int*>(A8 + i * 4) = p;
    }
    for (int it = bx * 8 + wave; it < NTOK / 4; it += G * 8) eidp_item(EIDX, EIDP, it, lane);
    for (int it = bx * 8 + wave; it < 8 * (NEXP / 64); it += G * 8) v4c_relayout_item(V8, V4C, it / (NEXP / 64), it % (NEXP / 64), lane);
  }
  SEAM(9);
  REP(10) if (IN(10)) {
    for (int u = ((G & 7) == 0) ? vx * nloc + vrank : bx; u < 256; u += G) peer_v_pass2(A8, V4C, EIDP, YB, lds, u >> 1, (u & 1) * (NTOK / 2), NTOK / 2, wave, lane);
  }
  SEAM(10);
  REP(11) if (IN(11)) {
    const int gw = bx * 8 + wave, NGW = G * 8;
    ln2_phase(X1B, YB, args.in[15], args.in[16], args.out, gw, NGW, lane);
  }
#undef IN
#undef SEAM
#undef lane
#undef tid
}

#ifndef REP_MASK
#define REP_MASK 0
#endif
extern "C" void kernel_launch(void* const* d_in, const int* in_sizes, int n_in, void* d_out, int out_size, void* d_ws, size_t ws_size, hipStream_t stream) {
  static int grid = 0;
  if (grid == 0) {
    if (n_in != 17 || in_sizes[0] != NTOK * DM || out_size != NTOK * DM || ws_size < WS_END) {
      fprintf(stderr, "kernel_launch: unexpected shapes: n_in %d in0 %d out %d ws %zu (need >= %zu)\n", n_in, n_in > 0 ? in_sizes[0] : -1, out_size, ws_size, (size_t)WS_END); grid = -1; return; }
    int dev = 0, cus = 0, per_cu = 0;
    if (hipGetDevice(&dev) != hipSuccess || hipDeviceGetAttribute(&cus, hipDeviceAttributeMultiprocessorCount, dev) != hipSuccess) { grid = -1; return; }
    if (hipFuncSetAttribute((const void*)mega_fwd, hipFuncAttributeMaxDynamicSharedMemorySize, LDS_BYTES) != hipSuccess) { fprintf(stderr, "kernel_launch: hipFuncSetAttribute failed\n"); grid = -1; return; }
    if (hipOccupancyMaxActiveBlocksPerMultiprocessor(&per_cu, (const void*)mega_fwd, 512, LDS_BYTES) != hipSuccess || per_cu < 1) { fprintf(stderr, "kernel_launch: occupancy query says %d\n", per_cu); per_cu = 1; }
    (void)hipGetLastError();
    grid = cus * (per_cu > 1 ? 1 : per_cu);
  }
  if (grid < 0) return;
  Args a{};
  for (int i = 0; i < 17; ++i) a.in[i] = (const float*)d_in[i];
  a.out = (float*)d_out; a.ws = (unsigned char*)d_ws;
  if (hipMemsetAsync((char*)d_ws + WS_CTL, 0, 16384, stream) != hipSuccess) { fprintf(stderr, "kernel_launch: memset failed\n"); return; }
#if MK_ONE_LAUNCH
  a.ph_lo = 0; a.ph_hi = N_PHASES;
  void* kargs[] = {&a};
  hipError_t e = hipLaunchCooperativeKernel((const void*)mega_fwd, dim3(grid), dim3(512), kargs, LDS_BYTES, stream);
  if (e != hipSuccess) fprintf(stderr, "kernel_launch: cooperative launch failed: %s (grid %d)\n", hipGetErrorString(e), grid);
#else
  for (int p = 0; p < N_PHASES; ++p) {
    a.ph_lo = p; a.ph_hi = p + 1;
    for (int rep = 0; rep < (((REP_MASK >> p) & 1) ? 2 : 1); ++rep)
      hipLaunchKernelGGL(mega_fwd, dim3(grid), dim3(512), LDS_BYTES, stream, a);
  }
  const hipError_t le = hipPeekAtLastError();
  if (le != hipSuccess) fprintf(stderr, "kernel_launch: launch failed: %s\n", hipGetErrorName(le));
#endif
}
```

```cpp
#include <hip/hip_runtime.h>
#include <hip/hip_cooperative_groups.h>
#include <cstdio>
#include <cstdint>
namespace cg = cooperative_groups;

#ifndef MK_ONE_LAUNCH
#define MK_ONE_LAUNCH 1
#endif

constexpr int NB = 16, SEQ = 2048, DM = 2048, NTOK = NB * SEQ;
constexpr int NPROJ = 5456, LDP = 5632;
constexpr int C_DQ = 0, C_DK = 1024, C_DV = 2048, C_SQ = 3072, C_SK = 4096, C_SV = 4224, C_IQ = 4352, C_IK = 5376, C_IW = 5440;
constexpr int NEXP = 16384;
constexpr float LN_EPS = 1e-5f, RMS_EPS = 1e-5f;
constexpr float ALPHA = 1.189207115002721f;
constexpr float LAM_INIT = 0.2f;
constexpr float LOG2E = 1.4426950408889634f;

constexpr size_t MiB = (size_t)1 << 20;
constexpr size_t WS_XB = 0;
constexpr size_t WS_PROJ = 128 * MiB;
constexpr size_t WS_EIDX = 384 * MiB;
constexpr size_t WS_EG = 400 * MiB;
constexpr size_t WS_X1B = 480 * MiB;
constexpr size_t WS_V4C = 416 * MiB;
constexpr size_t WS_EIDP = 432 * MiB;
constexpr size_t WS_CTL = 774 * MiB;
constexpr size_t WS_U8 = 608 * MiB;
constexpr size_t WS_V8 = 640 * MiB;
constexpr size_t WS_HPA = 0;
constexpr size_t WS_X1F8 = 672 * MiB;
constexpr size_t WS_WIN = 736 * MiB;
constexpr size_t WS_WO = 758 * MiB;
constexpr size_t WS_WQ = 766 * MiB;
constexpr size_t WS_A8 = 775 * MiB;
constexpr size_t WS_END = 779 * MiB;

constexpr int LDS_BYTES = 147456;

typedef unsigned short bf16;
#define LAS __attribute__((address_space(3)))


constexpr int HWTAB_OFF = LDS_BYTES - 128;
__device__ __forceinline__ int hw_slot() { return (int)(__builtin_amdgcn_s_getreg((6 << 11) | 4  ) & 63u); }
__device__ __forceinline__ int my_lane() { int r; asm volatile("v_mbcnt_lo_u32_b32 %0, -1, 0\n\tv_mbcnt_hi_u32_b32 %0, -1, %0" : "=v"(r)); return r; }
__device__ __forceinline__ int my_wave() { extern __shared__ __attribute__((aligned(16))) unsigned char lds_raw[]; return __builtin_amdgcn_readfirstlane((int)((volatile unsigned char*)lds_raw)[HWTAB_OFF + hw_slot()]); }
__device__ __forceinline__ int my_tid() { return my_wave() * 64 + my_lane(); }
namespace pg8 {
#define PG8_LAS __attribute__((address_space(3)))
typedef unsigned short bf16_t;
typedef short bf16x8 __attribute__((ext_vector_type(8)));
typedef float f32x4 __attribute__((ext_vector_type(4)));
typedef unsigned u32x4 __attribute__((ext_vector_type(4)));
typedef int v8i_t __attribute__((ext_vector_type(8)));
typedef int i32x4_t __attribute__((ext_vector_type(4)));
__device__ __forceinline__ v8i_t cat8(bf16x8 lo, bf16x8 hi) { return __builtin_shufflevector(__builtin_bit_cast(i32x4_t, lo), __builtin_bit_cast(i32x4_t, hi), 0, 1, 2, 3, 4, 5, 6, 7); }
constexpr int BM = 256, BK = 64, HALF = 128, HTB = HALF * BK * 2  , STAGE_BYTES = 8 * HTB, NXCD = 8, WGM = 8;

__host__ __device__ __forceinline__ int lds_byte(int r, int c) { const int st = (r >> 4) * 2 + (c >> 5), rr = r & 15, cc = c & 31, ob = rr * 64 + cc * 2; return st * 1024 + (ob ^ (((ob >> 9) & 1) << 5)); }
__host__ __device__ __forceinline__ void stage_rc(int b, int& R, int& C) { const int st = b / 1024, sb = b % 1024, swz = sb ^ (((sb >> 9) & 1) << 5); R = (st >> 1) * 16 + swz / 64; C = (st & 1) * 32 + (swz % 64) / 2; }
__host__ __device__ __forceinline__ int perm32(int rho) { const int n = rho >> 4, i = rho & 15; return 8 * (i >> 2) + 4 * n + (i & 3); }

struct Unit { int pm, pn; };
struct Gemm { const bf16_t* A; const bf16_t* Bt; int M, N, K; };

struct StaticOrder {
    int nM, nN, nwg, G, c;
    __host__ __device__ void init(int M, int N, int G_, int c_) { nM = M / BM; nN = N / BM; nwg = nM * nN; G = G_; c = c_; }
    __host__ __device__ bool next(int i, Unit& u) const {
        const long L = (long)i * G + c; if (L >= nwg) return false;
        int wgid = (int)L; { const int q = nwg / NXCD, r = nwg % NXCD, xcd = wgid % NXCD, off = wgid / NXCD; wgid = (xcd < r ? xcd * (q + 1) : r * (q + 1) + (xcd - r) * q) + off; }
        const int nig = WGM * nN, gid = wgid / nig, fm = gid * WGM, gsz = (nM - fm) < WGM ? (nM - fm) : WGM;
        u.pm = fm + ((wgid % nig) % gsz); u.pn = (wgid % nig) / gsz; return true;
    }
    __device__ __forceinline__ void a_ready(const Unit&) const {}
    __device__ __forceinline__ void done(const Unit&) const {}
};
__device__ __forceinline__ unsigned cvt_pk_bf16(float lo, float hi) { unsigned r; asm volatile("v_cvt_pk_bf16_f32 %0, %1, %2" : "=v"(r) : "v"(lo), "v"(hi)); return r; }
typedef float f32x2 __attribute__((ext_vector_type(2)));
__device__ __forceinline__ f32x2 gelu_pk(f32x2 v) {
    const f32x2 av = __builtin_elementwise_abs(v), d = av * 0.2316418882f + 1.0f;
    f32x2 t; t.x = __builtin_amdgcn_rcpf(d.x); t.y = __builtin_amdgcn_rcpf(d.y);
    f32x2 q = t * 0.5307027145f + (-0.7265760135f); q = q * t + 0.7107068705f; q = q * t + (-0.142248368f); q = q * t + 0.127414796f; q = q * t;
    const f32x2 s = (v * v) * (-0.72134752044f);
    f32x2 e; e.x = __builtin_amdgcn_exp2f(s.x); e.y = __builtin_amdgcn_exp2f(s.y);
    const f32x2 m = v * (q * e), r = v - m;
    f32x2 o; o.x = v.x < 0.f ? m.x : r.x; o.y = v.y < 0.f ? m.y : r.y; return o;
}

template <int ACT  > struct EpiBf16 {
    static constexpr bool PERM = true, AFTER_DRAIN = false; static_assert(ACT == 0 || ACT == 1, "EpiBf16: ACT is 0 (none) or 1 (gelu_pk)");
    bf16_t* O; int ldc; const float* bias; int split_cols; size_t split_stride; float scale0;
    __device__ __forceinline__ void operator()(const f32x4 (&acc)[2][2][4][2], const Unit& u, int wr, int wc, int fr, int fq) const {
        const int row0 = u.pm * BM + wr * 64 + fr; int colt = u.pn * BM; bf16_t* base = O;
        float sc = 1.f; if (split_cols) { const int t = colt / split_cols; base += (size_t)t * split_stride; colt -= t * split_cols; if (t == 0) sc = scale0; }
        const int col0 = colt + wc * 32 + 8 * fq, bcol0 = u.pn * BM + wc * 32 + 8 * fq;
        f32x4 bv[2][2];
#pragma unroll
        for (int bj = 0; bj < 2; ++bj)
#pragma unroll
            for (int n = 0; n < 2; ++n) bv[bj][n] = bias ? *(const f32x4*)(bias + bcol0 + bj * HALF + 4 * n) : (f32x4){0.f, 0.f, 0.f, 0.f};
#pragma unroll
        for (int ai = 0; ai < 2; ++ai)
#pragma unroll
            for (int m = 0; m < 4; ++m) { bf16_t* rowp = base + (size_t)(row0 + ai * HALF + m * 16) * ldc + col0;
#pragma unroll
                for (int bj = 0; bj < 2; ++bj) { f32x4 v0 = acc[ai][bj][m][0] + bv[bj][0], v1 = acc[ai][bj][m][1] + bv[bj][1];
                    if (ACT == 1) { f32x2 a = gelu_pk((f32x2){v0[0], v0[1]}), b = gelu_pk((f32x2){v0[2], v0[3]}), c = gelu_pk((f32x2){v1[0], v1[1]}), d = gelu_pk((f32x2){v1[2], v1[3]});
                        v0 = (f32x4){a.x, a.y, b.x, b.y}; v1 = (f32x4){c.x, c.y, d.x, d.y}; }
                    v0 = v0 * sc; v1 = v1 * sc; u32x4 w; w.x = cvt_pk_bf16(v0[0], v0[1]); w.y = cvt_pk_bf16(v0[2], v0[3]); w.z = cvt_pk_bf16(v1[0], v1[1]); w.w = cvt_pk_bf16(v1[2], v1[3]);
                    *(u32x4*)(rowp + bj * HALF) = w; } }
    }
};
struct EpiResid {
    static constexpr bool PERM = true, AFTER_DRAIN = false;
    const bf16_t* X; bf16_t* Z; int ldc; float alpha; float accscale;
    __device__ __forceinline__ void operator()(const f32x4 (&acc)[2][2][4][2], const Unit& u, int wr_, int wc_, int fr_, int fq_) const {
        int t = my_lane(); asm volatile("" : "+v"(t));
        const int wv = my_wave(), wr = wv >> 2, wc = wv & 3, fr = t & 15, fq = t >> 4; (void)wr_; (void)wc_; (void)fr_; (void)fq_;
        const int row0 = u.pm * BM + wr * 64 + fr, col0 = u.pn * BM + wc * 32 + 8 * fq;
#pragma unroll
        for (int ai = 0; ai < 2; ++ai)
#pragma unroll
            for (int m = 0; m < 4; ++m) { const unsigned off = (unsigned)(row0 + ai * HALF + m * 16) * (unsigned)ldc + (unsigned)col0;
#pragma unroll
                for (int bj = 0; bj < 2; ++bj) { const u32x4 xw = *(const u32x4*)(X + off + bj * HALF);
                    const f32x4 x0 = {__uint_as_float(xw.x << 16), __uint_as_float(xw.x & 0xffff0000u), __uint_as_float(xw.y << 16), __uint_as_float(xw.y & 0xffff0000u)};
                    const f32x4 x1 = {__uint_as_float(xw.z << 16), __uint_as_float(xw.z & 0xffff0000u), __uint_as_float(xw.w << 16), __uint_as_float(xw.w & 0xffff0000u)};
                    const f32x4 v0 = x0 * alpha + acc[ai][bj][m][0] * accscale, v1 = x1 * alpha + acc[ai][bj][m][1] * accscale;
                    u32x4 w; w.x = cvt_pk_bf16(v0[0], v0[1]); w.y = cvt_pk_bf16(v0[2], v0[3]); w.z = cvt_pk_bf16(v1[0], v1[1]); w.w = cvt_pk_bf16(v1[2], v1[3]);
                    *(u32x4*)(Z + off + bj * HALF) = w; }
                asm volatile("" ::: "memory"); }
    }
};

template <class Epi, class Sched, bool ALIGN_EPI = false, bool SP2 = false, bool FP8 = false, int SCALE_B = 0x7F7F7F7F>
__device__ __forceinline__ void gemm_phase(PG8_LAS unsigned char* lds, const Gemm g, const Sched& S, const Epi& E) {
    const int tid = my_tid(), wid = __builtin_amdgcn_readfirstlane(tid >> 6), lane = tid & 63, wr = wid >> 2, wc = wid & 3, fr = lane & 15, fq = lane >> 4;
    const int K = g.K, nt = FP8 ? K / 128 : K / BK;
    unsigned voffA[2], voffB[2];
#pragma unroll
    for (int i = 0; i < 2; ++i) { int R, C; stage_rc(tid * 16 + i * 8192, R, C); const int Rb = Epi::PERM ? ((R & ~31) + perm32(R & 31)) : R;
        voffA[i] = FP8 ? (unsigned)(R * K + C * 2) : (unsigned)(R * K + C) * 2u; voffB[i] = FP8 ? (unsigned)(Rb * K + C * 2) : (unsigned)(Rb * K + C) * 2u; }
    const unsigned kstep = (unsigned)(BK * 2);
    const unsigned hstep = (unsigned)HALF * (unsigned)K * (FP8 ? 1u : 2u);
    const unsigned tstep = 2u * hstep;
    const unsigned ldsw = (unsigned)wid * 1024u;
    const int aoff = lds_byte(wr * 64 + fr, fq * 8), boff = lds_byte(wc * 32 + fr, fq * 8);
#define PG8_SA(b, h) (((b) * 2 + (h)) * HTB)
#define PG8_SB(b, h) ((4 + (b) * 2 + (h)) * HTB)
    const __amdgpu_buffer_rsrc_t rsrc_voffA = __builtin_amdgcn_make_buffer_rsrc((void*)g.A, (short)0, -1, 0x00020000), rsrc_voffB = __builtin_amdgcn_make_buffer_rsrc((void*)g.Bt, (short)0, -1, 0x00020000);
    const char* const base_voffA = (const char*)g.A; const char* const base_voffB = (const char*)g.Bt;
#define PG8_STAGE(bufoff, goff, voff) do { _Pragma("unroll") for (int _i = 0; _i < 2; ++_i) { \
        if constexpr (FP8) __builtin_amdgcn_raw_ptr_buffer_load_lds(rsrc_##voff, (PG8_LAS void*)(lds + (bufoff) + ldsw + _i * 8192), 16, (int)(voff)[_i], (int)(goff), 0, 0); \
        else __builtin_amdgcn_global_load_lds((const unsigned*)(base_##voff + (size_t)(goff) + (voff)[_i]), (PG8_LAS unsigned*)(lds + (bufoff) + ldsw + _i * 8192), 16, 0, 0); } } while (0)
#define PG8_LDA(dst, b, h) do { _Pragma("unroll") for (int m = 0; m < 4; ++m) _Pragma("unroll") for (int k = 0; k < 2; ++k) dst[m][k] = *(const PG8_LAS bf16x8*)(lds + PG8_SA(b, h) + aoff + m * 2048 + k * 1024); } while (0)
#define PG8_LDB(dst, b, h) do { _Pragma("unroll") for (int n = 0; n < 2; ++n) _Pragma("unroll") for (int k = 0; k < 2; ++k) dst[n][k] = *(const PG8_LAS bf16x8*)(lds + PG8_SB(b, h) + boff + n * 2048 + k * 1024); } while (0)
#define PG8_MMA(ai, bj, At, Bt) do { __builtin_amdgcn_s_setprio(1); _Pragma("unroll") for (int m = 0; m < 4; ++m) _Pragma("unroll") for (int n = 0; n < 2; ++n) { \
        if constexpr (FP8) acc[ai][bj][m][n] = __builtin_amdgcn_mfma_scale_f32_16x16x128_f8f6f4(cat8(Bt[n][0], Bt[n][1]), cat8(At[m][0], At[m][1]), acc[ai][bj][m][n], 0, 0, 0, SCALE_B, 0, 0x7F7F7F7F); \
        else { _Pragma("unroll") for (int k = 0; k < 2; ++k) acc[ai][bj][m][n] = __builtin_amdgcn_mfma_f32_16x16x32_bf16(Bt[n][k], At[m][k], acc[ai][bj][m][n], 0, 0, 0); } } \
        __builtin_amdgcn_s_setprio(0); } while (0)
#define PG8_WAIT_V(n) asm volatile("s_waitcnt vmcnt(" #n ")" ::: "memory")
#define PG8_WAIT_L(n) asm volatile("s_waitcnt lgkmcnt(" #n ")" ::: "memory")
#define PG8_BAR __builtin_amdgcn_s_barrier()
#define PG8_SCHED __builtin_amdgcn_sched_barrier(0)
    Unit cur, nxt; int ui = 0;
    if (!S.next(0, cur)) return;
    f32x4 acc[2][2][4][2];
#pragma unroll
    for (int a = 0; a < 2; ++a)
#pragma unroll
        for (int b = 0; b < 2; ++b)
#pragma unroll
            for (int m = 0; m < 4; ++m)
#pragma unroll
                for (int n = 0; n < 2; ++n) acc[a][b][m][n] = (f32x4){0.f, 0.f, 0.f, 0.f};
    bf16x8 At[4][2], B0[2][2], B1[2][2];
    unsigned cA = (unsigned)cur.pm * tstep, cB = (unsigned)cur.pn * tstep;
    S.a_ready(cur);
    if constexpr (SP2) {
        PG8_STAGE(PG8_SB(0, 0), cB, voffB); PG8_STAGE(PG8_SB(0, 1), cB + hstep, voffB); PG8_STAGE(PG8_SA(0, 0), cA, voffA); PG8_STAGE(PG8_SA(0, 1), cA + hstep, voffA);
        if (wr == 1) PG8_BAR;
        PG8_WAIT_V(2); PG8_BAR;
        PG8_STAGE(PG8_SB(1, 0), cB + kstep, voffB); PG8_STAGE(PG8_SA(1, 0), cA + kstep, voffA); PG8_STAGE(PG8_SB(1, 1), cB + hstep + kstep, voffB);
        PG8_WAIT_V(6); PG8_BAR;
    } else {
        PG8_STAGE(PG8_SB(0, 0), cB, voffB); PG8_STAGE(PG8_SA(0, 0), cA, voffA); PG8_STAGE(PG8_SB(0, 1), cB + hstep, voffB); PG8_STAGE(PG8_SA(0, 1), cA + hstep, voffA);
        if (wr == 1) PG8_BAR;
        PG8_WAIT_V(4); PG8_BAR;
        PG8_STAGE(PG8_SB(1, 0), cB + kstep, voffB); PG8_STAGE(PG8_SA(1, 0), cA + kstep, voffA); PG8_STAGE(PG8_SB(1, 1), cB + hstep + kstep, voffB);
        PG8_WAIT_V(6); PG8_BAR;
    }
    for (;;) {
        const bool has_next = S.next(ui + 1, nxt);
        const unsigned nA = has_next ? (unsigned)nxt.pm * tstep : cA, nB = has_next ? (unsigned)nxt.pn * tstep : cB;
        for (int t = 0; t < nt; t += 2) {
            const bool last = (t == nt - 2);
            const unsigned a1 = cA + (unsigned)(t + 1) * kstep;
            const unsigned a2 = last ? nA : cA + (unsigned)(t + 2) * kstep, b2 = last ? nB : cB + (unsigned)(t + 2) * kstep;
            const unsigned a3 = a2 + kstep, b3 = b2 + kstep;
            if (last && has_next) S.a_ready(nxt);
            if constexpr (SP2) {
            PG8_LDB(B0, 0, 0); PG8_LDB(B1, 0, 1); PG8_SCHED; PG8_LDA(At, 0, 0); PG8_STAGE(PG8_SA(1, 1), a1 + hstep, voffA);
            PG8_WAIT_V(8); PG8_WAIT_L(0); PG8_BAR; PG8_MMA(0, 0, At, B0); PG8_MMA(0, 1, At, B1); PG8_BAR; PG8_SCHED;
            PG8_LDA(At, 0, 1); PG8_STAGE(PG8_SB(0, 0), b2, voffB); PG8_STAGE(PG8_SB(0, 1), b2 + hstep, voffB); PG8_STAGE(PG8_SA(0, 0), a2, voffA);
            PG8_WAIT_V(8); PG8_WAIT_L(0); PG8_BAR; PG8_MMA(1, 0, At, B0); PG8_MMA(1, 1, At, B1); PG8_BAR; PG8_SCHED;
            PG8_LDB(B0, 1, 0); PG8_LDB(B1, 1, 1); PG8_SCHED; PG8_LDA(At, 1, 0); PG8_STAGE(PG8_SA(0, 1), a2 + hstep, voffA);
            PG8_WAIT_V(8); PG8_WAIT_L(0); PG8_BAR; PG8_MMA(0, 0, At, B0); PG8_MMA(0, 1, At, B1); PG8_BAR; PG8_SCHED;
            PG8_LDA(At, 1, 1); PG8_STAGE(PG8_SB(1, 0), b3, voffB); PG8_STAGE(PG8_SB(1, 1), b3 + hstep, voffB); PG8_STAGE(PG8_SA(1, 0), a3, voffA);
            PG8_WAIT_V(8); PG8_WAIT_L(0); PG8_BAR; PG8_MMA(1, 0, At, B0); PG8_MMA(1, 1, At, B1); PG8_BAR; PG8_SCHED;
            } else {
            PG8_LDB(B0, 0, 0); PG8_SCHED; PG8_LDA(At, 0, 0); PG8_STAGE(PG8_SA(1, 1), a1 + hstep, voffA);
            PG8_WAIT_L(8); PG8_BAR; PG8_WAIT_L(0); PG8_MMA(0, 0, At, B0); PG8_BAR; PG8_SCHED;
            PG8_LDB(B1, 0, 1); PG8_STAGE(PG8_SB(0, 0), b2, voffB);
            PG8_BAR; PG8_WAIT_L(0); PG8_MMA(0, 1, At, B1); PG8_BAR;
            PG8_LDA(At, 0, 1); PG8_STAGE(PG8_SA(0, 0), a2, voffA);
            PG8_BAR; PG8_WAIT_L(0); PG8_MMA(1, 0, At, B0); PG8_BAR; PG8_SCHED;
            PG8_STAGE(PG8_SB(0, 1), b2 + hstep, voffB);
            PG8_WAIT_V(6); PG8_BAR; PG8_MMA(1, 1, At, B1); PG8_BAR;
            PG8_LDB(B0, 1, 0); PG8_SCHED; PG8_LDA(At, 1, 0); PG8_STAGE(PG8_SA(0, 1), a2 + hstep, voffA);
            PG8_WAIT_L(8); PG8_BAR; PG8_WAIT_L(0); PG8_MMA(0, 0, At, B0); PG8_BAR; PG8_SCHED;
            PG8_LDB(B1, 1, 1); PG8_STAGE(PG8_SB(1, 0), b3, voffB);
            PG8_BAR; PG8_WAIT_L(0); PG8_MMA(0, 1, At, B1); PG8_BAR;
            PG8_LDA(At, 1, 1); PG8_STAGE(PG8_SA(1, 0), a3, voffA);
            PG8_BAR; PG8_WAIT_L(0); PG8_MMA(1, 0, At, B0); PG8_BAR; PG8_SCHED;
            PG8_STAGE(PG8_SB(1, 1), b3 + hstep, voffB);
            PG8_WAIT_V(6); PG8_BAR; PG8_MMA(1, 1, At, B1); PG8_BAR;
            }
        }
        if constexpr (ALIGN_EPI) { if (wr == 0) PG8_BAR; }
        if constexpr (!Epi::AFTER_DRAIN) { E(acc, cur, wr, wc, fr, fq); S.done(cur); }
        if (!has_next) break;
#pragma unroll
        for (int a = 0; a < 2; ++a)
#pragma unroll
            for (int b = 0; b < 2; ++b)
#pragma unroll
                for (int m = 0; m < 4; ++m)
#pragma unroll
                    for (int n = 0; n < 2; ++n) acc[a][b][m][n] = (f32x4){0.f, 0.f, 0.f, 0.f};
        cur = nxt; cA = nA; cB = nB; ++ui;
        if constexpr (ALIGN_EPI) { if (wr == 1) PG8_BAR; }
    }
    PG8_WAIT_V(0);
    if constexpr (!ALIGN_EPI) { if (wr == 0) PG8_BAR; }
    PG8_BAR;
    if constexpr (Epi::AFTER_DRAIN) { E.fused(acc, cur, wr, wc, fr, fq, lds, wid, lane); S.done(cur); }
#undef PG8_SA
#undef PG8_SB
#undef PG8_STAGE
#undef PG8_LDA
#undef PG8_LDB
#undef PG8_MMA
#undef PG8_WAIT_V
#undef PG8_WAIT_L
#undef PG8_BAR
#undef PG8_SCHED
}
}


namespace att {
using bf16x8 = __attribute__((ext_vector_type(8))) short;
using s16x4  = __attribute__((ext_vector_type(4))) short;
using f32x16 = __attribute__((ext_vector_type(16))) float;
using u32x4  = __attribute__((ext_vector_type(4))) unsigned;
using u32x2  = __attribute__((ext_vector_type(2))) unsigned;
constexpr int SHM_V = 16384, SHM_K = 16384;
constexpr int L_V = 0, L_K = 32768, L_WS = 69632, L_SEL = 131072, L_END = 139264;
#ifndef ATT_SDEPTH
#define ATT_SDEPTH 1
#endif
constexpr int SDEPTH = ATT_SDEPTH;
constexpr float THR2 = 11.0f;
#define KSWZ(row, colB) ((row) * 256 + ((colB) ^ (((row) & 7) << 4)))
#define SBAR() __builtin_amdgcn_sched_barrier(0)
__device__ __forceinline__ int crow(int r, int hi) { return (r & 3) + 8 * (r >> 2) + 4 * hi; }
__device__ __forceinline__ unsigned cvtpk(float lo, float hi) { unsigned r; asm volatile("v_cvt_pk_bf16_f32 %0, %1, %2" : "=v"(r) : "v"(lo), "v"(hi)); return r; }
__device__ __forceinline__ bf16x8 ld8(const bf16* p) { return *reinterpret_cast<const bf16x8*>(p); }
__device__ __forceinline__ float bf2f(bf16 v) { return __uint_as_float((unsigned)v << 16); }
__device__ __forceinline__ float ninf() { return __uint_as_float(0xff800000u); }

template <int ND0> __device__ __forceinline__ void qkt(f32x16& p0, f32x16& p1, const char* Ks, const bf16x8* qr, int r32, int hi, int d0base) {
  p0 = f32x16{}; p1 = f32x16{};
#pragma unroll
  for (int d0 = 0; d0 < ND0; ++d0) { const int cb = ((d0base + d0) * 16 + hi * 8) * 2;
    bf16x8 b0 = *reinterpret_cast<const bf16x8*>(Ks + KSWZ(r32, cb));
    bf16x8 b1 = *reinterpret_cast<const bf16x8*>(Ks + KSWZ(32 + r32, cb));
    p0 = __builtin_amdgcn_mfma_f32_32x32x16_bf16(b0, qr[d0], p0, 0, 0, 0);
    p1 = __builtin_amdgcn_mfma_f32_32x32x16_bf16(b1, qr[d0], p1, 0, 0, 0); }
}
__device__ __forceinline__ int v_st(int k, int c) { const int kk = (k & ~0xC) | ((k & 4) << 1) | ((k & 8) >> 1); return ((kk >> 3) * 4 + (c >> 5)) * 512 + ((kk & 7) * 32 + (c & 31)) * 2; }
__device__ __forceinline__ int v_rd_base(int lane) { return ((lane & 3) << 3) | (((lane >> 2) & 3) << 6) | (((lane >> 4) & 1) << 5) | (((lane >> 5) & 1) << 8); }
constexpr int v_rd_off(int d0, int ks, int half) { return d0 * 512 + ks * 4096 + half * 2048; }
template <int OFF> __device__ __forceinline__ s16x4 tr_read(int vb) {
  s16x4 r; asm volatile("ds_read_b64_tr_b16 %0, %1 offset:%2" : "=&v"(r) : "v"(vb), "i"(OFF) : "memory"); return r;
}
template <int D0> __device__ __forceinline__ void pv_one(f32x16& od, int vb, bf16x8 pa0, bf16x8 pa1, bf16x8 pa2, bf16x8 pa3) {
#define PK(L, H) (bf16x8){L[0], L[1], L[2], L[3], H[0], H[1], H[2], H[3]}
  { const s16x4 l0 = tr_read<v_rd_off(D0, 0, 0)>(vb), h0 = tr_read<v_rd_off(D0, 0, 1)>(vb), l1 = tr_read<v_rd_off(D0, 1, 0)>(vb), h1 = tr_read<v_rd_off(D0, 1, 1)>(vb);
    asm volatile("s_waitcnt lgkmcnt(0)" ::: "memory"); SBAR();
    od = __builtin_amdgcn_mfma_f32_32x32x16_bf16(pa0, PK(l0, h0), od, 0, 0, 0);
    od = __builtin_amdgcn_mfma_f32_32x32x16_bf16(pa1, PK(l1, h1), od, 0, 0, 0); }
  { const s16x4 l2 = tr_read<v_rd_off(D0, 2, 0)>(vb), h2 = tr_read<v_rd_off(D0, 2, 1)>(vb), l3 = tr_read<v_rd_off(D0, 3, 0)>(vb), h3 = tr_read<v_rd_off(D0, 3, 1)>(vb);
    asm volatile("s_waitcnt lgkmcnt(0)" ::: "memory"); SBAR();
    od = __builtin_amdgcn_mfma_f32_32x32x16_bf16(pa2, PK(l2, h2), od, 0, 0, 0);
    od = __builtin_amdgcn_mfma_f32_32x32x16_bf16(pa3, PK(l3, h3), od, 0, 0, 0); }
#undef PK
}
__device__ __forceinline__ void pv_d0(f32x16* o, int vb, bf16x8 pa0, bf16x8 pa1, bf16x8 pa2, bf16x8 pa3) {
  pv_one<0>(o[0], vb, pa0, pa1, pa2, pa3); pv_one<1>(o[1], vb, pa0, pa1, pa2, pa3); pv_one<2>(o[2], vb, pa0, pa1, pa2, pa3); pv_one<3>(o[3], vb, pa0, pa1, pa2, pa3);
}

template <int MODE> __device__ __forceinline__ void partialSM(f32x16& p0, f32x16& p1, float Cs, float slope2, float thr, int k0, int qpos, int hi,
                                                              const char* selrow, bool diag, float& m_reg, float& off, float& alpha, bool& dead) {
#pragma unroll
  for (int r = 0; r < 16; ++r) { const float cr = (float)((r & 3) + 8 * (r >> 2)); p0[r] = fmaf(p0[r], Cs, cr); p1[r] = fmaf(p1[r], Cs, cr); }
  if (MODE == 0) {
    if (diag) { const int dqh = qpos - k0 - 4 * hi;
#pragma unroll
      for (int r = 0; r < 16; ++r) { const int cr = (r & 3) + 8 * (r >> 2); if (cr > dqh) p0[r] = ninf(); if (cr + 32 > dqh) p1[r] = ninf(); } }
  } else {
    const u32x2 w = *reinterpret_cast<const u32x2*>(selrow + (k0 >> 5) * 4);
    const unsigned w0 = w.x >> (4 * hi), w1 = w.y >> (4 * hi);
    const float ninf_ = ninf();
#pragma unroll
    for (int r = 0; r < 16; ++r) { const int cr = (r & 3) + 8 * (r >> 2); unsigned t0, t1;
      asm("v_bfe_i32 %0, %1, %2, 1" : "=v"(t0) : "v"(w0), "n"(cr)); asm("v_bfi_b32 %0, %1, %2, %0" : "+v"(p0[r]) : "v"(t0), "s"(ninf_));
      asm("v_bfe_i32 %0, %1, %2, 1" : "=v"(t1) : "v"(w1), "n"(cr)); asm("v_bfi_b32 %0, %1, %2, %0" : "+v"(p1[r]) : "v"(t1), "s"(ninf_)); }
  }
#ifdef VALU_PROBE
  { float z0 = 0.f, z1 = 0.f;
#pragma unroll
    for (int r = 0; r < 16; ++r) { asm volatile("v_fma_f32 %0, %1, %2, %0" : "+v"(z0) : "v"(Cs), "v"(slope2)); asm volatile("v_fma_f32 %0, %1, %2, %0" : "+v"(z1) : "v"(Cs), "v"(slope2)); }
    asm volatile("" :: "v"(z0), "v"(z1)); }
#endif
  float pm0 = p0[0], pm1 = p1[0];
#pragma unroll
  for (int r = 1; r < 16; ++r) { pm0 = fmaxf(pm0, p0[r]); pm1 = fmaxf(pm1, p1[r]); }
  const float tb = (float)(k0 + 4 * hi - qpos);
  float tmax = fmaxf(pm0, pm1 + 32.f) + tb;
  { auto rr = __builtin_amdgcn_permlane32_swap(__float_as_uint(tmax), __float_as_uint(tmax), false, false);
    tmax = fmaxf(__uint_as_float(rr[0]), __uint_as_float(rr[1])); }
  dead = (MODE == 0) && __all((tmax - m_reg) * slope2 < -150.f);
  if (dead) { alpha = 1.f; off = 0.f; return; }
  if (__builtin_expect(__all(tmax - m_reg <= thr), 1)) { alpha = 1.f; }
  else { const float mn = fmaxf(m_reg, tmax); alpha = __builtin_amdgcn_exp2f((m_reg - mn) * slope2); m_reg = mn; }
  off = (tb - m_reg) * slope2;
#pragma unroll
  for (int r = 0; r < 16; ++r) p0[r] = __builtin_amdgcn_exp2f(fmaf(p0[r], slope2, off));
}
__device__ __forceinline__ void finishSM(f32x16& p0, f32x16& p1, float slope2, float off1, float alpha, float& l_reg, bf16x8& pa0, bf16x8& pa1, bf16x8& pa2, bf16x8& pa3) {
#pragma unroll
  for (int r = 0; r < 16; ++r) p1[r] = __builtin_amdgcn_exp2f(fmaf(p1[r], slope2, off1));
  float ps = 0;
#pragma unroll
  for (int r = 0; r < 16; ++r) ps += p0[r];
#pragma unroll
  for (int r = 0; r < 16; ++r) ps += p1[r];
  { auto rr = __builtin_amdgcn_permlane32_swap(__float_as_uint(ps), __float_as_uint(ps), false, false);
    ps = __uint_as_float(rr[0]) + __uint_as_float(rr[1]); }
  l_reg = l_reg * alpha + ps;
#define PK4(P, BASE, OUT) do { unsigned a0 = cvtpk(P[BASE + 0], P[BASE + 1]), a1 = cvtpk(P[BASE + 2], P[BASE + 3]);   \
    unsigned b0 = cvtpk(P[BASE + 4], P[BASE + 5]), b1 = cvtpk(P[BASE + 6], P[BASE + 7]);                              \
    auto r0 = __builtin_amdgcn_permlane32_swap(a0, b0, false, false); auto r1 = __builtin_amdgcn_permlane32_swap(a1, b1, false, false); \
    u32x4 w = {r0[0], r1[0], r0[1], r1[1]}; OUT = *reinterpret_cast<bf16x8*>(&w); } while (0)
  PK4(p0, 0, pa0); PK4(p0, 8, pa1); PK4(p1, 0, pa2); PK4(p1, 8, pa3);
#undef PK4
}

typedef float f32x2v __attribute__((ext_vector_type(2)));
__device__ __forceinline__ void cnt_ge(int& cnt, unsigned a, unsigned b) { asm volatile("v_cmp_ge_u32_e32 vcc, %1, %2\n\tv_addc_co_u32_e32 %0, vcc, 0, %0, vcc" : "+v"(cnt) : "v"(a), "v"(b) : "vcc"); }
__device__ __forceinline__ void cnt_gt(int& cnt, unsigned a, unsigned b) { asm volatile("v_cmp_gt_u32_e32 vcc, %1, %2\n\tv_addc_co_u32_e32 %0, vcc, 0, %0, vcc" : "+v"(cnt) : "v"(a), "v"(b) : "vcc"); }
__device__ __forceinline__ void cnt_ge4(int& c0, int& c1, int& c2, int& c3, unsigned k0, unsigned k1, unsigned k2, unsigned k3, unsigned b) {
  unsigned long long m0, m1, m2, m3;
  asm volatile("v_cmp_ge_u32_e64 %4, %8, %12\n\tv_cmp_ge_u32_e64 %5, %9, %12\n\tv_cmp_ge_u32_e64 %6, %10, %12\n\tv_cmp_ge_u32_e64 %7, %11, %12\n\t"
               "v_addc_co_u32_e64 %0, %4, 0, %0, %4\n\tv_addc_co_u32_e64 %1, %5, 0, %1, %5\n\tv_addc_co_u32_e64 %2, %6, 0, %2, %6\n\tv_addc_co_u32_e64 %3, %7, 0, %3, %7"
               : "+v"(c0), "+v"(c1), "+v"(c2), "+v"(c3), "=&s"(m0), "=&s"(m1), "=&s"(m2), "=&s"(m3) : "v"(k0), "v"(k1), "v"(k2), "v"(k3), "v"(b));
}
__device__ __forceinline__ unsigned wlane(unsigned val, int ln, unsigned old) { asm volatile("v_writelane_b32 %0, %1, %2" : "+v"(old) : "s"(val), "s"(ln)); return old; }
__device__ __forceinline__ int half_sum(int x, int hi) {
  x += __builtin_amdgcn_update_dpp(0, x, 0x111, 0xf, 0xf, true);
  x += __builtin_amdgcn_update_dpp(0, x, 0x112, 0xf, 0xf, true);
  x += __builtin_amdgcn_update_dpp(0, x, 0x114, 0xf, 0xf, true);
  x += __builtin_amdgcn_update_dpp(0, x, 0x118, 0xf, 0xf, true);
  const int a = __builtin_amdgcn_readlane(x, 15) + __builtin_amdgcn_readlane(x, 31);
  const int b = __builtin_amdgcn_readlane(x, 47) + __builtin_amdgcn_readlane(x, 63);
  return hi ? b : a;
}
__device__ __forceinline__ unsigned take_low(unsigned m, int k) {
  while (__builtin_popcount(m) > k) m &= ~(0x80000000u >> __builtin_clz(m));
  return m;
}

__device__ __forceinline__ void dsa_select(const bf16* __restrict__ PROJ, int b, int q0, unsigned* SEL, char* lds) {
  int tid = my_tid(); asm volatile("" : "+v"(tid));
  const int wid = __builtin_amdgcn_readfirstlane(tid >> 6), lane = tid & 63, r32 = lane & 31, hi = lane >> 5;
  const size_t tokb = (size_t)b * SEQ;
  const int nt32 = (q0 >> 5) + 1, nch = (nt32 + 15) >> 4;
  const int srow = wid * 64 + (lane >> 3), spc = lane & 7;
  const unsigned sloff = (unsigned)((srow * LDP + 8 * spc) * 2);
  const __amdgpu_buffer_rsrc_t srd = __builtin_amdgcn_make_buffer_rsrc((void*)(PROJ + tokb * LDP + C_IK), (short)0, (int)(SEQ * LDP * 2), 0x00020000);
  bf16x8 af[4]; float w[16]; bf16x8 st[8];
#define DSA_LOADS(RD) do { const int tA_ = q0 + (RD) * 16 + wid * 2; \
    const bf16* ap_ = PROJ + (tokb + tA_ + (r32 >> 4)) * LDP + C_IQ + (r32 & 15) * 64 + hi * 8; \
    _Pragma("unroll") for (int ks = 0; ks < 4; ++ks) af[ks] = ld8(ap_ + ks * 16); \
    _Pragma("unroll") for (int r = 0; r < 16; ++r) { const int head = (r & 3) + 8 * ((r >> 2) & 1) + 4 * hi; w[r] = bf2f(PROJ[(tokb + tA_ + (r >> 3)) * LDP + C_IW + head]); } \
    _Pragma("unroll") for (int i = 0; i < 8; ++i) st[i] = __builtin_bit_cast(bf16x8, __builtin_amdgcn_raw_buffer_load_b128(srd, (int)(sloff + (unsigned)(8 * i * LDP * 2)), 0, 0)); } while (0)
  DSA_LOADS(0);
  for (int rd = 0; rd < 2; ++rd) {
    const int tl = rd * 16 + wid * 2, tA = q0 + tl;
#pragma unroll
    for (int r = 0; r < 16; ++r) w[r] *= 0.5f;
    const int myq = tA + hi;
    unsigned key[64];
#pragma unroll
    for (int c = 0; c < 4; ++c) {
      if (c < nch) {
        char* buf = lds + (c & 1) * 65536;
#pragma unroll
        for (int i = 0; i < 8; ++i) { const int row = srow + 8 * i; *reinterpret_cast<bf16x8*>(buf + row * 128 + ((spc ^ ((row >> 1) & 7)) << 4)) = st[i]; }
        if (c + 1 < nch) {
#pragma unroll
          for (int i = 0; i < 8; ++i) st[i] = __builtin_bit_cast(bf16x8, __builtin_amdgcn_raw_buffer_load_b128(srd, (int)(sloff + (unsigned)(8 * i * LDP * 2)), 512 * (c + 1) * LDP * 2, 0));
        }
        __syncthreads();
#define IDX_MMA(CC, U) do { const int row_ = 32 * (U) + r32; CC = f32x16{}; _Pragma("unroll") for (int ks = 0; ks < 4; ++ks) { \
            const bf16x8 bfr = *reinterpret_cast<const bf16x8*>(buf + row_ * 128 + (((2 * ks + hi) ^ ((row_ >> 1) & 7)) << 4)); CC = __builtin_amdgcn_mfma_f32_32x32x16_bf16(af[ks], bfr, CC, 0, 0, 0); } } while (0)
#define IDX_RED(CC, U) do { const int j_ = 16 * c + (U); f32x2v l0 = {0.f, 0.f}, l1 = {0.f, 0.f}; \
          _Pragma("unroll") for (int i = 0; i < 4; ++i) { l0 = __builtin_elementwise_fma((f32x2v){w[2 * i], w[2 * i + 1]}, (f32x2v){CC[2 * i], CC[2 * i + 1]}, l0); \
                                                          l1 = __builtin_elementwise_fma((f32x2v){w[8 + 2 * i], w[9 + 2 * i]}, (f32x2v){CC[8 + 2 * i], CC[9 + 2 * i]}, l1); } \
          float s0 = l0[0] + l0[1], s1 = l1[0] + l1[1]; \
          _Pragma("unroll") for (int r = 0; r < 8; ++r) { asm("v_fma_f32 %0, %1, |%2|, %0" : "+v"(s0) : "v"(w[r]), "v"(CC[r])); asm("v_fma_f32 %0, %1, |%2|, %0" : "+v"(s1) : "v"(w[8 + r]), "v"(CC[8 + r])); } \
          auto rr = __builtin_amdgcn_permlane32_swap(__float_as_uint(s0), __float_as_uint(s1), false, false); \
          const float tot = __uint_as_float(rr[0]) + __uint_as_float(rr[1]); \
          const unsigned bits = __float_as_uint(tot); \
          const unsigned srt = bits ^ ((unsigned)((int)bits >> 31) | 0x80000000u); \
          key[j_] = (j_ * 32 + r32 <= myq) ? srt : 0u; } while (0)
#if defined(DSK) && DSK == 3
        { f32x16 ccA, ccB; IDX_MMA(ccA, 0);
#pragma unroll
          for (int u = 0; u < 16; u += 2) { IDX_MMA(ccB, u + 1); IDX_RED(ccA, u); __builtin_amdgcn_sched_barrier(0); if (u + 2 < 16) IDX_MMA(ccA, u + 2); IDX_RED(ccB, u + 1); __builtin_amdgcn_sched_barrier(0); } }
        _Pragma("unroll") for (int u = 0; u < 16; ++u) asm volatile("" :: "v"(key[16 * c + u]));
#endif
        { f32x16 ccA, ccB; IDX_MMA(ccA, 0);
#pragma unroll
          for (int u = 0; u < 16; u += 2) { IDX_MMA(ccB, u + 1); IDX_RED(ccA, u); __builtin_amdgcn_sched_barrier(0); if (u + 2 < 16) IDX_MMA(ccA, u + 2); IDX_RED(ccB, u + 1); __builtin_amdgcn_sched_barrier(0); } }
#undef IDX_MMA
#undef IDX_RED
      } else {
#pragma unroll
        for (int u = 0; u < 16; ++u) key[16 * c + u] = 0u;
      }
    }
    __syncthreads();
    if (rd == 0) DSA_LOADS(1);
    unsigned T = 0u;
    if (tA + 2 > 256) {
      for (int bit = 31; bit >= 0; --bit) {
        const unsigned cand = T | (1u << bit);
        int cnt = 0;
#pragma unroll
        for (int cc = 0; cc < 8; ++cc) { if (cc * 8 < nt32) {
#pragma unroll
          for (int e = 0; e < 8; ++e) cnt_ge(cnt, key[cc * 8 + e], cand); } }
        const int tot = half_sum(cnt, hi);
        if (tot >= 256) T = cand;
        if (__all(tot == 256)) break;
      }
    }
    const unsigned Tm = T > 1u ? T : 1u;
    int cge = 0;
#pragma unroll
    for (int cc = 0; cc < 8; ++cc) { if (cc * 8 < nt32) {
#pragma unroll
      for (int e = 0; e < 8; ++e) cnt_ge(cge, key[cc * 8 + e], Tm); } }
    cge = half_sum(cge, hi);
    int ln = lane; asm volatile("" : "+v"(ln));
    unsigned m0 = 0xffffffffu, m1 = 0xffffffffu;
    if (__all(cge <= 256)) {
#pragma unroll
      for (int j = 0; j < 64; ++j) {
        const unsigned long long bal = __ballot(!(key[j] >= Tm));
        m0 = (ln == j) ? (unsigned)bal : m0; m1 = (ln == j) ? (unsigned)(bal >> 32) : m1; }
    } else {
      unsigned* kst = (unsigned*)(lds + wid * 16384);
#pragma unroll
      for (int j = 0; j < 64; ++j) kst[j * 64 + lane] = key[j];
      int cgt = 0;
#pragma unroll
      for (int cc = 0; cc < 8; ++cc) { if (cc * 8 < nt32) {
#pragma unroll
        for (int e = 0; e < 8; ++e) cnt_gt(cgt, key[cc * 8 + e], Tm); } }
      cgt = half_sum(cgt, hi);
      int need_lo = 256 - __builtin_amdgcn_readlane(cgt, 0), need_hi = 256 - __builtin_amdgcn_readlane(cgt, 32);
#pragma unroll 1
      for (int j = 0; j < 64; ++j) {
        const unsigned kj = kst[j * 64 + lane];
        const unsigned long long eqm = __ballot(kj == Tm), gtm = __ballot(kj > Tm);
        const unsigned tl_ = take_low((unsigned)eqm, need_lo > 0 ? need_lo : 0), th_ = take_low((unsigned)(eqm >> 32), need_hi > 0 ? need_hi : 0);
        need_lo -= __builtin_popcount(tl_); need_hi -= __builtin_popcount(th_);
        const unsigned sl = (unsigned)gtm | tl_, sh = (unsigned)(gtm >> 32) | th_;
        m0 = (ln == j) ? ~sl : m0; m1 = (ln == j) ? ~sh : m1; }
    }
    SEL[tl * 64 + lane] = m0; SEL[(tl + 1) * 64 + lane] = m1;
    __syncthreads();
  }
#undef DSA_LOADS
}

template <int MODE>
__device__ __forceinline__ void attn_unit(const bf16* __restrict__ PROJ, unsigned char* __restrict__ ATT, int b, int h, int qb, char* lds, float lam, const float* __restrict__ subln_g) {
  if (MODE == 1) { dsa_select(PROJ, b, qb * 32, (unsigned*)(lds + L_SEL), lds); __syncthreads(); }
  int tid = my_tid(); asm volatile("" : "+v"(tid));
  const int wid = __builtin_amdgcn_readfirstlane(tid >> 6), lane = tid & 63, r32 = lane & 31, hi = lane >> 5;
  constexpr int ND0 = MODE == 0 ? 4 : 8;
  const int q0 = MODE == 0 ? qb * 128 : qb * 32;
  const int wq = MODE == 0 ? (wid & 3) * 32 : 0;
  const int c = MODE == 0 ? (wid >> 2) : 0;
  const int qpos = q0 + wq + r32;
  const size_t tokb = (size_t)b * SEQ;
  const bf16* Qw = PROJ + (tokb + qpos) * LDP + (MODE == 0 ? C_DQ + h * 128 + c * 64 : C_SQ + wid * 128) + hi * 8;
  const bf16* Kh = PROJ + tokb * LDP + (MODE == 0 ? C_DK + h * 128 : C_SK);
  const bf16* Vh = PROJ + tokb * LDP + (MODE == 0 ? C_DV + h * 128 : C_SV);
  const int NT = MODE == 0 ? 2 * (qb + 1) : 2 * ((q0 + 32 + 127) >> 7);
  const float slope2 = (MODE == 0 ? exp2f(-0.5f * (float)(2 * h + 1)) : exp2f(-(float)(wid + 1))) * LOG2E;
  const float Cs = (MODE == 0 ? 0.125f : 0.08838834764831845f) * LOG2E / slope2;
  const float thr = THR2 / slope2, c32 = 32.f * slope2;
  char* V_lds = lds + L_V; char* K_lds = lds + L_K;
  float* ws = (float*)(lds + L_WS) + wid * 64; float* li_l = ws; float* al_l = ws + 32;
  unsigned* SEL = (unsigned*)(lds + L_SEL);
  const char* selrow = (const char*)(SEL + r32 * 64);

  float m_reg = -1e30f, l_reg = 0; f32x16 o[4] = {}; bf16x8 qr[ND0];
#pragma unroll
  for (int d0 = 0; d0 < ND0; ++d0) qr[d0] = ld8(Qw + d0 * 16);
  const int sr = tid >> 4, sc = (tid & 15) * 8, vst0 = v_st(sr, sc), vst1 = v_st(32 + sr, sc);
  const int vb0 = (int)(uintptr_t)V_lds + v_rd_base(lane);
  struct { bf16x8 vs0, vs1, ks0, ks1; } sr_[SDEPTH];
#define SLOAD(i, k0) do { sr_[i].vs0 = ld8(&Vh[(size_t)((k0) + sr) * LDP + sc]); sr_[i].vs1 = ld8(&Vh[(size_t)((k0) + 32 + sr) * LDP + sc]); \
    sr_[i].ks0 = ld8(&Kh[(size_t)((k0) + sr) * LDP + sc]); sr_[i].ks1 = ld8(&Kh[(size_t)((k0) + 32 + sr) * LDP + sc]); } while (0)
#define SWRITE(bb, i) do { *(bf16x8*)(V_lds + (bb) * SHM_V + vst0) = sr_[i].vs0;          \
    *(bf16x8*)(V_lds + (bb) * SHM_V + vst1) = sr_[i].vs1; const int kc = sc * 2;               \
    *(bf16x8*)(K_lds + (bb) * SHM_K + KSWZ(sr, kc)) = sr_[i].ks0;                       \
    *(bf16x8*)(K_lds + (bb) * SHM_K + KSWZ(32 + sr, kc)) = sr_[i].ks1; } while (0)
#define SWAIT() do { if constexpr (SDEPTH == 2) asm volatile("s_waitcnt vmcnt(4)" ::: "memory"); else asm volatile("s_waitcnt vmcnt(0)" ::: "memory"); } while (0)
#define RESC(a) do { if (__any((a) < 1.f)) { if (hi == 0) al_l[r32] = (a); asm volatile("s_waitcnt lgkmcnt(0)" ::: "memory"); \
    _Pragma("unroll") for (int d = 0; d < 4; ++d) _Pragma("unroll") for (int r = 0; r < 16; ++r) o[d][r] *= al_l[crow(r, hi)]; } } while (0)
#define DIAG(k0) ((k0) + 63 > q0 + wq)
  f32x16 pA0, pA1, pB0, pB1; float ofA, ofB, alA, alB; bool deadA = false, deadB = false; bf16x8 pa0, pa1, pa2, pa3;
  constexpr int SE = 0, SO = SDEPTH - 1;
  static_assert(SDEPTH == 1, "the tile loop below is written for one staging register set");
#define KT(i) ((MODE == 0 ? (NT - 1 - (i)) : (i)) * 64)
  SLOAD(SE, KT(0)); asm volatile("s_waitcnt vmcnt(0)" ::: "memory"); SWRITE(0, SE); SLOAD(SE, KT(1)); __syncthreads();
  qkt<ND0>(pA0, pA1, K_lds, qr, r32, hi, c * 4); partialSM<MODE>(pA0, pA1, Cs, slope2, thr, KT(0), qpos, hi, selrow, DIAG(KT(0)), m_reg, ofA, alA, deadA);
  SWAIT(); SWRITE(1, SO); if (2 < NT) SLOAD(SE, KT(2)); __syncthreads();
  for (int j = 1; j + 1 < NT; j += 2) {
    SBAR(); qkt<ND0>(pB0, pB1, K_lds + SHM_K, qr, r32, hi, c * 4);
    if (!deadA) { finishSM(pA0, pA1, slope2, ofA + c32, alA, l_reg, pa0, pa1, pa2, pa3); } SBAR();
    if (!deadA) { pv_d0(o, vb0, pa0, pa1, pa2, pa3); } partialSM<MODE>(pB0, pB1, Cs, slope2, thr, KT(j), qpos, hi, selrow, DIAG(KT(j)), m_reg, ofB, alB, deadB);
    __syncthreads(); SWAIT(); SWRITE(0, SE); SLOAD(SE, KT(j + 2));
    RESC(alB); __syncthreads();
    SBAR(); qkt<ND0>(pA0, pA1, K_lds, qr, r32, hi, c * 4);
    if (!deadB) { finishSM(pB0, pB1, slope2, ofB + c32, alB, l_reg, pa0, pa1, pa2, pa3); } SBAR();
    if (!deadB) { pv_d0(o, vb0 + SHM_V, pa0, pa1, pa2, pa3); } partialSM<MODE>(pA0, pA1, Cs, slope2, thr, KT(j + 1), qpos, hi, selrow, DIAG(KT(j + 1)), m_reg, ofA, alA, deadA);
    __syncthreads(); SWAIT(); SWRITE(1, SO); if (j + 3 < NT) SLOAD(SO, KT(j + 3));
    RESC(alA); __syncthreads();
  }
  SBAR(); qkt<ND0>(pB0, pB1, K_lds + SHM_K, qr, r32, hi, c * 4);
  if (!deadA) { finishSM(pA0, pA1, slope2, ofA + c32, alA, l_reg, pa0, pa1, pa2, pa3); } SBAR();
  if (!deadA) { pv_d0(o, vb0, pa0, pa1, pa2, pa3); } partialSM<MODE>(pB0, pB1, Cs, slope2, thr, KT(NT - 1), qpos, hi, selrow, DIAG(KT(NT - 1)), m_reg, ofB, alB, deadB);
  __syncthreads(); RESC(alB);
  if (!deadB) { finishSM(pB0, pB1, slope2, ofB + c32, alB, l_reg, pa0, pa1, pa2, pa3); } SBAR();
  if (!deadB) { pv_d0(o, vb0 + SHM_V, pa0, pa1, pa2, pa3); }
#undef KT
#undef SLOAD
#undef SWRITE
#undef SWAIT
#undef RESC
#undef DIAG
  if (hi == 0) li_l[r32] = l_reg; asm volatile("s_waitcnt lgkmcnt(0)" ::: "memory");
  {
    float rli[16];
#pragma unroll
    for (int r = 0; r < 16; ++r) rli[r] = __builtin_amdgcn_rcpf(li_l[crow(r, hi)]);
#pragma unroll
    for (int d0 = 0; d0 < 4; ++d0)
#pragma unroll
      for (int r = 0; r < 16; ++r) o[d0][r] *= rli[r];
  }
  __syncthreads();
  if (MODE == 0) {
    float* X = (float*)lds;
    if (wid >= 4) {
#pragma unroll
      for (int d0 = 0; d0 < 4; ++d0)
#pragma unroll
        for (int r = 0; r < 16; ++r) X[(wid - 4) * 4096 + crow(r, hi) * 128 + d0 * 32 + r32] = o[d0][r];
    }
    __syncthreads();
    if (wid < 4) {
#pragma unroll
      for (int d0 = 0; d0 < 4; ++d0)
#pragma unroll
        for (int r = 0; r < 16; ++r) o[d0][r] -= lam * X[wid * 4096 + crow(r, hi) * 128 + d0 * 32 + r32];
    }
    __syncthreads();
  }
  if (MODE == 1 || wid < 4) {
    bf16* stg = (bf16*)(lds + wid * 8704);
#pragma unroll
    for (int d0 = 0; d0 < 4; ++d0)
#pragma unroll
      for (int r = 0; r < 16; r += 2) {
        const unsigned pk = cvtpk(o[d0][r], o[d0][r + 1]);
        stg[crow(r, hi) * 136 + d0 * 32 + r32] = (bf16)(pk & 0xffffu);
        stg[crow(r + 1, hi) * 136 + d0 * 32 + r32] = (bf16)(pk >> 16);
      }
    asm volatile("s_waitcnt lgkmcnt(0)" ::: "memory");
    bf16x8 v[8];
#pragma unroll
    for (int j = 0; j < 8; ++j) v[j] = *reinterpret_cast<const bf16x8*>(stg + r32 * 136 + hi * 64 + j * 8);
    unsigned char* orow = ATT + (tokb + q0 + wq + r32) * DM + (MODE == 0 ? h * 128 : 1024 + wid * 128) + hi * 64;
    float rs = 1.0f;
    if (MODE == 0) {
      float ss = 0.f;
#pragma unroll
      for (int j = 0; j < 8; ++j)
#pragma unroll
        for (int e = 0; e < 8; ++e) { const float x = bf2f((bf16)v[j][e]); ss = fmaf(x, x, ss); }
      { auto rr = __builtin_amdgcn_permlane32_swap(__float_as_uint(ss), __float_as_uint(ss), false, false);
        ss = __uint_as_float(rr[0]) + __uint_as_float(rr[1]); }
      rs = __builtin_amdgcn_rsqf(ss * (1.0f / 128.0f) + RMS_EPS) * (1.0f - LAM_INIT);
    }
#pragma unroll
    for (int jj = 0; jj < 4; ++jj) { u32x4 w;
#pragma unroll
      for (int q = 0; q < 4; ++q) { float y[4];
#pragma unroll
        for (int e = 0; e < 4; ++e) { const int idx = 16 * jj + 4 * q + e; float x = bf2f((bf16)v[idx >> 3][idx & 7]); if (MODE == 0) x = x * rs * subln_g[hi * 64 + idx]; y[e] = x; }
        int p = __builtin_amdgcn_cvt_pk_fp8_f32(y[0], y[1], 0, false); p = __builtin_amdgcn_cvt_pk_fp8_f32(y[2], y[3], p, true); w[q] = (unsigned)p; }
      *reinterpret_cast<u32x4*>(orow + jj * 16) = w; }
  }
  __syncthreads();
}
}

typedef float f32x4 __attribute__((ext_vector_type(4)));
typedef unsigned u32x4 __attribute__((ext_vector_type(4)));
typedef unsigned u32x2 __attribute__((ext_vector_type(2)));
__device__ __forceinline__ unsigned cvt_pk(float lo, float hi) { unsigned r; asm volatile("v_cvt_pk_bf16_f32 %0, %1, %2" : "=v"(r) : "v"(lo), "v"(hi)); return r; }
__device__ __forceinline__ float bf_lo(unsigned w) { return __uint_as_float(w << 16); }
__device__ __forceinline__ float bf_hi(unsigned w) { return __uint_as_float(w & 0xffff0000u); }
__device__ __forceinline__ float wave_sum(float v) {
#pragma unroll
  for (int o = 1; o < 64; o <<= 1) v += __shfl_xor(v, o);
  return v;
}

__device__ __forceinline__ void cvt_stream(const float* __restrict__ src, bf16* __restrict__ dst, size_t n8, size_t gtid, size_t gsz) {
  for (size_t i = gtid; i < n8; i += gsz) {
    const f32x4 a = *reinterpret_cast<const f32x4*>(src + i * 8), b = *reinterpret_cast<const f32x4*>(src + i * 8 + 4);
    u32x4 w = {cvt_pk(a[0], a[1]), cvt_pk(a[2], a[3]), cvt_pk(b[0], b[1]), cvt_pk(b[2], b[3])};
    *reinterpret_cast<u32x4*>(dst + i * 8) = w;
  }
}
__device__ __forceinline__ void cvt_stream2(const float* __restrict__ src, bf16* __restrict__ dst, unsigned char* __restrict__ dst8, size_t n8, size_t gtid, size_t gsz) {
  for (size_t i0 = gtid; i0 < n8; i0 += 4 * gsz) {
    f32x4 a[4], b[4];
#pragma unroll
    for (int q = 0; q < 4; ++q) { const size_t i = i0 + q * gsz; if (i < n8) { a[q] = *reinterpret_cast<const f32x4*>(src + i * 8); b[q] = *reinterpret_cast<const f32x4*>(src + i * 8 + 4); } }
#pragma unroll
    for (int q = 0; q < 4; ++q) { const size_t i = i0 + q * gsz; if (i < n8) {
      u32x4 w = {cvt_pk(a[q][0], a[q][1]), cvt_pk(a[q][2], a[q][3]), cvt_pk(b[q][0], b[q][1]), cvt_pk(b[q][2], b[q][3])};
      *reinterpret_cast<u32x4*>(dst + i * 8) = w;
      int p0 = __builtin_amdgcn_cvt_pk_fp8_f32(a[q][0], a[q][1], 0, false); p0 = __builtin_amdgcn_cvt_pk_fp8_f32(a[q][2], a[q][3], p0, true);
      int p1 = __builtin_amdgcn_cvt_pk_fp8_f32(b[q][0], b[q][1], 0, false); p1 = __builtin_amdgcn_cvt_pk_fp8_f32(b[q][2], b[q][3], p1, true);
      *reinterpret_cast<u32x2*>(dst8 + i * 8) = (u32x2){(unsigned)p0, (unsigned)p1}; } }
  }
}
__device__ __forceinline__ void transpose_item(const float* __restrict__ W, int K, int N, bf16* __restrict__ WT, LAS float* scr, int kb, int nb, int lane) {
  const int k0 = 64 * kb, n0 = 32 * nb; const int nn = n0 + (lane & 31); const bool ok = nn < N;
  float tv[32];
#pragma unroll
  for (int i = 0; i < 32; ++i) { const int kk = 2 * i + (lane >> 5); tv[i] = ok ? W[(size_t)(k0 + kk) * N + nn] : 0.f; }
#pragma unroll
  for (int i = 0; i < 32; ++i) { const int kk = 2 * i + (lane >> 5); scr[kk * 33 + (lane & 31)] = tv[i]; }
  asm volatile("s_waitcnt lgkmcnt(0)" ::: "memory");
  const int c = lane & 7;
#pragma unroll
  for (int j = 0; j < 4; ++j) { const int n = (lane >> 3) + 8 * j; const LAS float* s = scr + (8 * c) * 33 + n;
    u32x4 o; o.x = cvt_pk(s[0 * 33], s[1 * 33]); o.y = cvt_pk(s[2 * 33], s[3 * 33]); o.z = cvt_pk(s[4 * 33], s[5 * 33]); o.w = cvt_pk(s[6 * 33], s[7 * 33]);
    *reinterpret_cast<u32x4*>(WT + (size_t)(n0 + n) * K + k0 + 8 * c) = o; }
  asm volatile("s_waitcnt lgkmcnt(0)" ::: "memory");
}

__device__ __forceinline__ void transpose_item_fp8(const float* __restrict__ W, int K, int N, unsigned char* __restrict__ WT, LAS float* scr, int kb, int nb, int lane, float scale) {
  const int k0 = 64 * kb, n0 = 32 * nb; const int nn = n0 + (lane & 31); const bool ok = nn < N;
  float tv[32];
#pragma unroll
  for (int i = 0; i < 32; ++i) { const int kk = 2 * i + (lane >> 5); tv[i] = ok ? W[(size_t)(k0 + kk) * N + nn] * scale : 0.f; }
#pragma unroll
  for (int i = 0; i < 32; ++i) { const int kk = 2 * i + (lane >> 5); scr[kk * 33 + (lane & 31)] = tv[i]; }
  asm volatile("s_waitcnt lgkmcnt(0)" ::: "memory");
  const int c = lane & 7;
#pragma unroll
  for (int j = 0; j < 4; ++j) { const int n = (lane >> 3) + 8 * j; const LAS float* s = scr + (8 * c) * 33 + n;
    int p0 = __builtin_amdgcn_cvt_pk_fp8_f32(s[0 * 33], s[1 * 33], 0, false); p0 = __builtin_amdgcn_cvt_pk_fp8_f32(s[2 * 33], s[3 * 33], p0, true);
    int p1 = __builtin_amdgcn_cvt_pk_fp8_f32(s[4 * 33], s[5 * 33], 0, false); p1 = __builtin_amdgcn_cvt_pk_fp8_f32(s[6 * 33], s[7 * 33], p1, true);
    *reinterpret_cast<u32x2*>(WT + (size_t)(n0 + n) * K + k0 + 8 * c) = (u32x2){(unsigned)p0, (unsigned)p1}; }
  asm volatile("s_waitcnt lgkmcnt(0)" ::: "memory");
}

__device__ __forceinline__ void ln1_phase(const bf16* __restrict__ Z, const float* __restrict__ g, const float* __restrict__ bta, bf16* __restrict__ OB, unsigned char* __restrict__ O8, int gw, int ngw, int lane) {
  f32x4 gv[8], bv[8];
#pragma unroll
  for (int j = 0; j < 4; ++j) { const int e0 = 512 * j + 8 * lane;
    gv[2 * j] = *reinterpret_cast<const f32x4*>(g + e0); gv[2 * j + 1] = *reinterpret_cast<const f32x4*>(g + e0 + 4);
    bv[2 * j] = *reinterpret_cast<const f32x4*>(bta + e0); bv[2 * j + 1] = *reinterpret_cast<const f32x4*>(bta + e0 + 4); }
  u32x4 nx[4];
  if (gw < NTOK) {
#pragma unroll
    for (int j = 0; j < 4; ++j) nx[j] = *reinterpret_cast<const u32x4*>(Z + (size_t)gw * DM + 512 * j + 8 * lane); }
  for (int m = gw; m < NTOK; m += ngw) {
    float v[32]; float s = 0.f;
#pragma unroll
    for (int j = 0; j < 4; ++j) {
#pragma unroll
      for (int q = 0; q < 4; ++q) { v[8 * j + 2 * q] = bf_lo(nx[j][q]); v[8 * j + 2 * q + 1] = bf_hi(nx[j][q]); } }
    if (m + ngw < NTOK) {
#pragma unroll
      for (int j = 0; j < 4; ++j) nx[j] = *reinterpret_cast<const u32x4*>(Z + (size_t)(m + ngw) * DM + 512 * j + 8 * lane); }
#pragma unroll
    for (int i = 0; i < 32; ++i) s += v[i];
    const float mean = wave_sum(s) * (1.f / DM); float s2 = 0.f;
#pragma unroll
    for (int i = 0; i < 32; ++i) { v[i] -= mean; s2 = fmaf(v[i], v[i], s2); }
    const float rstd = 1.0f / sqrtf(wave_sum(s2) * (1.f / DM) + LN_EPS);
    bf16* obrow = OB + (size_t)m * DM; unsigned char* o8row = O8 + (size_t)m * DM;
#pragma unroll
    for (int j = 0; j < 4; ++j) {
      const int e0 = 512 * j + 8 * lane;
      float y[8];
#pragma unroll
      for (int e = 0; e < 4; ++e) { y[e] = v[8 * j + e] * rstd * gv[2 * j][e] + bv[2 * j][e]; y[4 + e] = v[8 * j + 4 + e] * rstd * gv[2 * j + 1][e] + bv[2 * j + 1][e]; }
      u32x4 w = {cvt_pk(y[0], y[1]), cvt_pk(y[2], y[3]), cvt_pk(y[4], y[5]), cvt_pk(y[6], y[7])}; *reinterpret_cast<u32x4*>(obrow + e0) = w;
      int p0 = __builtin_amdgcn_cvt_pk_fp8_f32(y[0], y[1], 0, false); p0 = __builtin_amdgcn_cvt_pk_fp8_f32(y[2], y[3], p0, true);
      int p1 = __builtin_amdgcn_cvt_pk_fp8_f32(y[4], y[5], 0, false); p1 = __builtin_amdgcn_cvt_pk_fp8_f32(y[6], y[7], p1, true);
      *reinterpret_cast<u32x2*>(o8row + e0) = (u32x2){(unsigned)p0, (unsigned)p1};
    }
  }
}

namespace peer {
using bf16x8 = att::bf16x8; using f32x16 = att::f32x16;
constexpr int L_K1 = 0, L_K2 = 32768, L_SCR = 65536;
__device__ __forceinline__ unsigned srt(float x) { const unsigned b = __float_as_uint(x); return b ^ ((unsigned)((int)b >> 31) | 0x80000000u); }
__device__ __forceinline__ float unsrt(unsigned u) { const unsigned b = (u & 0x80000000u) ? (u ^ 0x80000000u) : ~u; return __uint_as_float(b); }
__device__ __forceinline__ unsigned umax(unsigned a, unsigned b) { return a > b ? a : b; }
__device__ __forceinline__ unsigned pair_max(unsigned m) {
  auto rr = __builtin_amdgcn_permlane32_swap(m, m, false, false); return umax(rr[0], rr[1]);
}
__device__ __forceinline__ void load_keys(const float* __restrict__ k1, const float* __restrict__ k2, char* lds) {
  for (int i = my_tid(); i < 2 * 128 * 16; i += 512) {
    const int t = i >> 11, row = (i >> 4) & 127, ch = i & 15; const float* src = (t ? k2 : k1) + row * 128 + ch * 8;
    const f32x4 a = *reinterpret_cast<const f32x4*>(src), b = *reinterpret_cast<const f32x4*>(src + 4);
    u32x4 w = {cvt_pk(a[0], a[1]), cvt_pk(a[2], a[3]), cvt_pk(b[0], b[1]), cvt_pk(b[2], b[3])};
    *reinterpret_cast<u32x4*>(lds + (t ? L_K2 : L_K1) + KSWZ(row, ch * 16)) = w;
  }
}
#define PK_CE(a, b) do { const unsigned hi_ = (a) > (b) ? (a) : (b), lo_ = (a) > (b) ? (b) : (a); (a) = hi_; (b) = lo_; } while (0)
__device__ __forceinline__ void sort16_desc(unsigned (&v)[64], const int base) {
  PK_CE(v[base + 0], v[base + 1]);
  PK_CE(v[base + 2], v[base + 3]);
  PK_CE(v[base + 0], v[base + 2]);
  PK_CE(v[base + 1], v[base + 3]);
  PK_CE(v[base + 1], v[base + 2]);
  PK_CE(v[base + 4], v[base + 5]);
  PK_CE(v[base + 6], v[base + 7]);
  PK_CE(v[base + 4], v[base + 6]);
  PK_CE(v[base + 5], v[base + 7]);
  PK_CE(v[base + 5], v[base + 6]);
  PK_CE(v[base + 0], v[base + 4]);
  PK_CE(v[base + 2], v[base + 6]);
  PK_CE(v[base + 2], v[base + 4]);
  PK_CE(v[base + 1], v[base + 5]);
  PK_CE(v[base + 3], v[base + 7]);
  PK_CE(v[base + 3], v[base + 5]);
  PK_CE(v[base + 1], v[base + 2]);
  PK_CE(v[base + 3], v[base + 4]);
  PK_CE(v[base + 5], v[base + 6]);
  PK_CE(v[base + 8], v[base + 9]);
  PK_CE(v[base + 10], v[base + 11]);
  PK_CE(v[base + 8], v[base + 10]);
  PK_CE(v[base + 9], v[base + 11]);
  PK_CE(v[base + 9], v[base + 10]);
  PK_CE(v[base + 12], v[base + 13]);
  PK_CE(v[base + 14], v[base + 15]);
  PK_CE(v[base + 12], v[base + 14]);
  PK_CE(v[base + 13], v[base + 15]);
  PK_CE(v[base + 13], v[base + 14]);
  PK_CE(v[base + 8], v[base + 12]);
  PK_CE(v[base + 10], v[base + 14]);
  PK_CE(v[base + 10], v[base + 12]);
  PK_CE(v[base + 9], v[base + 13]);
  PK_CE(v[base + 11], v[base + 15]);
  PK_CE(v[base + 11], v[base + 13]);
  PK_CE(v[base + 9], v[base + 10]);
  PK_CE(v[base + 11], v[base + 12]);
  PK_CE(v[base + 13], v[base + 14]);
  PK_CE(v[base + 0], v[base + 8]);
  PK_CE(v[base + 4], v[base + 12]);
  PK_CE(v[base + 4], v[base + 8]);
  PK_CE(v[base + 2], v[base + 10]);
  PK_CE(v[base + 6], v[base + 14]);
  PK_CE(v[base + 6], v[base + 10]);
  PK_CE(v[base + 2], v[base + 4]);
  PK_CE(v[base + 6], v[base + 8]);
  PK_CE(v[base + 10], v[base + 12]);
  PK_CE(v[base + 1], v[base + 9]);
  PK_CE(v[base + 5], v[base + 13]);
  PK_CE(v[base + 5], v[base + 9]);
  PK_CE(v[base + 3], v[base + 11]);
  PK_CE(v[base + 7], v[base + 15]);
  PK_CE(v[base + 7], v[base + 11]);
  PK_CE(v[base + 3], v[base + 5]);
  PK_CE(v[base + 7], v[base + 9]);
  PK_CE(v[base + 11], v[base + 13]);
  PK_CE(v[base + 1], v[base + 2]);
  PK_CE(v[base + 3], v[base + 4]);
  PK_CE(v[base + 5], v[base + 6]);
  PK_CE(v[base + 7], v[base + 8]);
  PK_CE(v[base + 9], v[base + 10]);
  PK_CE(v[base + 11], v[base + 12]);
  PK_CE(v[base + 13], v[base + 14]);
}
__device__ __forceinline__ void merge_top16(unsigned (&a)[16], const unsigned (&b)[16]) {
#pragma unroll
  for (int i = 0; i < 16; ++i) a[i] = a[i] > b[15 - i] ? a[i] : b[15 - i];
  PK_CE(a[0], a[8]);
  PK_CE(a[1], a[9]);
  PK_CE(a[2], a[10]);
  PK_CE(a[3], a[11]);
  PK_CE(a[4], a[12]);
  PK_CE(a[5], a[13]);
  PK_CE(a[6], a[14]);
  PK_CE(a[7], a[15]);
  PK_CE(a[0], a[4]);
  PK_CE(a[1], a[5]);
  PK_CE(a[2], a[6]);
  PK_CE(a[3], a[7]);
  PK_CE(a[8], a[12]);
  PK_CE(a[9], a[13]);
  PK_CE(a[10], a[14]);
  PK_CE(a[11], a[15]);
  PK_CE(a[0], a[2]);
  PK_CE(a[1], a[3]);
  PK_CE(a[4], a[6]);
  PK_CE(a[5], a[7]);
  PK_CE(a[8], a[10]);
  PK_CE(a[9], a[11]);
  PK_CE(a[12], a[14]);
  PK_CE(a[13], a[15]);
  PK_CE(a[0], a[1]);
  PK_CE(a[2], a[3]);
  PK_CE(a[4], a[5]);
  PK_CE(a[6], a[7]);
  PK_CE(a[8], a[9]);
  PK_CE(a[10], a[11]);
  PK_CE(a[12], a[13]);
  PK_CE(a[14], a[15]);
}
__device__ __forceinline__ void top16_of_128(const bf16x8* qf, const char* Kt, int r32, int hi, unsigned (&win)[16]) {
  unsigned pk[64];
#pragma unroll
  for (int t = 0; t < 4; ++t) {
    f32x16 c = f32x16{};
#pragma unroll
    for (int ks = 0; ks < 8; ++ks) { const bf16x8 a = *reinterpret_cast<const bf16x8*>(Kt + KSWZ(32 * t + r32, (ks * 16 + hi * 8) * 2));
      c = __builtin_amdgcn_mfma_f32_32x32x16_bf16(a, qf[ks], c, 0, 0, 0); }
#pragma unroll
    for (int r = 0; r < 16; ++r) { const int n = 32 * t + att::crow(r, hi); pk[t * 16 + r] = (srt(c[r]) & 0xffffff80u) | (unsigned)(127 - n); }
  }
  sort16_desc(pk, 0); sort16_desc(pk, 16); sort16_desc(pk, 32); sort16_desc(pk, 48);
  unsigned a[16], b[16];
#pragma unroll
  for (int i = 0; i < 16; ++i) { a[i] = pk[i]; b[i] = pk[16 + i]; }
  merge_top16(a, b);
  unsigned c[16];
#pragma unroll
  for (int i = 0; i < 16; ++i) { c[i] = pk[32 + i]; b[i] = pk[48 + i]; }
  merge_top16(c, b);
  merge_top16(a, c);
#pragma unroll
  for (int i = 0; i < 16; ++i) { auto rr = __builtin_amdgcn_permlane32_swap(a[i], a[i], false, false); b[i] = hi ? rr[0] : rr[1]; }
  merge_top16(a, b);
#pragma unroll
  for (int i = 0; i < 16; ++i) win[i] = a[i];
}
__device__ __forceinline__ void score_unit(const bf16* __restrict__ PQ, int* __restrict__ EIDX, float* __restrict__ EG, int t0, char* lds) {
  const int wid = my_wave(), lane = my_lane(), r32 = lane & 31, hi = lane >> 5;
  const bf16* qp = PQ + (size_t)(t0 + r32) * DM + wid * 256 + hi * 8;
  unsigned w1[16], w2[16];
  { bf16x8 qf[8];
#pragma unroll
    for (int ks = 0; ks < 8; ++ks) qf[ks] = att::ld8(qp + ks * 16);
    top16_of_128(qf, lds + L_K1, r32, hi, w1); }
  { bf16x8 qf[8];
#pragma unroll
    for (int ks = 0; ks < 8; ++ks) qf[ks] = att::ld8(qp + 128 + ks * 16);
    top16_of_128(qf, lds + L_K2, r32, hi, w2); }
  unsigned char* scr = (unsigned char*)(lds + L_SCR + wid * 1024) + r32 * 32;
  if (hi == 0) {
#pragma unroll
    for (int k = 0; k < 16; ++k) { scr[k] = (unsigned char)(127u - (w1[k] & 127u)); scr[16 + k] = (unsigned char)(127u - (w2[k] & 127u)); }
  }
  float v1[16], v2[16];
#pragma unroll
  for (int k = 0; k < 16; ++k) { v1[k] = unsrt(w1[k] & 0xffffff80u); v2[k] = unsrt(w2[k] & 0xffffff80u); }
  unsigned cd[25]; const unsigned hm0 = 0u - (unsigned)hi;
  { const unsigned e_ = (srt(v1[0] + v2[0]) & 0xffffff00u) | 255u, o_ = (srt(v1[0] + v2[1]) & 0xffffff00u) | 254u; cd[0] = (e_ & ~hm0) | (o_ & hm0); }
  { const unsigned e_ = (srt(v1[0] + v2[2]) & 0xffffff00u) | 253u, o_ = (srt(v1[0] + v2[3]) & 0xffffff00u) | 252u; cd[1] = (e_ & ~hm0) | (o_ & hm0); }
  { const unsigned e_ = (srt(v1[0] + v2[4]) & 0xffffff00u) | 251u, o_ = (srt(v1[0] + v2[5]) & 0xffffff00u) | 250u; cd[2] = (e_ & ~hm0) | (o_ & hm0); }
  { const unsigned e_ = (srt(v1[0] + v2[6]) & 0xffffff00u) | 249u, o_ = (srt(v1[0] + v2[7]) & 0xffffff00u) | 248u; cd[3] = (e_ & ~hm0) | (o_ & hm0); }
  { const unsigned e_ = (srt(v1[0] + v2[8]) & 0xffffff00u) | 247u, o_ = (srt(v1[0] + v2[9]) & 0xffffff00u) | 246u; cd[4] = (e_ & ~hm0) | (o_ & hm0); }
  { const unsigned e_ = (srt(v1[0] + v2[10]) & 0xffffff00u) | 245u, o_ = (srt(v1[0] + v2[11]) & 0xffffff00u) | 244u; cd[5] = (e_ & ~hm0) | (o_ & hm0); }
  { const unsigned e_ = (srt(v1[0] + v2[12]) & 0xffffff00u) | 243u, o_ = (srt(v1[0] + v2[13]) & 0xffffff00u) | 242u; cd[6] = (e_ & ~hm0) | (o_ & hm0); }
  { const unsigned e_ = (srt(v1[0] + v2[14]) & 0xffffff00u) | 241u, o_ = (srt(v1[0] + v2[15]) & 0xffffff00u) | 240u; cd[7] = (e_ & ~hm0) | (o_ & hm0); }
  { const unsigned e_ = (srt(v1[1] + v2[0]) & 0xffffff00u) | 239u, o_ = (srt(v1[1] + v2[1]) & 0xffffff00u) | 238u; cd[8] = (e_ & ~hm0) | (o_ & hm0); }
  { const unsigned e_ = (srt(v1[1] + v2[2]) & 0xffffff00u) | 237u, o_ = (srt(v1[1] + v2[3]) & 0xffffff00u) | 236u; cd[9] = (e_ & ~hm0) | (o_ & hm0); }
  { const unsigned e_ = (srt(v1[1] + v2[4]) & 0xffffff00u) | 235u, o_ = (srt(v1[1] + v2[5]) & 0xffffff00u) | 234u; cd[10] = (e_ & ~hm0) | (o_ & hm0); }
  { const unsigned e_ = (srt(v1[1] + v2[6]) & 0xffffff00u) | 233u, o_ = (srt(v1[1] + v2[7]) & 0xffffff00u) | 232u; cd[11] = (e_ & ~hm0) | (o_ & hm0); }
  { const unsigned e_ = (srt(v1[2] + v2[0]) & 0xffffff00u) | 223u, o_ = (srt(v1[2] + v2[1]) & 0xffffff00u) | 222u; cd[12] = (e_ & ~hm0) | (o_ & hm0); }
  { const unsigned e_ = (srt(v1[2] + v2[2]) & 0xffffff00u) | 221u, o_ = (srt(v1[2] + v2[3]) & 0xffffff00u) | 220u; cd[13] = (e_ & ~hm0) | (o_ & hm0); }
  { const unsigned e_ = (srt(v1[2] + v2[4]) & 0xffffff00u) | 219u, o_ = (srt(v1[3] + v2[0]) & 0xffffff00u) | 207u; cd[14] = (e_ & ~hm0) | (o_ & hm0); }
  { const unsigned e_ = (srt(v1[3] + v2[1]) & 0xffffff00u) | 206u, o_ = (srt(v1[3] + v2[2]) & 0xffffff00u) | 205u; cd[15] = (e_ & ~hm0) | (o_ & hm0); }
  { const unsigned e_ = (srt(v1[3] + v2[3]) & 0xffffff00u) | 204u, o_ = (srt(v1[4] + v2[0]) & 0xffffff00u) | 191u; cd[16] = (e_ & ~hm0) | (o_ & hm0); }
  { const unsigned e_ = (srt(v1[4] + v2[1]) & 0xffffff00u) | 190u, o_ = (srt(v1[4] + v2[2]) & 0xffffff00u) | 189u; cd[17] = (e_ & ~hm0) | (o_ & hm0); }
  { const unsigned e_ = (srt(v1[5] + v2[0]) & 0xffffff00u) | 175u, o_ = (srt(v1[5] + v2[1]) & 0xffffff00u) | 174u; cd[18] = (e_ & ~hm0) | (o_ & hm0); }
  { const unsigned e_ = (srt(v1[6] + v2[0]) & 0xffffff00u) | 159u, o_ = (srt(v1[6] + v2[1]) & 0xffffff00u) | 158u; cd[19] = (e_ & ~hm0) | (o_ & hm0); }
  { const unsigned e_ = (srt(v1[7] + v2[0]) & 0xffffff00u) | 143u, o_ = (srt(v1[7] + v2[1]) & 0xffffff00u) | 142u; cd[20] = (e_ & ~hm0) | (o_ & hm0); }
  { const unsigned e_ = (srt(v1[8] + v2[0]) & 0xffffff00u) | 127u, o_ = (srt(v1[9] + v2[0]) & 0xffffff00u) | 111u; cd[21] = (e_ & ~hm0) | (o_ & hm0); }
  { const unsigned e_ = (srt(v1[10] + v2[0]) & 0xffffff00u) | 95u, o_ = (srt(v1[11] + v2[0]) & 0xffffff00u) | 79u; cd[22] = (e_ & ~hm0) | (o_ & hm0); }
  { const unsigned e_ = (srt(v1[12] + v2[0]) & 0xffffff00u) | 63u, o_ = (srt(v1[13] + v2[0]) & 0xffffff00u) | 47u; cd[23] = (e_ & ~hm0) | (o_ & hm0); }
  { const unsigned e_ = (srt(v1[14] + v2[0]) & 0xffffff00u) | 31u, o_ = (srt(v1[15] + v2[0]) & 0xffffff00u) | 15u; cd[24] = (e_ & ~hm0) | (o_ & hm0); }
  unsigned win[16];
  { unsigned pk2[64];
#pragma unroll
    for (int i = 0; i < 25; ++i) pk2[i] = cd[i];
#pragma unroll
    for (int i = 25; i < 32; ++i) pk2[i] = 0u;
    sort16_desc(pk2, 0); sort16_desc(pk2, 16);
    unsigned wa[16], wb[16];
#pragma unroll
    for (int i = 0; i < 16; ++i) { wa[i] = pk2[i]; wb[i] = pk2[16 + i]; }
    merge_top16(wa, wb);
#pragma unroll
    for (int i = 0; i < 16; ++i) { auto rr = __builtin_amdgcn_permlane32_swap(wa[i], wa[i], false, false); wb[i] = hi ? rr[0] : rr[1]; }
    merge_top16(wa, wb);
#pragma unroll
    for (int i = 0; i < 16; ++i) win[i] = wa[i]; }
  asm volatile("s_waitcnt lgkmcnt(0)" ::: "memory");
  const float smax = unsrt(win[0] & 0xffffff00u);
  float ex[16], den = 0.f;
#pragma unroll
  for (int k = 0; k < 16; ++k) { ex[k] = __builtin_amdgcn_exp2f((unsrt(win[k] & 0xffffff00u) - smax) * LOG2E); den += ex[k]; }
  const float rden = 1.0f / den; const unsigned hm = 0u - (unsigned)hi;
  int* eo = EIDX + (size_t)(t0 + r32) * 128 + wid * 2 + hi; float* go = EG + (size_t)(t0 + r32) * 128 + wid * 2 + hi;
#pragma unroll
  for (int kk = 0; kk < 8; ++kk) {
    const unsigned wv = (win[kk] & ~hm) | (win[8 + kk] & hm); const float gv = __uint_as_float((__float_as_uint(ex[kk]) & ~hm) | (__float_as_uint(ex[8 + kk]) & hm)) * rden;
    const int flat = 255 - (int)(wv & 255u), a = flat >> 4, bq = flat & 15;
    eo[kk * 16] = (int)scr[a] * 128 + (int)scr[16 + bq]; go[kk * 16] = gv;
  }
  asm volatile("s_waitcnt lgkmcnt(0)" ::: "memory");
}
}

typedef float f32x2 __attribute__((ext_vector_type(2)));
typedef int i32x4 __attribute__((ext_vector_type(4)));
constexpr float U_SCALE = 128.f, V_SCALE = 4.f;
constexpr int NSLICE = 8, SLICE_COLS = 256;
template <int CTRL> __device__ __forceinline__ float dpp_mov(float v) { return __int_as_float(__builtin_amdgcn_update_dpp(0, __float_as_int(v), CTRL, 0xf, 0xf, false)); }
__device__ __forceinline__ void pe_load_ids(const int* __restrict__ EIDX, int t, int g, int (&id)[16]) {
#pragma unroll
  for (int q = 0; q < 4; ++q) { const i32x4 v = *reinterpret_cast<const i32x4*>(EIDX + (size_t)t * 128 + g * 16 + 4 * q); id[4 * q] = v[0]; id[4 * q + 1] = v[1]; id[4 * q + 2] = v[2]; id[4 * q + 3] = v[3]; }
}
__device__ __forceinline__ void pe_issue_segs(const unsigned char* __restrict__ TB, const int (&id)[16], int coff, u32x4 (&seg)[16]) {
#pragma unroll
  for (int i = 0; i < 16; ++i) { const unsigned off = (unsigned)id[i] * 128u + (unsigned)coff; seg[i] = *reinterpret_cast<const u32x4*>(TB + off); }
}
typedef int v8i __attribute__((ext_vector_type(8)));
__device__ __forceinline__ void pe_x8_load(const unsigned char* __restrict__ X8, int t, unsigned xoff, u32x4 (&xw)[4]) {
  const unsigned char* xp = X8 + (size_t)t * DM + xoff;
  xw[0] = *reinterpret_cast<const u32x4*>(xp); xw[1] = *reinterpret_cast<const u32x4*>(xp + 64); xw[2] = *reinterpret_cast<const u32x4*>(xp + 128); xw[3] = *reinterpret_cast<const u32x4*>(xp + 192);
}
__device__ __forceinline__ void peer_u_pass(const unsigned char* __restrict__ X8, const unsigned char* __restrict__ U4, const int* __restrict__ EIDX, float* __restrict__ HPs, char* wlds, int t0, int dt, int n, int s, int lane) {
  const int g = lane >> 3, j = lane & 7, e16 = lane & 15, g4 = lane >> 4, c = lane & 15;
  const int coff = s * (NEXP * 128) + 16 * j; const unsigned xoff = (unsigned)(s * SLICE_COLS + 16 * g4);
  int idn[16]; u32x4 seg[16]; u32x4 xC[4], xN[4];
  pe_load_ids(EIDX, t0, g, idn); pe_issue_segs(U4, idn, coff, seg); pe_x8_load(X8, t0, xoff, xN);
  pe_load_ids(EIDX, t0 + (n > 1 ? dt : 0), g, idn);
#pragma unroll 1
  for (int it = 0; it < n; ++it) {
    const int t = t0 + it * dt, tn = t0 + (it + 1 < n ? it + 1 : n - 1) * dt, tnn = t0 + (it + 2 < n ? it + 2 : n - 1) * dt;
#pragma unroll
    for (int i = 0; i < 16; ++i) { const int row = 16 * g + i; *reinterpret_cast<u32x4*>(wlds + row * 128 + ((j ^ (row & 7)) << 4)) = seg[i]; }
#pragma unroll
    for (int p = 0; p < 4; ++p) xC[p] = xN[p];
    pe_issue_segs(U4, idn, coff, seg); pe_x8_load(X8, tn, xoff, xN);
    pe_load_ids(EIDX, tnn, g, idn);
    asm volatile("s_waitcnt lgkmcnt(0)" ::: "memory");
    f32x4 acc[8];
#pragma unroll
    for (int G = 0; G < 8; ++G) acc[G] = (f32x4){0.f, 0.f, 0.f, 0.f};
#pragma unroll
    for (int kh = 0; kh < 2; ++kh) {
      const v8i b = {(int)xC[2 * kh][0], (int)xC[2 * kh][1], (int)xC[2 * kh][2], (int)xC[2 * kh][3], (int)xC[2 * kh + 1][0], (int)xC[2 * kh + 1][1], (int)xC[2 * kh + 1][2], (int)xC[2 * kh + 1][3]};
#pragma unroll
      for (int G = 0; G < 8; ++G) { const int row = 16 * G + e16; const u32x4 sw = *reinterpret_cast<const u32x4*>(wlds + row * 128 + (((4 * kh + g4) ^ (row & 7)) << 4));
        const v8i a = {(int)sw[0], (int)sw[1], (int)sw[2], (int)sw[3], 0, 0, 0, 0};
        acc[G] = __builtin_amdgcn_mfma_scale_f32_16x16x128_f8f6f4(a, b, acc[G], 4  , 0  , 0, 0x7F7F7F7F  , 0, 0x7F7F7F7F); }
    }
    float s0[8], s1[8];
#pragma unroll
    for (int G = 0; G < 8; ++G) { s0[G] = (c & 1) ? acc[G][2] : acc[G][0]; s1[G] = (c & 1) ? acc[G][3] : acc[G][1]; }
    const int Gs = c >> 1;
    const float a0 = (Gs & 4) ? ((Gs & 2) ? ((Gs & 1) ? s0[7] : s0[6]) : ((Gs & 1) ? s0[5] : s0[4])) : ((Gs & 2) ? ((Gs & 1) ? s0[3] : s0[2]) : ((Gs & 1) ? s0[1] : s0[0]));
    const float a1 = (Gs & 4) ? ((Gs & 2) ? ((Gs & 1) ? s1[7] : s1[6]) : ((Gs & 1) ? s1[5] : s1[4])) : ((Gs & 2) ? ((Gs & 1) ? s1[3] : s1[2]) : ((Gs & 1) ? s1[1] : s1[0]));
    *reinterpret_cast<f32x2*>(HPs + (size_t)t * 128 + 16 * Gs + 4 * g4 + 2 * (c & 1)) = (f32x2){a0, a1};
  }
}
typedef int v2i __attribute__((ext_vector_type(2)));
__device__ __forceinline__ void peer_v_pass(const unsigned char* __restrict__ A8, const unsigned char* __restrict__ V4, const int* __restrict__ EIDX, bf16* __restrict__ Y, char* wlds, int t0, int dt, int n, int s, int lane) {
  const int g = lane >> 3, j = lane & 7, e16 = lane & 15, g4 = lane >> 4;
  const int coff = s * (NEXP * 128) + 16 * j;
  int idn[16]; u32x4 seg[16]; u32x4 aC[2], aN[2];
#define PE_ALOAD(t, aw) do { const unsigned char* ap_ = A8 + (size_t)(t) * 128 + 16 * g4; aw[0] = *reinterpret_cast<const u32x4*>(ap_); aw[1] = *reinterpret_cast<const u32x4*>(ap_ + 64); } while (0)
  pe_load_ids(EIDX, t0, g, idn); pe_issue_segs(V4, idn, coff, seg); PE_ALOAD(t0, aN);
  pe_load_ids(EIDX, t0 + (n > 1 ? dt : 0), g, idn);
#pragma unroll 1
  for (int it = 0; it < n; ++it) {
    const int t = t0 + it * dt, tn = t0 + (it + 1 < n ? it + 1 : n - 1) * dt, tnn = t0 + (it + 2 < n ? it + 2 : n - 1) * dt;
#pragma unroll
    for (int i = 0; i < 16; ++i) { const int row = 16 * g + i; *reinterpret_cast<u32x4*>(wlds + row * 128 + ((j ^ (row & 7)) << 4)) = seg[i]; }
    aC[0] = aN[0]; aC[1] = aN[1];
    pe_issue_segs(V4, idn, coff, seg); PE_ALOAD(tn, aN);
    pe_load_ids(EIDX, tnn, g, idn);
    asm volatile("s_waitcnt lgkmcnt(0)" ::: "memory");
    const v8i a = {(int)aC[0][0], (int)aC[0][1], (int)aC[0][2], (int)aC[0][3], (int)aC[1][0], (int)aC[1][1], (int)aC[1][2], (int)aC[1][3]};
    const int r0 = 32 * g4 + e16, r1 = r0 + 16;
    float yv[4];
#pragma unroll
    for (int q = 0; q < 4; ++q) yv[q] = 0.f;
#pragma unroll
    for (int cb = 0; cb < 16; ++cb) {
      const v2i b0 = __builtin_amdgcn_ds_read_tr4_b64_v2i32((LAS v2i*)(wlds + r0 * 128 + ((((cb >> 1) ^ (r0 & 7)) << 4) | ((cb & 1) << 3))));
      const v2i b1 = __builtin_amdgcn_ds_read_tr4_b64_v2i32((LAS v2i*)(wlds + r1 * 128 + ((((cb >> 1) ^ (r1 & 7)) << 4) | ((cb & 1) << 3))));
      const v8i b = {b0[0], b0[1], b1[0], b1[1], 0, 0, 0, 0};
      const f32x4 d = __builtin_amdgcn_mfma_scale_f32_16x16x128_f8f6f4(a, b, (f32x4){0.f, 0.f, 0.f, 0.f}, 0  , 4  , 0, 0x79797979  , 0, 0x7D7D7D7D  );
      if ((cb & 3) == 0) yv[cb >> 2] = d[0];
      else yv[cb >> 2] = ((cb & 3) == g4) ? d[0] : yv[cb >> 2];
    }
#pragma unroll
    for (int q = 0; q < 4; ++q) Y[(size_t)t * DM + s * SLICE_COLS + 16 * (4 * q + g4) + e16] = (bf16)(cvt_pk(yv[q], 0.f) & 0xffffu);
  }
#undef PE_ALOAD
}
__device__ __forceinline__ void v4c_relayout_item(const unsigned char* __restrict__ V4, unsigned char* __restrict__ V4C, int s, int eb, int lane) {
  const int e = 64 * eb + lane; const unsigned char* src = V4 + (size_t)s * (NEXP * 128) + (size_t)e * 128;
  u32x4 w[8];
#pragma unroll
  for (int q = 0; q < 8; ++q) w[q] = *reinterpret_cast<const u32x4*>(src + 16 * q);
#pragma unroll
  for (int q = 0; q < 8; ++q) {
    *reinterpret_cast<u32x2*>(V4C + (size_t)(16 * s + 2 * q) * (NEXP * 8) + (size_t)e * 8) = (u32x2){w[q][0], w[q][1]};
    *reinterpret_cast<u32x2*>(V4C + (size_t)(16 * s + 2 * q + 1) * (NEXP * 8) + (size_t)e * 8) = (u32x2){w[q][2], w[q][3]}; }
}
__device__ __forceinline__ void eidp_item(const int* __restrict__ EIDX, unsigned* __restrict__ EIDP, int t4, int lane) {
  const int i16 = lane & 15, g4 = lane >> 4; u32x4 w;
#pragma unroll
  for (int e = 0; e < 4; ++e) { const int* r = EIDX + (size_t)(4 * t4 + e) * 128 + 32 * g4 + i16; const unsigned ia = (unsigned)r[0], ib = (unsigned)r[16]; w[e] = (ia ^ ((ia >> 7) & 31u)) | ((ib ^ ((ib >> 7) & 31u)) << 16); }
  *reinterpret_cast<u32x4*>(EIDP + ((size_t)t4 * 64 + lane) * 4) = w;
}
__device__ __forceinline__ void peer_v_pass2(const unsigned char* __restrict__ A8, const unsigned char* __restrict__ V4C, const unsigned* __restrict__ EIDP, bf16* __restrict__ Y, char* lds, int c, int tbeg, int ntok, int wave, int lane) {
  { const int tid = wave * 64 + lane; const unsigned char* tb = V4C + (size_t)c * (NEXP * 8);
#pragma unroll
    for (int i = 0; i < 16; ++i) { const int r2 = i * 512 + tid; const u32x4 w = *reinterpret_cast<const u32x4*>(tb + r2 * 16); const int m = (r2 >> 6) & 31;
      *reinterpret_cast<u32x2*>(lds + ((2 * r2) ^ m) * 8) = (u32x2){w[0], w[1]}; *reinterpret_cast<u32x2*>(lds + ((2 * r2 + 1) ^ m) * 8) = (u32x2){w[2], w[3]}; } }
  __syncthreads();
  const int i16 = lane & 15, g4 = lane >> 4;
  const int nstep = ntok / (16 * 8);
  const unsigned char* abase = A8 + (size_t)i16 * 128 + 16 * g4;
  const unsigned* ibase = EIDP + (size_t)lane * 4;
  bf16* ybase = Y + (size_t)(4 * g4) * DM + 16 * c + i16;
#define PV_LOAD(AW, ID, step) do { const int t0_ = tbeg + 16 * (wave + 8 * ((step) < nstep ? (step) : nstep - 1)); \
    AW[0] = *reinterpret_cast<const u32x4*>(abase + (size_t)t0_ * 128); AW[1] = *reinterpret_cast<const u32x4*>(abase + (size_t)t0_ * 128 + 64); \
    _Pragma("unroll") for (int j = 0; j < 4; ++j) ID[j] = *reinterpret_cast<const u32x4*>(ibase + ((size_t)(t0_ >> 2) + j) * 256); } while (0)
#define PV_READ(ID, j) do { _Pragma("unroll") for (int e = 0; e < 4; ++e) { const unsigned pk = ID[j][e]; \
      b0[j][e] = __builtin_amdgcn_ds_read_tr4_b64_v2i32((LAS v2i*)(lds + ((pk & 0xffffu) << 3))); \
      b1[j][e] = __builtin_amdgcn_ds_read_tr4_b64_v2i32((LAS v2i*)(lds + ((pk >> 16) << 3))); } __builtin_amdgcn_sched_barrier(0); } while (0)
#define PV_MMA(j) do { f32x4 d[4]; _Pragma("unroll") for (int e = 0; e < 4; ++e) { const v8i b = {b0[j][e][0], b0[j][e][1], b1[j][e][0], b1[j][e][1], 0, 0, 0, 0}; \
      d[e] = __builtin_amdgcn_mfma_scale_f32_16x16x128_f8f6f4(a, b, (f32x4){0.f, 0.f, 0.f, 0.f}, 0  , 4  , 0, 0x79797979  , 0, 0x7D7D7D7D  ); } \
    _Pragma("unroll") for (int e = 0; e < 4; ++e) y[e] = (g4 == j) ? d[e][e] : y[e]; __builtin_amdgcn_sched_barrier(0); } while (0)
#define PV_COMPUTE(AW, ID, step) do { const int t0_ = tbeg + 16 * (wave + 8 * (step)); \
    const v8i a = {(int)AW[0][0], (int)AW[0][1], (int)AW[0][2], (int)AW[0][3], (int)AW[1][0], (int)AW[1][1], (int)AW[1][2], (int)AW[1][3]}; \
    float y[4] = {0.f, 0.f, 0.f, 0.f}; v2i b0[4][4], b1[4][4]; \
    PV_READ(ID, 0); PV_READ(ID, 1); PV_MMA(0); PV_READ(ID, 2); PV_MMA(1); PV_READ(ID, 3); PV_MMA(2); PV_MMA(3); \
    _Pragma("unroll") for (int e = 0; e < 4; ++e) { const __bf16 yh = (__bf16)y[e]; ybase[(size_t)(t0_ + e) * DM] = __builtin_bit_cast(unsigned short, yh); } } while (0)
  u32x4 A0[2], A1[2], A2[2], A3[2], I0[4], I1[4], I2[4], I3[4];
  PV_LOAD(A0, I0, 0); PV_LOAD(A1, I1, 1); PV_LOAD(A2, I2, 2);
#pragma unroll 1
  for (int k = 0; k < nstep; k += 4) {
    PV_LOAD(A3, I3, k + 3); PV_COMPUTE(A0, I0, k);
    PV_LOAD(A0, I0, k + 4); PV_COMPUTE(A1, I1, k + 1);
    PV_LOAD(A1, I1, k + 5); PV_COMPUTE(A2, I2, k + 2);
    PV_LOAD(A2, I2, k + 6); PV_COMPUTE(A3, I3, k + 3);
  }
#undef PV_LOAD
#undef PV_COMPUTE
#undef PV_READ
#undef PV_MMA
  __syncthreads();
}
__device__ __forceinline__ void ln2_phase(const bf16* __restrict__ X1, const bf16* __restrict__ Y, const float* __restrict__ g, const float* __restrict__ bta, float* __restrict__ O, int gw, int ngw, int lane) {
  f32x4 gv[8], bv[8];
#pragma unroll
  for (int j = 0; j < 4; ++j) { const int e0 = 512 * j + 8 * lane;
    gv[2 * j] = *reinterpret_cast<const f32x4*>(g + e0); gv[2 * j + 1] = *reinterpret_cast<const f32x4*>(g + e0 + 4);
    bv[2 * j] = *reinterpret_cast<const f32x4*>(bta + e0); bv[2 * j + 1] = *reinterpret_cast<const f32x4*>(bta + e0 + 4); }
  u32x4 na[4], nb[4];
  if (gw < NTOK) {
#pragma unroll
    for (int j = 0; j < 4; ++j) { na[j] = *reinterpret_cast<const u32x4*>(X1 + (size_t)gw * DM + 512 * j + 8 * lane); nb[j] = *reinterpret_cast<const u32x4*>(Y + (size_t)gw * DM + 512 * j + 8 * lane); } }
  for (int m = gw; m < NTOK; m += ngw) {
    float v[32]; float s = 0.f;
#pragma unroll
    for (int j = 0; j < 4; ++j) {
#pragma unroll
      for (int q = 0; q < 4; ++q) { v[8 * j + 2 * q] = fmaf(ALPHA, bf_lo(na[j][q]), bf_lo(nb[j][q])); v[8 * j + 2 * q + 1] = fmaf(ALPHA, bf_hi(na[j][q]), bf_hi(nb[j][q])); } }
    if (m + ngw < NTOK) {
#pragma unroll
      for (int j = 0; j < 4; ++j) { na[j] = *reinterpret_cast<const u32x4*>(X1 + (size_t)(m + ngw) * DM + 512 * j + 8 * lane); nb[j] = *reinterpret_cast<const u32x4*>(Y + (size_t)(m + ngw) * DM + 512 * j + 8 * lane); } }
#pragma unroll
    for (int i = 0; i < 32; ++i) s += v[i];
    const float mean = wave_sum(s) * (1.f / DM); float s2 = 0.f;
#pragma unroll
    for (int i = 0; i < 32; ++i) { v[i] -= mean; s2 = fmaf(v[i], v[i], s2); }
    const float rstd = 1.0f / sqrtf(wave_sum(s2) * (1.f / DM) + LN_EPS);
    float* orow = O + (size_t)m * DM;
#pragma unroll
    for (int j = 0; j < 4; ++j) { const int e0 = 512 * j + 8 * lane;
      f32x4 o0, o1;
#pragma unroll
      for (int e = 0; e < 4; ++e) { o0[e] = v[8 * j + e] * rstd * gv[2 * j][e] + bv[2 * j][e]; o1[e] = v[8 * j + 4 + e] * rstd * gv[2 * j + 1][e] + bv[2 * j + 1][e]; }
      *reinterpret_cast<f32x4*>(orow + e0) = o0; *reinterpret_cast<f32x4*>(orow + e0 + 4) = o1; }
  }
}
__device__ __forceinline__ void cvt_stream_fp4(const float* __restrict__ src, unsigned char* __restrict__ dst, size_t n32, float scale, size_t gtid, size_t gsz) {
  for (size_t i0 = gtid; i0 < n32; i0 += 2 * gsz) {
    f32x4 a[2][8];
#pragma unroll
    for (int h = 0; h < 2; ++h) { const size_t i = i0 + h * gsz; if (i < n32) {
#pragma unroll
      for (int q = 0; q < 8; ++q) a[h][q] = *reinterpret_cast<const f32x4*>(src + i * 32 + 4 * q); } }
#pragma unroll
    for (int h = 0; h < 2; ++h) { const size_t i = i0 + h * gsz; if (i < n32) {
      u32x4 w;
#pragma unroll
      for (int q = 0; q < 4; ++q) { const f32x4 x = a[h][2 * q] * scale, y = a[h][2 * q + 1] * scale;
        unsigned p = __builtin_amdgcn_cvt_scalef32_pk_fp4_f32(0u, x[0], x[1], 1.0f, 0); p = __builtin_amdgcn_cvt_scalef32_pk_fp4_f32(p, x[2], x[3], 1.0f, 1);
        p = __builtin_amdgcn_cvt_scalef32_pk_fp4_f32(p, y[0], y[1], 1.0f, 2); p = __builtin_amdgcn_cvt_scalef32_pk_fp4_f32(p, y[2], y[3], 1.0f, 3); w[q] = p; }
      const size_t e = i >> 6, c16 = i & 63;
      *reinterpret_cast<u32x4*>(dst + (c16 >> 3) * ((size_t)NEXP * 128) + e * 128 + (c16 & 7) * 16) = w; } }
  }
}
__device__ __forceinline__ void peer_tables_share(const float* __restrict__ u, const float* __restrict__ v, unsigned char* __restrict__ U4, unsigned char* __restrict__ V4, int bx, int G) {
  int t = my_tid(); asm volatile("" : "+v"(t));
  const size_t gtid = (size_t)bx * 512 + t, gsz = (size_t)G * 512;
  cvt_stream_fp4(u, U4, (size_t)NEXP * DM / 32, U_SCALE, gtid, gsz);
  cvt_stream_fp4(v, V4, (size_t)NEXP * DM / 32, V_SCALE, gtid, gsz);
}
constexpr int TBL_NCH = 256;
__device__ __forceinline__ void peer_tables_chunk(const float* __restrict__ u, const float* __restrict__ v, unsigned char* __restrict__ U4, unsigned char* __restrict__ V4, int c) {
  int t = my_tid(); asm volatile("" : "+v"(t));
  const bool isv = c >= TBL_NCH; const int cc = isv ? c - TBL_NCH : c;
  const size_t gtid = (size_t)cc * 512 + t, gsz = (size_t)TBL_NCH * 512;
  cvt_stream_fp4(isv ? v : u, isv ? V4 : U4, (size_t)NEXP * DM / 32, isv ? V_SCALE : U_SCALE, gtid, gsz);
}

#define XB_TMO      128
#define XB_XCNT(j)  (256  + 64 * (j))
#define XB_XSUB(j)  (1280 + 64 * (j))
#define XB_XGEN(j)  (2304 + 64 * (j))
#define XB_TOP      3328
#define XB_TOPGEN   3392
#define XCD_BAR_WORDS 3456
#define XQ_TBL      3584
#define XB_SPIN_CAP (1u << 18)

__device__ __forceinline__ unsigned xb_ld(unsigned* p)              { return __hip_atomic_load(p, __ATOMIC_RELAXED, __HIP_MEMORY_SCOPE_AGENT); }
__device__ __forceinline__ unsigned xb_add(unsigned* p, unsigned v) { return __hip_atomic_fetch_add(p, v, __ATOMIC_RELAXED, __HIP_MEMORY_SCOPE_AGENT); }
__device__ __forceinline__ unsigned xb_xcc_id() { return (unsigned)__builtin_amdgcn_s_getreg((3 << 11) | 20) & 0xFu; }
#define XB_SPIN(cond, bar) do { unsigned _sp = 0; while (cond) { __builtin_amdgcn_s_sleep(1); \
    if ((++_sp & 255u) == 0u) { if (xb_ld(&(bar)[XB_TMO])) break; if (_sp > XB_SPIN_CAP) { atomicAdd(&(bar)[XB_TMO], 1u); break; } } } } while (0)

struct XcdBarrier {
    unsigned* bar; unsigned x;
    volatile LAS unsigned* st;
};

__device__ __forceinline__ XcdBarrier xcd_barrier_post(unsigned* bar, volatile LAS unsigned* st) {
    XcdBarrier b; b.bar = bar; b.x = xb_xcc_id(); b.st = st;
    if (threadIdx.x == 0) (void)xb_add(&bar[XB_XCNT(b.x)], 1u);
    return b;
}
__device__ __forceinline__ void xcd_barrier_complete(unsigned* bar, unsigned x, unsigned& nloc, unsigned& nx) {
    const unsigned G = gridDim.x * gridDim.y * gridDim.z;
    unsigned sum, cnt, mine, sp = 0u;
    for (;;) {
        sum = 0u; cnt = 0u; mine = 0u;
#pragma unroll
        for (unsigned j = 0; j < 16; ++j) { const unsigned c = xb_ld(&bar[XB_XCNT(j)]); sum += c; cnt += (c > 0u) ? 1u : 0u; mine = (j == x) ? c : mine; }
        if (sum == G) break;
        __builtin_amdgcn_s_sleep(1);
        if ((++sp & 255u) == 0u) { if (xb_ld(&bar[XB_TMO])) break; if (sp > XB_SPIN_CAP) { atomicAdd(&bar[XB_TMO], 1u); break; } }
    }
    nloc = mine > 0u ? mine : 1u; nx = cnt > 0u ? cnt : 1u;
}

__device__ __forceinline__ void xcd_barrier(const XcdBarrier& b) {
    asm volatile("s_waitcnt vmcnt(0)" ::: "memory");
    __syncthreads();
    if (my_tid() == 0) {
        unsigned* bar = b.bar;
        __builtin_amdgcn_s_waitcnt(0);
        unsigned nloc = b.st[0], nx = b.st[1];
        if (nloc == 0u) { xcd_barrier_complete(bar, b.x, nloc, nx); b.st[0] = nloc; b.st[1] = nx; }
        const unsigned old = xb_add(&bar[XB_XSUB(b.x)], 1u);
        const unsigned gen = old / nloc;
        if (old + 1u == (gen + 1u) * nloc) {
            __builtin_amdgcn_fence(__ATOMIC_RELEASE, "agent");
            asm volatile("s_waitcnt vmcnt(0)" ::: "memory");
            const unsigned og = xb_add(&bar[XB_TOP], 1u);
            const unsigned tg = og / nx;
            if (og + 1u == (tg + 1u) * nx) xb_add(&bar[XB_TOPGEN], 1u);
            else XB_SPIN(xb_ld(&bar[XB_TOPGEN]) == tg, bar);
            __builtin_amdgcn_fence(__ATOMIC_ACQUIRE, "agent");
            asm volatile("s_waitcnt vmcnt(0)" ::: "memory");
        } else {
            XB_SPIN(xb_ld(&bar[XB_TOPGEN]) == gen, bar);
            __builtin_amdgcn_fence(__ATOMIC_ACQUIRE, "agent");
            asm volatile("s_waitcnt vmcnt(0)" ::: "memory");
        }
    }
    __syncthreads();
}


__device__ __forceinline__ void flat_barrier(unsigned* bar) {
    asm volatile("s_waitcnt vmcnt(0)" ::: "memory");
    __syncthreads();
    if (threadIdx.x == 0) {
        const unsigned G = gridDim.x;
        __builtin_amdgcn_fence(__ATOMIC_RELEASE, "agent");
        asm volatile("s_waitcnt vmcnt(0)" ::: "memory");
        const unsigned old = xb_add(&bar[XB_TOP], 1u);
        const unsigned target = (old / G + 1u) * G;
        XB_SPIN(xb_ld(&bar[XB_TOP]) < target, bar);
        __builtin_amdgcn_fence(__ATOMIC_ACQUIRE, "agent");
        asm volatile("s_waitcnt vmcnt(0)" ::: "memory");
    }
    __syncthreads();
}
struct Args {
  const float* in[17];
  float* out; unsigned char* ws; int ph_lo, ph_hi;
};
constexpr int N_PHASES = 12;

__global__ void __launch_bounds__(512, 2) mega_fwd(Args args) {
  extern __shared__ __attribute__((aligned(16))) unsigned char lds_raw[];
  LAS unsigned char* ldsl = (LAS unsigned char*)lds_raw;
  char* lds = (char*)lds_raw;
  { const int t0_ = threadIdx.x; if ((t0_ & 63) == 0) ((volatile unsigned char*)lds_raw)[HWTAB_OFF + hw_slot()] = (unsigned char)(t0_ >> 6); }
  __syncthreads();
  const int wave = my_wave();
#define lane (my_lane())
#define tid (wave * 64 + my_lane())
  const int G = gridDim.x, bx = blockIdx.x;
  unsigned char* ws = args.ws;
  const float* x = args.in[0];
  bf16* XB = (bf16*)(ws + WS_XB); unsigned char* ATT = ws + WS_X1F8; bf16* PQ = XB;
  bf16* PROJ = (bf16*)(ws + WS_PROJ); bf16* ZB = (bf16*)(ws + WS_PROJ); bf16* YB = (bf16*)(ws + WS_PROJ + 128 * MiB);
  int* EIDX = (int*)(ws + WS_EIDX); float* EG = (float*)(ws + WS_EG);
  bf16* X1B = (bf16*)(ws + WS_X1B); unsigned char* U8 = ws + WS_U8; unsigned char* V8 = ws + WS_V8; unsigned char* V4C = ws + WS_V4C; unsigned char* XB8 = ws + WS_X1F8; unsigned char* WIN8 = ws + WS_WIN; constexpr int N_F8 = C_SK;     unsigned* EIDP = (unsigned*)(ws + WS_EIDP);
  unsigned char* A8 = ws + WS_A8; unsigned* ctl = (unsigned*)(ws + WS_CTL); unsigned char* X1F8 = ws + WS_X1F8;
  bf16* WIN = (bf16*)(ws + WS_WIN); unsigned char* WO = ws + WS_WO; bf16* WQ = (bf16*)(ws + WS_WQ);
  const int lo = args.ph_lo, hi_ph = args.ph_hi;
#if MK_ONE_LAUNCH
  volatile LAS unsigned* misc = (volatile LAS unsigned*)(ldsl + LDS_BYTES - 64);
  XcdBarrier xbar; xbar.bar = ctl; xbar.x = xb_xcc_id(); xbar.st = misc + 2;
  if (tid == 0) { misc[2] = 0u; misc[3] = 0u; misc[0] = xb_add(&ctl[XB_XCNT(xbar.x)], 1u); }
  __syncthreads();
  const int my_xcc = (int)xbar.x, my_rank = __builtin_amdgcn_readfirstlane((int)misc[0]);
#endif
#if MK_ONE_LAUNCH
#define GRID_SYNC() xcd_barrier(xbar)
#else
#define GRID_SYNC() do {} while (0)
#endif
#ifndef PH_MASK
#define PH_MASK 0xfff
#endif
#ifndef REP_MASK
#define REP_MASK 0
#endif
#define IN(k) (((PH_MASK >> (k)) & 1) && lo <= (k) && (k) < hi_ph)
#define REP(k)
#define SEAM(k) do { if (IN(k) && IN((k) + 1)) GRID_SYNC(); } while (0)

  REP(0) if (IN(0)) {
    const size_t gtid = (size_t)bx * 512 + tid, gsz = (size_t)G * 512;
    cvt_stream2(x, XB, XB8, (size_t)NTOK * DM / 8, gtid, gsz);
    LAS float* scr = (LAS float*)(ldsl + wave * 8704);
    const int gw = bx * 8 + wave, NGW = G * 8;
    constexpr int I_IN = (DM / 64) * (LDP / 32), I_SQ = (DM / 64) * (DM / 32);
    for (int it = gw; it < I_IN + 2 * I_SQ; it += NGW) {
      if (it < I_IN) { const int kb = it / (LDP / 32), nb = it % (LDP / 32);
        if (nb < N_F8 / 32) transpose_item_fp8(args.in[1], DM, NPROJ, WIN8, scr, kb, nb, lane, 64.f);
        else transpose_item(args.in[1], DM, NPROJ, WIN, scr, kb, nb, lane); }
      else if (it < I_IN + I_SQ) { const int r = it - I_IN; transpose_item_fp8(args.in[2], DM, DM, WO, scr, r / (DM / 32), r % (DM / 32), lane, 64.f); }
      else { const int r = it - I_IN - I_SQ; transpose_item(args.in[10], DM, DM, WQ, scr, r / (DM / 32), r % (DM / 32), lane); }
    }
    __syncthreads();
  }
  SEAM(0);
  int vx = bx & 7, vrank = bx >> 3; const int nloc = G >> 3;
#if MK_ONE_LAUNCH
  {
    int npop = 0, before = 0; bool regular = true;
#pragma unroll
    for (int q = 0; q < 16; ++q) { const int cq = (int)__hip_atomic_load(ctl + XB_XCNT(q), __ATOMIC_RELAXED, __HIP_MEMORY_SCOPE_AGENT); if (cq > 0) { ++npop; if (q < my_xcc) ++before; if (cq != nloc) regular = false; } }
    if (regular && npop == 8 && (G & 7) == 0) { vx = before; vrank = my_rank; }
  }
#endif
  const int vcu = vrank * 8 + vx;
  REP(1) if (IN(1)) {
    { pg8::Gemm g{(const pg8::bf16_t*)XB8, (const pg8::bf16_t*)WIN8, NTOK, N_F8, DM}; pg8::StaticOrder S; S.init(NTOK, N_F8, G, vcu);
      pg8::EpiBf16<0> E{PROJ, LDP, nullptr, N_F8, 0, 1.0f / 64.0f};
      pg8::gemm_phase<pg8::EpiBf16<0>, pg8::StaticOrder, true, true, true, 0x7F7F7F7F>(ldsl, g, S, E); }
    __syncthreads();
    { pg8::Gemm g{XB, WIN + (size_t)N_F8 * DM, NTOK, LDP - N_F8, DM}; pg8::StaticOrder S; S.init(NTOK, LDP - N_F8, G, vcu);
      pg8::EpiBf16<0> E{PROJ + N_F8, LDP, nullptr, 0, 0, 1.f};
      pg8::gemm_phase<pg8::EpiBf16<0>, pg8::StaticOrder, true, true>(ldsl, g, S, E); }
    __syncthreads();
  }
  SEAM(1);
  REP(2) if (IN(2)) {
    float lam;
    { const float a = args.in[3][lane] * args.in[4][lane], b = args.in[5][lane] * args.in[6][lane];
      lam = __expf(wave_sum(a)) - __expf(wave_sum(b)) + LAM_INIT; }
    for (int rnd = 0; rnd * G < 1024; ++rnd) {
      const int i = rnd * G + ((rnd & 1) ? (G - 1 - bx) : bx);
      if (i < 1024) { const int qb = 63 - (i >> 4), b = i & 15; att::attn_unit<1>(PROJ, ATT, b, 0, qb, lds, lam, args.in[7]); }
    }
  }
  REP(3) if (IN(3)) {
    float lam;
    { const float a = args.in[3][lane] * args.in[4][lane], b = args.in[5][lane] * args.in[6][lane];
      lam = __expf(wave_sum(a)) - __expf(wave_sum(b)) + LAM_INIT; }
    for (int rnd = 0; rnd * G < 2048; ++rnd) {
      const int j = rnd * G + ((rnd & 1) ? (G - 1 - bx) : bx);
      if (j < 2048) { const int qb = 15 - (j >> 7), bh = j & 127; att::attn_unit<0>(PROJ, ATT, bh >> 3, (bh + rnd) & 7, qb, lds, lam, args.in[7]); }
    }
    { volatile LAS unsigned* qw = (volatile LAS unsigned*)(ldsl + LDS_BYTES - 64) + 4;
      for (;;) {
        __syncthreads();
        if (my_tid() == 0) { unsigned* qp = ctl + XQ_TBL; asm volatile("" : "+s"(qp)); qw[0] = xb_add(qp, 1u); }
        __syncthreads();
        const int c = __builtin_amdgcn_readfirstlane((int)qw[0]);
        if (c >= 2 * TBL_NCH) break;
        peer_tables_chunk(args.in[13], args.in[14], U8, V8, c);
      } }
  }
  SEAM(3);
  REP(4) if (IN(4)) {
    pg8::Gemm g{(const pg8::bf16_t*)ATT, (const pg8::bf16_t*)WO, NTOK, DM, DM}; pg8::StaticOrder S; S.init(NTOK, DM, G, vcu);
    pg8::EpiResid E{(const pg8::bf16_t*)XB, ZB, DM, ALPHA, 1.0f / 64.0f};
    pg8::gemm_phase<pg8::EpiResid, pg8::StaticOrder, true, true, true, 0x7F7F7F7F>(ldsl, g, S, E);
    __syncthreads();
  }
  SEAM(4);
  REP(5) if (IN(5)) {
    const int gw = bx * 8 + wave, NGW = G * 8;
    ln1_phase(ZB, args.in[8], args.in[9], X1B, X1F8, gw, NGW, lane);
  }
  SEAM(5);
  REP(6) if (IN(6)) {
    pg8::Gemm g{X1B, WQ, NTOK, DM, DM}; pg8::StaticOrder S; S.init(NTOK, DM, G, vcu);
    pg8::EpiBf16<0> E{PQ, DM, nullptr, 0, 0, 1.f};
    pg8::gemm_phase<pg8::EpiBf16<0>, pg8::StaticOrder, true, true>(ldsl, g, S, E);
    __syncthreads();
  }
  SEAM(6);
  REP(7) if (IN(7)) {
    peer::load_keys(args.in[11], args.in[12], lds);
    __syncthreads();
    for (int u = bx; u < NTOK / 32; u += G) peer::score_unit(PQ, EIDX, EG, u * 32, lds);
    __syncthreads();
  }
  SEAM(7);
  float* HPA = (float*)(ws + WS_HPA);
  REP(8) if (IN(8)) {
    const int wv = vrank * 8 + wave, nwv = nloc * 8;
    peer_u_pass(X1F8, U8, EIDX, HPA + (size_t)vx * NTOK * 128, lds + wave * 16384, wv, nwv, NTOK / nwv, vx, lane);
  }
  SEAM(8);
  REP(9) if (IN(9)) {
    const size_t gtid = (size_t)bx * 512 + tid, gsz = (size_t)G * 512;
    for (size_t i = gtid; i < (size_t)NTOK * 32; i += gsz) {
      f32x4 h = *reinterpret_cast<const f32x4*>(HPA + i * 4);
#pragma unroll
      for (int sl = 1; sl < NSLICE; ++sl) h += *reinterpret_cast<const f32x4*>(HPA + (size_t)sl * NTOK * 128 + i * 4);
      const f32x4 gg = *reinterpret_cast<const f32x4*>(EG + i * 4); float a[4];
#pragma unroll
      for (int e = 0; e < 4; ++e) { const float hv = h[e] * (1.0f / U_SCALE); a[e] = 0.5f * hv * (1.0f + erff(hv * 0.70710678118654752f)) * gg[e] * 64.0f; }
      int p = __builtin_amdgcn_cvt_pk_fp8_f32(a[0], a[1], 0, false); p = __builtin_amdgcn_cvt_pk_fp8_f32(a[2], a[3], p, true);
      *reinterpret_cast<int*>(A8 + i * 4) = p;
    }
    for (int it = bx * 8 + wave; it < NTOK / 4; it += G * 8) eidp_item(EIDX, EIDP, it, lane);
    for (int it = bx * 8 + wave; it < 8 * (NEXP / 64); it += G * 8) v4c_relayout_item(V8, V4C, it / (NEXP / 64), it % (NEXP / 64), lane);
  }
  SEAM(9);
  REP(10) if (IN(10)) {
    for (int u = ((G & 7) == 0) ? vx * nloc + vrank : bx; u < 256; u += G) peer_v_pass2(A8, V4C, EIDP, YB, lds, u >> 1, (u & 1) * (NTOK / 2), NTOK / 2, wave, lane);
  }
  SEAM(10);
  REP(11) if (IN(11)) {
    const int gw = bx * 8 + wave, NGW = G * 8;
    ln2_phase(X1B, YB, args.in[15], args.in[16], args.out, gw, NGW, lane);
  }
#undef IN
#undef SEAM
#undef lane
#undef tid
}

#ifndef REP_MASK
#define REP_MASK 0
#endif
extern "C" void kernel_launch(void* const* d_in, const int* in_sizes, int n_in, void* d_out, int out_size, void* d_ws, size_t ws_size, hipStream_t stream) {
  static int grid = 0;
  if (grid == 0) {
    if (n_in != 17 || in_sizes[0] != NTOK * DM || out_size != NTOK * DM || ws_size < WS_END) {
      fprintf(stderr, "kernel_launch: unexpected shapes: n_in %d in0 %d out %d ws %zu (need >= %zu)\n", n_in, n_in > 0 ? in_sizes[0] : -1, out_size, ws_size, (size_t)WS_END); grid = -1; return; }
    int dev = 0, cus = 0, per_cu = 0;
    if (hipGetDevice(&dev) != hipSuccess || hipDeviceGetAttribute(&cus, hipDeviceAttributeMultiprocessorCount, dev) != hipSuccess) { grid = -1; return; }
    if (hipFuncSetAttribute((const void*)mega_fwd, hipFuncAttributeMaxDynamicSharedMemorySize, LDS_BYTES) != hipSuccess) { fprintf(stderr, "kernel_launch: hipFuncSetAttribute failed\n"); grid = -1; return; }
    if (hipOccupancyMaxActiveBlocksPerMultiprocessor(&per_cu, (const void*)mega_fwd, 512, LDS_BYTES) != hipSuccess || per_cu < 1) { fprintf(stderr, "kernel_launch: occupancy query says %d\n", per_cu); per_cu = 1; }
    (void)hipGetLastError();
    grid = cus * (per_cu > 1 ? 1 : per_cu);
  }
  if (grid < 0) return;
  Args a{};
  for (int i = 0; i < 17; ++i) a.in[i] = (const float*)d_in[i];
  a.out = (float*)d_out; a.ws = (unsigned char*)d_ws;
  if (hipMemsetAsync((char*)d_ws + WS_CTL, 0, 16384, stream) != hipSuccess) { fprintf(stderr, "kernel_launch: memset failed\n"); return; }
#if MK_ONE_LAUNCH
  a.ph_lo = 0; a.ph_hi = N_PHASES;
  void* kargs[] = {&a};
  hipError_t e = hipLaunchCooperativeKernel((const void*)mega_fwd, dim3(grid), dim3(512), kargs, LDS_BYTES, stream);
  if (e != hipSuccess) fprintf(stderr, "kernel_launch: cooperative launch failed: %s (grid %d)\n", hipGetErrorString(e), grid);
#else
  for (int p = 0; p < N_PHASES; ++p) {
    a.ph_lo = p; a.ph_hi = p + 1;
    for (int rep = 0; rep < (((REP_MASK >> p) & 1) ? 2 : 1); ++rep)
      hipLaunchKernelGGL(mega_fwd, dim3(grid), dim3(512), LDS_BYTES, stream, a);
  }
  const hipError_t le = hipPeekAtLastError();
  if (le != hipSuccess) fprintf(stderr, "kernel_launch: launch failed: %s\n", hipGetErrorName(le));
#endif
}
```

```cpp
#include <hip/hip_runtime.h>
#include <hip/hip_cooperative_groups.h>
#include <cstdio>
#include <cstdint>
namespace cg = cooperative_groups;

#ifndef MK_ONE_LAUNCH
#define MK_ONE_LAUNCH 1
#endif

constexpr int NB = 16, SEQ = 2048, DM = 2048, NTOK = NB * SEQ;
constexpr int NPROJ = 5456, LDP = 5632;
constexpr int C_DQ = 0, C_DK = 1024, C_DV = 2048, C_SQ = 3072, C_SK = 4096, C_SV = 4224, C_IQ = 4352, C_IK = 5376, C_IW = 5440;
constexpr int NEXP = 16384;
constexpr float LN_EPS = 1e-5f, RMS_EPS = 1e-5f;
constexpr float ALPHA = 1.189207115002721f;
constexpr float LAM_INIT = 0.2f;
constexpr float LOG2E = 1.4426950408889634f;

constexpr size_t MiB = (size_t)1 << 20;
constexpr size_t WS_XB = 0;
constexpr size_t WS_PROJ = 128 * MiB;
constexpr size_t WS_EIDX = 384 * MiB;
constexpr size_t WS_EG = 400 * MiB;
constexpr size_t WS_X1B = 480 * MiB;
constexpr size_t WS_V4C = 416 * MiB;
constexpr size_t WS_EIDP = 432 * MiB;
constexpr size_t WS_CTL = 774 * MiB;
constexpr size_t WS_U8 = 608 * MiB;
constexpr size_t WS_V8 = 640 * MiB;
constexpr size_t WS_HPA = 0;
constexpr size_t WS_X1F8 = 672 * MiB;
constexpr size_t WS_WIN = 736 * MiB;
constexpr size_t WS_WO = 758 * MiB;
constexpr size_t WS_WQ = 766 * MiB;
constexpr size_t WS_A8 = 775 * MiB;
constexpr size_t WS_END = 779 * MiB;

constexpr int LDS_BYTES = 147456;

typedef unsigned short bf16;
#define LAS __attribute__((address_space(3)))


constexpr int HWTAB_OFF = LDS_BYTES - 128;
__device__ __forceinline__ int hw_slot() { return (int)(__builtin_amdgcn_s_getreg((6 << 11) | 4  ) & 63u); }
__device__ __forceinline__ int my_lane() { int r; asm volatile("v_mbcnt_lo_u32_b32 %0, -1, 0\n\tv_mbcnt_hi_u32_b32 %0, -1, %0" : "=v"(r)); return r; }
__device__ __forceinline__ int my_wave() { extern __shared__ __attribute__((aligned(16))) unsigned char lds_raw[]; return __builtin_amdgcn_readfirstlane((int)((volatile unsigned char*)lds_raw)[HWTAB_OFF + hw_slot()]); }
__device__ __forceinline__ int my_tid() { return my_wave() * 64 + my_lane(); }
namespace pg8 {
#define PG8_LAS __attribute__((address_space(3)))
typedef unsigned short bf16_t;
typedef short bf16x8 __attribute__((ext_vector_type(8)));
typedef float f32x4 __attribute__((ext_vector_type(4)));
typedef unsigned u32x4 __attribute__((ext_vector_type(4)));
typedef int v8i_t __attribute__((ext_vector_type(8)));
typedef int i32x4_t __attribute__((ext_vector_type(4)));
__device__ __forceinline__ v8i_t cat8(bf16x8 lo, bf16x8 hi) { return __builtin_shufflevector(__builtin_bit_cast(i32x4_t, lo), __builtin_bit_cast(i32x4_t, hi), 0, 1, 2, 3, 4, 5, 6, 7); }
constexpr int BM = 256, BK = 64, HALF = 128, HTB = HALF * BK * 2  , STAGE_BYTES = 8 * HTB, NXCD = 8, WGM = 8;

__host__ __device__ __forceinline__ int lds_byte(int r, int c) { const int st = (r >> 4) * 2 + (c >> 5), rr = r & 15, cc = c & 31, ob = rr * 64 + cc * 2; return st * 1024 + (ob ^ (((ob >> 9) & 1) << 5)); }
__host__ __device__ __forceinline__ void stage_rc(int b, int& R, int& C) { const int st = b / 1024, sb = b % 1024, swz = sb ^ (((sb >> 9) & 1) << 5); R = (st >> 1) * 16 + swz / 64; C = (st & 1) * 32 + (swz % 64) / 2; }
__host__ __device__ __forceinline__ int perm32(int rho) { const int n = rho >> 4, i = rho & 15; return 8 * (i >> 2) + 4 * n + (i & 3); }

struct Unit { int pm, pn; };
struct Gemm { const bf16_t* A; const bf16_t* Bt; int M, N, K; };

struct StaticOrder {
    int nM, nN, nwg, G, c;
    __host__ __device__ void init(int M, int N, int G_, int c_) { nM = M / BM; nN = N / BM; nwg = nM * nN; G = G_; c = c_; }
    __host__ __device__ bool next(int i, Unit& u) const {
        const long L = (long)i * G + c; if (L >= nwg) return false;
        int wgid = (int)L; { const int q = nwg / NXCD, r = nwg % NXCD, xcd = wgid % NXCD, off = wgid / NXCD; wgid = (xcd < r ? xcd * (q + 1) : r * (q + 1) + (xcd - r) * q) + off; }
        const int nig = WGM * nN, gid = wgid / nig, fm = gid * WGM, gsz = (nM - fm) < WGM ? (nM - fm) : WGM;
        u.pm = fm + ((wgid % nig) % gsz); u.pn = (wgid % nig) / gsz; return true;
    }
    __device__ __forceinline__ void a_ready(const Unit&) const {}
    __device__ __forceinline__ void done(const Unit&) const {}
};
__device__ __forceinline__ unsigned cvt_pk_bf16(float lo, float hi) { unsigned r; asm volatile("v_cvt_pk_bf16_f32 %0, %1, %2" : "=v"(r) : "v"(lo), "v"(hi)); return r; }
typedef float f32x2 __attribute__((ext_vector_type(2)));
__device__ __forceinline__ f32x2 gelu_pk(f32x2 v) {
    const f32x2 av = __builtin_elementwise_abs(v), d = av * 0.2316418882f + 1.0f;
    f32x2 t; t.x = __builtin_amdgcn_rcpf(d.x); t.y = __builtin_amdgcn_rcpf(d.y);
    f32x2 q = t * 0.5307027145f + (-0.7265760135f); q = q * t + 0.7107068705f; q = q * t + (-0.142248368f); q = q * t + 0.127414796f; q = q * t;
    const f32x2 s = (v * v) * (-0.72134752044f);
    f32x2 e; e.x = __builtin_amdgcn_exp2f(s.x); e.y = __builtin_amdgcn_exp2f(s.y);
    const f32x2 m = v * (q * e), r = v - m;
    f32x2 o; o.x = v.x < 0.f ? m.x : r.x; o.y = v.y < 0.f ? m.y : r.y; return o;
}

template <int ACT  > struct EpiBf16 {
    static constexpr bool PERM = true, AFTER_DRAIN = false; static_assert(ACT == 0 || ACT == 1, "EpiBf16: ACT is 0 (none) or 1 (gelu_pk)");
    bf16_t* O; int ldc; const float* bias; int split_cols; size_t split_stride; float scale0;
    __device__ __forceinline__ void operator()(const f32x4 (&acc)[2][2][4][2], const Unit& u, int wr, int wc, int fr, int fq) const {
        const int row0 = u.pm * BM + wr * 64 + fr; int colt = u.pn * BM; bf16_t* base = O;
        float sc = 1.f; if (split_cols) { const int t = colt / split_cols; base += (size_t)t * split_stride; colt -= t * split_cols; if (t == 0) sc = scale0; }
        const int col0 = colt + wc * 32 + 8 * fq, bcol0 = u.pn * BM + wc * 32 + 8 * fq;
        f32x4 bv[2][2];
#pragma unroll
        for (int bj = 0; bj < 2; ++bj)
#pragma unroll
            for (int n = 0; n < 2; ++n) bv[bj][n] = bias ? *(const f32x4*)(bias + bcol0 + bj * HALF + 4 * n) : (f32x4){0.f, 0.f, 0.f, 0.f};
#pragma unroll
        for (int ai = 0; ai < 2; ++ai)
#pragma unroll
            for (int m = 0; m < 4; ++m) { bf16_t* rowp = base + (size_t)(row0 + ai * HALF + m * 16) * ldc + col0;
#pragma unroll
                for (int bj = 0; bj < 2; ++bj) { f32x4 v0 = acc[ai][bj][m][0] + bv[bj][0], v1 = acc[ai][bj][m][1] + bv[bj][1];
                    if (ACT == 1) { f32x2 a = gelu_pk((f32x2){v0[0], v0[1]}), b = gelu_pk((f32x2){v0[2], v0[3]}), c = gelu_pk((f32x2){v1[0], v1[1]}), d = gelu_pk((f32x2){v1[2], v1[3]});
                        v0 = (f32x4){a.x, a.y, b.x, b.y}; v1 = (f32x4){c.x, c.y, d.x, d.y}; }
                    v0 = v0 * sc; v1 = v1 * sc; u32x4 w; w.x = cvt_pk_bf16(v0[0], v0[1]); w.y = cvt_pk_bf16(v0[2], v0[3]); w.z = cvt_pk_bf16(v1[0], v1[1]); w.w = cvt_pk_bf16(v1[2], v1[3]);
                    *(u32x4*)(rowp + bj * HALF) = w; } }
    }
};
struct EpiResid {
    static constexpr bool PERM = true, AFTER_DRAIN = false;
    const bf16_t* X; bf16_t* Z; int ldc; float alpha; float accscale;
    __device__ __forceinline__ void operator()(const f32x4 (&acc)[2][2][4][2], const Unit& u, int wr_, int wc_, int fr_, int fq_) const {
        int t = my_lane(); asm volatile("" : "+v"(t));
        const int wv = my_wave(), wr = wv >> 2, wc = wv & 3, fr = t & 15, fq = t >> 4; (void)wr_; (void)wc_; (void)fr_; (void)fq_;
        const int row0 = u.pm * BM + wr * 64 + fr, col0 = u.pn * BM + wc * 32 + 8 * fq;
#pragma unroll
        for (int ai = 0; ai < 2; ++ai)
#pragma unroll
            for (int m = 0; m < 4; ++m) { const unsigned off = (unsigned)(row0 + ai * HALF + m * 16) * (unsigned)ldc + (unsigned)col0;
#pragma unroll
                for (int bj = 0; bj < 2; ++bj) { const u32x4 xw = *(const u32x4*)(X + off + bj * HALF);
                    const f32x4 x0 = {__uint_as_float(xw.x << 16), __uint_as_float(xw.x & 0xffff0000u), __uint_as_float(xw.y << 16), __uint_as_float(xw.y & 0xffff0000u)};
                    const f32x4 x1 = {__uint_as_float(xw.z << 16), __uint_as_float(xw.z & 0xffff0000u), __uint_as_float(xw.w << 16), __uint_as_float(xw.w & 0xffff0000u)};
                    const f32x4 v0 = x0 * alpha + acc[ai][bj][m][0] * accscale, v1 = x1 * alpha + acc[ai][bj][m][1] * accscale;
                    u32x4 w; w.x = cvt_pk_bf16(v0[0], v0[1]); w.y = cvt_pk_bf16(v0[2], v0[3]); w.z = cvt_pk_bf16(v1[0], v1[1]); w.w = cvt_pk_bf16(v1[2], v1[3]);
                    *(u32x4*)(Z + off + bj * HALF) = w; }
                asm volatile("" ::: "memory"); }
    }
};

template <class Epi, class Sched, bool ALIGN_EPI = false, bool SP2 = false, bool FP8 = false, int SCALE_B = 0x7F7F7F7F>
__device__ __forceinline__ void gemm_phase(PG8_LAS unsigned char* lds, const Gemm g, const Sched& S, const Epi& E) {
    const int tid = my_tid(), wid = __builtin_amdgcn_readfirstlane(tid >> 6), lane = tid & 63, wr = wid >> 2, wc = wid & 3, fr = lane & 15, fq = lane >> 4;
    const int K = g.K, nt = FP8 ? K / 128 : K / BK;
    unsigned voffA[2], voffB[2];
#pragma unroll
    for (int i = 0; i < 2; ++i) { int R, C; stage_rc(tid * 16 + i * 8192, R, C); const int Rb = Epi::PERM ? ((R & ~31) + perm32(R & 31)) : R;
        voffA[i] = FP8 ? (unsigned)(R * K + C * 2) : (unsigned)(R * K + C) * 2u; voffB[i] = FP8 ? (unsigned)(Rb * K + C * 2) : (unsigned)(Rb * K + C) * 2u; }
    const unsigned kstep = (unsigned)(BK * 2);
    const unsigned hstep = (unsigned)HALF * (unsigned)K * (FP8 ? 1u : 2u);
    const unsigned tstep = 2u * hstep;
    const unsigned ldsw = (unsigned)wid * 1024u;
    const int aoff = lds_byte(wr * 64 + fr, fq * 8), boff = lds_byte(wc * 32 + fr, fq * 8);
#define PG8_SA(b, h) (((b) * 2 + (h)) * HTB)
#define PG8_SB(b, h) ((4 + (b) * 2 + (h)) * HTB)
    const __amdgpu_buffer_rsrc_t rsrc_voffA = __builtin_amdgcn_make_buffer_rsrc((void*)g.A, (short)0, -1, 0x00020000), rsrc_voffB = __builtin_amdgcn_make_buffer_rsrc((void*)g.Bt, (short)0, -1, 0x00020000);
    const char* const base_voffA = (const char*)g.A; const char* const base_voffB = (const char*)g.Bt;
#define PG8_STAGE(bufoff, goff, voff) do { _Pragma("unroll") for (int _i = 0; _i < 2; ++_i) { \
        if constexpr (FP8) __builtin_amdgcn_raw_ptr_buffer_load_lds(rsrc_##voff, (PG8_LAS void*)(lds + (bufoff) + ldsw + _i * 8192), 16, (int)(voff)[_i], (int)(goff), 0, 0); \
        else __builtin_amdgcn_global_load_lds((const unsigned*)(base_##voff + (size_t)(goff) + (voff)[_i]), (PG8_LAS unsigned*)(lds + (bufoff) + ldsw + _i * 8192), 16, 0, 0); } } while (0)
#define PG8_LDA(dst, b, h) do { _Pragma("unroll") for (int m = 0; m < 4; ++m) _Pragma("unroll") for (int k = 0; k < 2; ++k) dst[m][k] = *(const PG8_LAS bf16x8*)(lds + PG8_SA(b, h) + aoff + m * 2048 + k * 1024); } while (0)
#define PG8_LDB(dst, b, h) do { _Pragma("unroll") for (int n = 0; n < 2; ++n) _Pragma("unroll") for (int k = 0; k < 2; ++k) dst[n][k] = *(const PG8_LAS bf16x8*)(lds + PG8_SB(b, h) + boff + n * 2048 + k * 1024); } while (0)
#define PG8_MMA(ai, bj, At, Bt) do { __builtin_amdgcn_s_setprio(1); _Pragma("unroll") for (int m = 0; m < 4; ++m) _Pragma("unroll") for (int n = 0; n < 2; ++n) { \
        if constexpr (FP8) acc[ai][bj][m][n] = __builtin_amdgcn_mfma_scale_f32_16x16x128_f8f6f4(cat8(Bt[n][0], Bt[n][1]), cat8(At[m][0], At[m][1]), acc[ai][bj][m][n], 0, 0, 0, SCALE_B, 0, 0x7F7F7F7F); \
        else { _Pragma("unroll") for (int k = 0; k < 2; ++k) acc[ai][bj][m][n] = __builtin_amdgcn_mfma_f32_16x16x32_bf16(Bt[n][k], At[m][k], acc[ai][bj][m][n], 0, 0, 0); } } \
        __builtin_amdgcn_s_setprio(0); } while (0)
#define PG8_WAIT_V(n) asm volatile("s_waitcnt vmcnt(" #n ")" ::: "memory")
#define PG8_WAIT_L(n) asm volatile("s_waitcnt lgkmcnt(" #n ")" ::: "memory")
#define PG8_BAR __builtin_amdgcn_s_barrier()
#define PG8_SCHED __builtin_amdgcn_sched_barrier(0)
    Unit cur, nxt; int ui = 0;
    if (!S.next(0, cur)) return;
    f32x4 acc[2][2][4][2];
#pragma unroll
    for (int a = 0; a < 2; ++a)
#pragma unroll
        for (int b = 0; b < 2; ++b)
#pragma unroll
            for (int m = 0; m < 4; ++m)
#pragma unroll
                for (int n = 0; n < 2; ++n) acc[a][b][m][n] = (f32x4){0.f, 0.f, 0.f, 0.f};
    bf16x8 At[4][2], B0[2][2], B1[2][2];
    unsigned cA = (unsigned)cur.pm * tstep, cB = (unsigned)cur.pn * tstep;
    S.a_ready(cur);
    if constexpr (SP2) {
        PG8_STAGE(PG8_SB(0, 0), cB, voffB); PG8_STAGE(PG8_SB(0, 1), cB + hstep, voffB); PG8_STAGE(PG8_SA(0, 0), cA, voffA); PG8_STAGE(PG8_SA(0, 1), cA + hstep, voffA);
        if (wr == 1) PG8_BAR;
        PG8_WAIT_V(2); PG8_BAR;
        PG8_STAGE(PG8_SB(1, 0), cB + kstep, voffB); PG8_STAGE(PG8_SA(1, 0), cA + kstep, voffA); PG8_STAGE(PG8_SB(1, 1), cB + hstep + kstep, voffB);
        PG8_WAIT_V(6); PG8_BAR;
    } else {
        PG8_STAGE(PG8_SB(0, 0), cB, voffB); PG8_STAGE(PG8_SA(0, 0), cA, voffA); PG8_STAGE(PG8_SB(0, 1), cB + hstep, voffB); PG8_STAGE(PG8_SA(0, 1), cA + hstep, voffA);
        if (wr == 1) PG8_BAR;
        PG8_WAIT_V(4); PG8_BAR;
        PG8_STAGE(PG8_SB(1, 0), cB + kstep, voffB); PG8_STAGE(PG8_SA(1, 0), cA + kstep, voffA); PG8_STAGE(PG8_SB(1, 1), cB + hstep + kstep, voffB);
        PG8_WAIT_V(6); PG8_BAR;
    }
    for (;;) {
        const bool has_next = S.next(ui + 1, nxt);
        const unsigned nA = has_next ? (unsigned)nxt.pm * tstep : cA, nB = has_next ? (unsigned)nxt.pn * tstep : cB;
        for (int t = 0; t < nt; t += 2) {
            const bool last = (t == nt - 2);
            const unsigned a1 = cA + (unsigned)(t + 1) * kstep;
            const unsigned a2 = last ? nA : cA + (unsigned)(t + 2) * kstep, b2 = last ? nB : cB + (unsigned)(t + 2) * kstep;
            const unsigned a3 = a2 + kstep, b3 = b2 + kstep;
            if (last && has_next) S.a_ready(nxt);
            if constexpr (SP2) {
            PG8_LDB(B0, 0, 0); PG8_LDB(B1, 0, 1); PG8_SCHED; PG8_LDA(At, 0, 0); PG8_STAGE(PG8_SA(1, 1), a1 + hstep, voffA);
            PG8_WAIT_V(8); PG8_WAIT_L(0); PG8_BAR; PG8_MMA(0, 0, At, B0); PG8_MMA(0, 1, At, B1); PG8_BAR; PG8_SCHED;
            PG8_LDA(At, 0, 1); PG8_STAGE(PG8_SB(0, 0), b2, voffB); PG8_STAGE(PG8_SB(0, 1), b2 + hstep, voffB); PG8_STAGE(PG8_SA(0, 0), a2, voffA);
            PG8_WAIT_V(8); PG8_WAIT_L(0); PG8_BAR; PG8_MMA(1, 0, At, B0); PG8_MMA(1, 1, At, B1); PG8_BAR; PG8_SCHED;
            PG8_LDB(B0, 1, 0); PG8_LDB(B1, 1, 1); PG8_SCHED; PG8_LDA(At, 1, 0); PG8_STAGE(PG8_SA(0, 1), a2 + hstep, voffA);
            PG8_WAIT_V(8); PG8_WAIT_L(0); PG8_BAR; PG8_MMA(0, 0, At, B0); PG8_MMA(0, 1, At, B1); PG8_BAR; PG8_SCHED;
            PG8_LDA(At, 1, 1); PG8_STAGE(PG8_SB(1, 0), b3, voffB); PG8_STAGE(PG8_SB(1, 1), b3 + hstep, voffB); PG8_STAGE(PG8_SA(1, 0), a3, voffA);
            PG8_WAIT_V(8); PG8_WAIT_L(0); PG8_BAR; PG8_MMA(1, 0, At, B0); PG8_MMA(1, 1, At, B1); PG8_BAR; PG8_SCHED;
            } else {
            PG8_LDB(B0, 0, 0); PG8_SCHED; PG8_LDA(At, 0, 0); PG8_STAGE(PG8_SA(1, 1), a1 + hstep, voffA);
            PG8_WAIT_L(8); PG8_BAR; PG8_WAIT_L(0); PG8_MMA(0, 0, At, B0); PG8_BAR; PG8_SCHED;
            PG8_LDB(B1, 0, 1); PG8_STAGE(PG8_SB(0, 0), b2, voffB);
            PG8_BAR; PG8_WAIT_L(0); PG8_MMA(0, 1, At, B1); PG8_BAR;
            PG8_LDA(At, 0, 1); PG8_STAGE(PG8_SA(0, 0), a2, voffA);
            PG8_BAR; PG8_WAIT_L(0); PG8_MMA(1, 0, At, B0); PG8_BAR; PG8_SCHED;
            PG8_STAGE(PG8_SB(0, 1), b2 + hstep, voffB);
            PG8_WAIT_V(6); PG8_BAR; PG8_MMA(1, 1, At, B1); PG8_BAR;
            PG8_LDB(B0, 1, 0); PG8_SCHED; PG8_LDA(At, 1, 0); PG8_STAGE(PG8_SA(0, 1), a2 + hstep, voffA);
            PG8_WAIT_L(8); PG8_BAR; PG8_WAIT_L(0); PG8_MMA(0, 0, At, B0); PG8_BAR; PG8_SCHED;
            PG8_LDB(B1, 1, 1); PG8_STAGE(PG8_SB(1, 0), b3, voffB);
            PG8_BAR; PG8_WAIT_L(0); PG8_MMA(0, 1, At, B1); PG8_BAR;
            PG8_LDA(At, 1, 1); PG8_STAGE(PG8_SA(1, 0), a3, voffA);
            PG8_BAR; PG8_WAIT_L(0); PG8_MMA(1, 0, At, B0); PG8_BAR; PG8_SCHED;
            PG8_STAGE(PG8_SB(1, 1), b3 + hstep, voffB);
            PG8_WAIT_V(6); PG8_BAR; PG8_MMA(1, 1, At, B1); PG8_BAR;
            }
        }
        if constexpr (ALIGN_EPI) { if (wr == 0) PG8_BAR; }
        if constexpr (!Epi::AFTER_DRAIN) { E(acc, cur, wr, wc, fr, fq); S.done(cur); }
        if (!has_next) break;
#pragma unroll
        for (int a = 0; a < 2; ++a)
#pragma unroll
            for (int b = 0; b < 2; ++b)
#pragma unroll
                for (int m = 0; m < 4; ++m)
#pragma unroll
                    for (int n = 0; n < 2; ++n) acc[a][b][m][n] = (f32x4){0.f, 0.f, 0.f, 0.f};
        cur = nxt; cA = nA; cB = nB; ++ui;
        if constexpr (ALIGN_EPI) { if (wr == 1) PG8_BAR; }
    }
    PG8_WAIT_V(0);
    if constexpr (!ALIGN_EPI) { if (wr == 0) PG8_BAR; }
    PG8_BAR;
    if constexpr (Epi::AFTER_DRAIN) { E.fused(acc, cur, wr, wc, fr, fq, lds, wid, lane); S.done(cur); }
#undef PG8_SA
#undef PG8_SB
#undef PG8_STAGE
#undef PG8_LDA
#undef PG8_LDB
#undef PG8_MMA
#undef PG8_WAIT_V
#undef PG8_WAIT_L
#undef PG8_BAR
#undef PG8_SCHED
}
}


namespace att {
using bf16x8 = __attribute__((ext_vector_type(8))) short;
using s16x4  = __attribute__((ext_vector_type(4))) short;
using f32x16 = __attribute__((ext_vector_type(16))) float;
using u32x4  = __attribute__((ext_vector_type(4))) unsigned;
using u32x2  = __attribute__((ext_vector_type(2))) unsigned;
constexpr int SHM_V = 16384, SHM_K = 16384;
constexpr int L_V = 0, L_K = 32768, L_WS = 69632, L_SEL = 131072, L_END = 139264;
#ifndef ATT_SDEPTH
#define ATT_SDEPTH 1
#endif
constexpr int SDEPTH = ATT_SDEPTH;
constexpr float THR2 = 11.0f;
#define KSWZ(row, colB) ((row) * 256 + ((colB) ^ (((row) & 7) << 4)))
#define SBAR() __builtin_amdgcn_sched_barrier(0)
__device__ __forceinline__ int crow(int r, int hi) { return (r & 3) + 8 * (r >> 2) + 4 * hi; }
__device__ __forceinline__ unsigned cvtpk(float lo, float hi) { unsigned r; asm volatile("v_cvt_pk_bf16_f32 %0, %1, %2" : "=v"(r) : "v"(lo), "v"(hi)); return r; }
__device__ __forceinline__ bf16x8 ld8(const bf16* p) { return *reinterpret_cast<const bf16x8*>(p); }
__device__ __forceinline__ float bf2f(bf16 v) { return __uint_as_float((unsigned)v << 16); }
__device__ __forceinline__ float ninf() { return __uint_as_float(0xff800000u); }

template <int ND0> __device__ __forceinline__ void qkt(f32x16& p0, f32x16& p1, const char* Ks, const bf16x8* qr, int r32, int hi, int d0base) {
  p0 = f32x16{}; p1 = f32x16{};
#pragma unroll
  for (int d0 = 0; d0 < ND0; ++d0) { const int cb = ((d0base + d0) * 16 + hi * 8) * 2;
    bf16x8 b0 = *reinterpret_cast<const bf16x8*>(Ks + KSWZ(r32, cb));
    bf16x8 b1 = *reinterpret_cast<const bf16x8*>(Ks + KSWZ(32 + r32, cb));
    p0 = __builtin_amdgcn_mfma_f32_32x32x16_bf16(b0, qr[d0], p0, 0, 0, 0);
    p1 = __builtin_amdgcn_mfma_f32_32x32x16_bf16(b1, qr[d0], p1, 0, 0, 0); }
}
__device__ __forceinline__ int v_st(int k, int c) { const int kk = (k & ~0xC) | ((k & 4) << 1) | ((k & 8) >> 1); return ((kk >> 3) * 4 + (c >> 5)) * 512 + ((kk & 7) * 32 + (c & 31)) * 2; }
__device__ __forceinline__ int v_rd_base(int lane) { return ((lane & 3) << 3) | (((lane >> 2) & 3) << 6) | (((lane >> 4) & 1) << 5) | (((lane >> 5) & 1) << 8); }
constexpr int v_rd_off(int d0, int ks, int half) { return d0 * 512 + ks * 4096 + half * 2048; }
template <int OFF> __device__ __forceinline__ s16x4 tr_read(int vb) {
  s16x4 r; asm volatile("ds_read_b64_tr_b16 %0, %1 offset:%2" : "=&v"(r) : "v"(vb), "i"(OFF) : "memory"); return r;
}
template <int D0> __device__ __forceinline__ void pv_one(f32x16& od, int vb, bf16x8 pa0, bf16x8 pa1, bf16x8 pa2, bf16x8 pa3) {
#define PK(L, H) (bf16x8){L[0], L[1], L[2], L[3], H[0], H[1], H[2], H[3]}
  { const s16x4 l0 = tr_read<v_rd_off(D0, 0, 0)>(vb), h0 = tr_read<v_rd_off(D0, 0, 1)>(vb), l1 = tr_read<v_rd_off(D0, 1, 0)>(vb), h1 = tr_read<v_rd_off(D0, 1, 1)>(vb);
    asm volatile("s_waitcnt lgkmcnt(0)" ::: "memory"); SBAR();
    od = __builtin_amdgcn_mfma_f32_32x32x16_bf16(pa0, PK(l0, h0), od, 0, 0, 0);
    od = __builtin_amdgcn_mfma_f32_32x32x16_bf16(pa1, PK(l1, h1), od, 0, 0, 0); }
  { const s16x4 l2 = tr_read<v_rd_off(D0, 2, 0)>(vb), h2 = tr_read<v_rd_off(D0, 2, 1)>(vb), l3 = tr_read<v_rd_off(D0, 3, 0)>(vb), h3 = tr_read<v_rd_off(D0, 3, 1)>(vb);
    asm volatile("s_waitcnt lgkmcnt(0)" ::: "memory"); SBAR();
    od = __builtin_amdgcn_mfma_f32_32x32x16_bf16(pa2, PK(l2, h2), od, 0, 0, 0);
    od = __builtin_amdgcn_mfma_f32_32x32x16_bf16(pa3, PK(l3, h3), od, 0, 0, 0); }
#undef PK
}
__device__ __forceinline__ void pv_d0(f32x16* o, int vb, bf16x8 pa0, bf16x8 pa1, bf16x8 pa2, bf16x8 pa3) {
  pv_one<0>(o[0], vb, pa0, pa1, pa2, pa3); pv_one<1>(o[1], vb, pa0, pa1, pa2, pa3); pv_one<2>(o[2], vb, pa0, pa1, pa2, pa3); pv_one<3>(o[3], vb, pa0, pa1, pa2, pa3);
}

template <int MODE> __device__ __forceinline__ void partialSM(f32x16& p0, f32x16& p1, float Cs, float slope2, float thr, int k0, int qpos, int hi,
                                                              const char* selrow, bool diag, float& m_reg, float& off, float& alpha, bool& dead) {
#pragma unroll
  for (int r = 0; r < 16; ++r) { const float cr = (float)((r & 3) + 8 * (r >> 2)); p0[r] = fmaf(p0[r], Cs, cr); p1[r] = fmaf(p1[r], Cs, cr); }
  if (MODE == 0) {
    if (diag) { const int dqh = qpos - k0 - 4 * hi;
#pragma unroll
      for (int r = 0; r < 16; ++r) { const int cr = (r & 3) + 8 * (r >> 2); if (cr > dqh) p0[r] = ninf(); if (cr + 32 > dqh) p1[r] = ninf(); } }
  } else {
    const u32x2 w = *reinterpret_cast<const u32x2*>(selrow + (k0 >> 5) * 4);
    const unsigned w0 = w.x >> (4 * hi), w1 = w.y >> (4 * hi);
    const float ninf_ = ninf();
#pragma unroll
    for (int r = 0; r < 16; ++r) { const int cr = (r & 3) + 8 * (r >> 2); unsigned t0, t1;
      asm("v_bfe_i32 %0, %1, %2, 1" : "=v"(t0) : "v"(w0), "n"(cr)); asm("v_bfi_b32 %0, %1, %2, %0" : "+v"(p0[r]) : "v"(t0), "s"(ninf_));
      asm("v_bfe_i32 %0, %1, %2, 1" : "=v"(t1) : "v"(w1), "n"(cr)); asm("v_bfi_b32 %0, %1, %2, %0" : "+v"(p1[r]) : "v"(t1), "s"(ninf_)); }
  }
#ifdef VALU_PROBE
  { float z0 = 0.f, z1 = 0.f;
#pragma unroll
    for (int r = 0; r < 16; ++r) { asm volatile("v_fma_f32 %0, %1, %2, %0" : "+v"(z0) : "v"(Cs), "v"(slope2)); asm volatile("v_fma_f32 %0, %1, %2, %0" : "+v"(z1) : "v"(Cs), "v"(slope2)); }
    asm volatile("" :: "v"(z0), "v"(z1)); }
#endif
  float pm0 = p0[0], pm1 = p1[0];
#pragma unroll
  for (int r = 1; r < 16; ++r) { pm0 = fmaxf(pm0, p0[r]); pm1 = fmaxf(pm1, p1[r]); }
  const float tb = (float)(k0 + 4 * hi - qpos);
  float tmax = fmaxf(pm0, pm1 + 32.f) + tb;
  { auto rr = __builtin_amdgcn_permlane32_swap(__float_as_uint(tmax), __float_as_uint(tmax), false, false);
    tmax = fmaxf(__uint_as_float(rr[0]), __uint_as_float(rr[1])); }
  dead = (MODE == 0) && __all((tmax - m_reg) * slope2 < -150.f);
  if (dead) { alpha = 1.f; off = 0.f; return; }
  if (__builtin_expect(__all(tmax - m_reg <= thr), 1)) { alpha = 1.f; }
  else { const float mn = fmaxf(m_reg, tmax); alpha = __builtin_amdgcn_exp2f((m_reg - mn) * slope2); m_reg = mn; }
  off = (tb - m_reg) * slope2;
#pragma unroll
  for (int r = 0; r < 16; ++r) p0[r] = __builtin_amdgcn_exp2f(fmaf(p0[r], slope2, off));
}
__device__ __forceinline__ void finishSM(f32x16& p0, f32x16& p1, float slope2, float off1, float alpha, float& l_reg, bf16x8& pa0, bf16x8& pa1, bf16x8& pa2, bf16x8& pa3) {
#pragma unroll
  for (int r = 0; r < 16; ++r) p1[r] = __builtin_amdgcn_exp2f(fmaf(p1[r], slope2, off1));
  float ps = 0;
#pragma unroll
  for (int r = 0; r < 16; ++r) ps += p0[r];
#pragma unroll
  for (int r = 0; r < 16; ++r) ps += p1[r];
  { auto rr = __builtin_amdgcn_permlane32_swap(__float_as_uint(ps), __float_as_uint(ps), false, false);
    ps = __uint_as_float(rr[0]) + __uint_as_float(rr[1]); }
  l_reg = l_reg * alpha + ps;
#define PK4(P, BASE, OUT) do { unsigned a0 = cvtpk(P[BASE + 0], P[BASE + 1]), a1 = cvtpk(P[BASE + 2], P[BASE + 3]);   \
    unsigned b0 = cvtpk(P[BASE + 4], P[BASE + 5]), b1 = cvtpk(P[BASE + 6], P[BASE + 7]);                              \
    auto r0 = __builtin_amdgcn_permlane32_swap(a0, b0, false, false); auto r1 = __builtin_amdgcn_permlane32_swap(a1, b1, false, false); \
    u32x4 w = {r0[0], r1[0], r0[1], r1[1]}; OUT = *reinterpret_cast<bf16x8*>(&w); } while (0)
  PK4(p0, 0, pa0); PK4(p0, 8, pa1); PK4(p1, 0, pa2); PK4(p1, 8, pa3);
#undef PK4
}

typedef float f32x2v __attribute__((ext_vector_type(2)));
__device__ __forceinline__ void cnt_ge(int& cnt, unsigned a, unsigned b) { asm volatile("v_cmp_ge_u32_e32 vcc, %1, %2\n\tv_addc_co_u32_e32 %0, vcc, 0, %0, vcc" : "+v"(cnt) : "v"(a), "v"(b) : "vcc"); }
__device__ __forceinline__ void cnt_gt(int& cnt, unsigned a, unsigned b) { asm volatile("v_cmp_gt_u32_e32 vcc, %1, %2\n\tv_addc_co_u32_e32 %0, vcc, 0, %0, vcc" : "+v"(cnt) : "v"(a), "v"(b) : "vcc"); }
__device__ __forceinline__ void cnt_ge4(int& c0, int& c1, int& c2, int& c3, unsigned k0, unsigned k1, unsigned k2, unsigned k3, unsigned b) {
  unsigned long long m0, m1, m2, m3;
  asm volatile("v_cmp_ge_u32_e64 %4, %8, %12\n\tv_cmp_ge_u32_e64 %5, %9, %12\n\tv_cmp_ge_u32_e64 %6, %10, %12\n\tv_cmp_ge_u32_e64 %7, %11, %12\n\t"
               "v_addc_co_u32_e64 %0, %4, 0, %0, %4\n\tv_addc_co_u32_e64 %1, %5, 0, %1, %5\n\tv_addc_co_u32_e64 %2, %6, 0, %2, %6\n\tv_addc_co_u32_e64 %3, %7, 0, %3, %7"
               : "+v"(c0), "+v"(c1), "+v"(c2), "+v"(c3), "=&s"(m0), "=&s"(m1), "=&s"(m2), "=&s"(m3) : "v"(k0), "v"(k1), "v"(k2), "v"(k3), "v"(b));
}
__device__ __forceinline__ unsigned wlane(unsigned val, int ln, unsigned old) { asm volatile("v_writelane_b32 %0, %1, %2" : "+v"(old) : "s"(val), "s"(ln)); return old; }
__device__ __forceinline__ int half_sum(int x, int hi) {
  x += __builtin_amdgcn_update_dpp(0, x, 0x111, 0xf, 0xf, true);
  x += __builtin_amdgcn_update_dpp(0, x, 0x112, 0xf, 0xf, true);
  x += __builtin_amdgcn_update_dpp(0, x, 0x114, 0xf, 0xf, true);
  x += __builtin_amdgcn_update_dpp(0, x, 0x118, 0xf, 0xf, true);
  const int a = __builtin_amdgcn_readlane(x, 15) + __builtin_amdgcn_readlane(x, 31);
  const int b = __builtin_amdgcn_readlane(x, 47) + __builtin_amdgcn_readlane(x, 63);
  return hi ? b : a;
}
__device__ __forceinline__ unsigned take_low(unsigned m, int k) {
  while (__builtin_popcount(m) > k) m &= ~(0x80000000u >> __builtin_clz(m));
  return m;
}

__device__ __forceinline__ void bit_transpose64(unsigned (&v)[64]) {
#define BT_STAGE(S, M) _Pragma("unroll") for (int blk = 0; blk < 64; blk += 32) { _Pragma("unroll") for (int k = 0; k < 32; ++k) { if ((k & (S)) == 0) { \
    const unsigned x = v[blk + k], y = v[blk + k + (S)]; \
    v[blk + k] = (x & (M)) | ((y << (S)) & ~(M)); v[blk + k + (S)] = ((x >> (S)) & (M)) | (y & ~(M)); } } }
  BT_STAGE(16, 0x0000ffffu) BT_STAGE(8, 0x00ff00ffu) BT_STAGE(4, 0x0f0f0f0fu) BT_STAGE(2, 0x33333333u) BT_STAGE(1, 0x55555555u)
#undef BT_STAGE
}
__device__ __forceinline__ void dsa_select(const bf16* __restrict__ PROJ, int b, int q0, unsigned* SEL, char* lds) {
  int tid = my_tid(); asm volatile("" : "+v"(tid));
  const int wid = __builtin_amdgcn_readfirstlane(tid >> 6), lane = tid & 63, r32 = lane & 31, hi = lane >> 5;
  const size_t tokb = (size_t)b * SEQ;
  const int nt32 = (q0 >> 5) + 1, nch = (nt32 + 15) >> 4;
  const int srow = wid * 64 + (lane >> 3), spc = lane & 7;
  const unsigned sloff = (unsigned)((srow * LDP + 8 * spc) * 2);
  const __amdgpu_buffer_rsrc_t srd = __builtin_amdgcn_make_buffer_rsrc((void*)(PROJ + tokb * LDP + C_IK), (short)0, (int)(SEQ * LDP * 2), 0x00020000);
  bf16x8 af[4]; float w[16]; bf16x8 st[8];
#define DSA_LOADS(RD) do { const int tA_ = q0 + (RD) * 16 + wid * 2; \
    const bf16* ap_ = PROJ + (tokb + tA_ + (r32 >> 4)) * LDP + C_IQ + (r32 & 15) * 64 + hi * 8; \
    _Pragma("unroll") for (int ks = 0; ks < 4; ++ks) af[ks] = ld8(ap_ + ks * 16); \
    _Pragma("unroll") for (int r = 0; r < 16; ++r) { const int head = (r & 3) + 8 * ((r >> 2) & 1) + 4 * hi; w[r] = bf2f(PROJ[(tokb + tA_ + (r >> 3)) * LDP + C_IW + head]); } \
    _Pragma("unroll") for (int i = 0; i < 8; ++i) st[i] = __builtin_bit_cast(bf16x8, __builtin_amdgcn_raw_buffer_load_b128(srd, (int)(sloff + (unsigned)(8 * i * LDP * 2)), 0, 0)); } while (0)
  DSA_LOADS(0);
  for (int rd = 0; rd < 2; ++rd) {
    const int tl = rd * 16 + wid * 2, tA = q0 + tl;
#pragma unroll
    for (int r = 0; r < 16; ++r) w[r] *= 0.5f;
    const int myq = tA + hi;
    unsigned key[64];
#pragma unroll
    for (int c = 0; c < 4; ++c) {
      if (c < nch) {
        char* buf = lds + (c & 1) * 65536;
#pragma unroll
        for (int i = 0; i < 8; ++i) { const int row = srow + 8 * i; *reinterpret_cast<bf16x8*>(buf + row * 128 + ((spc ^ ((row >> 1) & 7)) << 4)) = st[i]; }
        if (c + 1 < nch) {
#pragma unroll
          for (int i = 0; i < 8; ++i) st[i] = __builtin_bit_cast(bf16x8, __builtin_amdgcn_raw_buffer_load_b128(srd, (int)(sloff + (unsigned)(8 * i * LDP * 2)), 512 * (c + 1) * LDP * 2, 0));
        }
        __syncthreads();
#define IDX_MMA(CC, U) do { const int row_ = 32 * (U) + r32; CC = f32x16{}; _Pragma("unroll") for (int ks = 0; ks < 4; ++ks) { \
            const bf16x8 bfr = *reinterpret_cast<const bf16x8*>(buf + row_ * 128 + (((2 * ks + hi) ^ ((row_ >> 1) & 7)) << 4)); CC = __builtin_amdgcn_mfma_f32_32x32x16_bf16(af[ks], bfr, CC, 0, 0, 0); } } while (0)
#define IDX_RED(CC, U) do { const int j_ = 16 * c + (U); f32x2v l0 = {0.f, 0.f}, l1 = {0.f, 0.f}; \
          _Pragma("unroll") for (int i = 0; i < 4; ++i) { l0 = __builtin_elementwise_fma((f32x2v){w[2 * i], w[2 * i + 1]}, (f32x2v){CC[2 * i], CC[2 * i + 1]}, l0); \
                                                          l1 = __builtin_elementwise_fma((f32x2v){w[8 + 2 * i], w[9 + 2 * i]}, (f32x2v){CC[8 + 2 * i], CC[9 + 2 * i]}, l1); } \
          float s0 = l0[0] + l0[1], s1 = l1[0] + l1[1]; \
          _Pragma("unroll") for (int r = 0; r < 8; ++r) { asm("v_fma_f32 %0, %1, |%2|, %0" : "+v"(s0) : "v"(w[r]), "v"(CC[r])); asm("v_fma_f32 %0, %1, |%2|, %0" : "+v"(s1) : "v"(w[8 + r]), "v"(CC[8 + r])); } \
          auto rr = __builtin_amdgcn_permlane32_swap(__float_as_uint(s0), __float_as_uint(s1), false, false); \
          const float tot = __uint_as_float(rr[0]) + __uint_as_float(rr[1]); \
          const unsigned bits = __float_as_uint(tot); \
          const unsigned srt = bits ^ ((unsigned)((int)bits >> 31) | 0x80000000u); \
          key[j_] = (j_ * 32 + r32 <= myq) ? srt : 0u; } while (0)
#if defined(DSK) && DSK == 3
        { f32x16 ccA, ccB; IDX_MMA(ccA, 0);
#pragma unroll
          for (int u = 0; u < 16; u += 2) { IDX_MMA(ccB, u + 1); IDX_RED(ccA, u); __builtin_amdgcn_sched_barrier(0); if (u + 2 < 16) IDX_MMA(ccA, u + 2); IDX_RED(ccB, u + 1); __builtin_amdgcn_sched_barrier(0); } }
        _Pragma("unroll") for (int u = 0; u < 16; ++u) asm volatile("" :: "v"(key[16 * c + u]));
#endif
        { f32x16 ccA, ccB; IDX_MMA(ccA, 0);
#pragma unroll
          for (int u = 0; u < 16; u += 2) { IDX_MMA(ccB, u + 1); IDX_RED(ccA, u); __builtin_amdgcn_sched_barrier(0); if (u + 2 < 16) IDX_MMA(ccA, u + 2); IDX_RED(ccB, u + 1); __builtin_amdgcn_sched_barrier(0); } }
#undef IDX_MMA
#undef IDX_RED
      } else {
#pragma unroll
        for (int u = 0; u < 16; ++u) key[16 * c + u] = 0u;
      }
    }
    __syncthreads();
    if (rd == 0) DSA_LOADS(1);
    bit_transpose64(key);
    unsigned T = 0u, Alo = 0xffffffffu, Ahi = 0xffffffffu, Glo = 0u, Ghi = 0u; int gc = 0;
    const bool searched = tA + 2 > 256;
    if (searched) {
      bool done = false;
#pragma unroll
      for (int bit = 31; bit >= 0; --bit) {
        if (!done) {
          const unsigned m1lo = Alo & key[bit], m1hi = Ahi & key[32 + bit];
          const int c = __builtin_popcount(m1lo) + __builtin_popcount(m1hi);
          const int tot = half_sum(c + gc, hi);
          const bool take = tot >= 256;
          T = take ? (T | (1u << bit)) : T;
          Glo = take ? Glo : (Glo | m1lo); Ghi = take ? Ghi : (Ghi | m1hi); gc = take ? gc : gc + c;
          Alo = take ? m1lo : (Alo ^ m1lo); Ahi = take ? m1hi : (Ahi ^ m1hi);
          done = __all(tot == 256);
        }
      }
    }
    unsigned slo, shi;
    if (searched) { slo = Glo | Alo; shi = Ghi | Ahi; }
    else { slo = 0u; shi = 0u;
#pragma unroll
      for (int bb = 0; bb < 32; ++bb) { slo |= key[bb]; shi |= key[32 + bb]; } }
    const int cge = half_sum(__builtin_popcount(slo) + __builtin_popcount(shi), hi);
    int ln = lane; asm volatile("" : "+v"(ln));
    unsigned m0 = 0xffffffffu, m1 = 0xffffffffu;
    if (__all(cge <= 256)) {
      const unsigned nlo = ~slo, nhi = ~shi;
#pragma unroll
      for (int j = 0; j < 64; ++j) {
        const unsigned long long bal = __ballot((((j < 32) ? nlo : nhi) >> (j & 31)) & 1u);
        m0 = (ln == j) ? (unsigned)bal : m0; m1 = (ln == j) ? (unsigned)(bal >> 32) : m1; }
    } else {
      bit_transpose64(key);
      const unsigned Tm = T > 1u ? T : 1u;
      unsigned* kst = (unsigned*)(lds + wid * 16384);
#pragma unroll
      for (int j = 0; j < 64; ++j) kst[j * 64 + lane] = key[j];
      int cgt = 0;
#pragma unroll
      for (int cc = 0; cc < 8; ++cc) { if (cc * 8 < nt32) {
#pragma unroll
        for (int e = 0; e < 8; ++e) cnt_gt(cgt, key[cc * 8 + e], Tm); } }
      cgt = half_sum(cgt, hi);
      int need_lo = 256 - __builtin_amdgcn_readlane(cgt, 0), need_hi = 256 - __builtin_amdgcn_readlane(cgt, 32);
#pragma unroll 1
      for (int j = 0; j < 64; ++j) {
        const unsigned kj = kst[j * 64 + lane];
        const unsigned long long eqm = __ballot(kj == Tm), gtm = __ballot(kj > Tm);
        const unsigned tl_ = take_low((unsigned)eqm, need_lo > 0 ? need_lo : 0), th_ = take_low((unsigned)(eqm >> 32), need_hi > 0 ? need_hi : 0);
        need_lo -= __builtin_popcount(tl_); need_hi -= __builtin_popcount(th_);
        const unsigned sl = (unsigned)gtm | tl_, sh = (unsigned)(gtm >> 32) | th_;
        m0 = (ln == j) ? ~sl : m0; m1 = (ln == j) ? ~sh : m1; }
    }
    SEL[tl * 64 + lane] = m0; SEL[(tl + 1) * 64 + lane] = m1;
    __syncthreads();
  }
#undef DSA_LOADS
}

template <int MODE>
__device__ __forceinline__ void attn_unit(const bf16* __restrict__ PROJ, unsigned char* __restrict__ ATT, int b, int h, int qb, char* lds, float lam, const float* __restrict__ subln_g) {
  if (MODE == 1) { dsa_select(PROJ, b, qb * 32, (unsigned*)(lds + L_SEL), lds); __syncthreads(); }
  int tid = my_tid(); asm volatile("" : "+v"(tid));
  const int wid = __builtin_amdgcn_readfirstlane(tid >> 6), lane = tid & 63, r32 = lane & 31, hi = lane >> 5;
  constexpr int ND0 = MODE == 0 ? 4 : 8;
  const int q0 = MODE == 0 ? qb * 128 : qb * 32;
  const int wq = MODE == 0 ? (wid & 3) * 32 : 0;
  const int c = MODE == 0 ? (wid >> 2) : 0;
  const int qpos = q0 + wq + r32;
  const size_t tokb = (size_t)b * SEQ;
  const bf16* Qw = PROJ + (tokb + qpos) * LDP + (MODE == 0 ? C_DQ + h * 128 + c * 64 : C_SQ + wid * 128) + hi * 8;
  const bf16* Kh = PROJ + tokb * LDP + (MODE == 0 ? C_DK + h * 128 : C_SK);
  const bf16* Vh = PROJ + tokb * LDP + (MODE == 0 ? C_DV + h * 128 : C_SV);
  const int NT = MODE == 0 ? 2 * (qb + 1) : 2 * ((q0 + 32 + 127) >> 7);
  const float slope2 = (MODE == 0 ? exp2f(-0.5f * (float)(2 * h + 1)) : exp2f(-(float)(wid + 1))) * LOG2E;
  const float Cs = (MODE == 0 ? 0.125f : 0.08838834764831845f) * LOG2E / slope2;
  const float thr = THR2 / slope2, c32 = 32.f * slope2;
  char* V_lds = lds + L_V; char* K_lds = lds + L_K;
  float* ws = (float*)(lds + L_WS) + wid * 64; float* li_l = ws; float* al_l = ws + 32;
  unsigned* SEL = (unsigned*)(lds + L_SEL);
  const char* selrow = (const char*)(SEL + r32 * 64);

  float m_reg = -1e30f, l_reg = 0; f32x16 o[4] = {}; bf16x8 qr[ND0];
#pragma unroll
  for (int d0 = 0; d0 < ND0; ++d0) qr[d0] = ld8(Qw + d0 * 16);
  const int sr = tid >> 4, sc = (tid & 15) * 8, vst0 = v_st(sr, sc), vst1 = v_st(32 + sr, sc);
  const int vb0 = (int)(uintptr_t)V_lds + v_rd_base(lane);
  struct { bf16x8 vs0, vs1, ks0, ks1; } sr_[SDEPTH];
#define SLOAD(i, k0) do { sr_[i].vs0 = ld8(&Vh[(size_t)((k0) + sr) * LDP + sc]); sr_[i].vs1 = ld8(&Vh[(size_t)((k0) + 32 + sr) * LDP + sc]); \
    sr_[i].ks0 = ld8(&Kh[(size_t)((k0) + sr) * LDP + sc]); sr_[i].ks1 = ld8(&Kh[(size_t)((k0) + 32 + sr) * LDP + sc]); } while (0)
#define SWRITE(bb, i) do { *(bf16x8*)(V_lds + (bb) * SHM_V + vst0) = sr_[i].vs0;          \
    *(bf16x8*)(V_lds + (bb) * SHM_V + vst1) = sr_[i].vs1; const int kc = sc * 2;               \
    *(bf16x8*)(K_lds + (bb) * SHM_K + KSWZ(sr, kc)) = sr_[i].ks0;                       \
    *(bf16x8*)(K_lds + (bb) * SHM_K + KSWZ(32 + sr, kc)) = sr_[i].ks1; } while (0)
#define SWAIT() do { if constexpr (SDEPTH == 2) asm volatile("s_waitcnt vmcnt(4)" ::: "memory"); else asm volatile("s_waitcnt vmcnt(0)" ::: "memory"); } while (0)
#define RESC(a) do { if (__any((a) < 1.f)) { if (hi == 0) al_l[r32] = (a); asm volatile("s_waitcnt lgkmcnt(0)" ::: "memory"); \
    _Pragma("unroll") for (int d = 0; d < 4; ++d) _Pragma("unroll") for (int r = 0; r < 16; ++r) o[d][r] *= al_l[crow(r, hi)]; } } while (0)
#define DIAG(k0) ((k0) + 63 > q0 + wq)
  f32x16 pA0, pA1, pB0, pB1; float ofA, ofB, alA, alB; bool deadA = false, deadB = false; bf16x8 pa0, pa1, pa2, pa3;
  constexpr int SE = 0, SO = SDEPTH - 1;
  static_assert(SDEPTH == 1, "the tile loop below is written for one staging register set");
#define KT(i) ((MODE == 0 ? (NT - 1 - (i)) : (i)) * 64)
  SLOAD(SE, KT(0)); asm volatile("s_waitcnt vmcnt(0)" ::: "memory"); SWRITE(0, SE); SLOAD(SE, KT(1)); __syncthreads();
  qkt<ND0>(pA0, pA1, K_lds, qr, r32, hi, c * 4); partialSM<MODE>(pA0, pA1, Cs, slope2, thr, KT(0), qpos, hi, selrow, DIAG(KT(0)), m_reg, ofA, alA, deadA);
  SWAIT(); SWRITE(1, SO); if (2 < NT) SLOAD(SE, KT(2)); __syncthreads();
  for (int j = 1; j + 1 < NT; j += 2) {
    SBAR(); qkt<ND0>(pB0, pB1, K_lds + SHM_K, qr, r32, hi, c * 4);
    if (!deadA) { finishSM(pA0, pA1, slope2, ofA + c32, alA, l_reg, pa0, pa1, pa2, pa3); } SBAR();
    if (!deadA) { pv_d0(o, vb0, pa0, pa1, pa2, pa3); } partialSM<MODE>(pB0, pB1, Cs, slope2, thr, KT(j), qpos, hi, selrow, DIAG(KT(j)), m_reg, ofB, alB, deadB);
    __syncthreads(); SWAIT(); SWRITE(0, SE); SLOAD(SE, KT(j + 2));
    RESC(alB); __syncthreads();
    SBAR(); qkt<ND0>(pA0, pA1, K_lds, qr, r32, hi, c * 4);
    if (!deadB) { finishSM(pB0, pB1, slope2, ofB + c32, alB, l_reg, pa0, pa1, pa2, pa3); } SBAR();
    if (!deadB) { pv_d0(o, vb0 + SHM_V, pa0, pa1, pa2, pa3); } partialSM<MODE>(pA0, pA1, Cs, slope2, thr, KT(j + 1), qpos, hi, selrow, DIAG(KT(j + 1)), m_reg, ofA, alA, deadA);
    __syncthreads(); SWAIT(); SWRITE(1, SO); if (j + 3 < NT) SLOAD(SO, KT(j + 3));
    RESC(alA); __syncthreads();
  }
  SBAR(); qkt<ND0>(pB0, pB1, K_lds + SHM_K, qr, r32, hi, c * 4);
  if (!deadA) { finishSM(pA0, pA1, slope2, ofA + c32, alA, l_reg, pa0, pa1, pa2, pa3); } SBAR();
  if (!deadA) { pv_d0(o, vb0, pa0, pa1, pa2, pa3); } partialSM<MODE>(pB0, pB1, Cs, slope2, thr, KT(NT - 1), qpos, hi, selrow, DIAG(KT(NT - 1)), m_reg, ofB, alB, deadB);
  __syncthreads(); RESC(alB);
  if (!deadB) { finishSM(pB0, pB1, slope2, ofB + c32, alB, l_reg, pa0, pa1, pa2, pa3); } SBAR();
  if (!deadB) { pv_d0(o, vb0 + SHM_V, pa0, pa1, pa2, pa3); }
#undef KT
#undef SLOAD
#undef SWRITE
#undef SWAIT
#undef RESC
#undef DIAG
  if (hi == 0) li_l[r32] = l_reg; asm volatile("s_waitcnt lgkmcnt(0)" ::: "memory");
  {
    float rli[16];
#pragma unroll
    for (int r = 0; r < 16; ++r) rli[r] = __builtin_amdgcn_rcpf(li_l[crow(r, hi)]);
#pragma unroll
    for (int d0 = 0; d0 < 4; ++d0)
#pragma unroll
      for (int r = 0; r < 16; ++r) o[d0][r] *= rli[r];
  }
  __syncthreads();
  if (MODE == 0) {
    float* X = (float*)lds;
    if (wid >= 4) {
#pragma unroll
      for (int d0 = 0; d0 < 4; ++d0)
#pragma unroll
        for (int r = 0; r < 16; ++r) X[(wid - 4) * 4096 + crow(r, hi) * 128 + d0 * 32 + r32] = o[d0][r];
    }
    __syncthreads();
    if (wid < 4) {
#pragma unroll
      for (int d0 = 0; d0 < 4; ++d0)
#pragma unroll
        for (int r = 0; r < 16; ++r) o[d0][r] -= lam * X[wid * 4096 + crow(r, hi) * 128 + d0 * 32 + r32];
    }
    __syncthreads();
  }
  if (MODE == 1 || wid < 4) {
    bf16* stg = (bf16*)(lds + wid * 8704);
#pragma unroll
    for (int d0 = 0; d0 < 4; ++d0)
#pragma unroll
      for (int r = 0; r < 16; r += 2) {
        const unsigned pk = cvtpk(o[d0][r], o[d0][r + 1]);
        stg[crow(r, hi) * 136 + d0 * 32 + r32] = (bf16)(pk & 0xffffu);
        stg[crow(r + 1, hi) * 136 + d0 * 32 + r32] = (bf16)(pk >> 16);
      }
    asm volatile("s_waitcnt lgkmcnt(0)" ::: "memory");
    bf16x8 v[8];
#pragma unroll
    for (int j = 0; j < 8; ++j) v[j] = *reinterpret_cast<const bf16x8*>(stg + r32 * 136 + hi * 64 + j * 8);
    unsigned char* orow = ATT + (tokb + q0 + wq + r32) * DM + (MODE == 0 ? h * 128 : 1024 + wid * 128) + hi * 64;
    float rs = 1.0f;
    if (MODE == 0) {
      float ss = 0.f;
#pragma unroll
      for (int j = 0; j < 8; ++j)
#pragma unroll
        for (int e = 0; e < 8; ++e) { const float x = bf2f((bf16)v[j][e]); ss = fmaf(x, x, ss); }
      { auto rr = __builtin_amdgcn_permlane32_swap(__float_as_uint(ss), __float_as_uint(ss), false, false);
        ss = __uint_as_float(rr[0]) + __uint_as_float(rr[1]); }
      rs = __builtin_amdgcn_rsqf(ss * (1.0f / 128.0f) + RMS_EPS) * (1.0f - LAM_INIT);
    }
#pragma unroll
    for (int jj = 0; jj < 4; ++jj) { u32x4 w;
#pragma unroll
      for (int q = 0; q < 4; ++q) { float y[4];
#pragma unroll
        for (int e = 0; e < 4; ++e) { const int idx = 16 * jj + 4 * q + e; float x = bf2f((bf16)v[idx >> 3][idx & 7]); if (MODE == 0) x = x * rs * subln_g[hi * 64 + idx]; y[e] = x; }
        int p = __builtin_amdgcn_cvt_pk_fp8_f32(y[0], y[1], 0, false); p = __builtin_amdgcn_cvt_pk_fp8_f32(y[2], y[3], p, true); w[q] = (unsigned)p; }
      *reinterpret_cast<u32x4*>(orow + jj * 16) = w; }
  }
  __syncthreads();
}
}

typedef float f32x4 __attribute__((ext_vector_type(4)));
typedef unsigned u32x4 __attribute__((ext_vector_type(4)));
typedef unsigned u32x2 __attribute__((ext_vector_type(2)));
__device__ __forceinline__ unsigned cvt_pk(float lo, float hi) { unsigned r; asm volatile("v_cvt_pk_bf16_f32 %0, %1, %2" : "=v"(r) : "v"(lo), "v"(hi)); return r; }
__device__ __forceinline__ float bf_lo(unsigned w) { return __uint_as_float(w << 16); }
__device__ __forceinline__ float bf_hi(unsigned w) { return __uint_as_float(w & 0xffff0000u); }
__device__ __forceinline__ float wave_sum(float v) {
#pragma unroll
  for (int o = 1; o < 64; o <<= 1) v += __shfl_xor(v, o);
  return v;
}

__device__ __forceinline__ void cvt_stream(const float* __restrict__ src, bf16* __restrict__ dst, size_t n8, size_t gtid, size_t gsz) {
  for (size_t i = gtid; i < n8; i += gsz) {
    const f32x4 a = *reinterpret_cast<const f32x4*>(src + i * 8), b = *reinterpret_cast<const f32x4*>(src + i * 8 + 4);
    u32x4 w = {cvt_pk(a[0], a[1]), cvt_pk(a[2], a[3]), cvt_pk(b[0], b[1]), cvt_pk(b[2], b[3])};
    *reinterpret_cast<u32x4*>(dst + i * 8) = w;
  }
}
__device__ __forceinline__ void cvt_stream2(const float* __restrict__ src, bf16* __restrict__ dst, unsigned char* __restrict__ dst8, size_t n8, size_t gtid, size_t gsz) {
  for (size_t i0 = gtid; i0 < n8; i0 += 4 * gsz) {
    f32x4 a[4], b[4];
#pragma unroll
    for (int q = 0; q < 4; ++q) { const size_t i = i0 + q * gsz; if (i < n8) { a[q] = *reinterpret_cast<const f32x4*>(src + i * 8); b[q] = *reinterpret_cast<const f32x4*>(src + i * 8 + 4); } }
#pragma unroll
    for (int q = 0; q < 4; ++q) { const size_t i = i0 + q * gsz; if (i < n8) {
      u32x4 w = {cvt_pk(a[q][0], a[q][1]), cvt_pk(a[q][2], a[q][3]), cvt_pk(b[q][0], b[q][1]), cvt_pk(b[q][2], b[q][3])};
      *reinterpret_cast<u32x4*>(dst + i * 8) = w;
      int p0 = __builtin_amdgcn_cvt_pk_fp8_f32(a[q][0], a[q][1], 0, false); p0 = __builtin_amdgcn_cvt_pk_fp8_f32(a[q][2], a[q][3], p0, true);
      int p1 = __builtin_amdgcn_cvt_pk_fp8_f32(b[q][0], b[q][1], 0, false); p1 = __builtin_amdgcn_cvt_pk_fp8_f32(b[q][2], b[q][3], p1, true);
      *reinterpret_cast<u32x2*>(dst8 + i * 8) = (u32x2){(unsigned)p0, (unsigned)p1}; } }
  }
}
__device__ __forceinline__ void transpose_item(const float* __restrict__ W, int K, int N, bf16* __restrict__ WT, LAS float* scr, int kb, int nb, int lane) {
  const int k0 = 64 * kb, n0 = 32 * nb; const int nn = n0 + (lane & 31); const bool ok = nn < N;
  float tv[32];
#pragma unroll
  for (int i = 0; i < 32; ++i) { const int kk = 2 * i + (lane >> 5); tv[i] = ok ? W[(size_t)(k0 + kk) * N + nn] : 0.f; }
#pragma unroll
  for (int i = 0; i < 32; ++i) { const int kk = 2 * i + (lane >> 5); scr[kk * 33 + (lane & 31)] = tv[i]; }
  asm volatile("s_waitcnt lgkmcnt(0)" ::: "memory");
  const int c = lane & 7;
#pragma unroll
  for (int j = 0; j < 4; ++j) { const int n = (lane >> 3) + 8 * j; const LAS float* s = scr + (8 * c) * 33 + n;
    u32x4 o; o.x = cvt_pk(s[0 * 33], s[1 * 33]); o.y = cvt_pk(s[2 * 33], s[3 * 33]); o.z = cvt_pk(s[4 * 33], s[5 * 33]); o.w = cvt_pk(s[6 * 33], s[7 * 33]);
    *reinterpret_cast<u32x4*>(WT + (size_t)(n0 + n) * K + k0 + 8 * c) = o; }
  asm volatile("s_waitcnt lgkmcnt(0)" ::: "memory");
}

__device__ __forceinline__ void transpose_item_fp8(const float* __restrict__ W, int K, int N, unsigned char* __restrict__ WT, LAS float* scr, int kb, int nb, int lane, float scale) {
  const int k0 = 64 * kb, n0 = 32 * nb; const int nn = n0 + (lane & 31); const bool ok = nn < N;
  float tv[32];
#pragma unroll
  for (int i = 0; i < 32; ++i) { const int kk = 2 * i + (lane >> 5); tv[i] = ok ? W[(size_t)(k0 + kk) * N + nn] * scale : 0.f; }
#pragma unroll
  for (int i = 0; i < 32; ++i) { const int kk = 2 * i + (lane >> 5); scr[kk * 33 + (lane & 31)] = tv[i]; }
  asm volatile("s_waitcnt lgkmcnt(0)" ::: "memory");
  const int c = lane & 7;
#pragma unroll
  for (int j = 0; j < 4; ++j) { const int n = (lane >> 3) + 8 * j; const LAS float* s = scr + (8 * c) * 33 + n;
    int p0 = __builtin_amdgcn_cvt_pk_fp8_f32(s[0 * 33], s[1 * 33], 0, false); p0 = __builtin_amdgcn_cvt_pk_fp8_f32(s[2 * 33], s[3 * 33], p0, true);
    int p1 = __builtin_amdgcn_cvt_pk_fp8_f32(s[4 * 33], s[5 * 33], 0, false); p1 = __builtin_amdgcn_cvt_pk_fp8_f32(s[6 * 33], s[7 * 33], p1, true);
    *reinterpret_cast<u32x2*>(WT + (size_t)(n0 + n) * K + k0 + 8 * c) = (u32x2){(unsigned)p0, (unsigned)p1}; }
  asm volatile("s_waitcnt lgkmcnt(0)" ::: "memory");
}

__device__ __forceinline__ void ln1_phase(const bf16* __restrict__ Z, const float* __restrict__ g, const float* __restrict__ bta, bf16* __restrict__ OB, unsigned char* __restrict__ O8, int gw, int ngw, int lane) {
  f32x4 gv[8], bv[8];
#pragma unroll
  for (int j = 0; j < 4; ++j) { const int e0 = 512 * j + 8 * lane;
    gv[2 * j] = *reinterpret_cast<const f32x4*>(g + e0); gv[2 * j + 1] = *reinterpret_cast<const f32x4*>(g + e0 + 4);
    bv[2 * j] = *reinterpret_cast<const f32x4*>(bta + e0); bv[2 * j + 1] = *reinterpret_cast<const f32x4*>(bta + e0 + 4); }
  u32x4 nx[4];
  if (gw < NTOK) {
#pragma unroll
    for (int j = 0; j < 4; ++j) nx[j] = *reinterpret_cast<const u32x4*>(Z + (size_t)gw * DM + 512 * j + 8 * lane); }
  for (int m = gw; m < NTOK; m += ngw) {
    float v[32]; float s = 0.f;
#pragma unroll
    for (int j = 0; j < 4; ++j) {
#pragma unroll
      for (int q = 0; q < 4; ++q) { v[8 * j + 2 * q] = bf_lo(nx[j][q]); v[8 * j + 2 * q + 1] = bf_hi(nx[j][q]); } }
    if (m + ngw < NTOK) {
#pragma unroll
      for (int j = 0; j < 4; ++j) nx[j] = *reinterpret_cast<const u32x4*>(Z + (size_t)(m + ngw) * DM + 512 * j + 8 * lane); }
#pragma unroll
    for (int i = 0; i < 32; ++i) s += v[i];
    const float mean = wave_sum(s) * (1.f / DM); float s2 = 0.f;
#pragma unroll
    for (int i = 0; i < 32; ++i) { v[i] -= mean; s2 = fmaf(v[i], v[i], s2); }
    const float rstd = 1.0f / sqrtf(wave_sum(s2) * (1.f / DM) + LN_EPS);
    bf16* obrow = OB + (size_t)m * DM; unsigned char* o8row = O8 + (size_t)m * DM;
#pragma unroll
    for (int j = 0; j < 4; ++j) {
      const int e0 = 512 * j + 8 * lane;
      float y[8];
#pragma unroll
      for (int e = 0; e < 4; ++e) { y[e] = v[8 * j + e] * rstd * gv[2 * j][e] + bv[2 * j][e]; y[4 + e] = v[8 * j + 4 + e] * rstd * gv[2 * j + 1][e] + bv[2 * j + 1][e]; }
      u32x4 w = {cvt_pk(y[0], y[1]), cvt_pk(y[2], y[3]), cvt_pk(y[4], y[5]), cvt_pk(y[6], y[7])}; *reinterpret_cast<u32x4*>(obrow + e0) = w;
      int p0 = __builtin_amdgcn_cvt_pk_fp8_f32(y[0], y[1], 0, false); p0 = __builtin_amdgcn_cvt_pk_fp8_f32(y[2], y[3], p0, true);
      int p1 = __builtin_amdgcn_cvt_pk_fp8_f32(y[4], y[5], 0, false); p1 = __builtin_amdgcn_cvt_pk_fp8_f32(y[6], y[7], p1, true);
      *reinterpret_cast<u32x2*>(o8row + e0) = (u32x2){(unsigned)p0, (unsigned)p1};
    }
  }
}

namespace peer {
using bf16x8 = att::bf16x8; using f32x16 = att::f32x16;
constexpr int L_K1 = 0, L_K2 = 32768, L_SCR = 65536;
__device__ __forceinline__ unsigned srt(float x) { const unsigned b = __float_as_uint(x); return b ^ ((unsigned)((int)b >> 31) | 0x80000000u); }
__device__ __forceinline__ float unsrt(unsigned u) { const unsigned b = (u & 0x80000000u) ? (u ^ 0x80000000u) : ~u; return __uint_as_float(b); }
__device__ __forceinline__ unsigned umax(unsigned a, unsigned b) { return a > b ? a : b; }
__device__ __forceinline__ unsigned pair_max(unsigned m) {
  auto rr = __builtin_amdgcn_permlane32_swap(m, m, false, false); return umax(rr[0], rr[1]);
}
__device__ __forceinline__ void load_keys(const float* __restrict__ k1, const float* __restrict__ k2, char* lds) {
  for (int i = my_tid(); i < 2 * 128 * 16; i += 512) {
    const int t = i >> 11, row = (i >> 4) & 127, ch = i & 15; const float* src = (t ? k2 : k1) + row * 128 + ch * 8;
    const f32x4 a = *reinterpret_cast<const f32x4*>(src), b = *reinterpret_cast<const f32x4*>(src + 4);
    u32x4 w = {cvt_pk(a[0], a[1]), cvt_pk(a[2], a[3]), cvt_pk(b[0], b[1]), cvt_pk(b[2], b[3])};
    *reinterpret_cast<u32x4*>(lds + (t ? L_K2 : L_K1) + KSWZ(row, ch * 16)) = w;
  }
}
#define PK_CE(a, b) do { const unsigned hi_ = (a) > (b) ? (a) : (b), lo_ = (a) > (b) ? (b) : (a); (a) = hi_; (b) = lo_; } while (0)
__device__ __forceinline__ void sort16_desc(unsigned (&v)[64], const int base) {
  PK_CE(v[base + 0], v[base + 1]);
  PK_CE(v[base + 2], v[base + 3]);
  PK_CE(v[base + 0], v[base + 2]);
  PK_CE(v[base + 1], v[base + 3]);
  PK_CE(v[base + 1], v[base + 2]);
  PK_CE(v[base + 4], v[base + 5]);
  PK_CE(v[base + 6], v[base + 7]);
  PK_CE(v[base + 4], v[base + 6]);
  PK_CE(v[base + 5], v[base + 7]);
  PK_CE(v[base + 5], v[base + 6]);
  PK_CE(v[base + 0], v[base + 4]);
  PK_CE(v[base + 2], v[base + 6]);
  PK_CE(v[base + 2], v[base + 4]);
  PK_CE(v[base + 1], v[base + 5]);
  PK_CE(v[base + 3], v[base + 7]);
  PK_CE(v[base + 3], v[base + 5]);
  PK_CE(v[base + 1], v[base + 2]);
  PK_CE(v[base + 3], v[base + 4]);
  PK_CE(v[base + 5], v[base + 6]);
  PK_CE(v[base + 8], v[base + 9]);
  PK_CE(v[base + 10], v[base + 11]);
  PK_CE(v[base + 8], v[base + 10]);
  PK_CE(v[base + 9], v[base + 11]);
  PK_CE(v[base + 9], v[base + 10]);
  PK_CE(v[base + 12], v[base + 13]);
  PK_CE(v[base + 14], v[base + 15]);
  PK_CE(v[base + 12], v[base + 14]);
  PK_CE(v[base + 13], v[base + 15]);
  PK_CE(v[base + 13], v[base + 14]);
  PK_CE(v[base + 8], v[base + 12]);
  PK_CE(v[base + 10], v[base + 14]);
  PK_CE(v[base + 10], v[base + 12]);
  PK_CE(v[base + 9], v[base + 13]);
  PK_CE(v[base + 11], v[base + 15]);
  PK_CE(v[base + 11], v[base + 13]);
  PK_CE(v[base + 9], v[base + 10]);
  PK_CE(v[base + 11], v[base + 12]);
  PK_CE(v[base + 13], v[base + 14]);
  PK_CE(v[base + 0], v[base + 8]);
  PK_CE(v[base + 4], v[base + 12]);
  PK_CE(v[base + 4], v[base + 8]);
  PK_CE(v[base + 2], v[base + 10]);
  PK_CE(v[base + 6], v[base + 14]);
  PK_CE(v[base + 6], v[base + 10]);
  PK_CE(v[base + 2], v[base + 4]);
  PK_CE(v[base + 6], v[base + 8]);
  PK_CE(v[base + 10], v[base + 12]);
  PK_CE(v[base + 1], v[base + 9]);
  PK_CE(v[base + 5], v[base + 13]);
  PK_CE(v[base + 5], v[base + 9]);
  PK_CE(v[base + 3], v[base + 11]);
  PK_CE(v[base + 7], v[base + 15]);
  PK_CE(v[base + 7], v[base + 11]);
  PK_CE(v[base + 3], v[base + 5]);
  PK_CE(v[base + 7], v[base + 9]);
  PK_CE(v[base + 11], v[base + 13]);
  PK_CE(v[base + 1], v[base + 2]);
  PK_CE(v[base + 3], v[base + 4]);
  PK_CE(v[base + 5], v[base + 6]);
  PK_CE(v[base + 7], v[base + 8]);
  PK_CE(v[base + 9], v[base + 10]);
  PK_CE(v[base + 11], v[base + 12]);
  PK_CE(v[base + 13], v[base + 14]);
}
__device__ __forceinline__ void merge_top16(unsigned (&a)[16], const unsigned (&b)[16]) {
#pragma unroll
  for (int i = 0; i < 16; ++i) a[i] = a[i] > b[15 - i] ? a[i] : b[15 - i];
  PK_CE(a[0], a[8]);
  PK_CE(a[1], a[9]);
  PK_CE(a[2], a[10]);
  PK_CE(a[3], a[11]);
  PK_CE(a[4], a[12]);
  PK_CE(a[5], a[13]);
  PK_CE(a[6], a[14]);
  PK_CE(a[7], a[15]);
  PK_CE(a[0], a[4]);
  PK_CE(a[1], a[5]);
  PK_CE(a[2], a[6]);
  PK_CE(a[3], a[7]);
  PK_CE(a[8], a[12]);
  PK_CE(a[9], a[13]);
  PK_CE(a[10], a[14]);
  PK_CE(a[11], a[15]);
  PK_CE(a[0], a[2]);
  PK_CE(a[1], a[3]);
  PK_CE(a[4], a[6]);
  PK_CE(a[5], a[7]);
  PK_CE(a[8], a[10]);
  PK_CE(a[9], a[11]);
  PK_CE(a[12], a[14]);
  PK_CE(a[13], a[15]);
  PK_CE(a[0], a[1]);
  PK_CE(a[2], a[3]);
  PK_CE(a[4], a[5]);
  PK_CE(a[6], a[7]);
  PK_CE(a[8], a[9]);
  PK_CE(a[10], a[11]);
  PK_CE(a[12], a[13]);
  PK_CE(a[14], a[15]);
}
__device__ __forceinline__ void top16_of_128(const bf16x8* qf, const char* Kt, int r32, int hi, unsigned (&win)[16]) {
  unsigned pk[64];
#pragma unroll
  for (int t = 0; t < 4; ++t) {
    f32x16 c = f32x16{};
#pragma unroll
    for (int ks = 0; ks < 8; ++ks) { const bf16x8 a = *reinterpret_cast<const bf16x8*>(Kt + KSWZ(32 * t + r32, (ks * 16 + hi * 8) * 2));
      c = __builtin_amdgcn_mfma_f32_32x32x16_bf16(a, qf[ks], c, 0, 0, 0); }
#pragma unroll
    for (int r = 0; r < 16; ++r) { const int n = 32 * t + att::crow(r, hi); pk[t * 16 + r] = (srt(c[r]) & 0xffffff80u) | (unsigned)(127 - n); }
  }
  sort16_desc(pk, 0); sort16_desc(pk, 16); sort16_desc(pk, 32); sort16_desc(pk, 48);
  unsigned a[16], b[16];
#pragma unroll
  for (int i = 0; i < 16; ++i) { a[i] = pk[i]; b[i] = pk[16 + i]; }
  merge_top16(a, b);
  unsigned c[16];
#pragma unroll
  for (int i = 0; i < 16; ++i) { c[i] = pk[32 + i]; b[i] = pk[48 + i]; }
  merge_top16(c, b);
  merge_top16(a, c);
#pragma unroll
  for (int i = 0; i < 16; ++i) { auto rr = __builtin_amdgcn_permlane32_swap(a[i], a[i], false, false); b[i] = hi ? rr[0] : rr[1]; }
  merge_top16(a, b);
#pragma unroll
  for (int i = 0; i < 16; ++i) win[i] = a[i];
}
__device__ __forceinline__ void score_unit(const bf16* __restrict__ PQ, int* __restrict__ EIDX, float* __restrict__ EG, int t0, char* lds) {
  const int wid = my_wave(), lane = my_lane(), r32 = lane & 31, hi = lane >> 5;
  const bf16* qp = PQ + (size_t)(t0 + r32) * DM + wid * 256 + hi * 8;
  unsigned w1[16], w2[16];
  { bf16x8 qf[8];
#pragma unroll
    for (int ks = 0; ks < 8; ++ks) qf[ks] = att::ld8(qp + ks * 16);
    top16_of_128(qf, lds + L_K1, r32, hi, w1); }
  { bf16x8 qf[8];
#pragma unroll
    for (int ks = 0; ks < 8; ++ks) qf[ks] = att::ld8(qp + 128 + ks * 16);
    top16_of_128(qf, lds + L_K2, r32, hi, w2); }
  unsigned char* scr = (unsigned char*)(lds + L_SCR + wid * 1024) + r32 * 32;
  if (hi == 0) {
#pragma unroll
    for (int k = 0; k < 16; ++k) { scr[k] = (unsigned char)(127u - (w1[k] & 127u)); scr[16 + k] = (unsigned char)(127u - (w2[k] & 127u)); }
  }
  float v1[16], v2[16];
#pragma unroll
  for (int k = 0; k < 16; ++k) { v1[k] = unsrt(w1[k] & 0xffffff80u); v2[k] = unsrt(w2[k] & 0xffffff80u); }
  unsigned cd[25]; const unsigned hm0 = 0u - (unsigned)hi;
  { const unsigned e_ = (srt(v1[0] + v2[0]) & 0xffffff00u) | 255u, o_ = (srt(v1[0] + v2[1]) & 0xffffff00u) | 254u; cd[0] = (e_ & ~hm0) | (o_ & hm0); }
  { const unsigned e_ = (srt(v1[0] + v2[2]) & 0xffffff00u) | 253u, o_ = (srt(v1[0] + v2[3]) & 0xffffff00u) | 252u; cd[1] = (e_ & ~hm0) | (o_ & hm0); }
  { const unsigned e_ = (srt(v1[0] + v2[4]) & 0xffffff00u) | 251u, o_ = (srt(v1[0] + v2[5]) & 0xffffff00u) | 250u; cd[2] = (e_ & ~hm0) | (o_ & hm0); }
  { const unsigned e_ = (srt(v1[0] + v2[6]) & 0xffffff00u) | 249u, o_ = (srt(v1[0] + v2[7]) & 0xffffff00u) | 248u; cd[3] = (e_ & ~hm0) | (o_ & hm0); }
  { const unsigned e_ = (srt(v1[0] + v2[8]) & 0xffffff00u) | 247u, o_ = (srt(v1[0] + v2[9]) & 0xffffff00u) | 246u; cd[4] = (e_ & ~hm0) | (o_ & hm0); }
  { const unsigned e_ = (srt(v1[0] + v2[10]) & 0xffffff00u) | 245u, o_ = (srt(v1[0] + v2[11]) & 0xffffff00u) | 244u; cd[5] = (e_ & ~hm0) | (o_ & hm0); }
  { const unsigned e_ = (srt(v1[0] + v2[12]) & 0xffffff00u) | 243u, o_ = (srt(v1[0] + v2[13]) & 0xffffff00u) | 242u; cd[6] = (e_ & ~hm0) | (o_ & hm0); }
  { const unsigned e_ = (srt(v1[0] + v2[14]) & 0xffffff00u) | 241u, o_ = (srt(v1[0] + v2[15]) & 0xffffff00u) | 240u; cd[7] = (e_ & ~hm0) | (o_ & hm0); }
  { const unsigned e_ = (srt(v1[1] + v2[0]) & 0xffffff00u) | 239u, o_ = (srt(v1[1] + v2[1]) & 0xffffff00u) | 238u; cd[8] = (e_ & ~hm0) | (o_ & hm0); }
  { const unsigned e_ = (srt(v1[1] + v2[2]) & 0xffffff00u) | 237u, o_ = (srt(v1[1] + v2[3]) & 0xffffff00u) | 236u; cd[9] = (e_ & ~hm0) | (o_ & hm0); }
  { const unsigned e_ = (srt(v1[1] + v2[4]) & 0xffffff00u) | 235u, o_ = (srt(v1[1] + v2[5]) & 0xffffff00u) | 234u; cd[10] = (e_ & ~hm0) | (o_ & hm0); }
  { const unsigned e_ = (srt(v1[1] + v2[6]) & 0xffffff00u) | 233u, o_ = (srt(v1[1] + v2[7]) & 0xffffff00u) | 232u; cd[11] = (e_ & ~hm0) | (o_ & hm0); }
  { const unsigned e_ = (srt(v1[2] + v2[0]) & 0xffffff00u) | 223u, o_ = (srt(v1[2] + v2[1]) & 0xffffff00u) | 222u; cd[12] = (e_ & ~hm0) | (o_ & hm0); }
  { const unsigned e_ = (srt(v1[2] + v2[2]) & 0xffffff00u) | 221u, o_ = (srt(v1[2] + v2[3]) & 0xffffff00u) | 220u; cd[13] = (e_ & ~hm0) | (o_ & hm0); }
  { const unsigned e_ = (srt(v1[2] + v2[4]) & 0xffffff00u) | 219u, o_ = (srt(v1[3] + v2[0]) & 0xffffff00u) | 207u; cd[14] = (e_ & ~hm0) | (o_ & hm0); }
  { const unsigned e_ = (srt(v1[3] + v2[1]) & 0xffffff00u) | 206u, o_ = (srt(v1[3] + v2[2]) & 0xffffff00u) | 205u; cd[15] = (e_ & ~hm0) | (o_ & hm0); }
  { const unsigned e_ = (srt(v1[3] + v2[3]) & 0xffffff00u) | 204u, o_ = (srt(v1[4] + v2[0]) & 0xffffff00u) | 191u; cd[16] = (e_ & ~hm0) | (o_ & hm0); }
  { const unsigned e_ = (srt(v1[4] + v2[1]) & 0xffffff00u) | 190u, o_ = (srt(v1[4] + v2[2]) & 0xffffff00u) | 189u; cd[17] = (e_ & ~hm0) | (o_ & hm0); }
  { const unsigned e_ = (srt(v1[5] + v2[0]) & 0xffffff00u) | 175u, o_ = (srt(v1[5] + v2[1]) & 0xffffff00u) | 174u; cd[18] = (e_ & ~hm0) | (o_ & hm0); }
  { const unsigned e_ = (srt(v1[6] + v2[0]) & 0xffffff00u) | 159u, o_ = (srt(v1[6] + v2[1]) & 0xffffff00u) | 158u; cd[19] = (e_ & ~hm0) | (o_ & hm0); }
  { const unsigned e_ = (srt(v1[7] + v2[0]) & 0xffffff00u) | 143u, o_ = (srt(v1[7] + v2[1]) & 0xffffff00u) | 142u; cd[20] = (e_ & ~hm0) | (o_ & hm0); }
  { const unsigned e_ = (srt(v1[8] + v2[0]) & 0xffffff00u) | 127u, o_ = (srt(v1[9] + v2[0]) & 0xffffff00u) | 111u; cd[21] = (e_ & ~hm0) | (o_ & hm0); }
  { const unsigned e_ = (srt(v1[10] + v2[0]) & 0xffffff00u) | 95u, o_ = (srt(v1[11] + v2[0]) & 0xffffff00u) | 79u; cd[22] = (e_ & ~hm0) | (o_ & hm0); }
  { const unsigned e_ = (srt(v1[12] + v2[0]) & 0xffffff00u) | 63u, o_ = (srt(v1[13] + v2[0]) & 0xffffff00u) | 47u; cd[23] = (e_ & ~hm0) | (o_ & hm0); }
  { const unsigned e_ = (srt(v1[14] + v2[0]) & 0xffffff00u) | 31u, o_ = (srt(v1[15] + v2[0]) & 0xffffff00u) | 15u; cd[24] = (e_ & ~hm0) | (o_ & hm0); }
  unsigned win[16];
  { unsigned pk2[64];
#pragma unroll
    for (int i = 0; i < 25; ++i) pk2[i] = cd[i];
#pragma unroll
    for (int i = 25; i < 32; ++i) pk2[i] = 0u;
    sort16_desc(pk2, 0); sort16_desc(pk2, 16);
    unsigned wa[16], wb[16];
#pragma unroll
    for (int i = 0; i < 16; ++i) { wa[i] = pk2[i]; wb[i] = pk2[16 + i]; }
    merge_top16(wa, wb);
#pragma unroll
    for (int i = 0; i < 16; ++i) { auto rr = __builtin_amdgcn_permlane32_swap(wa[i], wa[i], false, false); wb[i] = hi ? rr[0] : rr[1]; }
    merge_top16(wa, wb);
#pragma unroll
    for (int i = 0; i < 16; ++i) win[i] = wa[i]; }
  asm volatile("s_waitcnt lgkmcnt(0)" ::: "memory");
  const float smax = unsrt(win[0] & 0xffffff00u);
  float ex[16], den = 0.f;
#pragma unroll
  for (int k = 0; k < 16; ++k) { ex[k] = __builtin_amdgcn_exp2f((unsrt(win[k] & 0xffffff00u) - smax) * LOG2E); den += ex[k]; }
  const float rden = 1.0f / den; const unsigned hm = 0u - (unsigned)hi;
  int* eo = EIDX + (size_t)(t0 + r32) * 128 + wid * 2 + hi; float* go = EG + (size_t)(t0 + r32) * 128 + wid * 2 + hi;
#pragma unroll
  for (int kk = 0; kk < 8; ++kk) {
    const unsigned wv = (win[kk] & ~hm) | (win[8 + kk] & hm); const float gv = __uint_as_float((__float_as_uint(ex[kk]) & ~hm) | (__float_as_uint(ex[8 + kk]) & hm)) * rden;
    const int flat = 255 - (int)(wv & 255u), a = flat >> 4, bq = flat & 15;
    eo[kk * 16] = (int)scr[a] * 128 + (int)scr[16 + bq]; go[kk * 16] = gv;
  }
  asm volatile("s_waitcnt lgkmcnt(0)" ::: "memory");
}
}

typedef float f32x2 __attribute__((ext_vector_type(2)));
typedef int i32x4 __attribute__((ext_vector_type(4)));
constexpr float U_SCALE = 128.f, V_SCALE = 4.f;
constexpr int NSLICE = 8, SLICE_COLS = 256;
template <int CTRL> __device__ __forceinline__ float dpp_mov(float v) { return __int_as_float(__builtin_amdgcn_update_dpp(0, __float_as_int(v), CTRL, 0xf, 0xf, false)); }
__device__ __forceinline__ void pe_load_ids(const int* __restrict__ EIDX, int t, int g, int (&id)[16]) {
#pragma unroll
  for (int q = 0; q < 4; ++q) { const i32x4 v = *reinterpret_cast<const i32x4*>(EIDX + (size_t)t * 128 + g * 16 + 4 * q); id[4 * q] = v[0]; id[4 * q + 1] = v[1]; id[4 * q + 2] = v[2]; id[4 * q + 3] = v[3]; }
}
__device__ __forceinline__ void pe_issue_segs(const unsigned char* __restrict__ TB, const int (&id)[16], int coff, u32x4 (&seg)[16]) {
#pragma unroll
  for (int i = 0; i < 16; ++i) { const unsigned off = (unsigned)id[i] * 128u + (unsigned)coff; seg[i] = *reinterpret_cast<const u32x4*>(TB + off); }
}
typedef int v8i __attribute__((ext_vector_type(8)));
__device__ __forceinline__ void pe_x8_load(const unsigned char* __restrict__ X8, int t, unsigned xoff, u32x4 (&xw)[4]) {
  const unsigned char* xp = X8 + (size_t)t * DM + xoff;
  xw[0] = *reinterpret_cast<const u32x4*>(xp); xw[1] = *reinterpret_cast<const u32x4*>(xp + 64); xw[2] = *reinterpret_cast<const u32x4*>(xp + 128); xw[3] = *reinterpret_cast<const u32x4*>(xp + 192);
}
__device__ __forceinline__ void peer_u_pass(const unsigned char* __restrict__ X8, const unsigned char* __restrict__ U4, const int* __restrict__ EIDX, float* __restrict__ HPs, char* wlds, int t0, int dt, int n, int s, int lane) {
  const int g = lane >> 3, j = lane & 7, e16 = lane & 15, g4 = lane >> 4, c = lane & 15;
  const int coff = s * (NEXP * 128) + 16 * j; const unsigned xoff = (unsigned)(s * SLICE_COLS + 16 * g4);
  int idn[16]; u32x4 seg[16]; u32x4 xC[4], xN[4];
  pe_load_ids(EIDX, t0, g, idn); pe_issue_segs(U4, idn, coff, seg); pe_x8_load(X8, t0, xoff, xN);
  pe_load_ids(EIDX, t0 + (n > 1 ? dt : 0), g, idn);
#pragma unroll 1
  for (int it = 0; it < n; ++it) {
    const int t = t0 + it * dt, tn = t0 + (it + 1 < n ? it + 1 : n - 1) * dt, tnn = t0 + (it + 2 < n ? it + 2 : n - 1) * dt;
#pragma unroll
    for (int i = 0; i < 16; ++i) { const int row = 16 * g + i; *reinterpret_cast<u32x4*>(wlds + row * 128 + ((j ^ (row & 7)) << 4)) = seg[i]; }
#pragma unroll
    for (int p = 0; p < 4; ++p) xC[p] = xN[p];
    pe_issue_segs(U4, idn, coff, seg); pe_x8_load(X8, tn, xoff, xN);
    pe_load_ids(EIDX, tnn, g, idn);
    asm volatile("s_waitcnt lgkmcnt(0)" ::: "memory");
    f32x4 acc[8];
#pragma unroll
    for (int G = 0; G < 8; ++G) acc[G] = (f32x4){0.f, 0.f, 0.f, 0.f};
#pragma unroll
    for (int kh = 0; kh < 2; ++kh) {
      const v8i b = {(int)xC[2 * kh][0], (int)xC[2 * kh][1], (int)xC[2 * kh][2], (int)xC[2 * kh][3], (int)xC[2 * kh + 1][0], (int)xC[2 * kh + 1][1], (int)xC[2 * kh + 1][2], (int)xC[2 * kh + 1][3]};
#pragma unroll
      for (int G = 0; G < 8; ++G) { const int row = 16 * G + e16; const u32x4 sw = *reinterpret_cast<const u32x4*>(wlds + row * 128 + (((4 * kh + g4) ^ (row & 7)) << 4));
        const v8i a = {(int)sw[0], (int)sw[1], (int)sw[2], (int)sw[3], 0, 0, 0, 0};
        acc[G] = __builtin_amdgcn_mfma_scale_f32_16x16x128_f8f6f4(a, b, acc[G], 4  , 0  , 0, 0x7F7F7F7F  , 0, 0x7F7F7F7F); }
    }
    float s0[8], s1[8];
#pragma unroll
    for (int G = 0; G < 8; ++G) { s0[G] = (c & 1) ? acc[G][2] : acc[G][0]; s1[G] = (c & 1) ? acc[G][3] : acc[G][1]; }
    const int Gs = c >> 1;
    const float a0 = (Gs & 4) ? ((Gs & 2) ? ((Gs & 1) ? s0[7] : s0[6]) : ((Gs & 1) ? s0[5] : s0[4])) : ((Gs & 2) ? ((Gs & 1) ? s0[3] : s0[2]) : ((Gs & 1) ? s0[1] : s0[0]));
    const float a1 = (Gs & 4) ? ((Gs & 2) ? ((Gs & 1) ? s1[7] : s1[6]) : ((Gs & 1) ? s1[5] : s1[4])) : ((Gs & 2) ? ((Gs & 1) ? s1[3] : s1[2]) : ((Gs & 1) ? s1[1] : s1[0]));
    *reinterpret_cast<f32x2*>(HPs + (size_t)t * 128 + 16 * Gs + 4 * g4 + 2 * (c & 1)) = (f32x2){a0, a1};
  }
}
typedef int v2i __attribute__((ext_vector_type(2)));
__device__ __forceinline__ void peer_v_pass(const unsigned char* __restrict__ A8, const unsigned char* __restrict__ V4, const int* __restrict__ EIDX, bf16* __restrict__ Y, char* wlds, int t0, int dt, int n, int s, int lane) {
  const int g = lane >> 3, j = lane & 7, e16 = lane & 15, g4 = lane >> 4;
  const int coff = s * (NEXP * 128) + 16 * j;
  int idn[16]; u32x4 seg[16]; u32x4 aC[2], aN[2];
#define PE_ALOAD(t, aw) do { const unsigned char* ap_ = A8 + (size_t)(t) * 128 + 16 * g4; aw[0] = *reinterpret_cast<const u32x4*>(ap_); aw[1] = *reinterpret_cast<const u32x4*>(ap_ + 64); } while (0)
  pe_load_ids(EIDX, t0, g, idn); pe_issue_segs(V4, idn, coff, seg); PE_ALOAD(t0, aN);
  pe_load_ids(EIDX, t0 + (n > 1 ? dt : 0), g, idn);
#pragma unroll 1
  for (int it = 0; it < n; ++it) {
    const int t = t0 + it * dt, tn = t0 + (it + 1 < n ? it + 1 : n - 1) * dt, tnn = t0 + (it + 2 < n ? it + 2 : n - 1) * dt;
#pragma unroll
    for (int i = 0; i < 16; ++i) { const int row = 16 * g + i; *reinterpret_cast<u32x4*>(wlds + row * 128 + ((j ^ (row & 7)) << 4)) = seg[i]; }
    aC[0] = aN[0]; aC[1] = aN[1];
    pe_issue_segs(V4, idn, coff, seg); PE_ALOAD(tn, aN);
    pe_load_ids(EIDX, tnn, g, idn);
    asm volatile("s_waitcnt lgkmcnt(0)" ::: "memory");
    const v8i a = {(int)aC[0][0], (int)aC[0][1], (int)aC[0][2], (int)aC[0][3], (int)aC[1][0], (int)aC[1][1], (int)aC[1][2], (int)aC[1][3]};
    const int r0 = 32 * g4 + e16, r1 = r0 + 16;
    float yv[4];
#pragma unroll
    for (int q = 0; q < 4; ++q) yv[q] = 0.f;
#pragma unroll
    for (int cb = 0; cb < 16; ++cb) {
      const v2i b0 = __builtin_amdgcn_ds_read_tr4_b64_v2i32((LAS v2i*)(wlds + r0 * 128 + ((((cb >> 1) ^ (r0 & 7)) << 4) | ((cb & 1) << 3))));
      const v2i b1 = __builtin_amdgcn_ds_read_tr4_b64_v2i32((LAS v2i*)(wlds + r1 * 128 + ((((cb >> 1) ^ (r1 & 7)) << 4) | ((cb & 1) << 3))));
      const v8i b = {b0[0], b0[1], b1[0], b1[1], 0, 0, 0, 0};
      const f32x4 d = __builtin_amdgcn_mfma_scale_f32_16x16x128_f8f6f4(a, b, (f32x4){0.f, 0.f, 0.f, 0.f}, 0  , 4  , 0, 0x79797979  , 0, 0x7D7D7D7D  );
      if ((cb & 3) == 0) yv[cb >> 2] = d[0];
      else yv[cb >> 2] = ((cb & 3) == g4) ? d[0] : yv[cb >> 2];
    }
#pragma unroll
    for (int q = 0; q < 4; ++q) Y[(size_t)t * DM + s * SLICE_COLS + 16 * (4 * q + g4) + e16] = (bf16)(cvt_pk(yv[q], 0.f) & 0xffffu);
  }
#undef PE_ALOAD
}
__device__ __forceinline__ void v4c_relayout_item(const unsigned char* __restrict__ V4, unsigned char* __restrict__ V4C, int s, int eb, int lane) {
  const int e = 64 * eb + lane; const unsigned char* src = V4 + (size_t)s * (NEXP * 128) + (size_t)e * 128;
  u32x4 w[8];
#pragma unroll
  for (int q = 0; q < 8; ++q) w[q] = *reinterpret_cast<const u32x4*>(src + 16 * q);
#pragma unroll
  for (int q = 0; q < 8; ++q) {
    *reinterpret_cast<u32x2*>(V4C + (size_t)(16 * s + 2 * q) * (NEXP * 8) + (size_t)e * 8) = (u32x2){w[q][0], w[q][1]};
    *reinterpret_cast<u32x2*>(V4C + (size_t)(16 * s + 2 * q + 1) * (NEXP * 8) + (size_t)e * 8) = (u32x2){w[q][2], w[q][3]}; }
}
__device__ __forceinline__ void eidp_item(const int* __restrict__ EIDX, unsigned* __restrict__ EIDP, int t4, int lane) {
  const int i16 = lane & 15, g4 = lane >> 4; u32x4 w;
#pragma unroll
  for (int e = 0; e < 4; ++e) { const int* r = EIDX + (size_t)(4 * t4 + e) * 128 + 32 * g4 + i16; const unsigned ia = (unsigned)r[0], ib = (unsigned)r[16]; w[e] = (ia ^ ((ia >> 7) & 31u)) | ((ib ^ ((ib >> 7) & 31u)) << 16); }
  *reinterpret_cast<u32x4*>(EIDP + ((size_t)t4 * 64 + lane) * 4) = w;
}
__device__ __forceinline__ void peer_v_pass2(const unsigned char* __restrict__ A8, const unsigned char* __restrict__ V4C, const unsigned* __restrict__ EIDP, bf16* __restrict__ Y, char* lds, int c, int tbeg, int ntok, int wave, int lane) {
  { const int tid = wave * 64 + lane; const unsigned char* tb = V4C + (size_t)c * (NEXP * 8);
#pragma unroll
    for (int i = 0; i < 16; ++i) { const int r2 = i * 512 + tid; const u32x4 w = *reinterpret_cast<const u32x4*>(tb + r2 * 16); const int m = (r2 >> 6) & 31;
      *reinterpret_cast<u32x2*>(lds + ((2 * r2) ^ m) * 8) = (u32x2){w[0], w[1]}; *reinterpret_cast<u32x2*>(lds + ((2 * r2 + 1) ^ m) * 8) = (u32x2){w[2], w[3]}; } }
  __syncthreads();
  const int i16 = lane & 15, g4 = lane >> 4;
  const int nstep = ntok / (16 * 8);
  const unsigned char* abase = A8 + (size_t)i16 * 128 + 16 * g4;
  const unsigned* ibase = EIDP + (size_t)lane * 4;
  bf16* ybase = Y + (size_t)(4 * g4) * DM + 16 * c + i16;
#define PV_LOAD(AW, ID, step) do { const int t0_ = tbeg + 16 * (wave + 8 * ((step) < nstep ? (step) : nstep - 1)); \
    AW[0] = *reinterpret_cast<const u32x4*>(abase + (size_t)t0_ * 128); AW[1] = *reinterpret_cast<const u32x4*>(abase + (size_t)t0_ * 128 + 64); \
    _Pragma("unroll") for (int j = 0; j < 4; ++j) ID[j] = *reinterpret_cast<const u32x4*>(ibase + ((size_t)(t0_ >> 2) + j) * 256); } while (0)
#define PV_READ(ID, j) do { _Pragma("unroll") for (int e = 0; e < 4; ++e) { const unsigned pk = ID[j][e]; \
      b0[j][e] = __builtin_amdgcn_ds_read_tr4_b64_v2i32((LAS v2i*)(lds + ((pk & 0xffffu) << 3))); \
      b1[j][e] = __builtin_amdgcn_ds_read_tr4_b64_v2i32((LAS v2i*)(lds + ((pk >> 16) << 3))); } __builtin_amdgcn_sched_barrier(0); } while (0)
#define PV_MMA(j) do { f32x4 d[4]; _Pragma("unroll") for (int e = 0; e < 4; ++e) { const v8i b = {b0[j][e][0], b0[j][e][1], b1[j][e][0], b1[j][e][1], 0, 0, 0, 0}; \
      d[e] = __builtin_amdgcn_mfma_scale_f32_16x16x128_f8f6f4(a, b, (f32x4){0.f, 0.f, 0.f, 0.f}, 0  , 4  , 0, 0x79797979  , 0, 0x7D7D7D7D  ); } \
    _Pragma("unroll") for (int e = 0; e < 4; ++e) y[e] = (g4 == j) ? d[e][e] : y[e]; __builtin_amdgcn_sched_barrier(0); } while (0)
#define PV_COMPUTE(AW, ID, step) do { const int t0_ = tbeg + 16 * (wave + 8 * (step)); \
    const v8i a = {(int)AW[0][0], (int)AW[0][1], (int)AW[0][2], (int)AW[0][3], (int)AW[1][0], (int)AW[1][1], (int)AW[1][2], (int)AW[1][3]}; \
    float y[4] = {0.f, 0.f, 0.f, 0.f}; v2i b0[4][4], b1[4][4]; \
    PV_READ(ID, 0); PV_READ(ID, 1); PV_MMA(0); PV_READ(ID, 2); PV_MMA(1); PV_READ(ID, 3); PV_MMA(2); PV_MMA(3); \
    _Pragma("unroll") for (int e = 0; e < 4; ++e) { const __bf16 yh = (__bf16)y[e]; ybase[(size_t)(t0_ + e) * DM] = __builtin_bit_cast(unsigned short, yh); } } while (0)
  u32x4 A0[2], A1[2], A2[2], A3[2], I0[4], I1[4], I2[4], I3[4];
  PV_LOAD(A0, I0, 0); PV_LOAD(A1, I1, 1); PV_LOAD(A2, I2, 2);
#pragma unroll 1
  for (int k = 0; k < nstep; k += 4) {
    PV_LOAD(A3, I3, k + 3); PV_COMPUTE(A0, I0, k);
    PV_LOAD(A0, I0, k + 4); PV_COMPUTE(A1, I1, k + 1);
    PV_LOAD(A1, I1, k + 5); PV_COMPUTE(A2, I2, k + 2);
    PV_LOAD(A2, I2, k + 6); PV_COMPUTE(A3, I3, k + 3);
  }
#undef PV_LOAD
#undef PV_COMPUTE
#undef PV_READ
#undef PV_MMA
  __syncthreads();
}
__device__ __forceinline__ void ln2_phase(const bf16* __restrict__ X1, const bf16* __restrict__ Y, const float* __restrict__ g, const float* __restrict__ bta, float* __restrict__ O, int gw, int ngw, int lane) {
  f32x4 gv[8], bv[8];
#pragma unroll
  for (int j = 0; j < 4; ++j) { const int e0 = 512 * j + 8 * lane;
    gv[2 * j] = *reinterpret_cast<const f32x4*>(g + e0); gv[2 * j + 1] = *reinterpret_cast<const f32x4*>(g + e0 + 4);
    bv[2 * j] = *reinterpret_cast<const f32x4*>(bta + e0); bv[2 * j + 1] = *reinterpret_cast<const f32x4*>(bta + e0 + 4); }
  u32x4 na[4], nb[4];
  if (gw < NTOK) {
#pragma unroll
    for (int j = 0; j < 4; ++j) { na[j] = *reinterpret_cast<const u32x4*>(X1 + (size_t)gw * DM + 512 * j + 8 * lane); nb[j] = *reinterpret_cast<const u32x4*>(Y + (size_t)gw * DM + 512 * j + 8 * lane); } }
  for (int m = gw; m < NTOK; m += ngw) {
    float v[32]; float s = 0.f;
#pragma unroll
    for (int j = 0; j < 4; ++j) {
#pragma unroll
      for (int q = 0; q < 4; ++q) { v[8 * j + 2 * q] = fmaf(ALPHA, bf_lo(na[j][q]), bf_lo(nb[j][q])); v[8 * j + 2 * q + 1] = fmaf(ALPHA, bf_hi(na[j][q]), bf_hi(nb[j][q])); } }
    if (m + ngw < NTOK) {
#pragma unroll
      for (int j = 0; j < 4; ++j) { na[j] = *reinterpret_cast<const u32x4*>(X1 + (size_t)(m + ngw) * DM + 512 * j + 8 * lane); nb[j] = *reinterpret_cast<const u32x4*>(Y + (size_t)(m + ngw) * DM + 512 * j + 8 * lane); } }
#pragma unroll
    for (int i = 0; i < 32; ++i) s += v[i];
    const float mean = wave_sum(s) * (1.f / DM); float s2 = 0.f;
#pragma unroll
    for (int i = 0; i < 32; ++i) { v[i] -= mean; s2 = fmaf(v[i], v[i], s2); }
    const float rstd = 1.0f / sqrtf(wave_sum(s2) * (1.f / DM) + LN_EPS);
    float* orow = O + (size_t)m * DM;
#pragma unroll
    for (int j = 0; j < 4; ++j) { const int e0 = 512 * j + 8 * lane;
      f32x4 o0, o1;
#pragma unroll
      for (int e = 0; e < 4; ++e) { o0[e] = v[8 * j + e] * rstd * gv[2 * j][e] + bv[2 * j][e]; o1[e] = v[8 * j + 4 + e] * rstd * gv[2 * j + 1][e] + bv[2 * j + 1][e]; }
      *reinterpret_cast<f32x4*>(orow + e0) = o0; *reinterpret_cast<f32x4*>(orow + e0 + 4) = o1; }
  }
}
__device__ __forceinline__ void cvt_stream_fp4(const float* __restrict__ src, unsigned char* __restrict__ dst, size_t n32, float scale, size_t gtid, size_t gsz) {
  for (size_t i0 = gtid; i0 < n32; i0 += 2 * gsz) {
    f32x4 a[2][8];
#pragma unroll
    for (int h = 0; h < 2; ++h) { const size_t i = i0 + h * gsz; if (i < n32) {
#pragma unroll
      for (int q = 0; q < 8; ++q) a[h][q] = *reinterpret_cast<const f32x4*>(src + i * 32 + 4 * q); } }
#pragma unroll
    for (int h = 0; h < 2; ++h) { const size_t i = i0 + h * gsz; if (i < n32) {
      u32x4 w;
#pragma unroll
      for (int q = 0; q < 4; ++q) { const f32x4 x = a[h][2 * q] * scale, y = a[h][2 * q + 1] * scale;
        unsigned p = __builtin_amdgcn_cvt_scalef32_pk_fp4_f32(0u, x[0], x[1], 1.0f, 0); p = __builtin_amdgcn_cvt_scalef32_pk_fp4_f32(p, x[2], x[3], 1.0f, 1);
        p = __builtin_amdgcn_cvt_scalef32_pk_fp4_f32(p, y[0], y[1], 1.0f, 2); p = __builtin_amdgcn_cvt_scalef32_pk_fp4_f32(p, y[2], y[3], 1.0f, 3); w[q] = p; }
      const size_t e = i >> 6, c16 = i & 63;
      *reinterpret_cast<u32x4*>(dst + (c16 >> 3) * ((size_t)NEXP * 128) + e * 128 + (c16 & 7) * 16) = w; } }
  }
}
__device__ __forceinline__ void peer_tables_share(const float* __restrict__ u, const float* __restrict__ v, unsigned char* __restrict__ U4, unsigned char* __restrict__ V4, int bx, int G) {
  int t = my_tid(); asm volatile("" : "+v"(t));
  const size_t gtid = (size_t)bx * 512 + t, gsz = (size_t)G * 512;
  cvt_stream_fp4(u, U4, (size_t)NEXP * DM / 32, U_SCALE, gtid, gsz);
  cvt_stream_fp4(v, V4, (size_t)NEXP * DM / 32, V_SCALE, gtid, gsz);
}
constexpr int TBL_NCH = 256;
__device__ __forceinline__ void peer_tables_chunk(const float* __restrict__ u, const float* __restrict__ v, unsigned char* __restrict__ U4, unsigned char* __restrict__ V4, int c) {
  int t = my_tid(); asm volatile("" : "+v"(t));
  const bool isv = c >= TBL_NCH; const int cc = isv ? c - TBL_NCH : c;
  const size_t gtid = (size_t)cc * 512 + t, gsz = (size_t)TBL_NCH * 512;
  cvt_stream_fp4(isv ? v : u, isv ? V4 : U4, (size_t)NEXP * DM / 32, isv ? V_SCALE : U_SCALE, gtid, gsz);
}

#define XB_TMO      128
#define XB_XCNT(j)  (256  + 64 * (j))
#define XB_XSUB(j)  (1280 + 64 * (j))
#define XB_XGEN(j)  (2304 + 64 * (j))
#define XB_TOP      3328
#define XB_TOPGEN   3392
#define XCD_BAR_WORDS 3456
#define XQ_TBL      3584
#define XB_SPIN_CAP (1u << 18)

__device__ __forceinline__ unsigned xb_ld(unsigned* p)              { return __hip_atomic_load(p, __ATOMIC_RELAXED, __HIP_MEMORY_SCOPE_AGENT); }
__device__ __forceinline__ unsigned xb_add(unsigned* p, unsigned v) { return __hip_atomic_fetch_add(p, v, __ATOMIC_RELAXED, __HIP_MEMORY_SCOPE_AGENT); }
__device__ __forceinline__ unsigned xb_xcc_id() { return (unsigned)__builtin_amdgcn_s_getreg((3 << 11) | 20) & 0xFu; }
#define XB_SPIN(cond, bar) do { unsigned _sp = 0; while (cond) { __builtin_amdgcn_s_sleep(1); \
    if ((++_sp & 255u) == 0u) { if (xb_ld(&(bar)[XB_TMO])) break; if (_sp > XB_SPIN_CAP) { atomicAdd(&(bar)[XB_TMO], 1u); break; } } } } while (0)

struct XcdBarrier {
    unsigned* bar; unsigned x;
    volatile LAS unsigned* st;
};

__device__ __forceinline__ XcdBarrier xcd_barrier_post(unsigned* bar, volatile LAS unsigned* st) {
    XcdBarrier b; b.bar = bar; b.x = xb_xcc_id(); b.st = st;
    if (threadIdx.x == 0) (void)xb_add(&bar[XB_XCNT(b.x)], 1u);
    return b;
}
__device__ __forceinline__ void xcd_barrier_complete(unsigned* bar, unsigned x, unsigned& nloc, unsigned& nx) {
    const unsigned G = gridDim.x * gridDim.y * gridDim.z;
    unsigned sum, cnt, mine, sp = 0u;
    for (;;) {
        sum = 0u; cnt = 0u; mine = 0u;
#pragma unroll
        for (unsigned j = 0; j < 16; ++j) { const unsigned c = xb_ld(&bar[XB_XCNT(j)]); sum += c; cnt += (c > 0u) ? 1u : 0u; mine = (j == x) ? c : mine; }
        if (sum == G) break;
        __builtin_amdgcn_s_sleep(1);
        if ((++sp & 255u) == 0u) { if (xb_ld(&bar[XB_TMO])) break; if (sp > XB_SPIN_CAP) { atomicAdd(&bar[XB_TMO], 1u); break; } }
    }
    nloc = mine > 0u ? mine : 1u; nx = cnt > 0u ? cnt : 1u;
}

__device__ __forceinline__ void xcd_barrier(const XcdBarrier& b) {
    asm volatile("s_waitcnt vmcnt(0)" ::: "memory");
    __syncthreads();
    if (my_tid() == 0) {
        unsigned* bar = b.bar;
        __builtin_amdgcn_s_waitcnt(0);
        unsigned nloc = b.st[0], nx = b.st[1];
        if (nloc == 0u) { xcd_barrier_complete(bar, b.x, nloc, nx); b.st[0] = nloc; b.st[1] = nx; }
        const unsigned old = xb_add(&bar[XB_XSUB(b.x)], 1u);
        const unsigned gen = old / nloc;
        if (old + 1u == (gen + 1u) * nloc) {
            __builtin_amdgcn_fence(__ATOMIC_RELEASE, "agent");
            asm volatile("s_waitcnt vmcnt(0)" ::: "memory");
            const unsigned og = xb_add(&bar[XB_TOP], 1u);
            const unsigned tg = og / nx;
            if (og + 1u == (tg + 1u) * nx) xb_add(&bar[XB_TOPGEN], 1u);
            else XB_SPIN(xb_ld(&bar[XB_TOPGEN]) == tg, bar);
            __builtin_amdgcn_fence(__ATOMIC_ACQUIRE, "agent");
            asm volatile("s_waitcnt vmcnt(0)" ::: "memory");
        } else {
            XB_SPIN(xb_ld(&bar[XB_TOPGEN]) == gen, bar);
            __builtin_amdgcn_fence(__ATOMIC_ACQUIRE, "agent");
            asm volatile("s_waitcnt vmcnt(0)" ::: "memory");
        }
    }
    __syncthreads();
}


__device__ __forceinline__ void flat_barrier(unsigned* bar) {
    asm volatile("s_waitcnt vmcnt(0)" ::: "memory");
    __syncthreads();
    if (threadIdx.x == 0) {
        const unsigned G = gridDim.x;
        __builtin_amdgcn_fence(__ATOMIC_RELEASE, "agent");
        asm volatile("s_waitcnt vmcnt(0)" ::: "memory");
        const unsigned old = xb_add(&bar[XB_TOP], 1u);
        const unsigned target = (old / G + 1u) * G;
        XB_SPIN(xb_ld(&bar[XB_TOP]) < target, bar);
        __builtin_amdgcn_fence(__ATOMIC_ACQUIRE, "agent");
        asm volatile("s_waitcnt vmcnt(0)" ::: "memory");
    }
    __syncthreads();
}
struct Args {
  const float* in[17];
  float* out; unsigned char* ws; int ph_lo, ph_hi;
};
constexpr int N_PHASES = 12;

__global__ void __launch_bounds__(512, 2) mega_fwd(Args args) {
  extern __shared__ __attribute__((aligned(16))) unsigned char lds_raw[];
  LAS unsigned char* ldsl = (LAS unsigned char*)lds_raw;
  char* lds = (char*)lds_raw;
  { const int t0_ = threadIdx.x; if ((t0_ & 63) == 0) ((volatile unsigned char*)lds_raw)[HWTAB_OFF + hw_slot()] = (unsigned char)(t0_ >> 6); }
  __syncthreads();
  const int wave = my_wave();
#define lane (my_lane())
#define tid (wave * 64 + my_lane())
  const int G = gridDim.x, bx = blockIdx.x;
  unsigned char* ws = args.ws;
  const float* x = args.in[0];
  bf16* XB = (bf16*)(ws + WS_XB); unsigned char* ATT = ws + WS_X1F8; bf16* PQ = XB;
  bf16* PROJ = (bf16*)(ws + WS_PROJ); bf16* ZB = (bf16*)(ws + WS_PROJ); bf16* YB = (bf16*)(ws + WS_PROJ + 128 * MiB);
  int* EIDX = (int*)(ws + WS_EIDX); float* EG = (float*)(ws + WS_EG);
  bf16* X1B = (bf16*)(ws + WS_X1B); unsigned char* U8 = ws + WS_U8; unsigned char* V8 = ws + WS_V8; unsigned char* V4C = ws + WS_V4C; unsigned char* XB8 = ws + WS_X1F8; unsigned char* WIN8 = ws + WS_WIN; constexpr int N_F8 = C_SK;     unsigned* EIDP = (unsigned*)(ws + WS_EIDP);
  unsigned char* A8 = ws + WS_A8; unsigned* ctl = (unsigned*)(ws + WS_CTL); unsigned char* X1F8 = ws + WS_X1F8;
  bf16* WIN = (bf16*)(ws + WS_WIN); unsigned char* WO = ws + WS_WO; bf16* WQ = (bf16*)(ws + WS_WQ);
  const int lo = args.ph_lo, hi_ph = args.ph_hi;
#if MK_ONE_LAUNCH
  volatile LAS unsigned* misc = (volatile LAS unsigned*)(ldsl + LDS_BYTES - 64);
  XcdBarrier xbar; xbar.bar = ctl; xbar.x = xb_xcc_id(); xbar.st = misc + 2;
  if (tid == 0) { misc[2] = 0u; misc[3] = 0u; misc[0] = xb_add(&ctl[XB_XCNT(xbar.x)], 1u); }
  __syncthreads();
  const int my_xcc = (int)xbar.x, my_rank = __builtin_amdgcn_readfirstlane((int)misc[0]);
#endif
#if MK_ONE_LAUNCH
#define GRID_SYNC() xcd_barrier(xbar)
#else
#define GRID_SYNC() do {} while (0)
#endif
#ifndef PH_MASK
#define PH_MASK 0xfff
#endif
#ifndef REP_MASK
#define REP_MASK 0
#endif
#define IN(k) (((PH_MASK >> (k)) & 1) && lo <= (k) && (k) < hi_ph)
#define REP(k)
#define SEAM(k) do { if (IN(k) && IN((k) + 1)) GRID_SYNC(); } while (0)

  REP(0) if (IN(0)) {
    const size_t gtid = (size_t)bx * 512 + tid, gsz = (size_t)G * 512;
    cvt_stream2(x, XB, XB8, (size_t)NTOK * DM / 8, gtid, gsz);
    LAS float* scr = (LAS float*)(ldsl + wave * 8704);
    const int gw = bx * 8 + wave, NGW = G * 8;
    constexpr int I_IN = (DM / 64) * (LDP / 32), I_SQ = (DM / 64) * (DM / 32);
    for (int it = gw; it < I_IN + 2 * I_SQ; it += NGW) {
      if (it < I_IN) { const int kb = it / (LDP / 32), nb = it % (LDP / 32);
        if (nb < N_F8 / 32) transpose_item_fp8(args.in[1], DM, NPROJ, WIN8, scr, kb, nb, lane, 64.f);
        else transpose_item(args.in[1], DM, NPROJ, WIN, scr, kb, nb, lane); }
      else if (it < I_IN + I_SQ) { const int r = it - I_IN; transpose_item_fp8(args.in[2], DM, DM, WO, scr, r / (DM / 32), r % (DM / 32), lane, 64.f); }
      else { const int r = it - I_IN - I_SQ; transpose_item(args.in[10], DM, DM, WQ, scr, r / (DM / 32), r % (DM / 32), lane); }
    }
    __syncthreads();
  }
  SEAM(0);
  int vx = bx & 7, vrank = bx >> 3; const int nloc = G >> 3;
#if MK_ONE_LAUNCH
  {
    int npop = 0, before = 0; bool regular = true;
#pragma unroll
    for (int q = 0; q < 16; ++q) { const int cq = (int)__hip_atomic_load(ctl + XB_XCNT(q), __ATOMIC_RELAXED, __HIP_MEMORY_SCOPE_AGENT); if (cq > 0) { ++npop; if (q < my_xcc) ++before; if (cq != nloc) regular = false; } }
    if (regular && npop == 8 && (G & 7) == 0) { vx = before; vrank = my_rank; }
  }
#endif
  const int vcu = vrank * 8 + vx;
  REP(1) if (IN(1)) {
    { pg8::Gemm g{(const pg8::bf16_t*)XB8, (const pg8::bf16_t*)WIN8, NTOK, N_F8, DM}; pg8::StaticOrder S; S.init(NTOK, N_F8, G, vcu);
      pg8::EpiBf16<0> E{PROJ, LDP, nullptr, N_F8, 0, 1.0f / 64.0f};
      pg8::gemm_phase<pg8::EpiBf16<0>, pg8::StaticOrder, true, true, true, 0x7F7F7F7F>(ldsl, g, S, E); }
    __syncthreads();
    { pg8::Gemm g{XB, WIN + (size_t)N_F8 * DM, NTOK, LDP - N_F8, DM}; pg8::StaticOrder S; S.init(NTOK, LDP - N_F8, G, vcu);
      pg8::EpiBf16<0> E{PROJ + N_F8, LDP, nullptr, 0, 0, 1.f};
      pg8::gemm_phase<pg8::EpiBf16<0>, pg8::StaticOrder, true, true>(ldsl, g, S, E); }
    __syncthreads();
  }
  SEAM(1);
  REP(2) if (IN(2)) {
    float lam;
    { const float a = args.in[3][lane] * args.in[4][lane], b = args.in[5][lane] * args.in[6][lane];
      lam = __expf(wave_sum(a)) - __expf(wave_sum(b)) + LAM_INIT; }
    for (int rnd = 0; rnd * G < 1024; ++rnd) {
      const int i = rnd * G + ((rnd & 1) ? (G - 1 - bx) : bx);
      if (i < 1024) { const int qb = 63 - (i >> 4), b = i & 15; att::attn_unit<1>(PROJ, ATT, b, 0, qb, lds, lam, args.in[7]); }
    }
  }
  REP(3) if (IN(3)) {
    float lam;
    { const float a = args.in[3][lane] * args.in[4][lane], b = args.in[5][lane] * args.in[6][lane];
      lam = __expf(wave_sum(a)) - __expf(wave_sum(b)) + LAM_INIT; }
    for (int rnd = 0; rnd * G < 2048; ++rnd) {
      const int j = rnd * G + ((rnd & 1) ? (G - 1 - bx) : bx);
      if (j < 2048) { const int qb = 15 - (j >> 7), bh = j & 127; att::attn_unit<0>(PROJ, ATT, bh >> 3, (bh + rnd) & 7, qb, lds, lam, args.in[7]); }
    }
    { volatile LAS unsigned* qw = (volatile LAS unsigned*)(ldsl + LDS_BYTES - 64) + 4;
      for (;;) {
        __syncthreads();
        if (my_tid() == 0) { unsigned* qp = ctl + XQ_TBL; asm volatile("" : "+s"(qp)); qw[0] = xb_add(qp, 1u); }
        __syncthreads();
        const int c = __builtin_amdgcn_readfirstlane((int)qw[0]);
        if (c >= 2 * TBL_NCH) break;
        peer_tables_chunk(args.in[13], args.in[14], U8, V8, c);
      } }
  }
  SEAM(3);
  REP(4) if (IN(4)) {
    pg8::Gemm g{(const pg8::bf16_t*)ATT, (const pg8::bf16_t*)WO, NTOK, DM, DM}; pg8::StaticOrder S; S.init(NTOK, DM, G, vcu);
    pg8::EpiResid E{(const pg8::bf16_t*)XB, ZB, DM, ALPHA, 1.0f / 64.0f};
    pg8::gemm_phase<pg8::EpiResid, pg8::StaticOrder, true, true, true, 0x7F7F7F7F>(ldsl, g, S, E);
    __syncthreads();
  }
  SEAM(4);
  REP(5) if (IN(5)) {
    const int gw = bx * 8 + wave, NGW = G * 8;
    ln1_phase(ZB, args.in[8], args.in[9], X1B, X1F8, gw, NGW, lane);
  }
  SEAM(5);
  REP(6) if (IN(6)) {
    pg8::Gemm g{X1B, WQ, NTOK, DM, DM}; pg8::StaticOrder S; S.init(NTOK, DM, G, vcu);
    pg8::EpiBf16<0> E{PQ, DM, nullptr, 0, 0, 1.f};
    pg8::gemm_phase<pg8::EpiBf16<0>, pg8::StaticOrder, true, true>(ldsl, g, S, E);
    __syncthreads();
  }
  SEAM(6);
  REP(7) if (IN(7)) {
    peer::load_keys(args.in[11], args.in[12], lds);
    __syncthreads();
    for (int u = bx; u < NTOK / 32; u += G) peer::score_unit(PQ, EIDX, EG, u * 32, lds);
    __syncthreads();
  }
  SEAM(7);
  float* HPA = (float*)(ws + WS_HPA);
  REP(8) if (IN(8)) {
    const int wv = vrank * 8 + wave, nwv = nloc * 8;
    peer_u_pass(X1F8, U8, EIDX, HPA + (size_t)vx * NTOK * 128, lds + wave * 16384, wv, nwv, NTOK / nwv, vx, lane);
  }
  SEAM(8);
  REP(9) if (IN(9)) {
    const size_t gtid = (size_t)bx * 512 + tid, gsz = (size_t)G * 512;
    for (size_t i = gtid; i < (size_t)NTOK * 32; i += gsz) {
      f32x4 h = *reinterpret_cast<const f32x4*>(HPA + i * 4);
#pragma unroll
      for (int sl = 1; sl < NSLICE; ++sl) h += *reinterpret_cast<const f32x4*>(HPA + (size_t)sl * NTOK * 128 + i * 4);
      const f32x4 gg = *reinterpret_cast<const f32x4*>(EG + i * 4); float a[4];
#pragma unroll
      for (int e = 0; e < 4; ++e) { const float hv = h[e] * (1.0f / U_SCALE); a[e] = 0.5f * hv * (1.0f + erff(hv * 0.70710678118654752f)) * gg[e] * 64.0f; }
      int p = __builtin_amdgcn_cvt_pk_fp8_f32(a[0], a[1], 0, false); p = __builtin_amdgcn_cvt_pk_fp8_f32(a[2], a[3], p, true);
      *reinterpret_cast<int*>(A8 + i * 4) = p;
    }
    for (int it = bx * 8 + wave; it < NTOK / 4; it += G * 8) eidp_item(EIDX, EIDP, it, lane);
    for (int it = bx * 8 + wave; it < 8 * (NEXP / 64); it += G * 8) v4c_relayout_item(V8, V4C, it / (NEXP / 64), it % (NEXP / 64), lane);
  }
  SEAM(9);
  REP(10) if (IN(10)) {
    for (int u = ((G & 7) == 0) ? vx * nloc + vrank : bx; u < 256; u += G) peer_v_pass2(A8, V4C, EIDP, YB, lds, u >> 1, (u & 1) * (NTOK / 2), NTOK / 2, wave, lane);
  }
  SEAM(10);
  REP(11) if (IN(11)) {
    const int gw = bx * 8 + wave, NGW = G * 8;
    ln2_phase(X1B, YB, args.in[15], args.in[16], args.out, gw, NGW, lane);
  }
#undef IN
#undef SEAM
#undef lane
#undef tid
}

#ifndef REP_MASK
#define REP_MASK 0
#endif
extern "C" void kernel_launch(void* const* d_in, const int* in_sizes, int n_in, void* d_out, int out_size, void* d_ws, size_t ws_size, hipStream_t stream) {
  static int grid = 0;
  if (grid == 0) {
    if (n_in != 17 || in_sizes[0] != NTOK * DM || out_size != NTOK * DM || ws_size < WS_END) {
      fprintf(stderr, "kernel_launch: unexpected shapes: n_in %d in0 %d out %d ws %zu (need >= %zu)\n", n_in, n_in > 0 ? in_sizes[0] : -1, out_size, ws_size, (size_t)WS_END); grid = -1; return; }
    int dev = 0, cus = 0, per_cu = 0;
    if (hipGetDevice(&dev) != hipSuccess || hipDeviceGetAttribute(&cus, hipDeviceAttributeMultiprocessorCount, dev) != hipSuccess) { grid = -1; return; }
    if (hipFuncSetAttribute((const void*)mega_fwd, hipFuncAttributeMaxDynamicSharedMemorySize, LDS_BYTES) != hipSuccess) { fprintf(stderr, "kernel_launch: hipFuncSetAttribute failed\n"); grid = -1; return; }
    if (hipOccupancyMaxActiveBlocksPerMultiprocessor(&per_cu, (const void*)mega_fwd, 512, LDS_BYTES) != hipSuccess || per_cu < 1) { fprintf(stderr, "kernel_launch: occupancy query says %d\n", per_cu); per_cu = 1; }
    (void)hipGetLastError();
    grid = cus * (per_cu > 1 ? 1 : per_cu);
  }
  if (grid < 0) return;
  Args a{};
  for (int i = 0; i < 17; ++i) a.in[i] = (const float*)d_in[i];
  a.out = (float*)d_out; a.ws = (unsigned char*)d_ws;
  if (hipMemsetAsync((char*)d_ws + WS_CTL, 0, 16384, stream) != hipSuccess) { fprintf(stderr, "kernel_launch: memset failed\n"); return; }
#if MK_ONE_LAUNCH
  a.ph_lo = 0; a.ph_hi = N_PHASES;
  void* kargs[] = {&a};
  hipError_t e = hipLaunchCooperativeKernel((const void*)mega_fwd, dim3(grid), dim3(512), kargs, LDS_BYTES, stream);
  if (e != hipSuccess) fprintf(stderr, "kernel_launch: cooperative launch failed: %s (grid %d)\n", hipGetErrorString(e), grid);
#else
  for (int p = 0; p < N_PHASES; ++p) {
    a.ph_lo = p; a.ph_hi = p + 1;
    for (int rep = 0; rep < (((REP_MASK >> p) & 1) ? 2 : 1); ++rep)
      hipLaunchKernelGGL(mega_fwd, dim3(grid), dim3(512), LDS_BYTES, stream, a);
  }
  const hipError_t le = hipPeekAtLastError();
  if (le != hipSuccess) fprintf(stderr, "kernel_launch: launch failed: %s\n", hipGetErrorName(le));
#endif
}
```
